# Optimizing an MI355X kernel written in HIP

```python
import jax, jax.numpy as jnp
from jax import lax
import numpy as np

D_MODEL = 2048
BATCH = 4
SEQ = 4096
DEPTH = 4

GRID_W = 64
CTX_LEN = 256
N_MIXERS = 2
N_ATTN_LAYERS = (DEPTH + N_MIXERS - 1) // N_MIXERS
N_RWKV_LAYERS = DEPTH // N_MIXERS
N_SUBLAYERS = 3
NORM_EPS = 1e-6
ATTN_HEAD_DIM = 128
ATTN_HEADS = D_MODEL // ATTN_HEAD_DIM
ATTN_KV_HEADS = ATTN_HEADS // 4
ATTN_GROUP = ATTN_HEADS // ATTN_KV_HEADS
Q_BLOCK = 128
ROPE_THETA = 10000.0
ROPE_AXIS_DIM = ATTN_HEAD_DIM // 2
RWKV_HEAD_DIM = 64
RWKV_HEADS = D_MODEL // RWKV_HEAD_DIM
DECAY_LORA = 96
ICL_LORA = 96
GATE_LORA = 256
LNX_EPS = 64e-5
D_FF = 5632

kernel_name = 'hybrid_gqa_rwkv7_macaron_dit'


def _rms(x, g):
    xf = x.astype(jnp.float32)
    y = xf * lax.rsqrt(jnp.mean(xf * xf, axis=-1, keepdims=True) + NORM_EPS)
    return y.astype(x.dtype) * g


def _modulate(x, g, shift, scale):
    return _rms(x, g) * (1 + scale) + shift


def _residual(x, out, g, gate, weight):
    return x + weight * gate * _rms(out, g)


def _swiglu(y, w_in, w_out):
    h = y @ w_in
    gate, up = h[..., :D_FF], h[..., D_FF:]
    return (jax.nn.silu(gate) * up) @ w_out


def _ffn_half(x, g_pre, g_post, mod, w_in, w_out):
    shift, scale, gate = mod
    return _residual(x, _swiglu(_modulate(x, g_pre, shift, scale), w_in, w_out), g_post, gate, 0.5)


def _axial_rope_tables(n_tokens):
    rows = n_tokens // GRID_W
    row = jnp.repeat(jnp.arange(rows, dtype=jnp.float32), GRID_W)
    col = jnp.tile(jnp.arange(GRID_W, dtype=jnp.float32), rows)
    n_freq = ROPE_AXIS_DIM // 2
    inv = ROPE_THETA ** (-jnp.arange(n_freq, dtype=jnp.float32) / n_freq)
    ang = jnp.concatenate([row[:, None] * inv, col[:, None] * inv], axis=-1)
    return jnp.cos(ang), jnp.sin(ang)


def _rope(x, cos, sin):
    shp = (cos.shape[0],) + (1,) * (x.ndim - 3) + (cos.shape[1],)
    cos = cos.reshape(shp)
    sin = sin.reshape(shp)
    xf = x.astype(jnp.float32).reshape(x.shape[:-1] + (-1, 2))
    x1, x2 = xf[..., 0], xf[..., 1]
    out = jnp.stack([x1 * cos - x2 * sin, x1 * sin + x2 * cos], axis=-1)
    return out.reshape(x.shape).astype(x.dtype)


def _attend(q, k, v):
    s = jnp.einsum('bqkgd,btkd->bkgqt', q, k).astype(jnp.float32) * (ATTN_HEAD_DIM ** -0.5)
    p = jax.nn.softmax(s, axis=-1).astype(v.dtype)
    return jnp.einsum('bkgqt,btkd->bqkgd', p, v)


def _attention_mixer(y_lat, y_ctx, w_qkv, w_o, q_gain, k_gain, cos, sin, ctx_out):
    B, S, _ = y_lat.shape
    L = y_ctx.shape[1]
    q_cols = ATTN_HEADS * ATTN_HEAD_DIM
    qkv_l = y_lat @ w_qkv
    q_l = _rope(_rms(qkv_l[..., :q_cols].reshape(B, S, ATTN_KV_HEADS, ATTN_GROUP, ATTN_HEAD_DIM), q_gain), cos, sin)
    kv_l = qkv_l[..., q_cols:].reshape(B, S, 2, ATTN_KV_HEADS, ATTN_HEAD_DIM)
    k_l = _rope(_rms(kv_l[:, :, 0], k_gain), cos, sin)
    v_l = kv_l[:, :, 1]
    kv_c = (y_ctx @ w_qkv[:, q_cols:]).reshape(B, L, 2, ATTN_KV_HEADS, ATTN_HEAD_DIM)
    k_c = _rms(kv_c[:, :, 0], k_gain)
    v_c = kv_c[:, :, 1]
    k_all = jnp.concatenate([k_c, k_l], axis=1)
    v_all = jnp.concatenate([v_c, v_l], axis=1)
    n_blk = S // Q_BLOCK
    q_blocks = jnp.moveaxis(q_l.reshape(B, n_blk, Q_BLOCK, ATTN_KV_HEADS, ATTN_GROUP, ATTN_HEAD_DIM), 1, 0)
    o_l = lax.map(lambda qb: _attend(qb, k_all, v_all), q_blocks)
    o_l = jnp.moveaxis(o_l, 0, 1).reshape(B, S, D_MODEL) @ w_o
    o_c = None
    if ctx_out:
        q_c = _rms((y_ctx @ w_qkv[:, :q_cols]).reshape(B, L, ATTN_KV_HEADS, ATTN_GROUP, ATTN_HEAD_DIM), q_gain)
        o_c = _attend(q_c, k_c, v_c).reshape(B, L, D_MODEL) @ w_o
    return o_l, o_c


def _centred_shift(y):
    pad = jnp.pad(y, ((0, 0), (1, 1), (0, 0)))
    return 0.5 * (pad[:, :-2] + pad[:, 2:])


def _heads(x):
    return x.reshape(x.shape[:2] + (RWKV_HEADS, RWKV_HEAD_DIM))


def _l2n(x):
    xf = x.astype(jnp.float32)
    return xf * lax.rsqrt(jnp.sum(xf * xf, axis=-1, keepdims=True) + 1e-12)


def _rwkv_prep(y, mu, w_rkv, g1, g2, dec_w0, dec_w1, dec_w2, icl_a0, icl_a1, icl_a2, k_k, k_a, with_out):
    xx = _centred_shift(y) - y
    mix = lambda j: y + xx * mu[j]
    xw, xk, xv, xa = mix(1), mix(2), mix(3), mix(4)
    k = xk @ w_rkv[1]
    v = _heads(xv @ w_rkv[2]).astype(jnp.float32)
    kk = _l2n(_heads(k * k_k))
    dirs = []
    for d in range(2):
        w_pre = (dec_w0[d] + jnp.tanh(xw @ dec_w1[d]) @ dec_w2[d]).astype(jnp.float32)
        decay = jnp.exp(-jnp.exp(-jax.nn.softplus(-w_pre) - 0.5))
        a = jax.nn.sigmoid(icl_a0[d] + (xa @ icl_a1[d]) @ icl_a2[d])
        k_d = _heads(k * (1 + (a - 1) * k_a)).astype(jnp.float32)
        dirs.append((_heads(decay), k_d, kk * _heads(a).astype(jnp.float32)))
    r = g = None
    if with_out:
        r = _heads(mix(0) @ w_rkv[0]).astype(jnp.float32)
        g = jax.nn.sigmoid(mix(5) @ g1) @ g2
    return r, g, v, kk, dirs


def _wkv_scan(S0, w, k, v, kk, b, r, reverse):
    xs = tuple(jnp.moveaxis(t, 1, 0) for t in (w, k, v, kk, b))
    if r is not None:
        xs = xs + (jnp.moveaxis(r, 1, 0),)

    def step(S, inp):
        w_t, k_t, v_t, kk_t, b_t = inp[:5]
        s_kk = jnp.einsum('bhvk,bhk->bhv', S, kk_t)
        S = S * w_t[:, :, None, :] - s_kk[..., None] * b_t[:, :, None, :] + v_t[..., None] * k_t[:, :, None, :]
        y = jnp.einsum('bhvk,bhk->bhv', S, inp[5]) if r is not None else None
        return S, y

    S, ys = lax.scan(step, S0, xs, reverse=reverse)
    return S, (None if r is None else jnp.moveaxis(ys, 0, 1))


def _rwkv_out(o, r, v, k_sum, g, r_k, lnx_w, lnx_b, w_o, dtype):
    B, T = o.shape[:2]
    mean = jnp.mean(o, axis=-1, keepdims=True)
    var = jnp.mean(jnp.square(o - mean), axis=-1, keepdims=True)
    o = (o - mean) * lax.rsqrt(var + LNX_EPS)
    o = o * lnx_w.reshape(RWKV_HEADS, RWKV_HEAD_DIM) + lnx_b.reshape(RWKV_HEADS, RWKV_HEAD_DIM)
    o = o + jnp.sum(r * k_sum * r_k, axis=-1, keepdims=True) * v
    return (o.reshape(B, T, D_MODEL).astype(dtype) * g) @ w_o


def _rwkv_mixer(y_lat, y_ctx, mu, w_rkv, w_o, g1, g2, dec_w0, dec_w1, dec_w2, icl_a0, icl_a1, icl_a2,
                k_k, k_a, r_k, lnx_w, lnx_b, ctx_out):
    args = (mu, w_rkv, g1, g2, dec_w0, dec_w1, dec_w2, icl_a0, icl_a1, icl_a2, k_k, k_a)
    r_l, g_l, v_l, kk_l, dirs_l = _rwkv_prep(y_lat, *args, True)
    r_c, g_c, v_c, kk_c, dirs_c = _rwkv_prep(y_ctx, *args, ctx_out)
    B = y_lat.shape[0]
    S0 = jnp.zeros((B, RWKV_HEADS, RWKV_HEAD_DIM, RWKV_HEAD_DIM), jnp.float32)
    ys_l, ys_c = [], []
    for d, rev in enumerate((False, True)):
        w_c, k_c, b_c = dirs_c[d]
        S_c, y_c = _wkv_scan(S0, w_c, k_c, v_c, kk_c, b_c, r_c, rev)
        w_l, k_l, b_l = dirs_l[d]
        _, y_l = _wkv_scan(S_c, w_l, k_l, v_l, kk_l, b_l, r_l, rev)
        ys_l.append(y_l)
        ys_c.append(y_c)
    o_l = _rwkv_out(ys_l[0] + ys_l[1], r_l, v_l, dirs_l[0][1] + dirs_l[1][1], g_l,
                    r_k, lnx_w, lnx_b, w_o, y_lat.dtype)
    o_c = None
    if ctx_out:
        o_c = _rwkv_out(ys_c[0] + ys_c[1], r_c, v_c, dirs_c[0][1] + dirs_c[1][1], g_c,
                        r_k, lnx_w, lnx_b, w_o, y_ctx.dtype)
    return o_l, o_c


def setup_inputs(seed: int = 0) -> dict:
    key = jax.random.key(seed)
    ks = jax.random.split(key, 32)
    f32 = jnp.float32
    D, F, NA, NR = D_MODEL, D_FF, N_ATTN_LAYERS, N_RWKV_LAYERS
    nrm = lambda k, shape, s: jax.random.normal(k, shape, f32) * s
    qkv_cols = (ATTN_HEADS + 2 * ATTN_KV_HEADS) * ATTN_HEAD_DIM
    return {
        'x': nrm(ks[0], (BATCH, SEQ, D), 1.0),
        'c': nrm(ks[1], (BATCH, D), 1.0),
        'ctx': nrm(ks[2], (BATCH, CTX_LEN, D), 1.0),
        'c_ctx': nrm(ks[3], (D,), 1.0),
        'ada_w': nrm(ks[4], (DEPTH, D, N_SUBLAYERS * 3 * D), 0.5 * D ** -0.5),
        'ada_b': nrm(ks[5], (DEPTH, N_SUBLAYERS * 3 * D), 0.02),
        'norm_pre': 1.0 + nrm(ks[6], (DEPTH, N_SUBLAYERS, D), 0.02),
        'norm_post': 1.0 + nrm(ks[7], (DEPTH, N_SUBLAYERS, D), 0.02),
        'ffn_w_in': nrm(ks[8], (DEPTH, 2, D, 2 * F), D ** -0.5),
        'ffn_w_out': nrm(ks[9], (DEPTH, 2, F, D), F ** -0.5),
        'attn_w_qkv': nrm(ks[10], (NA, D, qkv_cols), D ** -0.5),
        'attn_w_o': nrm(ks[11], (NA, D, D), D ** -0.5),
        'attn_q_gain': 1.0 + nrm(ks[12], (NA, ATTN_HEAD_DIM), 0.02),
        'attn_k_gain': 1.0 + nrm(ks[13], (NA, ATTN_HEAD_DIM), 0.02),
        'rwkv_mu': jax.random.uniform(ks[14], (NR, 6, D), f32),
        'rwkv_w_rkv': nrm(ks[15], (NR, 3, D, D), D ** -0.5),
        'rwkv_w_o': nrm(ks[16], (NR, D, D), D ** -0.5),
        'rwkv_g1': nrm(ks[17], (NR, D, GATE_LORA), D ** -0.5),
        'rwkv_g2': nrm(ks[18], (NR, GATE_LORA, D), GATE_LORA ** -0.5),
        'rwkv_dec_w0': jax.random.uniform(ks[19], (NR, 2, D), f32, -6.0, -1.0),
        'rwkv_dec_w1': nrm(ks[20], (NR, 2, D, DECAY_LORA), D ** -0.5),
        'rwkv_dec_w2': nrm(ks[21], (NR, 2, DECAY_LORA, D), 0.1 * DECAY_LORA ** -0.5),
        'rwkv_icl_a0': nrm(ks[22], (NR, 2, D), 0.1),
        'rwkv_icl_a1': nrm(ks[23], (NR, 2, D, ICL_LORA), D ** -0.5),
        'rwkv_icl_a2': nrm(ks[24], (NR, 2, ICL_LORA, D), 0.5 * ICL_LORA ** -0.5),
        'rwkv_k_k': 0.85 + nrm(ks[25], (NR, D), 0.02),
        'rwkv_k_a': 1.0 + nrm(ks[26], (NR, D), 0.02),
        'rwkv_r_k': nrm(ks[27], (NR, RWKV_HEADS, RWKV_HEAD_DIM), 0.1),
        'rwkv_lnx_w': 1.0 + nrm(ks[28], (NR, D), 0.02),
        'rwkv_lnx_b': nrm(ks[29], (NR, D), 0.01),
    }


def reference(x, c, ctx, c_ctx, ada_w, ada_b, norm_pre, norm_post, ffn_w_in, ffn_w_out,
              attn_w_qkv, attn_w_o, attn_q_gain, attn_k_gain,
              rwkv_mu, rwkv_w_rkv, rwkv_w_o, rwkv_g1, rwkv_g2, rwkv_dec_w0, rwkv_dec_w1, rwkv_dec_w2,
              rwkv_icl_a0, rwkv_icl_a1, rwkv_icl_a2, rwkv_k_k, rwkv_k_a, rwkv_r_k, rwkv_lnx_w, rwkv_lnx_b):
    n_tok = x.shape[1]
    cos, sin = _axial_rope_tables(n_tok)
    h = ctx
    s_lat = jax.nn.silu(c)
    s_ctx = jax.nn.silu(c_ctx)
    for i in range(DEPTH):
        last = i == DEPTH - 1
        j = i // N_MIXERS
        mod_l = (s_lat @ ada_w[i] + ada_b[i]).reshape(-1, N_SUBLAYERS, 3, D_MODEL)
        mod_l = jnp.transpose(mod_l, (1, 2, 0, 3))[:, :, :, None, :]
        mod_c = (s_ctx @ ada_w[i] + ada_b[i]).reshape(N_SUBLAYERS, 3, D_MODEL)
        x = _ffn_half(x, norm_pre[i, 0], norm_post[i, 0], mod_l[0], ffn_w_in[i, 0], ffn_w_out[i, 0])
        h = _ffn_half(h, norm_pre[i, 0], norm_post[i, 0], mod_c[0], ffn_w_in[i, 0], ffn_w_out[i, 0])
        y_l = _modulate(x, norm_pre[i, 1], mod_l[1, 0], mod_l[1, 1])
        y_c = _modulate(h, norm_pre[i, 1], mod_c[1, 0], mod_c[1, 1])
        if i % N_MIXERS == 0:
            o_l, o_c = _attention_mixer(y_l, y_c, attn_w_qkv[j], attn_w_o[j], attn_q_gain[j], attn_k_gain[j],
                                        cos, sin, not last)
        else:
            o_l, o_c = _rwkv_mixer(y_l, y_c, rwkv_mu[j], rwkv_w_rkv[j], rwkv_w_o[j], rwkv_g1[j], rwkv_g2[j],
                                   rwkv_dec_w0[j], rwkv_dec_w1[j], rwkv_dec_w2[j],
                                   rwkv_icl_a0[j], rwkv_icl_a1[j], rwkv_icl_a2[j],
                                   rwkv_k_k[j], rwkv_k_a[j], rwkv_r_k[j], rwkv_lnx_w[j], rwkv_lnx_b[j], not last)
        x = _residual(x, o_l, norm_post[i, 1], mod_l[1, 2], 1.0)
        x = _ffn_half(x, norm_pre[i, 2], norm_post[i, 2], mod_l[2], ffn_w_in[i, 1], ffn_w_out[i, 1])
        if not last:
            h = _residual(h, o_c, norm_post[i, 1], mod_c[1, 2], 1.0)
            h = _ffn_half(h, norm_pre[i, 2], norm_post[i, 2], mod_c[2], ffn_w_in[i, 1], ffn_w_out[i, 1])
    return x
```

```cpp
#include <hip/hip_runtime.h>
#include <cstdio>
#include <cstdint>
#include <cmath>
__device__ __forceinline__ int lane_opaque() { int l; asm volatile("v_mbcnt_lo_u32_b32 %0, -1, 0\n\tv_mbcnt_hi_u32_b32 %0, -1, %0" : "=v"(l)); return l; }
namespace pg8 {
#define PG8_LAS __attribute__((address_space(3)))
typedef unsigned short bf16_t;
typedef short bf16x8 __attribute__((ext_vector_type(8)));
typedef float f32x4 __attribute__((ext_vector_type(4)));
typedef unsigned u32x4 __attribute__((ext_vector_type(4)));
constexpr int BM = 256, BK = 64, HALF = 128, HTB = HALF * BK * 2  , STAGE_BYTES = 8 * HTB, NXCD = 8, WGM = 8;

__host__ __device__ __forceinline__ int lds_byte(int r, int c) { const int st = (r >> 4) * 2 + (c >> 5), rr = r & 15, cc = c & 31, ob = rr * 64 + cc * 2; return st * 1024 + (ob ^ (((ob >> 9) & 1) << 5)); }
__host__ __device__ __forceinline__ void stage_rc(int b, int& R, int& C) { const int st = b / 1024, sb = b % 1024, swz = sb ^ (((sb >> 9) & 1) << 5); R = (st >> 1) * 16 + swz / 64; C = (st & 1) * 32 + (swz % 64) / 2; }
__host__ __device__ __forceinline__ int perm32(int rho) { const int n = rho >> 4, i = rho & 15; return 8 * (i >> 2) + 4 * n + (i & 3); }

struct Unit { int pm, pn; };
struct Gemm { const bf16_t* A; const bf16_t* Bt; int K;
    __device__ __forceinline__ const char* a_tile(const Unit& u) const { return (const char*)A + (size_t)u.pm * (size_t)(BM * 2) * K; }
    __device__ __forceinline__ const char* b_tile(const Unit& u) const { return (const char*)Bt + (size_t)u.pn * (size_t)(BM * 2) * K; } };

struct StaticOrder {
    int nM, nN, nwg, G, c;
    __host__ __device__ void init(int M, int N, int G_, int c_) { nM = M / BM; nN = N / BM; nwg = nM * nN; G = G_; c = c_; }
    __host__ __device__ bool next(int i, Unit& u) const {
        const long L = (long)i * G + c; if (L >= nwg) return false;
        int wgid = (int)L; { const int q = nwg / NXCD, r = nwg % NXCD, xcd = wgid % NXCD, off = wgid / NXCD; wgid = (xcd < r ? xcd * (q + 1) : r * (q + 1) + (xcd - r) * q) + off; }
        const int nig = WGM * nN, gid = wgid / nig, fm = gid * WGM, gsz = (nM - fm) < WGM ? (nM - fm) : WGM;
        u.pm = fm + ((wgid % nig) % gsz); u.pn = (wgid % nig) / gsz; return true;
    }
    __device__ __forceinline__ void a_ready(const Unit&) const {}
    __device__ __forceinline__ void done(const Unit&) const {}
};

typedef __bf16 bf16x2_cv __attribute__((ext_vector_type(2)));
typedef float f32x2_cv __attribute__((ext_vector_type(2)));
__device__ __forceinline__ unsigned cvt_pk_bf16(float lo, float hi) { const f32x2_cv v = {lo, hi}; const bf16x2_cv b = __builtin_convertvector(v, bf16x2_cv); return __builtin_bit_cast(unsigned, b); }

template <class Epi, class Sched, class GT, bool ALIGN_EPI = false, bool SP2 = false>
__device__ __forceinline__ void gemm_phase(PG8_LAS unsigned char* lds, const GT g, const Sched& S, const Epi& E, const int wid  ) {
    const int lane = lane_opaque(), tid = wid * 64 + lane, wr = wid >> 2, wc = wid & 3, fr = lane & 15, fq = lane >> 4;
    const int K = g.K, nt = K / BK;
    unsigned voffA[2], voffB[2];
#pragma unroll
    for (int i = 0; i < 2; ++i) { int R, C; stage_rc(tid * 16 + i * 8192, R, C); const int Rb = Epi::PERM ? ((R & ~31) + perm32(R & 31)) : R;
        voffA[i] = (unsigned)(R * K + C) * 2u; voffB[i] = (unsigned)(Rb * K + C) * 2u; }
    asm volatile("" : "+v"(voffA[0]), "+v"(voffA[1]), "+v"(voffB[0]), "+v"(voffB[1]));
    const size_t kstep = (size_t)(BK * 2);
    const size_t hstep = (size_t)HALF * K * 2;
    const unsigned ldsw = (unsigned)wid * 1024u;
    const int aoff = lds_byte(wr * 64 + fr, fq * 8), boff = lds_byte(wc * 32 + fr, fq * 8);
#define PG8_SA(b, h) (((b) * 2 + (h)) * HTB)
#define PG8_SB(b, h) ((4 + (b) * 2 + (h)) * HTB)
#define PG8_STAGE(bufoff, gbase, voff) do { _Pragma("unroll") for (int _i = 0; _i < 2; ++_i) \
        __builtin_amdgcn_global_load_lds((const unsigned*)((const char*)(gbase) + (voff)[_i]), (PG8_LAS unsigned*)(lds + (bufoff) + ldsw + _i * 8192), 16, 0, 0); } while (0)
#define PG8_LDA(dst, b, h) do { _Pragma("unroll") for (int m = 0; m < 4; ++m) _Pragma("unroll") for (int k = 0; k < 2; ++k) dst[m][k] = *(const PG8_LAS bf16x8*)(lds + PG8_SA(b, h) + aoff + m * 2048 + k * 1024); } while (0)
#define PG8_LDB(dst, b, h) do { _Pragma("unroll") for (int n = 0; n < 2; ++n) _Pragma("unroll") for (int k = 0; k < 2; ++k) dst[n][k] = *(const PG8_LAS bf16x8*)(lds + PG8_SB(b, h) + boff + n * 2048 + k * 1024); } while (0)
#define PG8_MMA(ai, bj, At, Bt) do { __builtin_amdgcn_s_setprio(1); _Pragma("unroll") for (int m = 0; m < 4; ++m) _Pragma("unroll") for (int n = 0; n < 2; ++n) _Pragma("unroll") for (int k = 0; k < 2; ++k) \
        acc[ai][bj][m][n] = __builtin_amdgcn_mfma_f32_16x16x32_bf16(Bt[n][k], At[m][k], acc[ai][bj][m][n], 0, 0, 0); __builtin_amdgcn_s_setprio(0); } while (0)
#define PG8_WAIT_V(n) asm volatile("s_waitcnt vmcnt(" #n ")" ::: "memory")
#define PG8_WAIT_L(n) asm volatile("s_waitcnt lgkmcnt(" #n ")" ::: "memory")
#define PG8_BAR __builtin_amdgcn_s_barrier()
#define PG8_SCHED __builtin_amdgcn_sched_barrier(0)
    Unit cur, nxt; int ui = 0;
    if (!S.next(0, cur)) return;
    f32x4 acc[2][2][4][2];
#pragma unroll
    for (int a = 0; a < 2; ++a)
#pragma unroll
        for (int b = 0; b < 2; ++b)
#pragma unroll
            for (int m = 0; m < 4; ++m)
#pragma unroll
                for (int n = 0; n < 2; ++n) acc[a][b][m][n] = (f32x4){0.f, 0.f, 0.f, 0.f};
    bf16x8 At[4][2], B0[2][2], B1[2][2];
    const char* cA = g.a_tile(cur); const char* cB = g.b_tile(cur);
    S.a_ready(cur);
    if constexpr (SP2) {
        PG8_STAGE(PG8_SB(0, 0), cB, voffB); PG8_STAGE(PG8_SB(0, 1), cB + hstep, voffB); PG8_STAGE(PG8_SA(0, 0), cA, voffA); PG8_STAGE(PG8_SA(0, 1), cA + hstep, voffA);
        if (wr == 1) PG8_BAR;
        PG8_WAIT_V(2); PG8_BAR;
        PG8_STAGE(PG8_SB(1, 0), cB + kstep, voffB); PG8_STAGE(PG8_SA(1, 0), cA + kstep, voffA); PG8_STAGE(PG8_SB(1, 1), cB + hstep + kstep, voffB);
        PG8_WAIT_V(6); PG8_BAR;
    } else {
        PG8_STAGE(PG8_SB(0, 0), cB, voffB); PG8_STAGE(PG8_SA(0, 0), cA, voffA); PG8_STAGE(PG8_SB(0, 1), cB + hstep, voffB); PG8_STAGE(PG8_SA(0, 1), cA + hstep, voffA);
        if (wr == 1) PG8_BAR;
        PG8_WAIT_V(4); PG8_BAR;
        PG8_STAGE(PG8_SB(1, 0), cB + kstep, voffB); PG8_STAGE(PG8_SA(1, 0), cA + kstep, voffA); PG8_STAGE(PG8_SB(1, 1), cB + hstep + kstep, voffB);
        PG8_WAIT_V(6); PG8_BAR;
    }
    for (;;) {
        const bool has_next = S.next(ui + 1, nxt);
        const char* nA = has_next ? g.a_tile(nxt) : cA; const char* nB = has_next ? g.b_tile(nxt) : cB;
        for (int t = 0; t < nt; t += 2) {
            const bool last = (t == nt - 2);
            const char* a1 = cA + (size_t)(t + 1) * kstep;
            const char* a2 = last ? nA : cA + (size_t)(t + 2) * kstep; const char* b2 = last ? nB : cB + (size_t)(t + 2) * kstep;
            const char* a3 = a2 + kstep; const char* b3 = b2 + kstep;
            if (last && has_next) S.a_ready(nxt);
            if constexpr (SP2) {
            PG8_LDB(B0, 0, 0); PG8_LDB(B1, 0, 1); PG8_SCHED; PG8_LDA(At, 0, 0); PG8_STAGE(PG8_SA(1, 1), a1 + hstep, voffA);
            PG8_WAIT_V(8); PG8_WAIT_L(0); PG8_BAR; PG8_MMA(0, 0, At, B0); PG8_MMA(0, 1, At, B1); PG8_BAR; PG8_SCHED;
            PG8_LDA(At, 0, 1); PG8_STAGE(PG8_SB(0, 0), b2, voffB); PG8_STAGE(PG8_SB(0, 1), b2 + hstep, voffB); PG8_STAGE(PG8_SA(0, 0), a2, voffA);
            PG8_WAIT_V(8); PG8_WAIT_L(0); PG8_BAR; PG8_MMA(1, 0, At, B0); PG8_MMA(1, 1, At, B1); PG8_BAR; PG8_SCHED;
            PG8_LDB(B0, 1, 0); PG8_LDB(B1, 1, 1); PG8_SCHED; PG8_LDA(At, 1, 0); PG8_STAGE(PG8_SA(0, 1), a2 + hstep, voffA);
            PG8_WAIT_V(8); PG8_WAIT_L(0); PG8_BAR; PG8_MMA(0, 0, At, B0); PG8_MMA(0, 1, At, B1); PG8_BAR; PG8_SCHED;
            PG8_LDA(At, 1, 1); PG8_STAGE(PG8_SB(1, 0), b3, voffB); PG8_STAGE(PG8_SB(1, 1), b3 + hstep, voffB); PG8_STAGE(PG8_SA(1, 0), a3, voffA);
            PG8_WAIT_V(8); PG8_WAIT_L(0); PG8_BAR; PG8_MMA(1, 0, At, B0); PG8_MMA(1, 1, At, B1); PG8_BAR; PG8_SCHED;
            } else {
            PG8_LDB(B0, 0, 0); PG8_SCHED; PG8_LDA(At, 0, 0); PG8_STAGE(PG8_SA(1, 1), a1 + hstep, voffA);
            PG8_WAIT_L(8); PG8_BAR; PG8_WAIT_L(0); PG8_MMA(0, 0, At, B0); PG8_BAR; PG8_SCHED;
            PG8_LDB(B1, 0, 1); PG8_STAGE(PG8_SB(0, 0), b2, voffB);
            PG8_BAR; PG8_WAIT_L(0); PG8_MMA(0, 1, At, B1); PG8_BAR;
            PG8_LDA(At, 0, 1); PG8_STAGE(PG8_SA(0, 0), a2, voffA);
            PG8_BAR; PG8_WAIT_L(0); PG8_MMA(1, 0, At, B0); PG8_BAR; PG8_SCHED;
            PG8_STAGE(PG8_SB(0, 1), b2 + hstep, voffB);
            PG8_WAIT_V(6); PG8_BAR; PG8_MMA(1, 1, At, B1); PG8_BAR;
            PG8_LDB(B0, 1, 0); PG8_SCHED; PG8_LDA(At, 1, 0); PG8_STAGE(PG8_SA(0, 1), a2 + hstep, voffA);
            PG8_WAIT_L(8); PG8_BAR; PG8_WAIT_L(0); PG8_MMA(0, 0, At, B0); PG8_BAR; PG8_SCHED;
            PG8_LDB(B1, 1, 1); PG8_STAGE(PG8_SB(1, 0), b3, voffB);
            PG8_BAR; PG8_WAIT_L(0); PG8_MMA(0, 1, At, B1); PG8_BAR;
            PG8_LDA(At, 1, 1); PG8_STAGE(PG8_SA(1, 0), a3, voffA);
            PG8_BAR; PG8_WAIT_L(0); PG8_MMA(1, 0, At, B0); PG8_BAR; PG8_SCHED;
            PG8_STAGE(PG8_SB(1, 1), b3 + hstep, voffB);
            PG8_WAIT_V(6); PG8_BAR; PG8_MMA(1, 1, At, B1); PG8_BAR;
            }
        }
        if constexpr (ALIGN_EPI) { if (wr == 0) PG8_BAR; }
        if constexpr (!Epi::AFTER_DRAIN) { E(acc, cur, wr, wc, fr, fq); S.done(cur); }
        if (!has_next) break;
#pragma unroll
        for (int a = 0; a < 2; ++a)
#pragma unroll
            for (int b = 0; b < 2; ++b)
#pragma unroll
                for (int m = 0; m < 4; ++m)
#pragma unroll
                    for (int n = 0; n < 2; ++n) acc[a][b][m][n] = (f32x4){0.f, 0.f, 0.f, 0.f};
        cur = nxt; cA = nA; cB = nB; ++ui;
        if constexpr (ALIGN_EPI) { if (wr == 1) PG8_BAR; }
    }
    PG8_WAIT_V(0);
    if constexpr (!ALIGN_EPI) { if (wr == 0) PG8_BAR; }
    PG8_BAR;
    if constexpr (Epi::AFTER_DRAIN) { E.fused(acc, cur, wr, wc, fr, fq, lds, wid, lane); S.done(cur); }
#undef PG8_SA
#undef PG8_SB
#undef PG8_STAGE
#undef PG8_LDA
#undef PG8_LDB
#undef PG8_MMA
#undef PG8_WAIT_V
#undef PG8_WAIT_L
#undef PG8_BAR
#undef PG8_SCHED
}
}

#define LAS __attribute__((address_space(3)))
#define XB_TMO      128
#define XB_XCNT(j)  (256  + 64 * (j))
#define XB_XSUB(j)  (1280 + 64 * (j))
#define XB_XGEN(j)  (2304 + 64 * (j))
#define XB_TOP      3328
#define XB_TOPGEN   3392
#define XCD_BAR_WORDS 3456
#define XB_SPIN_CAP (1u << 20)

__device__ __forceinline__ unsigned xb_ld(unsigned* p)              { return __hip_atomic_load(p, __ATOMIC_RELAXED, __HIP_MEMORY_SCOPE_AGENT); }
__device__ __forceinline__ unsigned xb_add(unsigned* p, unsigned v) { return __hip_atomic_fetch_add(p, v, __ATOMIC_RELAXED, __HIP_MEMORY_SCOPE_AGENT); }
__device__ __forceinline__ unsigned xb_xcc_id() { return (unsigned)__builtin_amdgcn_s_getreg((3 << 11) | 20) & 0xFu; }
#define XB_SPIN(cond, bar) do { unsigned _sp = 0; while (cond) { __builtin_amdgcn_s_sleep(1); \
    if ((++_sp & 255u) == 0u) { if (xb_ld(&(bar)[XB_TMO])) break; if (_sp > XB_SPIN_CAP) { atomicAdd(&(bar)[XB_TMO], 1u); break; } } } } while (0)

struct XcdBarrier {
    unsigned* bar; unsigned x;
    volatile LAS unsigned* st;
};

__device__ __forceinline__ XcdBarrier xcd_barrier_post(unsigned* bar, volatile LAS unsigned* st) {
    XcdBarrier b; b.bar = bar; b.x = xb_xcc_id(); b.st = st;
    if (threadIdx.x == 0) (void)xb_add(&bar[XB_XCNT(b.x)], 1u);
    return b;
}
__device__ __forceinline__ void xcd_barrier_complete(unsigned* bar, unsigned x, unsigned& nloc, unsigned& nx) {
    const unsigned G = gridDim.x * gridDim.y * gridDim.z;
    unsigned sum, cnt, mine, sp = 0u;
    for (;;) {
        sum = 0u; cnt = 0u; mine = 0u;
#pragma unroll
        for (unsigned j = 0; j < 16; ++j) { const unsigned c = xb_ld(&bar[XB_XCNT(j)]); sum += c; cnt += (c > 0u) ? 1u : 0u; mine = (j == x) ? c : mine; }
        if (sum == G) break;
        __builtin_amdgcn_s_sleep(1);
        if ((++sp & 255u) == 0u) { if (xb_ld(&bar[XB_TMO])) break; if (sp > XB_SPIN_CAP) { atomicAdd(&bar[XB_TMO], 1u); break; } }
    }
    nloc = mine > 0u ? mine : 1u; nx = cnt > 0u ? cnt : 1u;
}

__device__ __forceinline__ void xcd_barrier(const XcdBarrier& b, const bool tid0  ) {
    asm volatile("s_waitcnt vmcnt(0)" ::: "memory");
    __syncthreads();
    if (tid0) {
        unsigned* bar = b.bar;
        __builtin_amdgcn_s_waitcnt(0);
        unsigned nloc = b.st[0], nx = b.st[1];
        if (nloc == 0u) { xcd_barrier_complete(bar, b.x, nloc, nx); b.st[0] = nloc; b.st[1] = nx; }
        const unsigned old = xb_add(&bar[XB_XSUB(b.x)], 1u);
        const unsigned gen = old / nloc;
        if (old + 1u == (gen + 1u) * nloc) {
            __builtin_amdgcn_fence(__ATOMIC_RELEASE, "agent");
            asm volatile("s_waitcnt vmcnt(0)" ::: "memory");
            const unsigned og = xb_add(&bar[XB_TOP], 1u);
            const unsigned tg = og / nx;
            if (og + 1u == (tg + 1u) * nx) xb_add(&bar[XB_TOPGEN], 1u);
            else XB_SPIN(xb_ld(&bar[XB_TOPGEN]) == tg, bar);
            __builtin_amdgcn_fence(__ATOMIC_ACQUIRE, "agent");
            xb_add(&bar[XB_XGEN(b.x)], 1u);
            asm volatile("s_waitcnt vmcnt(0)" ::: "memory");
        } else {
            XB_SPIN(xb_ld(&bar[XB_XGEN(b.x)]) == gen, bar);
            __builtin_amdgcn_fence(__ATOMIC_ACQUIRE, "agent");
            asm volatile("s_waitcnt vmcnt(0)" ::: "memory");
        }
    }
    __syncthreads();
}

namespace attn {
using bf16 = unsigned short;
constexpr int   D = 128, NW = 8, QBLK = 32, KVBLK = 64;
constexpr float SCALE = 0.088388347648318440f;
constexpr float THR = 8.f;
constexpr int SDEPTH = 2;
constexpr int LDQ = 2048, LDK = 512, LDO = 2048;
constexpr size_t SHM_V = KVBLK * D * 2, SHM_K = KVBLK * D * 2, SHM_ATTN = 2 * SHM_V + 2 * SHM_K + NW * 64 * 4;
using bf16x8 = __attribute__((ext_vector_type(8))) short;
using s16x4  = __attribute__((ext_vector_type(4))) short;
using f32x16 = __attribute__((ext_vector_type(16))) float;
using f32x8  = __attribute__((ext_vector_type(8))) float;
using u32x4  = __attribute__((ext_vector_type(4))) unsigned;
#define KSWZ(row, colB) ((row) * 256 + ((colB) ^ (((row) & 7) << 4)))
#define SBAR() __builtin_amdgcn_sched_barrier(0)
__device__ __forceinline__ int crow(int r, int hi) { return (r & 3) + 8 * (r >> 2) + 4 * hi; }
__device__ __forceinline__ unsigned cvtpk(float lo, float hi) {
  return pg8::cvt_pk_bf16(lo, hi);
}
template <typename TIn> struct Stage;
__device__ __forceinline__ unsigned f2bf_(float f) { unsigned u = __builtin_bit_cast(unsigned, f); return (u + 0x7fffu + ((u >> 16) & 1u)) >> 16; }
template <> struct Stage<bf16>  { using T = bf16x8;
  __device__ static __forceinline__ T ld8(const bf16* p) { return *reinterpret_cast<const bf16x8*>(p); }
  __device__ static __forceinline__ bf16x8 tobf(T x) { return x; } };
template <> struct Stage<float> { using T = f32x8;
  __device__ static __forceinline__ T ld8(const float* p) { return *reinterpret_cast<const f32x8*>(p); }
  __device__ static __forceinline__ bf16x8 tobf(T x) {
    u32x4 w = {cvtpk(x[0], x[1]), cvtpk(x[2], x[3]), cvtpk(x[4], x[5]), cvtpk(x[6], x[7])}; return *reinterpret_cast<bf16x8*>(&w); } };

__device__ __forceinline__ void partialSM(f32x16& p0, f32x16& p1, float& m_reg, float& mn, float& alpha) {
  constexpr float C = SCALE * 1.4426950408889634f;
  float pmax = p0[0]; for (int r = 1; r < 16; ++r) pmax = fmaxf(pmax, p0[r]); for (int r = 0; r < 16; ++r) pmax = fmaxf(pmax, p1[r]);
  { auto rr = __builtin_amdgcn_permlane32_swap(__float_as_uint(pmax), __float_as_uint(pmax), false, false);
    pmax = fmaxf(__uint_as_float(rr[0]), __uint_as_float(rr[1])); }
  if (__builtin_expect(__all(pmax - m_reg <= THR / SCALE), 1)) { mn = m_reg; alpha = 1.f; }
  else { mn = fmaxf(m_reg, pmax); alpha = __builtin_amdgcn_exp2f((m_reg - mn) * C); m_reg = mn; }
  float mnC = -mn * C;
  for (int r = 0; r < 16; ++r) p0[r] = fmaf(p0[r], C, mnC); for (int r = 0; r < 16; ++r) p1[r] = fmaf(p1[r], C, mnC);
  for (int r = 0; r < 16; ++r) p0[r] = __builtin_amdgcn_exp2f(p0[r]);
}
__device__ __forceinline__ void finishSM(f32x16& p0, f32x16& p1, float alpha, float& l_reg, bf16x8& pa0, bf16x8& pa1, bf16x8& pa2, bf16x8& pa3) {
  for (int r = 0; r < 16; ++r) p1[r] = __builtin_amdgcn_exp2f(p1[r]);
  float ps = 0; for (int r = 0; r < 16; ++r) ps += p0[r]; for (int r = 0; r < 16; ++r) ps += p1[r];
  { auto rr = __builtin_amdgcn_permlane32_swap(__float_as_uint(ps), __float_as_uint(ps), false, false);
    ps = __uint_as_float(rr[0]) + __uint_as_float(rr[1]); }
  l_reg = l_reg * alpha + ps;
#define PK4(P, BASE, OUT) do { unsigned a0 = cvtpk(P[BASE + 0], P[BASE + 1]), a1 = cvtpk(P[BASE + 2], P[BASE + 3]);   \
    unsigned b0 = cvtpk(P[BASE + 4], P[BASE + 5]), b1 = cvtpk(P[BASE + 6], P[BASE + 7]);                              \
    auto r0 = __builtin_amdgcn_permlane32_swap(a0, b0, false, false); auto r1 = __builtin_amdgcn_permlane32_swap(a1, b1, false, false); \
    u32x4 w = {r0[0], r1[0], r0[1], r1[1]}; OUT = *reinterpret_cast<bf16x8*>(&w); } while (0)
  PK4(p0, 0, pa0); PK4(p0, 8, pa1); PK4(p1, 0, pa2); PK4(p1, 8, pa3);
#undef PK4
}
__device__ __forceinline__ void qkt(f32x16& p0, f32x16& p1, const bf16* Ks, const bf16x8* qr, int r32, int hi) {
  p0 = f32x16{}; p1 = f32x16{};
  for (int d0 = 0; d0 < 8; ++d0) { int cb = (d0 * 16 + hi * 8) * 2;
    bf16x8 b0 = *reinterpret_cast<const bf16x8*>((const char*)Ks + KSWZ(r32, cb));
    bf16x8 b1 = *reinterpret_cast<const bf16x8*>((const char*)Ks + KSWZ(32 + r32, cb));
    p0 = __builtin_amdgcn_mfma_f32_32x32x16_bf16(b0, qr[d0], p0, 0, 0, 0);
    p1 = __builtin_amdgcn_mfma_f32_32x32x16_bf16(b1, qr[d0], p1, 0, 0, 0); }
}
__device__ __forceinline__ int v_st(int k, int c) { const int kk = (k & ~0xC) | ((k & 4) << 1) | ((k & 8) >> 1); return ((kk >> 3) * 4 + (c >> 5)) * 512 + ((kk & 7) * 32 + (c & 31)) * 2; }
__device__ __forceinline__ int v_rd_base(int lane) { return ((lane & 3) << 3) | (((lane >> 2) & 3) << 6) | (((lane >> 4) & 1) << 5) | (((lane >> 5) & 1) << 8); }
constexpr int v_rd_off(int d0, int ks, int half) { return d0 * 512 + ks * 4096 + half * 2048; }
template <int OFF> __device__ __forceinline__ s16x4 tr_read(int vb) {
  s16x4 r; asm volatile("ds_read_b64_tr_b16 %0, %1 offset:%2" : "=&v"(r) : "v"(vb), "i"(OFF) : "memory"); return r;
}
template <int D0> __device__ __forceinline__ void pv_one(f32x16& od, int vb, bf16x8 pa0, bf16x8 pa1, bf16x8 pa2, bf16x8 pa3) {
  const s16x4 l0 = tr_read<v_rd_off(D0, 0, 0)>(vb), h0 = tr_read<v_rd_off(D0, 0, 1)>(vb), l1 = tr_read<v_rd_off(D0, 1, 0)>(vb), h1 = tr_read<v_rd_off(D0, 1, 1)>(vb);
  const s16x4 l2 = tr_read<v_rd_off(D0, 2, 0)>(vb), h2 = tr_read<v_rd_off(D0, 2, 1)>(vb), l3 = tr_read<v_rd_off(D0, 3, 0)>(vb), h3 = tr_read<v_rd_off(D0, 3, 1)>(vb);
  asm volatile("s_waitcnt lgkmcnt(0)" ::: "memory"); SBAR();
#define PK(L, H) (bf16x8){L[0], L[1], L[2], L[3], H[0], H[1], H[2], H[3]}
  od = __builtin_amdgcn_mfma_f32_32x32x16_bf16(pa0, PK(l0, h0), od, 0, 0, 0);
  od = __builtin_amdgcn_mfma_f32_32x32x16_bf16(pa1, PK(l1, h1), od, 0, 0, 0);
  od = __builtin_amdgcn_mfma_f32_32x32x16_bf16(pa2, PK(l2, h2), od, 0, 0, 0);
  od = __builtin_amdgcn_mfma_f32_32x32x16_bf16(pa3, PK(l3, h3), od, 0, 0, 0);
#undef PK
}
__device__ __forceinline__ void pv_d0(f32x16* o, int vb, bf16x8 pa0, bf16x8 pa1, bf16x8 pa2, bf16x8 pa3) {
  pv_one<0>(o[0], vb, pa0, pa1, pa2, pa3); pv_one<1>(o[1], vb, pa0, pa1, pa2, pa3); pv_one<2>(o[2], vb, pa0, pa1, pa2, pa3); pv_one<3>(o[3], vb, pa0, pa1, pa2, pa3);
}

template <typename TQ>
__device__ __forceinline__ void attn_dense_body(const TQ* __restrict__ Qb, const bf16* __restrict__ Kh, const bf16* __restrict__ Vh,
                                                bf16* __restrict__ Ob, int seq, char* lds, const int wid) {
  using St = Stage<bf16>; using SQ = Stage<TQ>;
  const int lane = lane_opaque(), tid = wid * 64 + lane, r32 = lane & 31, hi = lane >> 5;
  bf16* V_lds = (bf16*)lds; bf16* K_lds = (bf16*)(lds + 2 * SHM_V);
  float* ws = (float*)(lds + 2 * SHM_V + 2 * SHM_K) + wid * 64; float* li_l = ws; float* al_l = ws + 32;
  float m_reg = -1e30f, l_reg = 0; f32x16 o[4] = {}; bf16x8 qr[8];
  const TQ* Qw = Qb + (long)(wid * QBLK + r32) * LDQ + hi * 8;
#pragma unroll
  for (int d0 = 0; d0 < 8; ++d0) qr[d0] = SQ::tobf(SQ::ld8(Qw + d0 * 16));
  const int sr = tid >> 4, sc = (tid & 15) * 8, vst0 = v_st(sr, sc), vst1 = v_st(32 + sr, sc);
  const int vb0 = (int)(uintptr_t)V_lds + v_rd_base(lane);
  struct { typename St::T vs0, vs1, ks0, ks1; } sr_[SDEPTH];
#define SLOAD(i, k0) do { sr_[i].vs0 = St::ld8(&Vh[(long)((k0) + sr) * LDK + sc]); sr_[i].vs1 = St::ld8(&Vh[(long)((k0) + 32 + sr) * LDK + sc]); \
    sr_[i].ks0 = St::ld8(&Kh[(long)((k0) + sr) * LDK + sc]); sr_[i].ks1 = St::ld8(&Kh[(long)((k0) + 32 + sr) * LDK + sc]); } while (0)
#define SWRITE(b, i) do { *(bf16x8*)((char*)V_lds + (b) * SHM_V + vst0) = St::tobf(sr_[i].vs0);          \
    *(bf16x8*)((char*)V_lds + (b) * SHM_V + vst1) = St::tobf(sr_[i].vs1); int kc = sc * 2;               \
    *(bf16x8*)((char*)K_lds + (b) * SHM_K + KSWZ(sr, kc)) = St::tobf(sr_[i].ks0);                       \
    *(bf16x8*)((char*)K_lds + (b) * SHM_K + KSWZ(32 + sr, kc)) = St::tobf(sr_[i].ks1); } while (0)
#define SWAIT() do { if constexpr (SDEPTH == 2) asm volatile("s_waitcnt vmcnt(4)" ::: "memory"); else asm volatile("s_waitcnt vmcnt(0)" ::: "memory"); } while (0)
#define RESC(a) do { if (__any((a) < 1.f)) { if (hi == 0) al_l[r32] = (a); asm volatile("s_waitcnt lgkmcnt(0)" ::: "memory"); \
    for (int d = 0; d < 4; ++d) for (int r = 0; r < 16; ++r) o[d][r] *= al_l[crow(r, hi)]; } } while (0)
  f32x16 pA0, pA1, pB0, pB1; float mnA, mnB, alA, alB; bf16x8 pa0, pa1, pa2, pa3; const int NT = seq / KVBLK;
  constexpr int SE = 0, SO = SDEPTH - 1;
  SLOAD(SE, 0); asm volatile("s_waitcnt vmcnt(0)" ::: "memory"); SWRITE(0, SE); __syncthreads();
  qkt(pA0, pA1, K_lds, qr, r32, hi); partialSM(pA0, pA1, m_reg, mnA, alA);
  SLOAD(SO, KVBLK); if constexpr (SDEPTH == 2) { if (2 < NT) SLOAD(SE, 2 * KVBLK); }
  SWAIT(); SWRITE(1, SO); __syncthreads();
  for (int j = 1; j + 1 < NT; j += 2) {
    SBAR(); qkt(pB0, pB1, (bf16*)((char*)K_lds + SHM_K), qr, r32, hi);
    finishSM(pA0, pA1, alA, l_reg, pa0, pa1, pa2, pa3); SBAR();
    SLOAD(SO, (j + SDEPTH) * KVBLK); SBAR();
    pv_d0(o, vb0, pa0, pa1, pa2, pa3); partialSM(pB0, pB1, m_reg, mnB, alB);
    __syncthreads(); SWAIT(); SWRITE(0, SE);
    RESC(alB); __syncthreads();
    SBAR(); qkt(pA0, pA1, K_lds, qr, r32, hi);
    finishSM(pB0, pB1, alB, l_reg, pa0, pa1, pa2, pa3); SBAR();
    if (SDEPTH == 1 || j + 3 < NT) SLOAD(SE, (j + 1 + SDEPTH) * KVBLK); SBAR();
    pv_d0(o, vb0 + (int)SHM_V, pa0, pa1, pa2, pa3); partialSM(pA0, pA1, m_reg, mnA, alA);
    __syncthreads(); SWAIT(); SWRITE(1, SO);
    RESC(alA); __syncthreads();
  }
  SBAR(); qkt(pB0, pB1, (bf16*)((char*)K_lds + SHM_K), qr, r32, hi);
  finishSM(pA0, pA1, alA, l_reg, pa0, pa1, pa2, pa3); SBAR();
  pv_d0(o, vb0, pa0, pa1, pa2, pa3); partialSM(pB0, pB1, m_reg, mnB, alB);
  __syncthreads(); RESC(alB);
  finishSM(pB0, pB1, alB, l_reg, pa0, pa1, pa2, pa3); SBAR();
  pv_d0(o, vb0 + (int)SHM_V, pa0, pa1, pa2, pa3);
  if (hi == 0) li_l[r32] = l_reg; asm volatile("s_waitcnt lgkmcnt(0)" ::: "memory");
  float rli[16];
#pragma unroll
  for (int r = 0; r < 16; ++r) rli[r] = __builtin_amdgcn_rcpf(li_l[crow(r, hi)]);
  bf16* Ow = Ob + (long)(wid * QBLK) * LDO;
#pragma unroll
  for (int r = 0; r < 16; ++r) { int orow = crow(r, hi);
    for (int d0 = 0; d0 < 4; ++d0) Ow[(long)orow * LDO + d0 * 32 + r32] = (bf16)f2bf_(o[d0][r] * rli[r]); }
#undef SLOAD
#undef SWRITE
#undef SWAIT
#undef RESC
}
#undef KSWZ
#undef SBAR
}

#define GAS __attribute__((address_space(1)))
typedef unsigned short bf16_t;
typedef unsigned u32x4 __attribute__((ext_vector_type(4)));
typedef unsigned u32x2 __attribute__((ext_vector_type(2)));
typedef float f32x4 __attribute__((ext_vector_type(4)));
typedef float f32x2 __attribute__((ext_vector_type(2)));
typedef short bf16x8 __attribute__((ext_vector_type(8)));

constexpr int D = 2048, NB = 4, SEQ = 4096, CTXL = 256, TB = SEQ + CTXL, M = NB * TB, FF = 5632, DEPTH = 4;
constexpr int NWAVES = 8, NTHR = 512;
constexpr float NORM_EPS = 1e-6f;
static_assert(M == 17408 && M % 256 == 0 && TB % 256 == 0, "row layout");

constexpr size_t MiB = 1u << 20;
constexpr size_t WS_CTL = 0, CTL_ZERO_BYTES = 4 * MiB;
constexpr size_t WS_MOD = 1 * MiB;
constexpr size_t WS_ROPE = 4 * MiB;
constexpr size_t WS_WB = 8 * MiB;
constexpr size_t E_F1 = (size_t)2 * FF * D, E_F2 = (size_t)D * FF;
constexpr size_t WS_WA = WS_WB + 8 * (E_F1 + E_F2) * 2;
constexpr size_t E_QKV = (size_t)3072 * D, E_SQ = (size_t)D * D;
constexpr size_t WS_WR = WS_WA + 2 * (E_QKV + E_SQ) * 2;
constexpr size_t E_RW1 = (size_t)6912 * D, E_RW2 = (size_t)10240 * 256;
constexpr size_t WS_WEND = WS_WR + 2 * (E_RW1 + E_RW2 + E_SQ) * 2;
static_assert(WS_WEND == 656 * MiB, "weight map");
constexpr size_t SZ_R2 = (size_t)M * D * 2, SZ_R4 = (size_t)M * D * 4;
constexpr size_t WS_X = 656 * MiB;
constexpr size_t WS_Y = WS_X + SZ_R4;
constexpr size_t WS_ACT = WS_Y + SZ_R2;
constexpr size_t WS_OUT = 1048 * MiB;
constexpr size_t WS_MIX = WS_OUT + SZ_R2;
static_assert(WS_ACT + (size_t)M * FF * 2 <= WS_OUT, "act map");
constexpr size_t WS_Q = WS_MIX, WS_K = WS_Q + SZ_R2, WS_V = WS_K + SZ_R2 / 4, WS_O = WS_V + SZ_R2 / 4;
constexpr size_t WS_MIX6 = WS_MIX;
constexpr size_t WS_WDEC = WS_MIX;
constexpr size_t WS_AA = WS_MIX + 2 * SZ_R4;
constexpr size_t WS_RR = WS_MIX + 6 * SZ_R2;
constexpr size_t WS_KK_ = WS_RR + SZ_R2;
constexpr size_t WS_VV = WS_KK_ + SZ_R2;
constexpr size_t WS_KN = WS_VV + SZ_R2;
constexpr size_t WS_GG = WS_KN + SZ_R2;
constexpr size_t WS_GL = WS_GG + SZ_R2;
constexpr size_t WS_WL = WS_GL + 9 * MiB, WS_AL = WS_WL + 9 * MiB;
constexpr size_t WS_END = WS_AL + 9 * MiB;
constexpr size_t WS_YS = WS_ACT;
constexpr size_t WS_PREP = WS_Y;
static_assert(WS_AA + 2 * SZ_R2 == WS_RR, "rwkv overlay");
static_assert(WS_END <= 2100 * MiB, "ws map");
constexpr int CW_BAR = 4096;
constexpr int MAX_LAUNCH = 64;
static_assert((CW_BAR + MAX_LAUNCH * XCD_BAR_WORDS) * 4 <= (int)WS_MOD, "ctl map");

constexpr int RING_BYTES = 131072, LDSCTL_OFF = RING_BYTES, MISC_OFF = LDSCTL_OFF + 320, LDS_BYTES = 147456;

struct Args { const float* in[30]; float* out; unsigned char* ws; int ph_lo, ph_hi, li, dbg; };
typedef const __attribute__((address_space(4))) Args KArgs;
struct Frame { LAS unsigned char* lds; unsigned char* ldsg; int wave, G, bid; };

#define LDS_WAIT() asm volatile("s_waitcnt lgkmcnt(0)" ::: "memory")
__device__ __forceinline__ unsigned f2bf(float f) { unsigned u = __builtin_bit_cast(unsigned, f); return (u + 0x7fffu + ((u >> 16) & 1u)) >> 16; }
__device__ __forceinline__ unsigned pk2(float lo, float hi) { return pg8::cvt_pk_bf16(lo, hi); }
__device__ __forceinline__ float bflo(unsigned w) { return __builtin_bit_cast(float, w << 16); }
__device__ __forceinline__ float bfhi(unsigned w) { return __builtin_bit_cast(float, w & 0xffff0000u); }
__device__ __forceinline__ void unpack8(const u32x4 w, float (&v)[8]) { v[0] = bflo(w.x); v[1] = bfhi(w.x); v[2] = bflo(w.y); v[3] = bfhi(w.y); v[4] = bflo(w.z); v[5] = bfhi(w.z); v[6] = bflo(w.w); v[7] = bfhi(w.w); }
__device__ __forceinline__ u32x4 pack8(const float (&v)[8]) { u32x4 w; w.x = pk2(v[0], v[1]); w.y = pk2(v[2], v[3]); w.z = pk2(v[4], v[5]); w.w = pk2(v[6], v[7]); return w; }
__device__ __forceinline__ float wave_sum(float v) {
#pragma unroll
    for (int o = 1; o < 64; o <<= 1) v += __shfl_xor(v, o);
    return v;
}
template <int CTRL> __device__ __forceinline__ float dppf(float x) { return __builtin_bit_cast(float, __builtin_amdgcn_mov_dpp(__builtin_bit_cast(int, x), CTRL, 0xF, 0xF, true)); }
__device__ __forceinline__ float sum8(float v) { v += dppf<0xB1>(v); v += dppf<0x4E>(v); v += dppf<0x141>(v); return v; }
__device__ __forceinline__ float sum16(float v) { v = sum8(v); v += dppf<0x140>(v); return v; }
__device__ __forceinline__ float fsigmoid(float x) { return __builtin_amdgcn_rcpf(1.0f + __builtin_amdgcn_exp2f(-1.4426950408889634f * x)); }
__device__ __forceinline__ float ftanh(float x) { return 1.0f - 2.0f * __builtin_amdgcn_rcpf(1.0f + __builtin_amdgcn_exp2f(2.8853900817779268f * x)); }
__device__ __forceinline__ float fsilu(float x) { return x * fsigmoid(x); }

using pg8::Unit;
typedef float accf32x4 __attribute__((ext_vector_type(4)));
struct EpiPlain {
    static constexpr bool PERM = true, AFTER_DRAIN = false;
    bf16_t* O; int ldc;
    __device__ __forceinline__ void operator()(const accf32x4 (&acc)[2][2][4][2], const Unit& u, int wr, int wc, int fr, int fq) const {
        const int row0 = u.pm * 256 + wr * 64 + fr, col0 = u.pn * 256 + wc * 32 + 8 * fq;
#pragma unroll
        for (int ai = 0; ai < 2; ++ai)
#pragma unroll
            for (int m = 0; m < 4; ++m) { bf16_t* rowp = O + (size_t)(row0 + ai * 128 + m * 16) * ldc + col0;
#pragma unroll
                for (int bj = 0; bj < 2; ++bj) { const accf32x4 v0 = acc[ai][bj][m][0], v1 = acc[ai][bj][m][1];
                    u32x4 w; w.x = pk2(v0[0], v0[1]); w.y = pk2(v0[2], v0[3]); w.z = pk2(v1[0], v1[1]); w.w = pk2(v1[2], v1[3]);
                    *(u32x4*)(rowp + bj * 128) = w; } }
    }
};
struct EpiQKV {
    static constexpr bool PERM = true, AFTER_DRAIN = false;
    unsigned char* wsb;
    __device__ __forceinline__ void operator()(const accf32x4 (&acc)[2][2][4][2], const Unit& u, int wr, int wc, int fr, int fq) const {
        size_t ooff; int ldc, ct;
        if (u.pn < 8) { ooff = WS_Q; ldc = 2048; ct = u.pn; } else if (u.pn < 10) { ooff = WS_K; ldc = 512; ct = u.pn - 8; } else { ooff = WS_V; ldc = 512; ct = u.pn - 10; }
        bf16_t* O = (bf16_t*)(wsb + ooff);
        const int row0 = u.pm * 256 + wr * 64 + fr, col0 = ct * 256 + wc * 32 + 8 * fq;
#pragma unroll
        for (int ai = 0; ai < 2; ++ai)
#pragma unroll
            for (int m = 0; m < 4; ++m) { bf16_t* rowp = O + (size_t)(row0 + ai * 128 + m * 16) * ldc + col0;
#pragma unroll
                for (int bj = 0; bj < 2; ++bj) { const accf32x4 v0 = acc[ai][bj][m][0], v1 = acc[ai][bj][m][1];
                    u32x4 w; w.x = pk2(v0[0], v0[1]); w.y = pk2(v0[2], v0[3]); w.z = pk2(v1[0], v1[1]); w.w = pk2(v1[2], v1[3]);
                    *(u32x4*)(rowp + bj * 128) = w; } }
    }
};
struct EpiSwiGLU {
    static constexpr bool PERM = true, AFTER_DRAIN = false;
    bf16_t* O;
    __device__ __forceinline__ void operator()(const accf32x4 (&acc)[2][2][4][2], const Unit& u, int wr, int wc, int fr, int fq) const {
        const int row0 = u.pm * 256 + wr * 64 + fr, col0 = u.pn * 128 + wc * 32 + 8 * fq;
#pragma unroll
        for (int ai = 0; ai < 2; ++ai)
#pragma unroll
            for (int m = 0; m < 4; ++m) { bf16_t* rowp = O + (size_t)(row0 + ai * 128 + m * 16) * FF + col0;
                float r[8];
#pragma unroll
                for (int n = 0; n < 2; ++n)
#pragma unroll
                    for (int e = 0; e < 4; ++e) { const float g = acc[ai][0][m][n][e], up = acc[ai][1][m][n][e]; r[4 * n + e] = fsilu(g) * up; }
                *(u32x4*)rowp = pack8(r); }
    }
};
struct EpiRw1 {
    static constexpr bool PERM = true, AFTER_DRAIN = false;
    unsigned char* wsb; const float* k_k;
    __device__ __forceinline__ void operator()(const accf32x4 (&acc)[2][2][4][2], const Unit& u, int wr, int wc, int fr, int fq) const {
        const int row0 = u.pm * 256 + wr * 64 + fr, cit = 64 * wc + 8 * fq;
        const int pn = u.pn;
        if (pn >= 8 && pn < 16) {
            bf16_t* K = (bf16_t*)(wsb + WS_KK_); bf16_t* KN = (bf16_t*)(wsb + WS_KN);
            const int colb = (pn - 8) * 256 + cit;
            float kk0[8], kk1[8];
            { const f32x4 a0 = *(const f32x4*)(k_k + colb), a1 = *(const f32x4*)(k_k + colb + 4), b0 = *(const f32x4*)(k_k + colb + 32), b1 = *(const f32x4*)(k_k + colb + 36);
#pragma unroll
              for (int e = 0; e < 4; ++e) { kk0[e] = a0[e]; kk0[4 + e] = a1[e]; kk1[e] = b0[e]; kk1[4 + e] = b1[e]; } }
#pragma unroll
            for (int ai = 0; ai < 2; ++ai)
#pragma unroll
                for (int m = 0; m < 4; ++m) { const size_t ro = (size_t)(row0 + ai * 128 + m * 16) * D + colb;
                    float k0[8], k1[8], q0[8], q1[8]; float ss = 0.f;
#pragma unroll
                    for (int n = 0; n < 2; ++n)
#pragma unroll
                        for (int e = 0; e < 4; ++e) { k0[4 * n + e] = acc[ai][0][m][n][e]; k1[4 * n + e] = acc[ai][1][m][n][e]; }
#pragma unroll
                    for (int i = 0; i < 8; ++i) { q0[i] = k0[i] * kk0[i]; q1[i] = k1[i] * kk1[i]; ss += q0[i] * q0[i] + q1[i] * q1[i]; }
                    ss += __shfl_xor(ss, 16); ss += __shfl_xor(ss, 32);
                    const float rs = rsqrtf(ss + 1e-12f);
#pragma unroll
                    for (int i = 0; i < 8; ++i) { q0[i] *= rs; q1[i] *= rs; }
                    *(u32x4*)(K + ro) = pack8(k0); *(u32x4*)(K + ro + 32) = pack8(k1);
                    *(u32x4*)(KN + ro) = pack8(q0); *(u32x4*)(KN + ro + 32) = pack8(q1); }
        } else if (pn < 24) {
            bf16_t* O = (bf16_t*)(wsb + (pn < 8 ? WS_RR : WS_VV)); const int colb = (pn & 7) * 256 + cit;
#pragma unroll
            for (int ai = 0; ai < 2; ++ai)
#pragma unroll
                for (int m = 0; m < 4; ++m) { const size_t ro = (size_t)(row0 + ai * 128 + m * 16) * D + colb;
#pragma unroll
                    for (int bj = 0; bj < 2; ++bj) { const accf32x4 v0 = acc[ai][bj][m][0], v1 = acc[ai][bj][m][1];
                        u32x4 w; w.x = pk2(v0[0], v0[1]); w.y = pk2(v0[2], v0[3]); w.z = pk2(v1[0], v1[1]); w.w = pk2(v1[2], v1[3]);
                        *(u32x4*)(O + ro + 32 * bj) = w; } }
        } else {
            bf16_t* O = (bf16_t*)(wsb + WS_GL + (size_t)(pn - 24) * (9 * MiB));
#pragma unroll
            for (int ai = 0; ai < 2; ++ai)
#pragma unroll
                for (int m = 0; m < 4; ++m) { const size_t ro = (size_t)(row0 + ai * 128 + m * 16) * 256 + cit;
#pragma unroll
                    for (int bj = 0; bj < 2; ++bj) { float r[8];
#pragma unroll
                        for (int n = 0; n < 2; ++n)
#pragma unroll
                            for (int e = 0; e < 4; ++e) { const float x = acc[ai][bj][m][n][e]; r[4 * n + e] = pn == 24 ? fsigmoid(x) : (pn == 25 ? ftanh(x) : x); }
                        *(u32x4*)(O + ro + 32 * bj) = pack8(r); } }
        }
    }
};
struct EpiRw2 {
    static constexpr bool PERM = true, AFTER_DRAIN = false;
    unsigned char* wsb; const float *w0, *a0; size_t aa_off;
    __device__ __forceinline__ void operator()(const accf32x4 (&acc)[2][2][4][2], const Unit& u, int wr, int wc, int fr, int fq) const {
        const int row0 = u.pm * 256 + wr * 64 + fr, cit = 64 * wc + 8 * fq;
        const int pn = u.pn;
        if (pn < 8) {
            bf16_t* G = (bf16_t*)(wsb + WS_GG);
            const int colb = pn * 256 + cit;
#pragma unroll
            for (int ai = 0; ai < 2; ++ai)
#pragma unroll
                for (int m = 0; m < 4; ++m) { const size_t ro = (size_t)(row0 + ai * 128 + m * 16) * D + colb;
#pragma unroll
                    for (int bj = 0; bj < 2; ++bj) { const accf32x4 v0 = acc[ai][bj][m][0], v1 = acc[ai][bj][m][1];
                        u32x4 w; w.x = pk2(v0[0], v0[1]); w.y = pk2(v0[2], v0[3]); w.z = pk2(v1[0], v1[1]); w.w = pk2(v1[2], v1[3]);
                        *(u32x4*)(G + ro + 32 * bj) = w; } }
        } else if (pn < 24) {
            const int d = (pn - 8) >> 3, colb = ((pn - 8) & 7) * 256 + cit;
            float* Wd = (float*)(wsb + WS_WDEC) + (size_t)d * M * D;
#pragma unroll
            for (int bj = 0; bj < 2; ++bj) {
                const f32x4 b0 = *(const f32x4*)(w0 + d * D + colb + 32 * bj), b1 = *(const f32x4*)(w0 + d * D + colb + 32 * bj + 4);
#pragma unroll
                for (int ai = 0; ai < 2; ++ai)
#pragma unroll
                    for (int m = 0; m < 4; ++m) { const size_t ro = (size_t)(row0 + ai * 128 + m * 16) * D + colb + 32 * bj;
                        f32x4 o0, o1;
#pragma unroll
                        for (int e = 0; e < 4; ++e) { o0[e] = __builtin_amdgcn_exp2f(-0.8750387749f * fsigmoid(acc[ai][bj][m][0][e] + b0[e]));
                                                      o1[e] = __builtin_amdgcn_exp2f(-0.8750387749f * fsigmoid(acc[ai][bj][m][1][e] + b1[e])); }
                        *(f32x4*)(Wd + ro) = o0; *(f32x4*)(Wd + ro + 4) = o1; } }
        } else {
            const int d = (pn - 24) >> 3, colb = ((pn - 24) & 7) * 256 + cit;
            bf16_t* AAd = (bf16_t*)(wsb + aa_off) + (size_t)d * M * D;
#pragma unroll
            for (int bj = 0; bj < 2; ++bj) {
                const int cb = colb + 32 * bj;
                const f32x4 b0 = *(const f32x4*)(a0 + d * D + cb), b1 = *(const f32x4*)(a0 + d * D + cb + 4);
#pragma unroll
                for (int ai = 0; ai < 2; ++ai)
#pragma unroll
                    for (int m = 0; m < 4; ++m) { const size_t ro = (size_t)(row0 + ai * 128 + m * 16) * D + cb;
                        float av[8];
#pragma unroll
                        for (int e = 0; e < 4; ++e) { av[e] = fsigmoid(acc[ai][bj][m][0][e] + b0[e]); av[4 + e] = fsigmoid(acc[ai][bj][m][1][e] + b1[e]); }
                        *(u32x4*)(AAd + ro) = pack8(av); } }
        }
    }
};
struct GemmRw1 { const bf16_t* MIX; const bf16_t* Bt;  int K;
    __device__ __forceinline__ const char* a_tile(const Unit& u) const { int idx = u.pn < 24 ? (u.pn >> 3) : (u.pn - 21);
#ifdef DBG_RW1_SAMEA
        idx = 0;
#endif
        return (const char*)MIX + (size_t)idx * SZ_R2 + (size_t)u.pm * (size_t)(256 * 2) * D; }
    __device__ __forceinline__ const char* b_tile(const Unit& u) const { return (const char*)Bt + (size_t)u.pn * (size_t)(256 * 2) * D; } };
struct GemmRw2 { const unsigned char* wsb; const bf16_t* Bt; int K;
    __device__ __forceinline__ const char* a_tile(const Unit& u) const { const size_t ao = u.pn < 8 ? WS_GL : (u.pn < 24 ? WS_WL : WS_AL); return (const char*)wsb + ao + (size_t)u.pm * (size_t)(256 * 2) * 256; }
    __device__ __forceinline__ const char* b_tile(const Unit& u) const { return (const char*)Bt + (size_t)u.pn * (size_t)(256 * 2) * 256; } };

__device__ __forceinline__ int hp_row(int c) { return 128 * ((c & 63) >> 5) + 32 * (c >> 6) + (c & 31); }
__device__ __forceinline__ int hp_col(int rho) { return 64 * ((rho & 127) >> 5) + 32 * (rho >> 7) + (rho & 31); }
__device__ __forceinline__ void cvt_item(const float* W, int K, int N, bf16_t* WT, int mode, int row_off, LAS float* scr, int item, int lane) {
    const int nblk = N / 32, kb = item / nblk, nb = item - kb * nblk, k0 = 64 * kb, n0 = 32 * nb;
#pragma unroll 8
    for (int i = 0; i < 32; ++i) { const int kk = 2 * i + (lane >> 5); scr[kk * 33 + (lane & 31)] = W[(size_t)(k0 + kk) * N + n0 + (lane & 31)]; }
    LDS_WAIT(); asm volatile("" ::: "memory");
    int dr;
    if (mode == 0) dr = n0;
    else if (mode == 1) { dr = n0 < FF ? 256 * (n0 / 128) + (n0 % 128) : 256 * ((n0 - FF) / 128) + 128 + ((n0 - FF) % 128); }
    else { dr = (n0 & ~255) + hp_row(n0 & 255); }
    dr += row_off;
    const int c = lane & 7;
#pragma unroll
    for (int j = 0; j < 4; ++j) { const int n = (lane >> 3) + 8 * j; const LAS float* s = scr + (8 * c) * 33 + n;
        u32x4 o; o.x = pk2(s[0 * 33], s[1 * 33]); o.y = pk2(s[2 * 33], s[3 * 33]); o.z = pk2(s[4 * 33], s[5 * 33]); o.w = pk2(s[6 * 33], s[7 * 33]);
        *(u32x4*)(WT + (size_t)(dr + n) * K + k0 + 8 * c) = o; }
    LDS_WAIT(); asm volatile("" ::: "memory");
}
__device__ __forceinline__ void p0a_phase(const Frame F, KArgs* a) {
    const int lane_ = lane_opaque(), tid_ = F.wave * 64 + lane_; (void)tid_; (void)lane_;
    LAS float* scr = (LAS float*)(F.lds + F.wave * 16384);
    const int gw = F.bid * NWAVES + F.wave, NGW = F.G * NWAVES;
    bf16_t* WB = (bf16_t*)(a->ws + WS_WB); bf16_t* WA = (bf16_t*)(a->ws + WS_WA); bf16_t* WR = (bf16_t*)(a->ws + WS_WR);
    constexpr int I_F1 = (D / 64) * (2 * FF / 32), I_F2 = (FF / 64) * (D / 32), I_QKV = (D / 64) * (3072 / 32), I_SQ = (D / 64) * (D / 32), I_G1 = (D / 64) * (256 / 32), I_G2 = (256 / 64) * (D / 32);
    constexpr int N_FFN = 8 * (I_F1 + I_F2), N_ATT = 2 * (I_QKV + I_SQ), N_RW = 2 * (4 * I_SQ + I_G1 + I_G2);
    constexpr int NITEMS = N_FFN + N_ATT + N_RW;
    for (int it = gw; it < NITEMS; it += NGW) {
        int r = it;
        if (r < N_FFN) { const int lh = r / (I_F1 + I_F2); r -= lh * (I_F1 + I_F2);
            bf16_t* base = WB + (size_t)lh * (E_F1 + E_F2);
            if (r < I_F1) cvt_item(a->in[8] + (size_t)lh * D * 2 * FF, D, 2 * FF, base, 1, 0, scr, r, lane_);
            else cvt_item(a->in[9] + (size_t)lh * FF * D, FF, D, base + E_F1, 0, 0, scr, r - I_F1, lane_);
            continue; }
        r -= N_FFN;
        if (r < N_ATT) { const int j = r / (I_QKV + I_SQ); r -= j * (I_QKV + I_SQ);
            bf16_t* base = WA + (size_t)j * (E_QKV + E_SQ);
            if (r < I_QKV) cvt_item(a->in[10] + (size_t)j * D * 3072, D, 3072, base, 0, 0, scr, r, lane_);
            else cvt_item(a->in[11] + (size_t)j * D * D, D, D, base + E_QKV, 0, 0, scr, r - I_QKV, lane_);
            continue; }
        r -= N_ATT;
        { const int per = 4 * I_SQ + I_G1 + I_G2; const int j = r / per; r -= j * per;
          bf16_t* rw1 = WR + (size_t)j * (E_RW1 + E_RW2 + E_SQ); bf16_t* rw2 = rw1 + E_RW1; bf16_t* ro = rw2 + E_RW2;
          if (r < 3 * I_SQ) { const int q = r / I_SQ; cvt_item(a->in[15] + ((size_t)j * 3 + q) * D * D, D, D, rw1, 2, q * 2048, scr, r - q * I_SQ, lane_); continue; }
          r -= 3 * I_SQ;
          if (r < I_SQ) { cvt_item(a->in[16] + (size_t)j * D * D, D, D, ro, 0, 0, scr, r, lane_); continue; }
          r -= I_SQ;
          if (r < I_G1) { cvt_item(a->in[17] + (size_t)j * D * 256, D, 256, rw1, 2, 6144, scr, r, lane_); continue; }
          r -= I_G1;
          cvt_item(a->in[18] + (size_t)j * 256 * D, 256, D, rw2, 2, 0, scr, r, lane_); }
    }
    {
        constexpr int P_A = 256 * 2048 / 2, P_C = 4096 * 256 / 2, P_J = 2 * P_A + 2 * P_C;
        for (int p = F.bid * NTHR + tid_; p < 2 * P_J; p += F.G * NTHR) {
            const int j = p / P_J; int r = p - j * P_J;
            bf16_t* rw1 = WR + (size_t)j * (E_RW1 + E_RW2 + E_SQ); bf16_t* rw2 = rw1 + E_RW1;
            if (r < 2 * P_A) { const int which = r / P_A; r -= which * P_A;
                const int rho = r / 1024, k = (r - rho * 1024) * 2, c = hp_col(rho);
                const float* src = (which == 0 ? a->in[20] : a->in[23]);
                float v0 = 0.f, v1 = 0.f;
                if (c < 192) { const int d = c / 96, jj = c - d * 96; const float* s = src + (((size_t)j * 2 + d) * D + k) * 96 + jj; v0 = s[0]; v1 = s[96]; }
                *(unsigned*)(rw1 + (size_t)(6400 + 256 * which + rho) * D + k) = pk2(v0, v1);
            } else { r -= 2 * P_A; const int which = r / P_C; r -= which * P_C;
                const int nrow = r / 128, k = (r - nrow * 128) * 2;
                const int d = nrow >> 11, np = nrow & 2047, c = (np & ~255) + hp_col(np & 255);
                const float* src = (which == 0 ? a->in[21] : a->in[24]);
                float v0 = 0.f, v1 = 0.f;
                if (k < 192 && (k / 96) == d) { const int kk = k - d * 96; const float* s = src + (((size_t)j * 2 + d) * 96 + kk) * D + c; v0 = s[0]; v1 = s[D]; }
                *(unsigned*)(rw2 + (size_t)(2048 + 4096 * which + nrow) * 256 + k) = pk2(v0, v1);
            }
        }
    }
#ifdef DBG_FILL_WS
    {
        u32x4* p = (u32x4*)(a->ws + WS_X); const size_t n16 = (WS_END - WS_X) / 16;
        for (size_t i = (size_t)F.bid * NTHR + tid_; i < n16; i += (size_t)F.G * NTHR) p[i] = (u32x4){0xAAAAAAAAu, 0xAAAAAAAAu, 0xAAAAAAAAu, 0xAAAAAAAAu};
    }
#endif
    {
        float* COS = (float*)(a->ws + WS_ROPE); float* SIN = COS + 4096 * 64;
        for (int p = F.bid * NTHR + tid_; p < 4096 * 64; p += F.G * NTHR) {
            const int t = p >> 6, f = p & 63; const int pos = f < 32 ? (t >> 6) : (t & 63); const int fi = f & 31;
            const float inv = exp2f(-(float)fi * (13.287712379549449f / 32.0f));
            const float ang = (float)pos * inv;
            COS[p] = cosf(ang); SIN[p] = sinf(ang);
        }
    }
    {
        LAS float* sv = (LAS float*)F.lds;
        LAS float* part = (LAS float*)(F.lds + 65536);
        float* MOD = (float*)(a->ws + WS_MOD);
        __syncthreads();
        for (int idx = tid_; idx < 5 * D; idx += NTHR) { const int cc = idx >> 11, kk = idx & 2047; const float x = cc < 4 ? a->in[1][cc * D + kk] : a->in[3][kk]; sv[kk * 8 + cc] = fsilu(x); }
        __syncthreads();
        for (int u = F.bid; u < 4 * 72; u += F.G) {
            const int l = u / 72, nb = u - l * 72;
            const int n = nb * 256 + lane_ * 4, k0 = F.wave * 256;
            const float* wp = a->in[4] + ((size_t)l * D + k0) * 18432 + n;
            f32x4 acc[5];
#pragma unroll
            for (int c = 0; c < 5; ++c) acc[c] = (f32x4){0.f, 0.f, 0.f, 0.f};
#pragma unroll 8
            for (int kk = 0; kk < 256; ++kk) { const f32x4 w4 = *(const f32x4*)(wp + (size_t)kk * 18432);
                const f32x4 s4 = *(const LAS f32x4*)(sv + (k0 + kk) * 8); const float s5 = sv[(k0 + kk) * 8 + 4];
                acc[0] += w4 * s4[0]; acc[1] += w4 * s4[1]; acc[2] += w4 * s4[2]; acc[3] += w4 * s4[3]; acc[4] += w4 * s5; }
#pragma unroll
            for (int c = 0; c < 5; ++c) *(LAS f32x4*)(part + (F.wave * 5 + c) * 256 + lane_ * 4) = acc[c];
            __syncthreads();
            for (int o = tid_; o < 5 * 256; o += NTHR) { const int c = o >> 8, col = o & 255; float s = a->in[5][(size_t)l * 18432 + nb * 256 + col];
#pragma unroll
                for (int w = 0; w < 8; ++w) s += part[(w * 5 + c) * 256 + col];
                MOD[((size_t)l * 5 + c) * 18432 + nb * 256 + col] = s; }
            __syncthreads();
        }
    }
}

template <int MODE> struct ThinCtx { float PA[4][8], PB[4][8], PC[4][8]; int cur_c; };
template <int MODE>
__device__ __forceinline__ void thin_row(ThinCtx<MODE>& T, KArgs* a, const int lane, const int m, int l, int s, float wgt, int nl, int ns) {
    const float* MOD = (const float*)(a->ws + WS_MOD);
    float* X = (float*)(a->ws + WS_X); bf16_t* Y = (bf16_t*)(a->ws + WS_Y); const bf16_t* OUT = (const bf16_t*)(a->ws + WS_OUT);
    const int b = m / TB, j = m - b * TB, c = j < CTXL ? 4 : b;
    if (MODE == 2 && c == 4) return;
    if (c != T.cur_c) {
        T.cur_c = c;
#pragma unroll
        for (int q = 0; q < 4; ++q) { const int e0 = 512 * q + 8 * lane;
            if (MODE != 0) { const float* gp = MOD + (((size_t)l * 5 + c) * 9 + s * 3 + 2) * D + e0; const float* np = a->in[7] + ((size_t)l * 3 + s) * D + e0;
#pragma unroll
                for (int i = 0; i < 8; ++i) T.PA[q][i] = wgt * gp[i] * np[i]; }
            if (MODE != 2) { const float* sc = MOD + (((size_t)nl * 5 + c) * 9 + ns * 3 + 1) * D + e0; const float* sh = MOD + (((size_t)nl * 5 + c) * 9 + ns * 3 + 0) * D + e0; const float* np = a->in[6] + ((size_t)nl * 3 + ns) * D + e0;
#pragma unroll
                for (int i = 0; i < 8; ++i) { T.PB[q][i] = np[i] * (1.0f + sc[i]); T.PC[q][i] = sh[i]; } } }
    }
    float x[4][8];
    if (MODE == 0) {
        const float* src = j < CTXL ? a->in[2] + ((size_t)b * CTXL + j) * D : a->in[0] + ((size_t)b * SEQ + (j - CTXL)) * D;
#pragma unroll
        for (int q = 0; q < 4; ++q) { const f32x4 v0 = *(const f32x4*)(src + 512 * q + 8 * lane), v1 = *(const f32x4*)(src + 512 * q + 8 * lane + 4);
#pragma unroll
            for (int e = 0; e < 4; ++e) { x[q][e] = v0[e]; x[q][4 + e] = v1[e]; } }
    } else {
        float o[4][8]; float ss = 0.f;
#pragma unroll
        for (int q = 0; q < 4; ++q) { unpack8(*(const u32x4*)(OUT + (size_t)m * D + 512 * q + 8 * lane), o[q]);
#pragma unroll
            for (int i = 0; i < 8; ++i) ss += o[q][i] * o[q][i]; }
        ss = wave_sum(ss);
        const float r1 = rsqrtf(ss * (1.0f / D) + NORM_EPS);
#pragma unroll
        for (int q = 0; q < 4; ++q) { const f32x4 v0 = *(const f32x4*)(X + (size_t)m * D + 512 * q + 8 * lane), v1 = *(const f32x4*)(X + (size_t)m * D + 512 * q + 8 * lane + 4);
#pragma unroll
            for (int e = 0; e < 4; ++e) { x[q][e] = v0[e] + T.PA[q][e] * (o[q][e] * r1); x[q][4 + e] = v1[e] + T.PA[q][4 + e] * (o[q][4 + e] * r1); } }
    }
    if (MODE == 2) {
        float* dst = a->out + ((size_t)b * SEQ + (j - CTXL)) * D;
#pragma unroll
        for (int q = 0; q < 4; ++q) { *(f32x4*)(dst + 512 * q + 8 * lane) = (f32x4){x[q][0], x[q][1], x[q][2], x[q][3]}; *(f32x4*)(dst + 512 * q + 8 * lane + 4) = (f32x4){x[q][4], x[q][5], x[q][6], x[q][7]}; }
        return;
    }
    float ss2 = 0.f;
#pragma unroll
    for (int q = 0; q < 4; ++q) { *(f32x4*)(X + (size_t)m * D + 512 * q + 8 * lane) = (f32x4){x[q][0], x[q][1], x[q][2], x[q][3]}; *(f32x4*)(X + (size_t)m * D + 512 * q + 8 * lane + 4) = (f32x4){x[q][4], x[q][5], x[q][6], x[q][7]};
#pragma unroll
        for (int i = 0; i < 8; ++i) ss2 += x[q][i] * x[q][i]; }
    ss2 = wave_sum(ss2);
    const float r2 = rsqrtf(ss2 * (1.0f / D) + NORM_EPS);
#pragma unroll
    for (int q = 0; q < 4; ++q) { float y[8];
#pragma unroll
        for (int i = 0; i < 8; ++i) y[i] = (x[q][i] * r2) * T.PB[q][i] + T.PC[q][i];
        *(u32x4*)(Y + (size_t)m * D + 512 * q + 8 * lane) = pack8(y); }
}
template <int MODE, int ROWSET>
__device__ __forceinline__ void thin_phase(const Frame F, KArgs* a, int l, int s, float wgt, int nl, int ns) {
    const int lane_ = lane_opaque();
    ThinCtx<MODE> T; T.cur_c = -1;
    if (ROWSET == 0) {
        for (int ch = F.bid; ch < M / 68; ch += F.G) {
            const int r0 = ch * 68 + (F.wave < 4 ? 9 * F.wave : 36 + 8 * (F.wave - 4)), nr = F.wave < 4 ? 9 : 8;
            for (int r = 0; r < nr; ++r) thin_row<MODE>(T, a, lane_, r0 + r, l, s, wgt, nl, ns);
        }
    } else if (ROWSET == 1) {
        const int nw = (F.G - 32) * NWAVES, wv = (F.bid - 32) * NWAVES + F.wave;
        const int l0 = (int)(((long)wv * (NB * SEQ)) / nw), l1 = (int)(((long)(wv + 1) * (NB * SEQ)) / nw);
        for (int li = l0; li < l1; ++li) thin_row<MODE>(T, a, lane_, (li >> 12) * TB + CTXL + (li & (SEQ - 1)), l, s, wgt, nl, ns);
    } else {
        for (int c = F.bid * NWAVES + F.wave; c < NB * CTXL; c += F.G * NWAVES) thin_row<MODE>(T, a, lane_, (c >> 8) * TB + (c & (CTXL - 1)), l, s, wgt, nl, ns);
    }
}
struct LatentOrder : pg8::StaticOrder {
    __device__ void init_lat(int N, int G_, int c_) { init(64 * 256, N, G_, c_); }
    __device__ bool next(int i, Unit& u) const { if (!pg8::StaticOrder::next(i, u)) return false; u.pm = u.pm + (u.pm >> 4) + 1; return true; }
};
struct CtxOrder {
    int c;
    __device__ bool next(int i, Unit& u) const { if (i != 0 || c >= 32) return false; u.pm = (c >> 3) * 17; u.pn = c & 7; return true; }
    __device__ __forceinline__ void a_ready(const Unit&) const {}
    __device__ __forceinline__ void done(const Unit&) const {}
};
#ifndef DBG_DUMP_OFF
#define DBG_DUMP_OFF WS_X
#define DBG_DUMP_F32 1
#endif
__device__ __forceinline__ void copyout_phase(const Frame F, KArgs* a) {
    const int lane_ = lane_opaque();
    for (int m = F.bid * NWAVES + F.wave; m < M; m += F.G * NWAVES) { const int b = m / TB, j = m - b * TB; if (j < CTXL) continue;
        float* dst = a->out + ((size_t)b * SEQ + (j - CTXL)) * D;
#if defined(DBG_DUMP_P256)
        { const size_t offs[] = {DBG_DUMP_P256}; constexpr int NL = sizeof(offs) / sizeof(offs[0]);
          for (int q = 0; q < 4; ++q) { float acc[8], v[8]; for (int e = 0; e < 8; ++e) acc[e] = 0.f;
              if (q == 0 && lane_ < 32) { for (int t = 0; t < NL; ++t) { unpack8(*(const u32x4*)((const bf16_t*)(a->ws + offs[t]) + (size_t)m * 256 + 8 * lane_), v); for (int e = 0; e < 8; ++e) acc[e] += (1.f + t) * v[e]; } }
              *(f32x4*)(dst + 512 * q + 8 * lane_) = (f32x4){acc[0], acc[1], acc[2], acc[3]}; *(f32x4*)(dst + 512 * q + 8 * lane_ + 4) = (f32x4){acc[4], acc[5], acc[6], acc[7]}; }
          continue; }
#endif
#ifndef DBG_DUMP_W
#define DBG_DUMP_W(t) (1.f + (t))
#endif
#if defined(DBG_DUMP_LIST)
        { const size_t offs[] = {DBG_DUMP_LIST}; constexpr int NL = sizeof(offs) / sizeof(offs[0]);
#pragma unroll
          for (int q = 0; q < 4; ++q) { const size_t ro = (size_t)m * D + 512 * q + 8 * lane_; float acc[8], v[8];
              for (int e = 0; e < 8; ++e) acc[e] = 0.f;
#pragma unroll
              for (int t = 0; t < NL; ++t) { unpack8(*(const u32x4*)((const bf16_t*)(a->ws + offs[t]) + ro), v); for (int e = 0; e < 8; ++e) acc[e] += DBG_DUMP_W(t) * v[e]; }
              *(f32x4*)(dst + 512 * q + 8 * lane_) = (f32x4){acc[0], acc[1], acc[2], acc[3]}; *(f32x4*)(dst + 512 * q + 8 * lane_ + 4) = (f32x4){acc[4], acc[5], acc[6], acc[7]}; }
          continue; }
#endif
        if (DBG_DUMP_F32) { const float* X = (const float*)(a->ws + (DBG_DUMP_OFF));
#pragma unroll
            for (int q = 0; q < 8; ++q) *(f32x4*)(dst + 256 * q + 4 * lane_) = *(const f32x4*)(X + (size_t)m * D + 256 * q + 4 * lane_); }
        else { const bf16_t* Bq = (const bf16_t*)(a->ws + (DBG_DUMP_OFF));
#pragma unroll
            for (int q = 0; q < 4; ++q) { float v[8]; unpack8(*(const u32x4*)(Bq + (size_t)m * D + 512 * q + 8 * lane_), v);
                *(f32x4*)(dst + 512 * q + 8 * lane_) = (f32x4){v[0], v[1], v[2], v[3]}; *(f32x4*)(dst + 512 * q + 8 * lane_ + 4) = (f32x4){v[4], v[5], v[6], v[7]}; } }
    }
}

__device__ __forceinline__ void mixes_phase(const Frame F, KArgs* a, int jr) {
    const int lane_ = lane_opaque(), tid_ = F.wave * 64 + lane_; (void)tid_; (void)lane_;
    const bf16_t* Y = (const bf16_t*)(a->ws + WS_Y); bf16_t* MIX = (bf16_t*)(a->ws + WS_MIX6);
    const int rg = F.wave >> 2, e0 = 512 * (F.wave & 3) + 8 * lane_;
    float mu[6][8];
    { const int muidx[6] = {0, 2, 3, 5, 1, 4};
#pragma unroll
      for (int q = 0; q < 6; ++q) { const float* mp = a->in[14] + ((size_t)jr * 6 + muidx[q]) * D + e0;
#pragma unroll
          for (int i = 0; i < 8; ++i) mu[q][i] = mp[i]; } }
    for (int ch = F.bid; ch < M / 68; ch += F.G) {
        const int r0 = ch * 68 + 34 * rg;
        float yp[8], yc[8], yn[8];
        if (r0 > 0) unpack8(*(const u32x4*)(Y + (size_t)(r0 - 1) * D + e0), yp); else {
#pragma unroll
            for (int i = 0; i < 8; ++i) yp[i] = 0.f; }
        unpack8(*(const u32x4*)(Y + (size_t)r0 * D + e0), yc);
        for (int r = 0; r < 34; ++r) { const int m = r0 + r, j = m % TB;
            if (m + 1 < M) unpack8(*(const u32x4*)(Y + (size_t)(m + 1) * D + e0), yn); else {
#pragma unroll
                for (int i = 0; i < 8; ++i) yn[i] = 0.f; }
            const float pv = (j != 0 && j != CTXL) ? 0.5f : 0.f, nv = (j != CTXL - 1 && j != TB - 1) ? 0.5f : 0.f;
            float xx[8];
#pragma unroll
            for (int i = 0; i < 8; ++i) xx[i] = (pv * yp[i] + nv * yn[i]) - yc[i];
#pragma unroll
            for (int q = 0; q < 6; ++q) { float o[8];
#pragma unroll
                for (int i = 0; i < 8; ++i) o[i] = yc[i] + xx[i] * mu[q][i];
                *(u32x4*)(MIX + (size_t)q * M * D + (size_t)m * D + e0) = pack8(o); }
#pragma unroll
            for (int i = 0; i < 8; ++i) { yp[i] = yc[i]; yc[i] = yn[i]; }
        }
    }
}

__device__ __forceinline__ void qknorm_phase(const Frame F, KArgs* a, int ja) {
    const int lane_ = lane_opaque(), tid_ = F.wave * 64 + lane_; (void)tid_; (void)lane_;
    bf16_t* Q = (bf16_t*)(a->ws + WS_Q); bf16_t* K = (bf16_t*)(a->ws + WS_K);
    const float* COS = (const float*)(a->ws + WS_ROPE); const float* SIN = COS + 4096 * 64;
    const int li = lane_ & 15, hs = lane_ >> 4;
    float gq[8], gk[8];
#pragma unroll
    for (int i = 0; i < 8; ++i) { gq[i] = a->in[12][ja * 128 + 8 * li + i]; gk[i] = a->in[13][ja * 128 + 8 * li + i]; }
    for (int m = F.bid * NWAVES + F.wave; m < M; m += F.G * NWAVES) {
        const int j = m % TB; const bool lat = j >= CTXL; const int pos = lat ? j - CTXL : 0;
        f32x4 cs = (f32x4){1.f, 1.f, 1.f, 1.f}, sn = (f32x4){0.f, 0.f, 0.f, 0.f};
        if (lat) { cs = *(const f32x4*)(COS + (size_t)pos * 64 + 4 * li); sn = *(const f32x4*)(SIN + (size_t)pos * 64 + 4 * li); }
#pragma unroll
        for (int p = 0; p < 5; ++p) {
            bf16_t* ptr = p < 4 ? Q + (size_t)m * D + (4 * p + hs) * 128 + 8 * li : K + (size_t)m * 512 + hs * 128 + 8 * li;
            float v[8]; unpack8(*(const u32x4*)ptr, v);
            float ss = 0.f;
#pragma unroll
            for (int i = 0; i < 8; ++i) ss += v[i] * v[i];
            ss = sum16(ss);
            const float rs = rsqrtf(ss * (1.0f / 128.0f) + NORM_EPS);
            float o[8];
#pragma unroll
            for (int i = 0; i < 4; ++i) { const float x1 = v[2 * i] * rs * (p < 4 ? gq[2 * i] : gk[2 * i]), x2 = v[2 * i + 1] * rs * (p < 4 ? gq[2 * i + 1] : gk[2 * i + 1]);
                o[2 * i] = x1 * cs[i] - x2 * sn[i]; o[2 * i + 1] = x1 * sn[i] + x2 * cs[i]; }
            *(u32x4*)ptr = pack8(o);
        }
    }
}

template <int R> __device__ __forceinline__ float ror16(float x) { return __builtin_bit_cast(float, __builtin_amdgcn_mov_dpp(__builtin_bit_cast(int, x), 0x120 + R, 0xF, 0xF, true)); }
__device__ __forceinline__ float sum_row16(float x) { x += ror16<8>(x); x += ror16<4>(x); x += ror16<2>(x); x += ror16<1>(x); return x; }
__device__ __forceinline__ float sum_rows(float x) {
    x += ror16<8>(x);
    { const unsigned u = __builtin_bit_cast(unsigned, x); auto rr = __builtin_amdgcn_permlane16_swap(u, u, false, false); const unsigned r0 = rr[0], r1 = rr[1];
      x = __builtin_bit_cast(float, r0) + __builtin_bit_cast(float, r1); }
    { const unsigned u = __builtin_bit_cast(unsigned, x); auto rr = __builtin_amdgcn_permlane32_swap(u, u, false, false); const unsigned r0 = rr[0], r1 = rr[1];
      x = __builtin_bit_cast(float, r0) + __builtin_bit_cast(float, r1); }
    return x;
}
__device__ __forceinline__ void scan_phase(const Frame F, KArgs* a, int jr) {
    const int lane_ = lane_opaque(), tid_ = F.wave * 64 + lane_; (void)tid_; (void)lane_;
    LAS float* L = (LAS float*)F.lds;
    constexpr int BUF = 32 * 384, YB0 = 2 * BUF, YBUF = 32 * 64;
    const int tid = tid_, lane = lane_, li4 = (lane & 15) * 4, vrow = 8 * F.wave + 2 * (lane >> 4);
    const float* WDEC = (const float*)(a->ws + WS_WDEC);
    const bf16_t* KR = (const bf16_t*)(a->ws + WS_KK_); const bf16_t* AA = (const bf16_t*)(a->ws + WS_AA);
    const bf16_t* KN = (const bf16_t*)(a->ws + WS_KN); const bf16_t* RR = (const bf16_t*)(a->ws + WS_RR); const bf16_t* VV = (const bf16_t*)(a->ws + WS_VV);
    bf16_t* YS = (bf16_t*)(a->ws + WS_YS);
    for (int chain = F.bid; chain < 256; chain += F.G) {
        const int b = chain >> 6, h = (chain >> 1) & 31, dir = chain & 1;
        const size_t doff = (size_t)dir * M * D;
        const int hc = h * 64;
        const int lrow = (tid & 255) >> 3, lpart = tid & 7, wrow = tid >> 4, wpart = tid & 15; const bool lo = tid < 256;
        const bf16_t* pa = (lo ? KR : RR) + hc + lpart * 8; const bf16_t* pb = (lo ? KN : VV) + hc + lpart * 8; const bf16_t* pc = AA + doff + hc + lpart * 8;
        float ka[8];
#pragma unroll
        for (int i = 0; i < 8; ++i) ka[i] = a->in[26][(size_t)jr * D + hc + lpart * 8 + i];
        const float* pw = WDEC + doff + hc + wpart * 4;
        u32x4 ra, rb, rc; f32x4 rw;
        f32x2 S2[4];
#pragma unroll
        for (int i = 0; i < 4; ++i) S2[i] = (f32x2){0.f, 0.f};
#define SCAN_M0(q) (b * TB + (dir == 0 ? 32 * (q) : ((q) < 8 ? 224 - 32 * (q) : 4576 - 32 * (q))))
#define SCAN_LOAD(q) do { const size_t m0_ = (size_t)SCAN_M0(q); ra = *(const u32x4*)(pa + (m0_ + lrow) * D); rb = *(const u32x4*)(pb + (m0_ + lrow) * D); if (lo) rc = *(const u32x4*)(pc + (m0_ + lrow) * D); \
        rw = *(const f32x4*)(pw + (m0_ + wrow) * D); } while (0)
#define SCAN_ST8(off_, t_) do { *(LAS f32x4*)(d_ + (off_)) = (f32x4){t_[0], t_[1], t_[2], t_[3]}; *(LAS f32x4*)(d_ + (off_) + 4) = (f32x4){t_[4], t_[5], t_[6], t_[7]}; } while (0)
#define SCAN_WRITE(bufi) do { LAS float* d_ = L + (bufi) * BUF + lrow * 384 + lpart * 8; float ta_[8], tb_[8]; \
        unpack8(ra, ta_); unpack8(rb, tb_); \
        if (lo) { float tc_[8], kd_[8], bb_[8]; unpack8(rc, tc_); _Pragma("unroll") for (int i_ = 0; i_ < 8; ++i_) { kd_[i_] = ta_[i_] * (1.0f + (tc_[i_] - 1.0f) * ka[i_]); bb_[i_] = tb_[i_] * tc_[i_]; } \
            SCAN_ST8(64, kd_); SCAN_ST8(128, bb_); SCAN_ST8(192, tb_); } \
        else { SCAN_ST8(256, ta_); SCAN_ST8(320, tb_); } \
        *(LAS f32x4*)(L + (bufi) * BUF + wrow * 384 + wpart * 4) = rw; } while (0)
        __syncthreads();
        SCAN_LOAD(0); SCAN_WRITE(0); __syncthreads();
        for (int q = 0; q < 136; ++q) {
            const int bi = q & 1;
            if (q + 1 < 136) SCAN_LOAD(q + 1);
            const LAS float* base = L + bi * BUF + (dir ? 31 * 384 : 0); const int stp = dir ? -384 : 384;
            LAS float* yb = L + YB0 + bi * YBUF + (dir ? 31 * 64 : 0) + vrow; const int ystp = dir ? -64 : 64;
#define SUM2_ROW16(a_, b_) asm volatile("s_nop 1\n\t" \
    "v_add_f32_dpp %0, %0, %0 row_ror:8 row_mask:0xf bank_mask:0xf\n\tv_add_f32_dpp %1, %1, %1 row_ror:8 row_mask:0xf bank_mask:0xf\n\ts_nop 0\n\t" \
    "v_add_f32_dpp %0, %0, %0 row_ror:4 row_mask:0xf bank_mask:0xf\n\tv_add_f32_dpp %1, %1, %1 row_ror:4 row_mask:0xf bank_mask:0xf\n\ts_nop 0\n\t" \
    "v_add_f32_dpp %0, %0, %0 row_ror:2 row_mask:0xf bank_mask:0xf\n\tv_add_f32_dpp %1, %1, %1 row_ror:2 row_mask:0xf bank_mask:0xf\n\ts_nop 0\n\t" \
    "v_add_f32_dpp %0, %0, %0 row_ror:1 row_mask:0xf bank_mask:0xf\n\tv_add_f32_dpp %1, %1, %1 row_ror:1 row_mask:0xf bank_mask:0xf\n\ts_nop 1" : "+v"(a_), "+v"(b_))
            f32x4 nw4 = *(const LAS f32x4*)(base + li4), nd4 = *(const LAS f32x4*)(base + 64 + li4), nb4 = *(const LAS f32x4*)(base + 128 + li4), nn4 = *(const LAS f32x4*)(base + 192 + li4), nr4 = *(const LAS f32x4*)(base + 256 + li4);
            f32x2 nv2 = *(const LAS f32x2*)(base + 320 + vrow);
#pragma unroll 4
            for (int s = 0; s < 32; ++s) {
                const f32x4 w4 = nw4, d4 = nd4, b4 = nb4, n4 = nn4, r4 = nr4; const f32x2 v2 = nv2;
                { const LAS float* p = base + (s < 31 ? s + 1 : s) * stp;
                  nw4 = *(const LAS f32x4*)(p + li4); nd4 = *(const LAS f32x4*)(p + 64 + li4); nb4 = *(const LAS f32x4*)(p + 128 + li4); nn4 = *(const LAS f32x4*)(p + 192 + li4); nr4 = *(const LAS f32x4*)(p + 256 + li4);
                  nv2 = *(const LAS f32x2*)(p + 320 + vrow); }
                f32x2 pk = S2[0] * n4[0]; pk = S2[1] * n4[1] + pk; pk = S2[2] * n4[2] + pk; pk = S2[3] * n4[3] + pk;
                SUM2_ROW16(pk.x, pk.y); const f32x2 nsk = -pk;
#pragma unroll
                for (int qq = 0; qq < 4; ++qq) S2[qq] = S2[qq] * w4[qq] + (v2 * d4[qq] + nsk * b4[qq]);
                f32x2 yk = S2[0] * r4[0]; yk = S2[1] * r4[1] + yk; yk = S2[2] * r4[2] + yk; yk = S2[3] * r4[3] + yk;
                SUM2_ROW16(yk.x, yk.y);
                if ((lane & 15) == 0) *(LAS f32x2*)(yb + s * ystp) = yk;
            }
#undef SUM2_ROW16
            if (q + 1 < 136) SCAN_WRITE(bi ^ 1);
            __syncthreads();
            if (tid < 256) { const LAS float* ys = L + YB0 + bi * YBUF + lrow * 64 + lpart * 8; float t[8];
                const f32x4 y0 = *(const LAS f32x4*)ys, y1 = *(const LAS f32x4*)(ys + 4);
#pragma unroll
                for (int e = 0; e < 4; ++e) { t[e] = y0[e]; t[4 + e] = y1[e]; }
                *(u32x4*)(YS + doff + ((size_t)SCAN_M0(q) + lrow) * D + hc + lpart * 8) = pack8(t); }
        }
        __syncthreads();
#undef SCAN_M0
#undef SCAN_LOAD
#undef SCAN_WRITE
#undef SCAN_ST8
    }
}

__device__ __forceinline__ void outprep_phase(const Frame F, KArgs* a, int jr) {
    const int lane_ = lane_opaque(), tid_ = F.wave * 64 + lane_; (void)tid_; (void)lane_;
    const bf16_t* YS = (const bf16_t*)(a->ws + WS_YS); const bf16_t* AA = (const bf16_t*)(a->ws + WS_AA); const bf16_t* KR = (const bf16_t*)(a->ws + WS_KK_);
    const bf16_t* RR = (const bf16_t*)(a->ws + WS_RR); const bf16_t* VV = (const bf16_t*)(a->ws + WS_VV); const bf16_t* GG = (const bf16_t*)(a->ws + WS_GG);
    bf16_t* PREP = (bf16_t*)(a->ws + WS_PREP);
    const float* lw = a->in[28] + (size_t)jr * D; const float* lb = a->in[29] + (size_t)jr * D; const float* rk = a->in[27] + (size_t)jr * D; const float* kav = a->in[26] + (size_t)jr * D;
    for (int m = F.bid * NWAVES + F.wave; m < M; m += F.G * NWAVES) {
#pragma unroll
        for (int q = 0; q < 4; ++q) { const int e0 = 512 * q + 8 * lane_; const size_t ro = (size_t)m * D + e0;
            float y0[8], y1[8], o[8];
            unpack8(*(const u32x4*)(YS + ro), y0); unpack8(*(const u32x4*)(YS + (size_t)M * D + ro), y1);
            float sm = 0.f;
#pragma unroll
            for (int i = 0; i < 8; ++i) { o[i] = y0[i] + y1[i]; sm += o[i]; }
            const float mean = sum8(sm) * (1.0f / 64.0f);
            float sq = 0.f;
#pragma unroll
            for (int i = 0; i < 8; ++i) { o[i] -= mean; sq += o[i] * o[i]; }
            const float rs = rsqrtf(sum8(sq) * (1.0f / 64.0f) + 64e-5f);
            float r[8], k0[8], k1[8], kr[8], v[8], g[8];
            unpack8(*(const u32x4*)(RR + ro), r); unpack8(*(const u32x4*)(AA + ro), k0); unpack8(*(const u32x4*)(AA + (size_t)M * D + ro), k1); unpack8(*(const u32x4*)(KR + ro), kr);
            unpack8(*(const u32x4*)(VV + ro), v); unpack8(*(const u32x4*)(GG + ro), g);
            float bs = 0.f;
#pragma unroll
            for (int i = 0; i < 8; ++i) bs += r[i] * (kr[i] * (2.0f + (k0[i] + k1[i] - 2.0f) * kav[e0 + i])) * rk[e0 + i];
            bs = sum8(bs);
            float out[8];
#pragma unroll
            for (int i = 0; i < 8; ++i) out[i] = (o[i] * rs * lw[e0 + i] + lb[e0 + i] + bs * v[i]) * g[i];
            *(u32x4*)(PREP + ro) = pack8(out); }
    }
}

__device__ __forceinline__ void attention_phase(const Frame F, KArgs* a) {
    const attn::bf16* Q = (const attn::bf16*)(a->ws + WS_Q); const attn::bf16* K = (const attn::bf16*)(a->ws + WS_K); const attn::bf16* V = (const attn::bf16*)(a->ws + WS_V);
    attn::bf16* O = (attn::bf16*)(a->ws + WS_O);
    for (int u = F.bid; u < 1024 + 64; u += F.G) {
        size_t qoff, koff; int seq;
        if (u < 1024) { const int c = u & 255, i = u >> 8, grp = (c & 7) >> 1, member = (c & 1) * 32 + (c >> 3), bk = i * 4 + grp, b = bk >> 2, kvh = bk & 3, hq = kvh * 4 + (member >> 4), qb = member & 15;
            qoff = (size_t)(b * TB + CTXL + qb * 256) * 2048 + hq * 128; koff = (size_t)b * TB * 512 + kvh * 128; seq = TB; }
        else { const int cu = u - 1024, b = cu >> 4, hq = cu & 15, kvh = hq >> 2;
            qoff = (size_t)(b * TB) * 2048 + hq * 128; koff = (size_t)b * TB * 512 + kvh * 128; seq = CTXL; }
        attn::attn_dense_body<attn::bf16>(Q + qoff, K + koff, V + koff, O + qoff, seq, (char*)F.ldsg, F.wave);
        __syncthreads();
    }
}

#ifndef EN_P0
#define EN_P0 1
#endif
#ifndef EN_THIN
#define EN_THIN 1
#endif
#ifndef EN_QKN
#define EN_QKN 1
#endif
#ifndef EN_ATT
#define EN_ATT 1
#endif
#ifndef EN_MIX
#define EN_MIX 1
#endif
#ifndef EN_SCAN
#define EN_SCAN 1
#endif
#ifndef EN_OPREP
#define EN_OPREP 1
#endif
#ifndef EN_FFN
#define EN_FFN 1
#endif
#ifndef EN_GQKV
#define EN_GQKV 1
#endif
#ifndef EN_GWO
#define EN_GWO 1
#endif
#ifndef EN_RW1
#define EN_RW1 1
#endif
#ifndef EN_RW2
#define EN_RW2 1
#endif
__device__ __forceinline__ KArgs* opaque_k(KArgs* p) { asm volatile("" : "+s"(p)); return p; }
#ifndef DBG_STOP
#define DBG_STOP -1
#endif
__device__ __forceinline__ Frame fresh(const Frame& F) { Frame R = F; asm volatile("" : "+s"(R.bid), "+s"(R.G), "+s"(R.wave)); return R; }
#ifndef GEMM_ALIGN
#define GEMM_ALIGN true
#define GEMM_SP2 true
#endif
#ifndef RW2_ALIGN
#define RW2_ALIGN true
#define RW2_SP2 true
#endif
#ifndef RW1_ALIGN
#define RW1_ALIGN true
#define RW1_SP2 true
#endif
#ifndef REP_THIN
#define REP_THIN 1
#endif
#ifndef REP_OG
#define REP_OG 1
#endif
#ifndef REP_EW
#define REP_EW 1
#endif
#ifndef REP_FFN1
#define REP_FFN1 1
#endif
#ifndef REP_FFN2
#define REP_FFN2 1
#endif
#ifndef REP_P0
#define REP_P0 1
#endif
#ifndef REP_SCAN
#define REP_SCAN 1
#endif
#ifndef REP_ATT
#define REP_ATT 1
#endif
#ifndef REP_RW1
#define REP_RW1 1
#endif
constexpr int NPHASE = 50;
constexpr int STOP_PHASE = (DBG_STOP >= 0) ? DBG_STOP : NPHASE - 1;
__global__ void __launch_bounds__(NTHR, 2) fwd_kernel(Args args) {
    extern __shared__ __attribute__((aligned(16))) unsigned char lds[];
    Frame F;
    F.lds = (LAS unsigned char*)lds; F.ldsg = lds;
    F.wave = __builtin_amdgcn_readfirstlane((int)threadIdx.x >> 6);
    F.G = gridDim.x; F.bid = blockIdx.x;
    for (int u = threadIdx.x; u < (LDS_BYTES - LDSCTL_OFF) / 4; u += NTHR) ((LAS unsigned*)(F.lds + LDSCTL_OFF))[u] = 0u;
    __syncthreads();
    KArgs* const kap = (KArgs*)__builtin_amdgcn_kernarg_segment_ptr();
    XcdBarrier bar = xcd_barrier_post((unsigned*)(kap->ws + WS_CTL) + CW_BAR + kap->li * XCD_BAR_WORDS, (volatile LAS unsigned*)(F.lds + MISC_OFF) + 8);
#define KA (opaque_k(kap))
#define ws (KA->ws)
#define IN(k) ((k) <= STOP_PHASE)
#define SEAM(k) do { if (IN(k) && IN((k) + 1)) { XcdBarrier bb_ = bar; asm volatile("" : "+s"(bb_.x), "+s"(bb_.bar)); xcd_barrier(bb_, fresh(F).wave == 0 && lane_opaque() == 0); } } while (0)
#define Yb ((bf16_t*)(ws + WS_Y))
#define ACTb ((bf16_t*)(ws + WS_ACT))
#define OUTb ((bf16_t*)(ws + WS_OUT))
#define BAR_NOW() do { XcdBarrier bb_ = bar; asm volatile("" : "+s"(bb_.x), "+s"(bb_.bar)); xcd_barrier(bb_, fresh(F).wave == 0 && lane_opaque() == 0); } while (0)
#define FFN_HALF(pk, lh, FINAL, tl, ts, tw, tnl, tns) do { \
    for (int rep_ = 0; rep_ < REP_FFN1; ++rep_) { if (rep_) __syncthreads(); \
    if (EN_FFN && IN(pk)) { const Frame Ff_ = fresh(F); const bf16_t* w1_ = (const bf16_t*)(ws + WS_WB) + (size_t)(lh) * (E_F1 + E_F2); \
        pg8::Gemm g_{Yb, w1_, D}; EpiSwiGLU E_{ACTb}; \
        if (FINAL) { LatentOrder S_; S_.init_lat(2 * FF, Ff_.G, Ff_.bid); pg8::gemm_phase<EpiSwiGLU, LatentOrder, pg8::Gemm, GEMM_ALIGN, GEMM_SP2>(Ff_.lds, g_, S_, E_, Ff_.wave); } \
        else { pg8::StaticOrder S_; S_.init(M, 2 * FF, Ff_.G, Ff_.bid); pg8::gemm_phase<EpiSwiGLU, pg8::StaticOrder, pg8::Gemm, GEMM_ALIGN, GEMM_SP2>(Ff_.lds, g_, S_, E_, Ff_.wave); } } } \
    SEAM(pk); \
    for (int rep_ = 0; rep_ < REP_FFN2; ++rep_) { if (rep_) __syncthreads(); \
    if (EN_FFN && IN((pk) + 1)) { const Frame Ff_ = fresh(F); const bf16_t* w2_ = (const bf16_t*)(ws + WS_WB) + (size_t)(lh) * (E_F1 + E_F2) + E_F1; \
        pg8::Gemm g_{ACTb, w2_, FF}; LatentOrder S_; S_.init_lat(D, Ff_.G, Ff_.bid); EpiPlain E_{OUTb, D}; \
        pg8::gemm_phase<EpiPlain, LatentOrder, pg8::Gemm, GEMM_ALIGN, GEMM_SP2>(Ff_.lds, g_, S_, E_, Ff_.wave); } } \
    SEAM((pk) + 1); \
    if (IN((pk) + 2)) { const Frame Ff_ = fresh(F); \
        if (Ff_.bid < 32) { if (!(FINAL)) { const bf16_t* w2_ = (const bf16_t*)(ws + WS_WB) + (size_t)(lh) * (E_F1 + E_F2) + E_F1; \
            pg8::Gemm g_{ACTb, w2_, FF}; CtxOrder S_{Ff_.bid}; EpiPlain E_{OUTb, D}; \
            pg8::gemm_phase<EpiPlain, CtxOrder, pg8::Gemm, GEMM_ALIGN, GEMM_SP2>(Ff_.lds, g_, S_, E_, Ff_.wave); } } \
        else { for (int rt_ = 1; rt_ < REP_THIN; ++rt_) { if (!(FINAL)) thin_phase<1, 1>(Ff_, KA, tl, ts, 0.f, tnl, tns); } if (FINAL) thin_phase<2, 1>(Ff_, KA, tl, ts, tw, tnl, tns); else thin_phase<1, 1>(Ff_, KA, tl, ts, tw, tnl, tns); } \
        if (!(FINAL)) { BAR_NOW(); thin_phase<1, 2>(fresh(F), KA, tl, ts, tw, tnl, tns); } } \
    SEAM((pk) + 2); } while (0)

    for (int rep_ = 0; rep_ < REP_P0; ++rep_) { if (rep_) __syncthreads(); if (EN_P0 && IN(0)) p0a_phase(fresh(F), KA); }
    SEAM(0);
    if (EN_THIN && IN(1)) thin_phase<0, 0>(fresh(F), KA, 0, 0, 0.f, 0, 0);
    SEAM(1);
    for (int lp = 0; lp < 2; ++lp) {
        const int pb = 2 + 24 * lp, la = 2 * lp, lr = 2 * lp + 1;
        FFN_HALF(pb + 0, la * 2 + 0, 0, la, 0, 0.5f, la, 1);
        for (int rep_ = 0; rep_ < REP_OG; ++rep_) { if (rep_) __syncthreads();
        if (EN_GQKV && IN(pb + 3)) { const Frame Ff = fresh(F); const bf16_t* wq = (const bf16_t*)(ws + WS_WA) + (size_t)lp * (E_QKV + E_SQ);
            pg8::Gemm g{Yb, wq, D}; pg8::StaticOrder S; S.init(M, 3072, Ff.G, Ff.bid); EpiQKV E{ws};
            pg8::gemm_phase<EpiQKV, pg8::StaticOrder, pg8::Gemm, GEMM_ALIGN, GEMM_SP2>(Ff.lds, g, S, E, Ff.wave); } }
        SEAM(pb + 3);
        if (EN_QKN && IN(pb + 4)) qknorm_phase(fresh(F), KA, lp);
        SEAM(pb + 4);
        for (int rep_ = 0; rep_ < REP_ATT; ++rep_) { if (rep_) __syncthreads(); if (EN_ATT && IN(pb + 5)) attention_phase(fresh(F), KA); }
        SEAM(pb + 5);
        for (int rep_ = 0; rep_ < REP_OG; ++rep_) { if (rep_) __syncthreads();
        if (EN_GWO && IN(pb + 6)) { const Frame Ff = fresh(F); const bf16_t* wo = (const bf16_t*)(ws + WS_WA) + (size_t)lp * (E_QKV + E_SQ) + E_QKV;
            pg8::Gemm g{(const bf16_t*)(ws + WS_O), wo, D}; pg8::StaticOrder S; S.init(M, D, Ff.G, Ff.bid); EpiPlain E{OUTb, D};
            pg8::gemm_phase<EpiPlain, pg8::StaticOrder, pg8::Gemm, GEMM_ALIGN, GEMM_SP2>(Ff.lds, g, S, E, Ff.wave); } }
        SEAM(pb + 6);
        if (EN_THIN && IN(pb + 7)) thin_phase<1, 0>(fresh(F), KA, la, 1, 1.0f, la, 2);
        SEAM(pb + 7);
        FFN_HALF(pb + 8, la * 2 + 1, 0, la, 2, 0.5f, lr, 0);
        FFN_HALF(pb + 11, lr * 2 + 0, 0, lr, 0, 0.5f, lr, 1);
        for (int rep_ = 0; rep_ < REP_EW; ++rep_) { if (EN_MIX && IN(pb + 14)) mixes_phase(fresh(F), KA, lp); }
        SEAM(pb + 14);
#ifdef DBG_DOUBLE_BAR
        SEAM(pb + 14);
#endif
#define rw1 ((const bf16_t*)(ws + WS_WR) + (size_t)lp * (E_RW1 + E_RW2 + E_SQ))
        for (int rep_ = 0; rep_ < REP_OG; ++rep_) { if (rep_) __syncthreads();
        if (EN_RW1 && IN(pb + 15)) { const Frame Ff = fresh(F); GemmRw1 g{(const bf16_t*)(ws + WS_MIX6), rw1, D}; pg8::StaticOrder S; S.init(M, 6912, Ff.G, Ff.bid);
            EpiRw1 E{ws, KA->in[25] + (size_t)lp * D};
            pg8::gemm_phase<EpiRw1, pg8::StaticOrder, GemmRw1, RW1_ALIGN, RW1_SP2>(Ff.lds, g, S, E, Ff.wave); } }
        SEAM(pb + 15);
        for (int rep_ = 0; rep_ < REP_OG; ++rep_) { if (rep_) __syncthreads();
        if (EN_RW2 && IN(pb + 16)) { const Frame Ff = fresh(F); int k2_ = 256; asm volatile("" : "+s"(k2_));     GemmRw2 g{ws, rw1 + E_RW1, k2_}; pg8::StaticOrder S; S.init(M, 10240, Ff.G, Ff.bid);
            EpiRw2 E{ws,
                     KA->in[19] + (size_t)lp * 2 * D, KA->in[22] + (size_t)lp * 2 * D, WS_AA};
            pg8::gemm_phase<EpiRw2, pg8::StaticOrder, GemmRw2, RW2_ALIGN, RW2_SP2>(Ff.lds, g, S, E, Ff.wave); } }
        #ifdef DBG_RW2_TWICE
        __syncthreads();
        if (EN_RW2 && IN(pb + 16)) { const Frame Ff = fresh(F); int k2_ = 256; asm volatile("" : "+s"(k2_));     GemmRw2 g{ws, rw1 + E_RW1, k2_}; pg8::StaticOrder S; S.init(M, 10240, Ff.G, Ff.bid);
            EpiRw2 E{ws,
                     KA->in[19] + (size_t)lp * 2 * D, KA->in[22] + (size_t)lp * 2 * D, WS_END};
            pg8::gemm_phase<EpiRw2, pg8::StaticOrder, GemmRw2, RW2_ALIGN, RW2_SP2>(Ff.lds, g, S, E, Ff.wave); }
#endif
        SEAM(pb + 16);
        for (int rep_ = 0; rep_ < REP_SCAN; ++rep_) { if (rep_) __syncthreads(); if (EN_SCAN && IN(pb + 17)) scan_phase(fresh(F), KA, lp); }
        SEAM(pb + 17);
        for (int rep_ = 0; rep_ < REP_EW; ++rep_) { if (EN_OPREP && IN(pb + 18)) outprep_phase(fresh(F), KA, lp); }
        SEAM(pb + 18);
        for (int rep_ = 0; rep_ < REP_OG; ++rep_) { if (rep_) __syncthreads();
        if (EN_GWO && IN(pb + 19)) { const Frame Ff = fresh(F); pg8::Gemm g{(const bf16_t*)(ws + WS_PREP), rw1 + E_RW1 + E_RW2, D}; pg8::StaticOrder S; S.init(M, D, Ff.G, Ff.bid); EpiPlain E{OUTb, D};
            pg8::gemm_phase<EpiPlain, pg8::StaticOrder, pg8::Gemm, GEMM_ALIGN, GEMM_SP2>(Ff.lds, g, S, E, Ff.wave); } }
        SEAM(pb + 19);
        if (EN_THIN && IN(pb + 20)) thin_phase<1, 0>(fresh(F), KA, lr, 1, 1.0f, lr, 2);
        SEAM(pb + 20);
        if (lp == 1) FFN_HALF(pb + 21, lr * 2 + 1, 1, lr, 2, 0.5f, 0, 0); else FFN_HALF(pb + 21, lr * 2 + 1, 0, lr, 2, 0.5f, lr + 1, 0);
    }
    if (DBG_STOP >= 0) { xcd_barrier(bar, fresh(F).wave == 0 && lane_opaque() == 0); copyout_phase(fresh(F), KA); }
#undef IN
#undef SEAM
#undef FFN_HALF
#undef BAR_NOW
#undef rw1
#undef ws
#undef KA
#undef Yb
#undef ACTb
#undef OUTb
}

extern "C" void kernel_launch(void* const* d_in, const int* in_sizes, int n_in, void* d_out, int out_size, void* d_ws, size_t ws_size, hipStream_t stream) {
    static int grid = 0;
    if (grid == 0) {
        if (n_in != 30 || in_sizes[0] != NB * SEQ * D || out_size != NB * SEQ * D || ws_size < WS_END) {
            fprintf(stderr, "kernel_launch: shape mismatch: n_in %d in0 %d out %d ws %zu (need >= %zu)\n", n_in, n_in > 0 ? in_sizes[0] : -1, out_size, ws_size, (size_t)WS_END); grid = -1; return; }
        int dev = 0, cus = 0, per_cu = 0;
        if (hipGetDevice(&dev) != hipSuccess || hipDeviceGetAttribute(&cus, hipDeviceAttributeMultiprocessorCount, dev) != hipSuccess) { fprintf(stderr, "kernel_launch: device query failed\n"); grid = -1; return; }
        if (hipFuncSetAttribute((const void*)fwd_kernel, hipFuncAttributeMaxDynamicSharedMemorySize, LDS_BYTES) != hipSuccess) { fprintf(stderr, "kernel_launch: hipFuncSetAttribute failed\n"); grid = -1; return; }
        if (hipOccupancyMaxActiveBlocksPerMultiprocessor(&per_cu, (const void*)fwd_kernel, NTHR, LDS_BYTES) != hipSuccess || per_cu < 1) { fprintf(stderr, "kernel_launch: occupancy query says %d blocks per CU\n", per_cu); }
        (void)hipGetLastError();
        grid = cus;
        if (grid > 256) grid = 256;
    }
    if (grid < 0) return;
    if (hipMemsetAsync((char*)d_ws + WS_CTL, 0, CTL_ZERO_BYTES, stream) != hipSuccess) { fprintf(stderr, "kernel_launch: memset failed\n"); return; }
    Args a{};
    for (int i = 0; i < 30; ++i) a.in[i] = (const float*)d_in[i];
    a.out = (float*)d_out; a.ws = (unsigned char*)d_ws;
    a.ph_lo = 0; a.ph_hi = NPHASE; a.li = 0; a.dbg = 0;
    hipLaunchKernelGGL(fwd_kernel, dim3(grid), dim3(NTHR), LDS_BYTES, stream, a);
    const hipError_t le = hipPeekAtLastError();
    if (le != hipSuccess) fprintf(stderr, "kernel_launch: launch failed: %s\n", hipGetErrorName(le));
}
```

```cpp
#include <hip/hip_runtime.h>
#include <cstdio>
#include <cstdint>
#include <cmath>
__device__ __forceinline__ int lane_opaque() { int l; asm volatile("v_mbcnt_lo_u32_b32 %0, -1, 0\n\tv_mbcnt_hi_u32_b32 %0, -1, %0" : "=v"(l)); return l; }
namespace pg8 {
#define PG8_LAS __attribute__((address_space(3)))
typedef unsigned short bf16_t;
typedef short bf16x8 __attribute__((ext_vector_type(8)));
typedef float f32x4 __attribute__((ext_vector_type(4)));
typedef unsigned u32x4 __attribute__((ext_vector_type(4)));
constexpr int BM = 256, BK = 64, HALF = 128, HTB = HALF * BK * 2  , STAGE_BYTES = 8 * HTB, NXCD = 8, WGM = 8;

__host__ __device__ __forceinline__ int lds_byte(int r, int c) { const int st = (r >> 4) * 2 + (c >> 5), rr = r & 15, cc = c & 31, ob = rr * 64 + cc * 2; return st * 1024 + (ob ^ (((ob >> 9) & 1) << 5)); }
__host__ __device__ __forceinline__ void stage_rc(int b, int& R, int& C) { const int st = b / 1024, sb = b % 1024, swz = sb ^ (((sb >> 9) & 1) << 5); R = (st >> 1) * 16 + swz / 64; C = (st & 1) * 32 + (swz % 64) / 2; }
__host__ __device__ __forceinline__ int perm32(int rho) { const int n = rho >> 4, i = rho & 15; return 8 * (i >> 2) + 4 * n + (i & 3); }

struct Unit { int pm, pn; };
struct Gemm { const bf16_t* A; const bf16_t* Bt; int K;
    __device__ __forceinline__ const char* a_tile(const Unit& u) const { return (const char*)A + (size_t)u.pm * (size_t)(BM * 2) * K; }
    __device__ __forceinline__ const char* b_tile(const Unit& u) const { return (const char*)Bt + (size_t)u.pn * (size_t)(BM * 2) * K; } };

struct StaticOrder {
    int nM, nN, nwg, G, c;
    __host__ __device__ void init(int M, int N, int G_, int c_) { nM = M / BM; nN = N / BM; nwg = nM * nN; G = G_; c = c_; }
    __host__ __device__ bool next(int i, Unit& u) const {
        const long L = (long)i * G + c; if (L >= nwg) return false;
        int wgid = (int)L; { const int q = nwg / NXCD, r = nwg % NXCD, xcd = wgid % NXCD, off = wgid / NXCD; wgid = (xcd < r ? xcd * (q + 1) : r * (q + 1) + (xcd - r) * q) + off; }
        const int nig = WGM * nN, gid = wgid / nig, fm = gid * WGM, gsz = (nM - fm) < WGM ? (nM - fm) : WGM;
        u.pm = fm + ((wgid % nig) % gsz); u.pn = (wgid % nig) / gsz; return true;
    }
    __device__ __forceinline__ void a_ready(const Unit&) const {}
    __device__ __forceinline__ void done(const Unit&) const {}
};

typedef __bf16 bf16x2_cv __attribute__((ext_vector_type(2)));
typedef float f32x2_cv __attribute__((ext_vector_type(2)));
__device__ __forceinline__ unsigned cvt_pk_bf16(float lo, float hi) { const f32x2_cv v = {lo, hi}; const bf16x2_cv b = __builtin_convertvector(v, bf16x2_cv); return __builtin_bit_cast(unsigned, b); }

template <class Epi, class Sched, class GT, bool ALIGN_EPI = false, bool SP2 = false>
__device__ __forceinline__ void gemm_phase(PG8_LAS unsigned char* lds, const GT g, const Sched& S, const Epi& E, const int wid  ) {
    const int lane = lane_opaque(), tid = wid * 64 + lane, wr = wid >> 2, wc = wid & 3, fr = lane & 15, fq = lane >> 4;
    const int K = g.K, nt = K / BK;
    unsigned voffA[2], voffB[2];
#pragma unroll
    for (int i = 0; i < 2; ++i) { int R, C; stage_rc(tid * 16 + i * 8192, R, C); const int Rb = Epi::PERM ? ((R & ~31) + perm32(R & 31)) : R;
        voffA[i] = (unsigned)(R * K + C) * 2u; voffB[i] = (unsigned)(Rb * K + C) * 2u; }
    asm volatile("" : "+v"(voffA[0]), "+v"(voffA[1]), "+v"(voffB[0]), "+v"(voffB[1]));
    const size_t kstep = (size_t)(BK * 2);
    const size_t hstep = (size_t)HALF * K * 2;
    const unsigned ldsw = (unsigned)wid * 1024u;
    const int aoff = lds_byte(wr * 64 + fr, fq * 8), boff = lds_byte(wc * 32 + fr, fq * 8);
#define PG8_SA(b, h) (((b) * 2 + (h)) * HTB)
#define PG8_SB(b, h) ((4 + (b) * 2 + (h)) * HTB)
#define PG8_STAGE(bufoff, gbase, voff) do { _Pragma("unroll") for (int _i = 0; _i < 2; ++_i) \
        __builtin_amdgcn_global_load_lds((const unsigned*)((const char*)(gbase) + (voff)[_i]), (PG8_LAS unsigned*)(lds + (bufoff) + ldsw + _i * 8192), 16, 0, 0); } while (0)
#define PG8_LDA(dst, b, h) do { _Pragma("unroll") for (int m = 0; m < 4; ++m) _Pragma("unroll") for (int k = 0; k < 2; ++k) dst[m][k] = *(const PG8_LAS bf16x8*)(lds + PG8_SA(b, h) + aoff + m * 2048 + k * 1024); } while (0)
#define PG8_LDB(dst, b, h) do { _Pragma("unroll") for (int n = 0; n < 2; ++n) _Pragma("unroll") for (int k = 0; k < 2; ++k) dst[n][k] = *(const PG8_LAS bf16x8*)(lds + PG8_SB(b, h) + boff + n * 2048 + k * 1024); } while (0)
#define PG8_MMA(ai, bj, At, Bt) do { __builtin_amdgcn_s_setprio(1); _Pragma("unroll") for (int m = 0; m < 4; ++m) _Pragma("unroll") for (int n = 0; n < 2; ++n) _Pragma("unroll") for (int k = 0; k < 2; ++k) \
        acc[ai][bj][m][n] = __builtin_amdgcn_mfma_f32_16x16x32_bf16(Bt[n][k], At[m][k], acc[ai][bj][m][n], 0, 0, 0); __builtin_amdgcn_s_setprio(0); } while (0)
#define PG8_WAIT_V(n) asm volatile("s_waitcnt vmcnt(" #n ")" ::: "memory")
#define PG8_WAIT_L(n) asm volatile("s_waitcnt lgkmcnt(" #n ")" ::: "memory")
#define PG8_BAR __builtin_amdgcn_s_barrier()
#define PG8_SCHED __builtin_amdgcn_sched_barrier(0)
    Unit cur, nxt; int ui = 0;
    if (!S.next(0, cur)) return;
    f32x4 acc[2][2][4][2];
#pragma unroll
    for (int a = 0; a < 2; ++a)
#pragma unroll
        for (int b = 0; b < 2; ++b)
#pragma unroll
            for (int m = 0; m < 4; ++m)
#pragma unroll
                for (int n = 0; n < 2; ++n) acc[a][b][m][n] = (f32x4){0.f, 0.f, 0.f, 0.f};
    bf16x8 At[4][2], B0[2][2], B1[2][2];
    const char* cA = g.a_tile(cur); const char* cB = g.b_tile(cur);
    S.a_ready(cur);
    if constexpr (SP2) {
        PG8_STAGE(PG8_SB(0, 0), cB, voffB); PG8_STAGE(PG8_SB(0, 1), cB + hstep, voffB); PG8_STAGE(PG8_SA(0, 0), cA, voffA); PG8_STAGE(PG8_SA(0, 1), cA + hstep, voffA);
        if (wr == 1) PG8_BAR;
        PG8_WAIT_V(2); PG8_BAR;
        PG8_STAGE(PG8_SB(1, 0), cB + kstep, voffB); PG8_STAGE(PG8_SA(1, 0), cA + kstep, voffA); PG8_STAGE(PG8_SB(1, 1), cB + hstep + kstep, voffB);
        PG8_WAIT_V(6); PG8_BAR;
    } else {
        PG8_STAGE(PG8_SB(0, 0), cB, voffB); PG8_STAGE(PG8_SA(0, 0), cA, voffA); PG8_STAGE(PG8_SB(0, 1), cB + hstep, voffB); PG8_STAGE(PG8_SA(0, 1), cA + hstep, voffA);
        if (wr == 1) PG8_BAR;
        PG8_WAIT_V(4); PG8_BAR;
        PG8_STAGE(PG8_SB(1, 0), cB + kstep, voffB); PG8_STAGE(PG8_SA(1, 0), cA + kstep, voffA); PG8_STAGE(PG8_SB(1, 1), cB + hstep + kstep, voffB);
        PG8_WAIT_V(6); PG8_BAR;
    }
    for (;;) {
        const bool has_next = S.next(ui + 1, nxt);
        const char* nA = has_next ? g.a_tile(nxt) : cA; const char* nB = has_next ? g.b_tile(nxt) : cB;
        for (int t = 0; t < nt; t += 2) {
            const bool last = (t == nt - 2);
            const char* a1 = cA + (size_t)(t + 1) * kstep;
            const char* a2 = last ? nA : cA + (size_t)(t + 2) * kstep; const char* b2 = last ? nB : cB + (size_t)(t + 2) * kstep;
            const char* a3 = a2 + kstep; const char* b3 = b2 + kstep;
            if (last && has_next) S.a_ready(nxt);
            if constexpr (SP2) {
            PG8_LDB(B0, 0, 0); PG8_LDB(B1, 0, 1); PG8_SCHED; PG8_LDA(At, 0, 0); PG8_STAGE(PG8_SA(1, 1), a1 + hstep, voffA);
            PG8_WAIT_V(8); PG8_WAIT_L(0); PG8_BAR; PG8_MMA(0, 0, At, B0); PG8_MMA(0, 1, At, B1); PG8_BAR; PG8_SCHED;
            PG8_LDA(At, 0, 1); PG8_STAGE(PG8_SB(0, 0), b2, voffB); PG8_STAGE(PG8_SB(0, 1), b2 + hstep, voffB); PG8_STAGE(PG8_SA(0, 0), a2, voffA);
            PG8_WAIT_V(8); PG8_WAIT_L(0); PG8_BAR; PG8_MMA(1, 0, At, B0); PG8_MMA(1, 1, At, B1); PG8_BAR; PG8_SCHED;
            PG8_LDB(B0, 1, 0); PG8_LDB(B1, 1, 1); PG8_SCHED; PG8_LDA(At, 1, 0); PG8_STAGE(PG8_SA(0, 1), a2 + hstep, voffA);
            PG8_WAIT_V(8); PG8_WAIT_L(0); PG8_BAR; PG8_MMA(0, 0, At, B0); PG8_MMA(0, 1, At, B1); PG8_BAR; PG8_SCHED;
            PG8_LDA(At, 1, 1); PG8_STAGE(PG8_SB(1, 0), b3, voffB); PG8_STAGE(PG8_SB(1, 1), b3 + hstep, voffB); PG8_STAGE(PG8_SA(1, 0), a3, voffA);
            PG8_WAIT_V(8); PG8_WAIT_L(0); PG8_BAR; PG8_MMA(1, 0, At, B0); PG8_MMA(1, 1, At, B1); PG8_BAR; PG8_SCHED;
            } else {
            PG8_LDB(B0, 0, 0); PG8_SCHED; PG8_LDA(At, 0, 0); PG8_STAGE(PG8_SA(1, 1), a1 + hstep, voffA);
            PG8_WAIT_L(8); PG8_BAR; PG8_WAIT_L(0); PG8_MMA(0, 0, At, B0); PG8_BAR; PG8_SCHED;
            PG8_LDB(B1, 0, 1); PG8_STAGE(PG8_SB(0, 0), b2, voffB);
            PG8_BAR; PG8_WAIT_L(0); PG8_MMA(0, 1, At, B1); PG8_BAR;
            PG8_LDA(At, 0, 1); PG8_STAGE(PG8_SA(0, 0), a2, voffA);
            PG8_BAR; PG8_WAIT_L(0); PG8_MMA(1, 0, At, B0); PG8_BAR; PG8_SCHED;
            PG8_STAGE(PG8_SB(0, 1), b2 + hstep, voffB);
            PG8_WAIT_V(6); PG8_BAR; PG8_MMA(1, 1, At, B1); PG8_BAR;
            PG8_LDB(B0, 1, 0); PG8_SCHED; PG8_LDA(At, 1, 0); PG8_STAGE(PG8_SA(0, 1), a2 + hstep, voffA);
            PG8_WAIT_L(8); PG8_BAR; PG8_WAIT_L(0); PG8_MMA(0, 0, At, B0); PG8_BAR; PG8_SCHED;
            PG8_LDB(B1, 1, 1); PG8_STAGE(PG8_SB(1, 0), b3, voffB);
            PG8_BAR; PG8_WAIT_L(0); PG8_MMA(0, 1, At, B1); PG8_BAR;
            PG8_LDA(At, 1, 1); PG8_STAGE(PG8_SA(1, 0), a3, voffA);
            PG8_BAR; PG8_WAIT_L(0); PG8_MMA(1, 0, At, B0); PG8_BAR; PG8_SCHED;
            PG8_STAGE(PG8_SB(1, 1), b3 + hstep, voffB);
            PG8_WAIT_V(6); PG8_BAR; PG8_MMA(1, 1, At, B1); PG8_BAR;
            }
        }
        if constexpr (ALIGN_EPI) { if (wr == 0) PG8_BAR; }
        if constexpr (!Epi::AFTER_DRAIN) { E(acc, cur, wr, wc, fr, fq); S.done(cur); }
        if (!has_next) break;
#pragma unroll
        for (int a = 0; a < 2; ++a)
#pragma unroll
            for (int b = 0; b < 2; ++b)
#pragma unroll
                for (int m = 0; m < 4; ++m)
#pragma unroll
                    for (int n = 0; n < 2; ++n) acc[a][b][m][n] = (f32x4){0.f, 0.f, 0.f, 0.f};
        cur = nxt; cA = nA; cB = nB; ++ui;
        if constexpr (ALIGN_EPI) { if (wr == 1) PG8_BAR; }
    }
    PG8_WAIT_V(0);
    if constexpr (!ALIGN_EPI) { if (wr == 0) PG8_BAR; }
    PG8_BAR;
    if constexpr (Epi::AFTER_DRAIN) { E.fused(acc, cur, wr, wc, fr, fq, lds, wid, lane); S.done(cur); }
#undef PG8_SA
#undef PG8_SB
#undef PG8_STAGE
#undef PG8_LDA
#undef PG8_LDB
#undef PG8_MMA
#undef PG8_WAIT_V
#undef PG8_WAIT_L
#undef PG8_BAR
#undef PG8_SCHED
}
}

#define LAS __attribute__((address_space(3)))
#define XB_TMO      128
#define XB_XCNT(j)  (256  + 64 * (j))
#define XB_XSUB(j)  (1280 + 64 * (j))
#define XB_XGEN(j)  (2304 + 64 * (j))
#define XB_TOP      3328
#define XB_TOPGEN   3392
#define XCD_BAR_WORDS 3456
#define XB_SPIN_CAP (1u << 20)

__device__ __forceinline__ unsigned xb_ld(unsigned* p)              { return __hip_atomic_load(p, __ATOMIC_RELAXED, __HIP_MEMORY_SCOPE_AGENT); }
__device__ __forceinline__ unsigned xb_add(unsigned* p, unsigned v) { return __hip_atomic_fetch_add(p, v, __ATOMIC_RELAXED, __HIP_MEMORY_SCOPE_AGENT); }
__device__ __forceinline__ unsigned xb_xcc_id() { return (unsigned)__builtin_amdgcn_s_getreg((3 << 11) | 20) & 0xFu; }
#define XB_SPIN(cond, bar) do { unsigned _sp = 0; while (cond) { __builtin_amdgcn_s_sleep(1); \
    if ((++_sp & 255u) == 0u) { if (xb_ld(&(bar)[XB_TMO])) break; if (_sp > XB_SPIN_CAP) { atomicAdd(&(bar)[XB_TMO], 1u); break; } } } } while (0)

struct XcdBarrier {
    unsigned* bar; unsigned x;
    volatile LAS unsigned* st;
};

__device__ __forceinline__ XcdBarrier xcd_barrier_post(unsigned* bar, volatile LAS unsigned* st) {
    XcdBarrier b; b.bar = bar; b.x = xb_xcc_id(); b.st = st;
    if (threadIdx.x == 0) (void)xb_add(&bar[XB_XCNT(b.x)], 1u);
    return b;
}
__device__ __forceinline__ void xcd_barrier_complete(unsigned* bar, unsigned x, unsigned& nloc, unsigned& nx) {
    const unsigned G = gridDim.x * gridDim.y * gridDim.z;
    unsigned sum, cnt, mine, sp = 0u;
    for (;;) {
        sum = 0u; cnt = 0u; mine = 0u;
#pragma unroll
        for (unsigned j = 0; j < 16; ++j) { const unsigned c = xb_ld(&bar[XB_XCNT(j)]); sum += c; cnt += (c > 0u) ? 1u : 0u; mine = (j == x) ? c : mine; }
        if (sum == G) break;
        __builtin_amdgcn_s_sleep(1);
        if ((++sp & 255u) == 0u) { if (xb_ld(&bar[XB_TMO])) break; if (sp > XB_SPIN_CAP) { atomicAdd(&bar[XB_TMO], 1u); break; } }
    }
    nloc = mine > 0u ? mine : 1u; nx = cnt > 0u ? cnt : 1u;
}

__device__ __forceinline__ void xcd_barrier(const XcdBarrier& b, const bool tid0  ) {
    asm volatile("s_waitcnt vmcnt(0)" ::: "memory");
    __syncthreads();
    if (tid0) {
        unsigned* bar = b.bar;
        __builtin_amdgcn_s_waitcnt(0);
        unsigned nloc = b.st[0], nx = b.st[1];
        if (nloc == 0u) { xcd_barrier_complete(bar, b.x, nloc, nx); b.st[0] = nloc; b.st[1] = nx; }
        const unsigned old = xb_add(&bar[XB_XSUB(b.x)], 1u);
        const unsigned gen = old / nloc;
        if (old + 1u == (gen + 1u) * nloc) {
            __builtin_amdgcn_fence(__ATOMIC_RELEASE, "agent");
            asm volatile("s_waitcnt vmcnt(0)" ::: "memory");
            const unsigned og = xb_add(&bar[XB_TOP], 1u);
            const unsigned tg = og / nx;
            if (og + 1u == (tg + 1u) * nx) xb_add(&bar[XB_TOPGEN], 1u);
            else XB_SPIN(xb_ld(&bar[XB_TOPGEN]) == tg, bar);
            __builtin_amdgcn_fence(__ATOMIC_ACQUIRE, "agent");
            xb_add(&bar[XB_XGEN(b.x)], 1u);
            asm volatile("s_waitcnt vmcnt(0)" ::: "memory");
        } else {
            XB_SPIN(xb_ld(&bar[XB_XGEN(b.x)]) == gen, bar);
            __builtin_amdgcn_fence(__ATOMIC_ACQUIRE, "agent");
            asm volatile("s_waitcnt vmcnt(0)" ::: "memory");
        }
    }
    __syncthreads();
}

namespace attn {
using bf16 = unsigned short;
constexpr int   D = 128, NW = 8, QBLK = 32, KVBLK = 64;
constexpr float SCALE = 0.088388347648318440f;
constexpr float THR = 8.f;
constexpr int SDEPTH = 2;
constexpr int LDQ = 2048, LDK = 512, LDO = 2048;
constexpr size_t SHM_V = KVBLK * D * 2, SHM_K = KVBLK * D * 2, SHM_ATTN = 2 * SHM_V + 2 * SHM_K + NW * 64 * 4;
using bf16x8 = __attribute__((ext_vector_type(8))) short;
using s16x4  = __attribute__((ext_vector_type(4))) short;
using f32x16 = __attribute__((ext_vector_type(16))) float;
using f32x8  = __attribute__((ext_vector_type(8))) float;
using u32x4  = __attribute__((ext_vector_type(4))) unsigned;
#define KSWZ(row, colB) ((row) * 256 + ((colB) ^ (((row) & 7) << 4)))
#define SBAR() __builtin_amdgcn_sched_barrier(0)
__device__ __forceinline__ int crow(int r, int hi) { return (r & 3) + 8 * (r >> 2) + 4 * hi; }
__device__ __forceinline__ unsigned cvtpk(float lo, float hi) {
  return pg8::cvt_pk_bf16(lo, hi);
}
template <typename TIn> struct Stage;
__device__ __forceinline__ unsigned f2bf_(float f) { unsigned u = __builtin_bit_cast(unsigned, f); return (u + 0x7fffu + ((u >> 16) & 1u)) >> 16; }
template <> struct Stage<bf16>  { using T = bf16x8;
  __device__ static __forceinline__ T ld8(const bf16* p) { return *reinterpret_cast<const bf16x8*>(p); }
  __device__ static __forceinline__ bf16x8 tobf(T x) { return x; } };
template <> struct Stage<float> { using T = f32x8;
  __device__ static __forceinline__ T ld8(const float* p) { return *reinterpret_cast<const f32x8*>(p); }
  __device__ static __forceinline__ bf16x8 tobf(T x) {
    u32x4 w = {cvtpk(x[0], x[1]), cvtpk(x[2], x[3]), cvtpk(x[4], x[5]), cvtpk(x[6], x[7])}; return *reinterpret_cast<bf16x8*>(&w); } };

__device__ __forceinline__ void partialSM(f32x16& p0, f32x16& p1, float& m_reg, float& mn, float& alpha) {
  constexpr float C = SCALE * 1.4426950408889634f;
  float pmax = p0[0]; for (int r = 1; r < 16; ++r) pmax = fmaxf(pmax, p0[r]); for (int r = 0; r < 16; ++r) pmax = fmaxf(pmax, p1[r]);
  { auto rr = __builtin_amdgcn_permlane32_swap(__float_as_uint(pmax), __float_as_uint(pmax), false, false);
    pmax = fmaxf(__uint_as_float(rr[0]), __uint_as_float(rr[1])); }
  if (__builtin_expect(__all(pmax - m_reg <= THR / SCALE), 1)) { mn = m_reg; alpha = 1.f; }
  else { mn = fmaxf(m_reg, pmax); alpha = __builtin_amdgcn_exp2f((m_reg - mn) * C); m_reg = mn; }
  float mnC = -mn * C;
  for (int r = 0; r < 16; ++r) p0[r] = fmaf(p0[r], C, mnC); for (int r = 0; r < 16; ++r) p1[r] = fmaf(p1[r], C, mnC);
  for (int r = 0; r < 16; ++r) p0[r] = __builtin_amdgcn_exp2f(p0[r]);
}
__device__ __forceinline__ void finishSM(f32x16& p0, f32x16& p1, float alpha, float& l_reg, bf16x8& pa0, bf16x8& pa1, bf16x8& pa2, bf16x8& pa3) {
  for (int r = 0; r < 16; ++r) p1[r] = __builtin_amdgcn_exp2f(p1[r]);
  float ps = 0; for (int r = 0; r < 16; ++r) ps += p0[r]; for (int r = 0; r < 16; ++r) ps += p1[r];
  { auto rr = __builtin_amdgcn_permlane32_swap(__float_as_uint(ps), __float_as_uint(ps), false, false);
    ps = __uint_as_float(rr[0]) + __uint_as_float(rr[1]); }
  l_reg = l_reg * alpha + ps;
#define PK4(P, BASE, OUT) do { unsigned a0 = cvtpk(P[BASE + 0], P[BASE + 1]), a1 = cvtpk(P[BASE + 2], P[BASE + 3]);   \
    unsigned b0 = cvtpk(P[BASE + 4], P[BASE + 5]), b1 = cvtpk(P[BASE + 6], P[BASE + 7]);                              \
    auto r0 = __builtin_amdgcn_permlane32_swap(a0, b0, false, false); auto r1 = __builtin_amdgcn_permlane32_swap(a1, b1, false, false); \
    u32x4 w = {r0[0], r1[0], r0[1], r1[1]}; OUT = *reinterpret_cast<bf16x8*>(&w); } while (0)
  PK4(p0, 0, pa0); PK4(p0, 8, pa1); PK4(p1, 0, pa2); PK4(p1, 8, pa3);
#undef PK4
}
__device__ __forceinline__ void qkt(f32x16& p0, f32x16& p1, const bf16* Ks, const bf16x8* qr, int r32, int hi) {
  p0 = f32x16{}; p1 = f32x16{};
  for (int d0 = 0; d0 < 8; ++d0) { int cb = (d0 * 16 + hi * 8) * 2;
    bf16x8 b0 = *reinterpret_cast<const bf16x8*>((const char*)Ks + KSWZ(r32, cb));
    bf16x8 b1 = *reinterpret_cast<const bf16x8*>((const char*)Ks + KSWZ(32 + r32, cb));
    p0 = __builtin_amdgcn_mfma_f32_32x32x16_bf16(b0, qr[d0], p0, 0, 0, 0);
    p1 = __builtin_amdgcn_mfma_f32_32x32x16_bf16(b1, qr[d0], p1, 0, 0, 0); }
}
__device__ __forceinline__ int v_st(int k, int c) { const int kk = (k & ~0xC) | ((k & 4) << 1) | ((k & 8) >> 1); return ((kk >> 3) * 4 + (c >> 5)) * 512 + ((kk & 7) * 32 + (c & 31)) * 2; }
__device__ __forceinline__ int v_rd_base(int lane) { return ((lane & 3) << 3) | (((lane >> 2) & 3) << 6) | (((lane >> 4) & 1) << 5) | (((lane >> 5) & 1) << 8); }
constexpr int v_rd_off(int d0, int ks, int half) { return d0 * 512 + ks * 4096 + half * 2048; }
template <int OFF> __device__ __forceinline__ s16x4 tr_read(int vb) {
  s16x4 r; asm volatile("ds_read_b64_tr_b16 %0, %1 offset:%2" : "=&v"(r) : "v"(vb), "i"(OFF) : "memory"); return r;
}
template <int D0> __device__ __forceinline__ void pv_one(f32x16& od, int vb, bf16x8 pa0, bf16x8 pa1, bf16x8 pa2, bf16x8 pa3) {
  const s16x4 l0 = tr_read<v_rd_off(D0, 0, 0)>(vb), h0 = tr_read<v_rd_off(D0, 0, 1)>(vb), l1 = tr_read<v_rd_off(D0, 1, 0)>(vb), h1 = tr_read<v_rd_off(D0, 1, 1)>(vb);
  const s16x4 l2 = tr_read<v_rd_off(D0, 2, 0)>(vb), h2 = tr_read<v_rd_off(D0, 2, 1)>(vb), l3 = tr_read<v_rd_off(D0, 3, 0)>(vb), h3 = tr_read<v_rd_off(D0, 3, 1)>(vb);
  asm volatile("s_waitcnt lgkmcnt(0)" ::: "memory"); SBAR();
#define PK(L, H) (bf16x8){L[0], L[1], L[2], L[3], H[0], H[1], H[2], H[3]}
  od = __builtin_amdgcn_mfma_f32_32x32x16_bf16(pa0, PK(l0, h0), od, 0, 0, 0);
  od = __builtin_amdgcn_mfma_f32_32x32x16_bf16(pa1, PK(l1, h1), od, 0, 0, 0);
  od = __builtin_amdgcn_mfma_f32_32x32x16_bf16(pa2, PK(l2, h2), od, 0, 0, 0);
  od = __builtin_amdgcn_mfma_f32_32x32x16_bf16(pa3, PK(l3, h3), od, 0, 0, 0);
#undef PK
}
__device__ __forceinline__ void pv_d0(f32x16* o, int vb, bf16x8 pa0, bf16x8 pa1, bf16x8 pa2, bf16x8 pa3) {
  pv_one<0>(o[0], vb, pa0, pa1, pa2, pa3); pv_one<1>(o[1], vb, pa0, pa1, pa2, pa3); pv_one<2>(o[2], vb, pa0, pa1, pa2, pa3); pv_one<3>(o[3], vb, pa0, pa1, pa2, pa3);
}

template <typename TQ>
__device__ __forceinline__ void attn_dense_body(const TQ* __restrict__ Qb, const bf16* __restrict__ Kh, const bf16* __restrict__ Vh,
                                                bf16* __restrict__ Ob, int seq, char* lds, const int wid) {
  using St = Stage<bf16>; using SQ = Stage<TQ>;
  const int lane = lane_opaque(), tid = wid * 64 + lane, r32 = lane & 31, hi = lane >> 5;
  bf16* V_lds = (bf16*)lds; bf16* K_lds = (bf16*)(lds + 2 * SHM_V);
  float* ws = (float*)(lds + 2 * SHM_V + 2 * SHM_K) + wid * 64; float* li_l = ws; float* al_l = ws + 32;
  float m_reg = -1e30f, l_reg = 0; f32x16 o[4] = {}; bf16x8 qr[8];
  const TQ* Qw = Qb + (long)(wid * QBLK + r32) * LDQ + hi * 8;
#pragma unroll
  for (int d0 = 0; d0 < 8; ++d0) qr[d0] = SQ::tobf(SQ::ld8(Qw + d0 * 16));
  const int sr = tid >> 4, sc = (tid & 15) * 8, vst0 = v_st(sr, sc), vst1 = v_st(32 + sr, sc);
  const int vb0 = (int)(uintptr_t)V_lds + v_rd_base(lane);
  struct { typename St::T vs0, vs1, ks0, ks1; } sr_[SDEPTH];
#define SLOAD(i, k0) do { sr_[i].vs0 = St::ld8(&Vh[(long)((k0) + sr) * LDK + sc]); sr_[i].vs1 = St::ld8(&Vh[(long)((k0) + 32 + sr) * LDK + sc]); \
    sr_[i].ks0 = St::ld8(&Kh[(long)((k0) + sr) * LDK + sc]); sr_[i].ks1 = St::ld8(&Kh[(long)((k0) + 32 + sr) * LDK + sc]); } while (0)
#define SWRITE(b, i) do { *(bf16x8*)((char*)V_lds + (b) * SHM_V + vst0) = St::tobf(sr_[i].vs0);          \
    *(bf16x8*)((char*)V_lds + (b) * SHM_V + vst1) = St::tobf(sr_[i].vs1); int kc = sc * 2;               \
    *(bf16x8*)((char*)K_lds + (b) * SHM_K + KSWZ(sr, kc)) = St::tobf(sr_[i].ks0);                       \
    *(bf16x8*)((char*)K_lds + (b) * SHM_K + KSWZ(32 + sr, kc)) = St::tobf(sr_[i].ks1); } while (0)
#define SWAIT() do { if constexpr (SDEPTH == 2) asm volatile("s_waitcnt vmcnt(4)" ::: "memory"); else asm volatile("s_waitcnt vmcnt(0)" ::: "memory"); } while (0)
#define RESC(a) do { if (__any((a) < 1.f)) { if (hi == 0) al_l[r32] = (a); asm volatile("s_waitcnt lgkmcnt(0)" ::: "memory"); \
    for (int d = 0; d < 4; ++d) for (int r = 0; r < 16; ++r) o[d][r] *= al_l[crow(r, hi)]; } } while (0)
  f32x16 pA0, pA1, pB0, pB1; float mnA, mnB, alA, alB; bf16x8 pa0, pa1, pa2, pa3; const int NT = seq / KVBLK;
  constexpr int SE = 0, SO = SDEPTH - 1;
  SLOAD(SE, 0); asm volatile("s_waitcnt vmcnt(0)" ::: "memory"); SWRITE(0, SE); __syncthreads();
  qkt(pA0, pA1, K_lds, qr, r32, hi); partialSM(pA0, pA1, m_reg, mnA, alA);
  SLOAD(SO, KVBLK); if constexpr (SDEPTH == 2) { if (2 < NT) SLOAD(SE, 2 * KVBLK); }
  SWAIT(); SWRITE(1, SO); __syncthreads();
  for (int j = 1; j + 1 < NT; j += 2) {
    SBAR(); qkt(pB0, pB1, (bf16*)((char*)K_lds + SHM_K), qr, r32, hi);
    finishSM(pA0, pA1, alA, l_reg, pa0, pa1, pa2, pa3); SBAR();
    SLOAD(SO, (j + SDEPTH) * KVBLK); SBAR();
    pv_d0(o, vb0, pa0, pa1, pa2, pa3); partialSM(pB0, pB1, m_reg, mnB, alB);
    __syncthreads(); SWAIT(); SWRITE(0, SE);
    RESC(alB); __syncthreads();
    SBAR(); qkt(pA0, pA1, K_lds, qr, r32, hi);
    finishSM(pB0, pB1, alB, l_reg, pa0, pa1, pa2, pa3); SBAR();
    if (SDEPTH == 1 || j + 3 < NT) SLOAD(SE, (j + 1 + SDEPTH) * KVBLK); SBAR();
    pv_d0(o, vb0 + (int)SHM_V, pa0, pa1, pa2, pa3); partialSM(pA0, pA1, m_reg, mnA, alA);
    __syncthreads(); SWAIT(); SWRITE(1, SO);
    RESC(alA); __syncthreads();
  }
  SBAR(); qkt(pB0, pB1, (bf16*)((char*)K_lds + SHM_K), qr, r32, hi);
  finishSM(pA0, pA1, alA, l_reg, pa0, pa1, pa2, pa3); SBAR();
  pv_d0(o, vb0, pa0, pa1, pa2, pa3); partialSM(pB0, pB1, m_reg, mnB, alB);
  __syncthreads(); RESC(alB);
  finishSM(pB0, pB1, alB, l_reg, pa0, pa1, pa2, pa3); SBAR();
  pv_d0(o, vb0 + (int)SHM_V, pa0, pa1, pa2, pa3);
  if (hi == 0) li_l[r32] = l_reg; asm volatile("s_waitcnt lgkmcnt(0)" ::: "memory");
  float rli[16];
#pragma unroll
  for (int r = 0; r < 16; ++r) rli[r] = __builtin_amdgcn_rcpf(li_l[crow(r, hi)]);
  bf16* Ow = Ob + (long)(wid * QBLK) * LDO;
#pragma unroll
  for (int r = 0; r < 16; ++r) { int orow = crow(r, hi);
    for (int d0 = 0; d0 < 4; ++d0) Ow[(long)orow * LDO + d0 * 32 + r32] = (bf16)f2bf_(o[d0][r] * rli[r]); }
#undef SLOAD
#undef SWRITE
#undef SWAIT
#undef RESC
}
#undef KSWZ
#undef SBAR
}

#define GAS __attribute__((address_space(1)))
typedef unsigned short bf16_t;
typedef unsigned u32x4 __attribute__((ext_vector_type(4)));
typedef unsigned u32x2 __attribute__((ext_vector_type(2)));
typedef float f32x4 __attribute__((ext_vector_type(4)));
typedef float f32x2 __attribute__((ext_vector_type(2)));
typedef short bf16x8 __attribute__((ext_vector_type(8)));

constexpr int D = 2048, NB = 4, SEQ = 4096, CTXL = 256, TB = SEQ + CTXL, M = NB * TB, FF = 5632, DEPTH = 4;
constexpr int NWAVES = 8, NTHR = 512;
constexpr float NORM_EPS = 1e-6f;
static_assert(M == 17408 && M % 256 == 0 && TB % 256 == 0, "row layout");

constexpr size_t MiB = 1u << 20;
constexpr size_t WS_CTL = 0, CTL_ZERO_BYTES = 4 * MiB;
constexpr size_t WS_MOD = 1 * MiB;
constexpr size_t WS_ROPE = 4 * MiB;
constexpr size_t WS_WB = 8 * MiB;
constexpr size_t E_F1 = (size_t)2 * FF * D, E_F2 = (size_t)D * FF;
constexpr size_t WS_WA = WS_WB + 8 * (E_F1 + E_F2) * 2;
constexpr size_t E_QKV = (size_t)3072 * D, E_SQ = (size_t)D * D;
constexpr size_t WS_WR = WS_WA + 2 * (E_QKV + E_SQ) * 2;
constexpr size_t E_RW1 = (size_t)6912 * D, E_RW2 = (size_t)10240 * 256;
constexpr size_t WS_WEND = WS_WR + 2 * (E_RW1 + E_RW2 + E_SQ) * 2;
static_assert(WS_WEND == 656 * MiB, "weight map");
constexpr size_t SZ_R2 = (size_t)M * D * 2, SZ_R4 = (size_t)M * D * 4;
constexpr size_t WS_X = 656 * MiB;
constexpr size_t WS_Y = WS_X + SZ_R4;
constexpr size_t WS_ACT = WS_Y + SZ_R2;
constexpr size_t WS_OUT = 1048 * MiB;
constexpr size_t WS_MIX = WS_OUT + SZ_R2;
static_assert(WS_ACT + (size_t)M * FF * 2 <= WS_OUT, "act map");
constexpr size_t WS_Q = WS_MIX, WS_K = WS_Q + SZ_R2, WS_V = WS_K + SZ_R2 / 4, WS_O = WS_V + SZ_R2 / 4;
constexpr size_t WS_MIX6 = WS_MIX;
constexpr size_t WS_WDEC = WS_MIX;
constexpr size_t WS_AA = WS_MIX + 2 * SZ_R4;
constexpr size_t WS_RR = WS_MIX + 6 * SZ_R2;
constexpr size_t WS_KK_ = WS_RR + SZ_R2;
constexpr size_t WS_VV = WS_KK_ + SZ_R2;
constexpr size_t WS_KN = WS_VV + SZ_R2;
constexpr size_t WS_GG = WS_KN + SZ_R2;
constexpr size_t WS_GL = WS_GG + SZ_R2;
constexpr size_t WS_WL = WS_GL + 9 * MiB, WS_AL = WS_WL + 9 * MiB;
constexpr size_t WS_END = WS_AL + 9 * MiB;
constexpr size_t WS_YS = WS_ACT;
constexpr size_t WS_PREP = WS_Y;
static_assert(WS_AA + 2 * SZ_R2 == WS_RR, "rwkv overlay");
static_assert(WS_END <= 2100 * MiB, "ws map");
constexpr int CW_BAR = 4096;
constexpr int MAX_LAUNCH = 64;
static_assert((CW_BAR + MAX_LAUNCH * XCD_BAR_WORDS) * 4 <= (int)WS_MOD, "ctl map");

constexpr int RING_BYTES = 131072, LDSCTL_OFF = RING_BYTES, MISC_OFF = LDSCTL_OFF + 320, LDS_BYTES = 147456;

struct Args { const float* in[30]; float* out; unsigned char* ws; int ph_lo, ph_hi, li, dbg; };
typedef const __attribute__((address_space(4))) Args KArgs;
struct Frame { LAS unsigned char* lds; unsigned char* ldsg; int wave, G, bid; };

#define LDS_WAIT() asm volatile("s_waitcnt lgkmcnt(0)" ::: "memory")
__device__ __forceinline__ unsigned f2bf(float f) { unsigned u = __builtin_bit_cast(unsigned, f); return (u + 0x7fffu + ((u >> 16) & 1u)) >> 16; }
__device__ __forceinline__ unsigned pk2(float lo, float hi) { return pg8::cvt_pk_bf16(lo, hi); }
__device__ __forceinline__ float bflo(unsigned w) { return __builtin_bit_cast(float, w << 16); }
__device__ __forceinline__ float bfhi(unsigned w) { return __builtin_bit_cast(float, w & 0xffff0000u); }
__device__ __forceinline__ void unpack8(const u32x4 w, float (&v)[8]) { v[0] = bflo(w.x); v[1] = bfhi(w.x); v[2] = bflo(w.y); v[3] = bfhi(w.y); v[4] = bflo(w.z); v[5] = bfhi(w.z); v[6] = bflo(w.w); v[7] = bfhi(w.w); }
__device__ __forceinline__ u32x4 pack8(const float (&v)[8]) { u32x4 w; w.x = pk2(v[0], v[1]); w.y = pk2(v[2], v[3]); w.z = pk2(v[4], v[5]); w.w = pk2(v[6], v[7]); return w; }
typedef _Float16 h16x2 __attribute__((ext_vector_type(2)));
__device__ __forceinline__ void unpack8h(const u32x4 w, float (&v)[8]) {
    const unsigned wx = w.x, wy = w.y, wz = w.z, ww = w.w;
    const h16x2 a = __builtin_bit_cast(h16x2, wx), b = __builtin_bit_cast(h16x2, wy), c = __builtin_bit_cast(h16x2, wz), d = __builtin_bit_cast(h16x2, ww);
    v[0] = (float)a.x; v[1] = (float)a.y; v[2] = (float)b.x; v[3] = (float)b.y; v[4] = (float)c.x; v[5] = (float)c.y; v[6] = (float)d.x; v[7] = (float)d.y; }
__device__ __forceinline__ u32x4 pack8h(const float (&v)[8]) {
    h16x2 a, b, c, d; a.x = (_Float16)v[0]; a.y = (_Float16)v[1]; b.x = (_Float16)v[2]; b.y = (_Float16)v[3]; c.x = (_Float16)v[4]; c.y = (_Float16)v[5]; d.x = (_Float16)v[6]; d.y = (_Float16)v[7];
    u32x4 w; w.x = __builtin_bit_cast(unsigned, a); w.y = __builtin_bit_cast(unsigned, b); w.z = __builtin_bit_cast(unsigned, c); w.w = __builtin_bit_cast(unsigned, d); return w; }
__device__ __forceinline__ float wave_sum(float v) {
#pragma unroll
    for (int o = 1; o < 64; o <<= 1) v += __shfl_xor(v, o);
    return v;
}
template <int CTRL> __device__ __forceinline__ float dppf(float x) { return __builtin_bit_cast(float, __builtin_amdgcn_mov_dpp(__builtin_bit_cast(int, x), CTRL, 0xF, 0xF, true)); }
__device__ __forceinline__ float sum8(float v) { v += dppf<0xB1>(v); v += dppf<0x4E>(v); v += dppf<0x141>(v); return v; }
__device__ __forceinline__ float sum16(float v) { v = sum8(v); v += dppf<0x140>(v); return v; }
__device__ __forceinline__ float fsigmoid(float x) { return __builtin_amdgcn_rcpf(1.0f + __builtin_amdgcn_exp2f(-1.4426950408889634f * x)); }
__device__ __forceinline__ float ftanh(float x) { return 1.0f - 2.0f * __builtin_amdgcn_rcpf(1.0f + __builtin_amdgcn_exp2f(2.8853900817779268f * x)); }
__device__ __forceinline__ float fsilu(float x) { return x * fsigmoid(x); }

using pg8::Unit;
typedef float accf32x4 __attribute__((ext_vector_type(4)));
struct EpiPlain {
    static constexpr bool PERM = true, AFTER_DRAIN = false;
    bf16_t* O; int ldc;
    __device__ __forceinline__ void operator()(const accf32x4 (&acc)[2][2][4][2], const Unit& u, int wr, int wc, int fr, int fq) const {
        const int row0 = u.pm * 256 + wr * 64 + fr, col0 = u.pn * 256 + wc * 32 + 8 * fq;
#pragma unroll
        for (int ai = 0; ai < 2; ++ai)
#pragma unroll
            for (int m = 0; m < 4; ++m) { bf16_t* rowp = O + (size_t)(row0 + ai * 128 + m * 16) * ldc + col0;
#pragma unroll
                for (int bj = 0; bj < 2; ++bj) { const accf32x4 v0 = acc[ai][bj][m][0], v1 = acc[ai][bj][m][1];
                    u32x4 w; w.x = pk2(v0[0], v0[1]); w.y = pk2(v0[2], v0[3]); w.z = pk2(v1[0], v1[1]); w.w = pk2(v1[2], v1[3]);
                    *(u32x4*)(rowp + bj * 128) = w; } }
    }
};
struct EpiQKV {
    static constexpr bool PERM = true, AFTER_DRAIN = false;
    unsigned char* wsb;
    __device__ __forceinline__ void operator()(const accf32x4 (&acc)[2][2][4][2], const Unit& u, int wr, int wc, int fr, int fq) const {
        size_t ooff; int ldc, ct;
        if (u.pn < 8) { ooff = WS_Q; ldc = 2048; ct = u.pn; } else if (u.pn < 10) { ooff = WS_K; ldc = 512; ct = u.pn - 8; } else { ooff = WS_V; ldc = 512; ct = u.pn - 10; }
        bf16_t* O = (bf16_t*)(wsb + ooff);
        const int row0 = u.pm * 256 + wr * 64 + fr, col0 = ct * 256 + wc * 32 + 8 * fq;
#pragma unroll
        for (int ai = 0; ai < 2; ++ai)
#pragma unroll
            for (int m = 0; m < 4; ++m) { bf16_t* rowp = O + (size_t)(row0 + ai * 128 + m * 16) * ldc + col0;
#pragma unroll
                for (int bj = 0; bj < 2; ++bj) { const accf32x4 v0 = acc[ai][bj][m][0], v1 = acc[ai][bj][m][1];
                    u32x4 w; w.x = pk2(v0[0], v0[1]); w.y = pk2(v0[2], v0[3]); w.z = pk2(v1[0], v1[1]); w.w = pk2(v1[2], v1[3]);
                    *(u32x4*)(rowp + bj * 128) = w; } }
    }
};
struct EpiSwiGLU {
    static constexpr bool PERM = true, AFTER_DRAIN = false;
    bf16_t* O;
    __device__ __forceinline__ void operator()(const accf32x4 (&acc)[2][2][4][2], const Unit& u, int wr, int wc, int fr, int fq) const {
        const int row0 = u.pm * 256 + wr * 64 + fr, col0 = u.pn * 128 + wc * 32 + 8 * fq;
#pragma unroll
        for (int ai = 0; ai < 2; ++ai)
#pragma unroll
            for (int m = 0; m < 4; ++m) { bf16_t* rowp = O + (size_t)(row0 + ai * 128 + m * 16) * FF + col0;
                float r[8];
#pragma unroll
                for (int n = 0; n < 2; ++n)
#pragma unroll
                    for (int e = 0; e < 4; ++e) { const float g = acc[ai][0][m][n][e], up = acc[ai][1][m][n][e]; r[4 * n + e] = fsilu(g) * up; }
                *(u32x4*)rowp = pack8(r); }
    }
};
struct EpiRw1 {
    static constexpr bool PERM = true, AFTER_DRAIN = false;
    unsigned char* wsb; const float* k_k;
    __device__ __forceinline__ void operator()(const accf32x4 (&acc)[2][2][4][2], const Unit& u, int wr, int wc, int fr, int fq) const {
        const int row0 = u.pm * 256 + wr * 64 + fr, cit = 64 * wc + 8 * fq;
        const int pn = u.pn;
        if (pn >= 8 && pn < 16) {
            bf16_t* K = (bf16_t*)(wsb + WS_KK_); bf16_t* KN = (bf16_t*)(wsb + WS_KN);
            const int colb = (pn - 8) * 256 + cit;
            float kk0[8], kk1[8];
            { const f32x4 a0 = *(const f32x4*)(k_k + colb), a1 = *(const f32x4*)(k_k + colb + 4), b0 = *(const f32x4*)(k_k + colb + 32), b1 = *(const f32x4*)(k_k + colb + 36);
#pragma unroll
              for (int e = 0; e < 4; ++e) { kk0[e] = a0[e]; kk0[4 + e] = a1[e]; kk1[e] = b0[e]; kk1[4 + e] = b1[e]; } }
#pragma unroll
            for (int ai = 0; ai < 2; ++ai)
#pragma unroll
                for (int m = 0; m < 4; ++m) { const size_t ro = (size_t)(row0 + ai * 128 + m * 16) * D + colb;
                    float k0[8], k1[8], q0[8], q1[8]; float ss = 0.f;
#pragma unroll
                    for (int n = 0; n < 2; ++n)
#pragma unroll
                        for (int e = 0; e < 4; ++e) { k0[4 * n + e] = acc[ai][0][m][n][e]; k1[4 * n + e] = acc[ai][1][m][n][e]; }
#pragma unroll
                    for (int i = 0; i < 8; ++i) { q0[i] = k0[i] * kk0[i]; q1[i] = k1[i] * kk1[i]; ss += q0[i] * q0[i] + q1[i] * q1[i]; }
                    ss += __shfl_xor(ss, 16); ss += __shfl_xor(ss, 32);
                    const float rs = rsqrtf(ss + 1e-12f);
#pragma unroll
                    for (int i = 0; i < 8; ++i) { q0[i] *= rs; q1[i] *= rs; }
                    *(u32x4*)(K + ro) = pack8(k0); *(u32x4*)(K + ro + 32) = pack8(k1);
                    *(u32x4*)(KN + ro) = pack8(q0); *(u32x4*)(KN + ro + 32) = pack8(q1); }
        } else if (pn < 24) {
            bf16_t* O = (bf16_t*)(wsb + (pn < 8 ? WS_RR : WS_VV)); const int colb = (pn & 7) * 256 + cit;
#pragma unroll
            for (int ai = 0; ai < 2; ++ai)
#pragma unroll
                for (int m = 0; m < 4; ++m) { const size_t ro = (size_t)(row0 + ai * 128 + m * 16) * D + colb;
#pragma unroll
                    for (int bj = 0; bj < 2; ++bj) { const accf32x4 v0 = acc[ai][bj][m][0], v1 = acc[ai][bj][m][1];
                        u32x4 w; w.x = pk2(v0[0], v0[1]); w.y = pk2(v0[2], v0[3]); w.z = pk2(v1[0], v1[1]); w.w = pk2(v1[2], v1[3]);
                        *(u32x4*)(O + ro + 32 * bj) = w; } }
        } else {
            bf16_t* O = (bf16_t*)(wsb + WS_GL + (size_t)(pn - 24) * (9 * MiB));
#pragma unroll
            for (int ai = 0; ai < 2; ++ai)
#pragma unroll
                for (int m = 0; m < 4; ++m) { const size_t ro = (size_t)(row0 + ai * 128 + m * 16) * 256 + cit;
#pragma unroll
                    for (int bj = 0; bj < 2; ++bj) { float r[8];
#pragma unroll
                        for (int n = 0; n < 2; ++n)
#pragma unroll
                            for (int e = 0; e < 4; ++e) { const float x = acc[ai][bj][m][n][e]; r[4 * n + e] = pn == 24 ? fsigmoid(x) : (pn == 25 ? ftanh(x) : x); }
                        *(u32x4*)(O + ro + 32 * bj) = pack8(r); } }
        }
    }
};
struct EpiRw2 {
    static constexpr bool PERM = true, AFTER_DRAIN = false;
    unsigned char* wsb; const float *w0, *a0; size_t aa_off;
    __device__ __forceinline__ void operator()(const accf32x4 (&acc)[2][2][4][2], const Unit& u, int wr, int wc, int fr, int fq) const {
        const int row0 = u.pm * 256 + wr * 64 + fr, cit = 64 * wc + 8 * fq;
        const int pn = u.pn;
        if (pn < 8) {
            bf16_t* G = (bf16_t*)(wsb + WS_GG);
            const int colb = pn * 256 + cit;
#pragma unroll
            for (int ai = 0; ai < 2; ++ai)
#pragma unroll
                for (int m = 0; m < 4; ++m) { const size_t ro = (size_t)(row0 + ai * 128 + m * 16) * D + colb;
#pragma unroll
                    for (int bj = 0; bj < 2; ++bj) { const accf32x4 v0 = acc[ai][bj][m][0], v1 = acc[ai][bj][m][1];
                        u32x4 w; w.x = pk2(v0[0], v0[1]); w.y = pk2(v0[2], v0[3]); w.z = pk2(v1[0], v1[1]); w.w = pk2(v1[2], v1[3]);
                        *(u32x4*)(G + ro + 32 * bj) = w; } }
        } else if (pn < 24) {
            const int d = (pn - 8) >> 3, colb = ((pn - 8) & 7) * 256 + cit;
            float* Wd = (float*)(wsb + WS_WDEC) + (size_t)d * M * D;
#pragma unroll
            for (int bj = 0; bj < 2; ++bj) {
                const f32x4 b0 = *(const f32x4*)(w0 + d * D + colb + 32 * bj), b1 = *(const f32x4*)(w0 + d * D + colb + 32 * bj + 4);
#pragma unroll
                for (int ai = 0; ai < 2; ++ai)
#pragma unroll
                    for (int m = 0; m < 4; ++m) { const size_t ro = (size_t)(row0 + ai * 128 + m * 16) * D + colb + 32 * bj;
                        f32x4 o0, o1;
#pragma unroll
                        for (int e = 0; e < 4; ++e) { o0[e] = __builtin_amdgcn_exp2f(-0.8750387749f * fsigmoid(acc[ai][bj][m][0][e] + b0[e]));
                                                      o1[e] = __builtin_amdgcn_exp2f(-0.8750387749f * fsigmoid(acc[ai][bj][m][1][e] + b1[e])); }
                        *(f32x4*)(Wd + ro) = o0; *(f32x4*)(Wd + ro + 4) = o1; } }
        } else {
            const int d = (pn - 24) >> 3, colb = ((pn - 24) & 7) * 256 + cit;
            bf16_t* AAd = (bf16_t*)(wsb + aa_off) + (size_t)d * M * D;
#pragma unroll
            for (int bj = 0; bj < 2; ++bj) {
                const int cb = colb + 32 * bj;
                const f32x4 b0 = *(const f32x4*)(a0 + d * D + cb), b1 = *(const f32x4*)(a0 + d * D + cb + 4);
#pragma unroll
                for (int ai = 0; ai < 2; ++ai)
#pragma unroll
                    for (int m = 0; m < 4; ++m) { const size_t ro = (size_t)(row0 + ai * 128 + m * 16) * D + cb;
                        float av[8];
#pragma unroll
                        for (int e = 0; e < 4; ++e) { av[e] = fsigmoid(acc[ai][bj][m][0][e] + b0[e]); av[4 + e] = fsigmoid(acc[ai][bj][m][1][e] + b1[e]); }
                        *(u32x4*)(AAd + ro) = pack8(av); } }
        }
    }
};
struct GemmRw1 { const bf16_t* MIX; const bf16_t* Bt;  int K;
    __device__ __forceinline__ const char* a_tile(const Unit& u) const { int idx = u.pn < 24 ? (u.pn >> 3) : (u.pn - 21);
#ifdef DBG_RW1_SAMEA
        idx = 0;
#endif
        return (const char*)MIX + (size_t)idx * SZ_R2 + (size_t)u.pm * (size_t)(256 * 2) * D; }
    __device__ __forceinline__ const char* b_tile(const Unit& u) const { return (const char*)Bt + (size_t)u.pn * (size_t)(256 * 2) * D; } };
struct GemmRw2 { const unsigned char* wsb; const bf16_t* Bt; int K;
    __device__ __forceinline__ const char* a_tile(const Unit& u) const { const size_t ao = u.pn < 8 ? WS_GL : (u.pn < 24 ? WS_WL : WS_AL); return (const char*)wsb + ao + (size_t)u.pm * (size_t)(256 * 2) * 256; }
    __device__ __forceinline__ const char* b_tile(const Unit& u) const { return (const char*)Bt + (size_t)u.pn * (size_t)(256 * 2) * 256; } };

__device__ __forceinline__ int hp_row(int c) { return 128 * ((c & 63) >> 5) + 32 * (c >> 6) + (c & 31); }
__device__ __forceinline__ int hp_col(int rho) { return 64 * ((rho & 127) >> 5) + 32 * (rho >> 7) + (rho & 31); }
__device__ __forceinline__ void cvt_item(const float* W, int K, int N, bf16_t* WT, int mode, int row_off, LAS float* scr, int item, int lane) {
    const int nblk = N / 32, kb = item / nblk, nb = item - kb * nblk, k0 = 64 * kb, n0 = 32 * nb;
#pragma unroll 8
    for (int i = 0; i < 32; ++i) { const int kk = 2 * i + (lane >> 5); scr[kk * 33 + (lane & 31)] = W[(size_t)(k0 + kk) * N + n0 + (lane & 31)]; }
    LDS_WAIT(); asm volatile("" ::: "memory");
    int dr;
    if (mode == 0) dr = n0;
    else if (mode == 1) { dr = n0 < FF ? 256 * (n0 / 128) + (n0 % 128) : 256 * ((n0 - FF) / 128) + 128 + ((n0 - FF) % 128); }
    else { dr = (n0 & ~255) + hp_row(n0 & 255); }
    dr += row_off;
    const int c = lane & 7;
#pragma unroll
    for (int j = 0; j < 4; ++j) { const int n = (lane >> 3) + 8 * j; const LAS float* s = scr + (8 * c) * 33 + n;
        u32x4 o; o.x = pk2(s[0 * 33], s[1 * 33]); o.y = pk2(s[2 * 33], s[3 * 33]); o.z = pk2(s[4 * 33], s[5 * 33]); o.w = pk2(s[6 * 33], s[7 * 33]);
        *(u32x4*)(WT + (size_t)(dr + n) * K + k0 + 8 * c) = o; }
    LDS_WAIT(); asm volatile("" ::: "memory");
}
__device__ __forceinline__ void p0a_phase(const Frame F, KArgs* a) {
    const int lane_ = lane_opaque(), tid_ = F.wave * 64 + lane_; (void)tid_; (void)lane_;
    LAS float* scr = (LAS float*)(F.lds + F.wave * 16384);
    const int gw = F.bid * NWAVES + F.wave, NGW = F.G * NWAVES;
    bf16_t* WB = (bf16_t*)(a->ws + WS_WB); bf16_t* WA = (bf16_t*)(a->ws + WS_WA); bf16_t* WR = (bf16_t*)(a->ws + WS_WR);
    constexpr int I_F1 = (D / 64) * (2 * FF / 32), I_F2 = (FF / 64) * (D / 32), I_QKV = (D / 64) * (3072 / 32), I_SQ = (D / 64) * (D / 32), I_G1 = (D / 64) * (256 / 32), I_G2 = (256 / 64) * (D / 32);
    constexpr int N_FFN = 8 * (I_F1 + I_F2), N_ATT = 2 * (I_QKV + I_SQ), N_RW = 2 * (4 * I_SQ + I_G1 + I_G2);
    constexpr int NITEMS = N_FFN + N_ATT + N_RW;
    for (int it = gw; it < NITEMS; it += NGW) {
        int r = it;
        if (r < N_FFN) { const int lh = r / (I_F1 + I_F2); r -= lh * (I_F1 + I_F2);
            bf16_t* base = WB + (size_t)lh * (E_F1 + E_F2);
            if (r < I_F1) cvt_item(a->in[8] + (size_t)lh * D * 2 * FF, D, 2 * FF, base, 1, 0, scr, r, lane_);
            else cvt_item(a->in[9] + (size_t)lh * FF * D, FF, D, base + E_F1, 0, 0, scr, r - I_F1, lane_);
            continue; }
        r -= N_FFN;
        if (r < N_ATT) { const int j = r / (I_QKV + I_SQ); r -= j * (I_QKV + I_SQ);
            bf16_t* base = WA + (size_t)j * (E_QKV + E_SQ);
            if (r < I_QKV) cvt_item(a->in[10] + (size_t)j * D * 3072, D, 3072, base, 0, 0, scr, r, lane_);
            else cvt_item(a->in[11] + (size_t)j * D * D, D, D, base + E_QKV, 0, 0, scr, r - I_QKV, lane_);
            continue; }
        r -= N_ATT;
        { const int per = 4 * I_SQ + I_G1 + I_G2; const int j = r / per; r -= j * per;
          bf16_t* rw1 = WR + (size_t)j * (E_RW1 + E_RW2 + E_SQ); bf16_t* rw2 = rw1 + E_RW1; bf16_t* ro = rw2 + E_RW2;
          if (r < 3 * I_SQ) { const int q = r / I_SQ; cvt_item(a->in[15] + ((size_t)j * 3 + q) * D * D, D, D, rw1, 2, q * 2048, scr, r - q * I_SQ, lane_); continue; }
          r -= 3 * I_SQ;
          if (r < I_SQ) { cvt_item(a->in[16] + (size_t)j * D * D, D, D, ro, 0, 0, scr, r, lane_); continue; }
          r -= I_SQ;
          if (r < I_G1) { cvt_item(a->in[17] + (size_t)j * D * 256, D, 256, rw1, 2, 6144, scr, r, lane_); continue; }
          r -= I_G1;
          cvt_item(a->in[18] + (size_t)j * 256 * D, 256, D, rw2, 2, 0, scr, r, lane_); }
    }
    {
        constexpr int P_A = 256 * 2048 / 2, P_C = 4096 * 256 / 2, P_J = 2 * P_A + 2 * P_C;
        for (int p = F.bid * NTHR + tid_; p < 2 * P_J; p += F.G * NTHR) {
            const int j = p / P_J; int r = p - j * P_J;
            bf16_t* rw1 = WR + (size_t)j * (E_RW1 + E_RW2 + E_SQ); bf16_t* rw2 = rw1 + E_RW1;
            if (r < 2 * P_A) { const int which = r / P_A; r -= which * P_A;
                const int rho = r / 1024, k = (r - rho * 1024) * 2, c = hp_col(rho);
                const float* src = (which == 0 ? a->in[20] : a->in[23]);
                float v0 = 0.f, v1 = 0.f;
                if (c < 192) { const int d = c / 96, jj = c - d * 96; const float* s = src + (((size_t)j * 2 + d) * D + k) * 96 + jj; v0 = s[0]; v1 = s[96]; }
                *(unsigned*)(rw1 + (size_t)(6400 + 256 * which + rho) * D + k) = pk2(v0, v1);
            } else { r -= 2 * P_A; const int which = r / P_C; r -= which * P_C;
                const int nrow = r / 128, k = (r - nrow * 128) * 2;
                const int d = nrow >> 11, np = nrow & 2047, c = (np & ~255) + hp_col(np & 255);
                const float* src = (which == 0 ? a->in[21] : a->in[24]);
                float v0 = 0.f, v1 = 0.f;
                if (k < 192 && (k / 96) == d) { const int kk = k - d * 96; const float* s = src + (((size_t)j * 2 + d) * 96 + kk) * D + c; v0 = s[0]; v1 = s[D]; }
                *(unsigned*)(rw2 + (size_t)(2048 + 4096 * which + nrow) * 256 + k) = pk2(v0, v1);
            }
        }
    }
#ifdef DBG_FILL_WS
    {
        u32x4* p = (u32x4*)(a->ws + WS_X); const size_t n16 = (WS_END - WS_X) / 16;
        for (size_t i = (size_t)F.bid * NTHR + tid_; i < n16; i += (size_t)F.G * NTHR) p[i] = (u32x4){0xAAAAAAAAu, 0xAAAAAAAAu, 0xAAAAAAAAu, 0xAAAAAAAAu};
    }
#endif
    {
        float* COS = (float*)(a->ws + WS_ROPE); float* SIN = COS + 4096 * 64;
        for (int p = F.bid * NTHR + tid_; p < 4096 * 64; p += F.G * NTHR) {
            const int t = p >> 6, f = p & 63; const int pos = f < 32 ? (t >> 6) : (t & 63); const int fi = f & 31;
            const float inv = exp2f(-(float)fi * (13.287712379549449f / 32.0f));
            const float ang = (float)pos * inv;
            COS[p] = cosf(ang); SIN[p] = sinf(ang);
        }
    }
    {
        LAS float* sv = (LAS float*)F.lds;
        LAS float* part = (LAS float*)(F.lds + 65536);
        float* MOD = (float*)(a->ws + WS_MOD);
        __syncthreads();
        for (int idx = tid_; idx < 5 * D; idx += NTHR) { const int cc = idx >> 11, kk = idx & 2047; const float x = cc < 4 ? a->in[1][cc * D + kk] : a->in[3][kk]; sv[kk * 8 + cc] = fsilu(x); }
        __syncthreads();
        for (int u = F.bid; u < 4 * 72; u += F.G) {
            const int l = u / 72, nb = u - l * 72;
            const int n = nb * 256 + lane_ * 4, k0 = F.wave * 256;
            const float* wp = a->in[4] + ((size_t)l * D + k0) * 18432 + n;
            f32x4 acc[5];
#pragma unroll
            for (int c = 0; c < 5; ++c) acc[c] = (f32x4){0.f, 0.f, 0.f, 0.f};
#pragma unroll 8
            for (int kk = 0; kk < 256; ++kk) { const f32x4 w4 = *(const f32x4*)(wp + (size_t)kk * 18432);
                const f32x4 s4 = *(const LAS f32x4*)(sv + (k0 + kk) * 8); const float s5 = sv[(k0 + kk) * 8 + 4];
                acc[0] += w4 * s4[0]; acc[1] += w4 * s4[1]; acc[2] += w4 * s4[2]; acc[3] += w4 * s4[3]; acc[4] += w4 * s5; }
#pragma unroll
            for (int c = 0; c < 5; ++c) *(LAS f32x4*)(part + (F.wave * 5 + c) * 256 + lane_ * 4) = acc[c];
            __syncthreads();
            for (int o = tid_; o < 5 * 256; o += NTHR) { const int c = o >> 8, col = o & 255; float s = a->in[5][(size_t)l * 18432 + nb * 256 + col];
#pragma unroll
                for (int w = 0; w < 8; ++w) s += part[(w * 5 + c) * 256 + col];
                MOD[((size_t)l * 5 + c) * 18432 + nb * 256 + col] = s; }
            __syncthreads();
        }
    }
}

template <int MODE> struct ThinCtx { float PA[4][8], PB[4][8], PC[4][8]; int cur_c; };
template <int MODE>
__device__ __forceinline__ void thin_row(ThinCtx<MODE>& T, KArgs* a, const int lane, const int m, int l, int s, float wgt, int nl, int ns) {
    const float* MOD = (const float*)(a->ws + WS_MOD);
    bf16_t* X = (bf16_t*)(a->ws + WS_X)  ; bf16_t* Y = (bf16_t*)(a->ws + WS_Y); const bf16_t* OUT = (const bf16_t*)(a->ws + WS_OUT);
    const int b = m / TB, j = m - b * TB, c = j < CTXL ? 4 : b;
    if (MODE == 2 && c == 4) return;
    if (c != T.cur_c) {
        T.cur_c = c;
#pragma unroll
        for (int q = 0; q < 4; ++q) { const int e0 = 512 * q + 8 * lane;
            if (MODE != 0) { const float* gp = MOD + (((size_t)l * 5 + c) * 9 + s * 3 + 2) * D + e0; const float* np = a->in[7] + ((size_t)l * 3 + s) * D + e0;
#pragma unroll
                for (int i = 0; i < 8; ++i) T.PA[q][i] = wgt * gp[i] * np[i]; }
            if (MODE != 2) { const float* sc = MOD + (((size_t)nl * 5 + c) * 9 + ns * 3 + 1) * D + e0; const float* sh = MOD + (((size_t)nl * 5 + c) * 9 + ns * 3 + 0) * D + e0; const float* np = a->in[6] + ((size_t)nl * 3 + ns) * D + e0;
#pragma unroll
                for (int i = 0; i < 8; ++i) { T.PB[q][i] = np[i] * (1.0f + sc[i]); T.PC[q][i] = sh[i]; } } }
    }
    float x[4][8];
    if (MODE == 0) {
        const float* src = j < CTXL ? a->in[2] + ((size_t)b * CTXL + j) * D : a->in[0] + ((size_t)b * SEQ + (j - CTXL)) * D;
#pragma unroll
        for (int q = 0; q < 4; ++q) { const f32x4 v0 = *(const f32x4*)(src + 512 * q + 8 * lane), v1 = *(const f32x4*)(src + 512 * q + 8 * lane + 4);
#pragma unroll
            for (int e = 0; e < 4; ++e) { x[q][e] = v0[e]; x[q][4 + e] = v1[e]; } }
    } else {
        float o[4][8]; float ss = 0.f;
#pragma unroll
        for (int q = 0; q < 4; ++q) { unpack8(*(const u32x4*)(OUT + (size_t)m * D + 512 * q + 8 * lane), o[q]);
#pragma unroll
            for (int i = 0; i < 8; ++i) ss += o[q][i] * o[q][i]; }
        ss = wave_sum(ss);
        const float r1 = rsqrtf(ss * (1.0f / D) + NORM_EPS);
#pragma unroll
        for (int q = 0; q < 4; ++q) { float xo[8]; unpack8h(*(const u32x4*)(X + (size_t)m * D + 512 * q + 8 * lane), xo);
#pragma unroll
            for (int e = 0; e < 8; ++e) x[q][e] = xo[e] + T.PA[q][e] * (o[q][e] * r1); }
    }
    if (MODE == 2) {
        float* dst = a->out + ((size_t)b * SEQ + (j - CTXL)) * D;
#pragma unroll
        for (int q = 0; q < 4; ++q) { *(f32x4*)(dst + 512 * q + 8 * lane) = (f32x4){x[q][0], x[q][1], x[q][2], x[q][3]}; *(f32x4*)(dst + 512 * q + 8 * lane + 4) = (f32x4){x[q][4], x[q][5], x[q][6], x[q][7]}; }
        return;
    }
    float ss2 = 0.f;
#pragma unroll
    for (int q = 0; q < 4; ++q) { *(u32x4*)(X + (size_t)m * D + 512 * q + 8 * lane) = pack8h(x[q]);
#pragma unroll
        for (int i = 0; i < 8; ++i) ss2 += x[q][i] * x[q][i]; }
    ss2 = wave_sum(ss2);
    const float r2 = rsqrtf(ss2 * (1.0f / D) + NORM_EPS);
#pragma unroll
    for (int q = 0; q < 4; ++q) { float y[8];
#pragma unroll
        for (int i = 0; i < 8; ++i) y[i] = (x[q][i] * r2) * T.PB[q][i] + T.PC[q][i];
        *(u32x4*)(Y + (size_t)m * D + 512 * q + 8 * lane) = pack8(y); }
}
template <int MODE, int ROWSET>
__device__ __forceinline__ void thin_phase(const Frame F, KArgs* a, int l, int s, float wgt, int nl, int ns) {
    const int lane_ = lane_opaque();
    ThinCtx<MODE> T; T.cur_c = -1;
    if (ROWSET == 0) {
        for (int ch = F.bid; ch < M / 68; ch += F.G) {
            const int r0 = ch * 68 + (F.wave < 4 ? 9 * F.wave : 36 + 8 * (F.wave - 4)), nr = F.wave < 4 ? 9 : 8;
            for (int r = 0; r < nr; ++r) thin_row<MODE>(T, a, lane_, r0 + r, l, s, wgt, nl, ns);
        }
    } else if (ROWSET == 1) {
        const int nw = (F.G - 32) * NWAVES, wv = (F.bid - 32) * NWAVES + F.wave;
        const int l0 = (int)(((long)wv * (NB * SEQ)) / nw), l1 = (int)(((long)(wv + 1) * (NB * SEQ)) / nw);
        for (int li = l0; li < l1; ++li) thin_row<MODE>(T, a, lane_, (li >> 12) * TB + CTXL + (li & (SEQ - 1)), l, s, wgt, nl, ns);
    } else {
        for (int c = F.bid * NWAVES + F.wave; c < NB * CTXL; c += F.G * NWAVES) thin_row<MODE>(T, a, lane_, (c >> 8) * TB + (c & (CTXL - 1)), l, s, wgt, nl, ns);
    }
}
struct LatentOrder : pg8::StaticOrder {
    __device__ void init_lat(int N, int G_, int c_) { init(64 * 256, N, G_, c_); }
    __device__ bool next(int i, Unit& u) const { if (!pg8::StaticOrder::next(i, u)) return false; u.pm = u.pm + (u.pm >> 4) + 1; return true; }
};
struct CtxOrder {
    int c;
    __device__ bool next(int i, Unit& u) const { if (i != 0 || c >= 32) return false; u.pm = (c >> 3) * 17; u.pn = c & 7; return true; }
    __device__ __forceinline__ void a_ready(const Unit&) const {}
    __device__ __forceinline__ void done(const Unit&) const {}
};
#ifndef DBG_DUMP_OFF
#define DBG_DUMP_OFF WS_X
#define DBG_DUMP_F32 1
#endif
__device__ __forceinline__ void copyout_phase(const Frame F, KArgs* a) {
    const int lane_ = lane_opaque();
    for (int m = F.bid * NWAVES + F.wave; m < M; m += F.G * NWAVES) { const int b = m / TB, j = m - b * TB; if (j < CTXL) continue;
        float* dst = a->out + ((size_t)b * SEQ + (j - CTXL)) * D;
#if defined(DBG_DUMP_P256)
        { const size_t offs[] = {DBG_DUMP_P256}; constexpr int NL = sizeof(offs) / sizeof(offs[0]);
          for (int q = 0; q < 4; ++q) { float acc[8], v[8]; for (int e = 0; e < 8; ++e) acc[e] = 0.f;
              if (q == 0 && lane_ < 32) { for (int t = 0; t < NL; ++t) { unpack8(*(const u32x4*)((const bf16_t*)(a->ws + offs[t]) + (size_t)m * 256 + 8 * lane_), v); for (int e = 0; e < 8; ++e) acc[e] += (1.f + t) * v[e]; } }
              *(f32x4*)(dst + 512 * q + 8 * lane_) = (f32x4){acc[0], acc[1], acc[2], acc[3]}; *(f32x4*)(dst + 512 * q + 8 * lane_ + 4) = (f32x4){acc[4], acc[5], acc[6], acc[7]}; }
          continue; }
#endif
#ifndef DBG_DUMP_W
#define DBG_DUMP_W(t) (1.f + (t))
#endif
#if defined(DBG_DUMP_LIST)
        { const size_t offs[] = {DBG_DUMP_LIST}; constexpr int NL = sizeof(offs) / sizeof(offs[0]);
#pragma unroll
          for (int q = 0; q < 4; ++q) { const size_t ro = (size_t)m * D + 512 * q + 8 * lane_; float acc[8], v[8];
              for (int e = 0; e < 8; ++e) acc[e] = 0.f;
#pragma unroll
              for (int t = 0; t < NL; ++t) { unpack8(*(const u32x4*)((const bf16_t*)(a->ws + offs[t]) + ro), v); for (int e = 0; e < 8; ++e) acc[e] += DBG_DUMP_W(t) * v[e]; }
              *(f32x4*)(dst + 512 * q + 8 * lane_) = (f32x4){acc[0], acc[1], acc[2], acc[3]}; *(f32x4*)(dst + 512 * q + 8 * lane_ + 4) = (f32x4){acc[4], acc[5], acc[6], acc[7]}; }
          continue; }
#endif
        if (DBG_DUMP_F32) { const float* X = (const float*)(a->ws + (DBG_DUMP_OFF));
#pragma unroll
            for (int q = 0; q < 8; ++q) *(f32x4*)(dst + 256 * q + 4 * lane_) = *(const f32x4*)(X + (size_t)m * D + 256 * q + 4 * lane_); }
        else { const bf16_t* Bq = (const bf16_t*)(a->ws + (DBG_DUMP_OFF));
#pragma unroll
            for (int q = 0; q < 4; ++q) { float v[8]; unpack8(*(const u32x4*)(Bq + (size_t)m * D + 512 * q + 8 * lane_), v);
                *(f32x4*)(dst + 512 * q + 8 * lane_) = (f32x4){v[0], v[1], v[2], v[3]}; *(f32x4*)(dst + 512 * q + 8 * lane_ + 4) = (f32x4){v[4], v[5], v[6], v[7]}; } }
    }
}

__device__ __forceinline__ void mixes_phase(const Frame F, KArgs* a, int jr) {
    const int lane_ = lane_opaque(), tid_ = F.wave * 64 + lane_; (void)tid_; (void)lane_;
    const bf16_t* Y = (const bf16_t*)(a->ws + WS_Y); bf16_t* MIX = (bf16_t*)(a->ws + WS_MIX6);
    const int rg = F.wave >> 2, e0 = 512 * (F.wave & 3) + 8 * lane_;
    float mu[6][8];
    { const int muidx[6] = {0, 2, 3, 5, 1, 4};
#pragma unroll
      for (int q = 0; q < 6; ++q) { const float* mp = a->in[14] + ((size_t)jr * 6 + muidx[q]) * D + e0;
#pragma unroll
          for (int i = 0; i < 8; ++i) mu[q][i] = mp[i]; } }
    for (int ch = F.bid; ch < M / 68; ch += F.G) {
        const int r0 = ch * 68 + 34 * rg;
        float yp[8], yc[8], yn[8];
        if (r0 > 0) unpack8(*(const u32x4*)(Y + (size_t)(r0 - 1) * D + e0), yp); else {
#pragma unroll
            for (int i = 0; i < 8; ++i) yp[i] = 0.f; }
        unpack8(*(const u32x4*)(Y + (size_t)r0 * D + e0), yc);
        for (int r = 0; r < 34; ++r) { const int m = r0 + r, j = m % TB;
            if (m + 1 < M) unpack8(*(const u32x4*)(Y + (size_t)(m + 1) * D + e0), yn); else {
#pragma unroll
                for (int i = 0; i < 8; ++i) yn[i] = 0.f; }
            const float pv = (j != 0 && j != CTXL) ? 0.5f : 0.f, nv = (j != CTXL - 1 && j != TB - 1) ? 0.5f : 0.f;
            float xx[8];
#pragma unroll
            for (int i = 0; i < 8; ++i) xx[i] = (pv * yp[i] + nv * yn[i]) - yc[i];
#pragma unroll
            for (int q = 0; q < 6; ++q) { float o[8];
#pragma unroll
                for (int i = 0; i < 8; ++i) o[i] = yc[i] + xx[i] * mu[q][i];
                *(u32x4*)(MIX + (size_t)q * M * D + (size_t)m * D + e0) = pack8(o); }
#pragma unroll
            for (int i = 0; i < 8; ++i) { yp[i] = yc[i]; yc[i] = yn[i]; }
        }
    }
}

__device__ __forceinline__ void qknorm_phase(const Frame F, KArgs* a, int ja) {
    const int lane_ = lane_opaque(), tid_ = F.wave * 64 + lane_; (void)tid_; (void)lane_;
    bf16_t* Q = (bf16_t*)(a->ws + WS_Q); bf16_t* K = (bf16_t*)(a->ws + WS_K);
    const float* COS = (const float*)(a->ws + WS_ROPE); const float* SIN = COS + 4096 * 64;
    const int li = lane_ & 15, hs = lane_ >> 4;
    float gq[8], gk[8];
#pragma unroll
    for (int i = 0; i < 8; ++i) { gq[i] = a->in[12][ja * 128 + 8 * li + i]; gk[i] = a->in[13][ja * 128 + 8 * li + i]; }
    for (int m = F.bid * NWAVES + F.wave; m < M; m += F.G * NWAVES) {
        const int j = m % TB; const bool lat = j >= CTXL; const int pos = lat ? j - CTXL : 0;
        f32x4 cs = (f32x4){1.f, 1.f, 1.f, 1.f}, sn = (f32x4){0.f, 0.f, 0.f, 0.f};
        if (lat) { cs = *(const f32x4*)(COS + (size_t)pos * 64 + 4 * li); sn = *(const f32x4*)(SIN + (size_t)pos * 64 + 4 * li); }
#pragma unroll
        for (int p = 0; p < 5; ++p) {
            bf16_t* ptr = p < 4 ? Q + (size_t)m * D + (4 * p + hs) * 128 + 8 * li : K + (size_t)m * 512 + hs * 128 + 8 * li;
            float v[8]; unpack8(*(const u32x4*)ptr, v);
            float ss = 0.f;
#pragma unroll
            for (int i = 0; i < 8; ++i) ss += v[i] * v[i];
            ss = sum16(ss);
            const float rs = rsqrtf(ss * (1.0f / 128.0f) + NORM_EPS);
            float o[8];
#pragma unroll
            for (int i = 0; i < 4; ++i) { const float x1 = v[2 * i] * rs * (p < 4 ? gq[2 * i] : gk[2 * i]), x2 = v[2 * i + 1] * rs * (p < 4 ? gq[2 * i + 1] : gk[2 * i + 1]);
                o[2 * i] = x1 * cs[i] - x2 * sn[i]; o[2 * i + 1] = x1 * sn[i] + x2 * cs[i]; }
            *(u32x4*)ptr = pack8(o);
        }
    }
}

template <int R> __device__ __forceinline__ float ror16(float x) { return __builtin_bit_cast(float, __builtin_amdgcn_mov_dpp(__builtin_bit_cast(int, x), 0x120 + R, 0xF, 0xF, true)); }
__device__ __forceinline__ float sum_row16(float x) { x += ror16<8>(x); x += ror16<4>(x); x += ror16<2>(x); x += ror16<1>(x); return x; }
__device__ __forceinline__ float sum_rows(float x) {
    x += ror16<8>(x);
    { const unsigned u = __builtin_bit_cast(unsigned, x); auto rr = __builtin_amdgcn_permlane16_swap(u, u, false, false); const unsigned r0 = rr[0], r1 = rr[1];
      x = __builtin_bit_cast(float, r0) + __builtin_bit_cast(float, r1); }
    { const unsigned u = __builtin_bit_cast(unsigned, x); auto rr = __builtin_amdgcn_permlane32_swap(u, u, false, false); const unsigned r0 = rr[0], r1 = rr[1];
      x = __builtin_bit_cast(float, r0) + __builtin_bit_cast(float, r1); }
    return x;
}
__device__ __forceinline__ void scan_phase(const Frame F, KArgs* a, int jr) {
    const int lane_ = lane_opaque(), tid_ = F.wave * 64 + lane_; (void)tid_; (void)lane_;
    LAS float* L = (LAS float*)F.lds;
    constexpr int BUF = 32 * 384, YB0 = 2 * BUF, YBUF = 32 * 64;
    const int tid = tid_, lane = lane_, li4 = (lane & 15) * 4, vrow = 8 * F.wave + 2 * (lane >> 4);
    const float* WDEC = (const float*)(a->ws + WS_WDEC);
    const bf16_t* KR = (const bf16_t*)(a->ws + WS_KK_); const bf16_t* AA = (const bf16_t*)(a->ws + WS_AA);
    const bf16_t* KN = (const bf16_t*)(a->ws + WS_KN); const bf16_t* RR = (const bf16_t*)(a->ws + WS_RR); const bf16_t* VV = (const bf16_t*)(a->ws + WS_VV);
    bf16_t* YS = (bf16_t*)(a->ws + WS_YS);
    for (int chain = F.bid; chain < 256; chain += F.G) {
        const int b = chain >> 6, h = (chain >> 1) & 31, dir = chain & 1;
        const size_t doff = (size_t)dir * M * D;
        const int hc = h * 64;
        const int lrow = (tid & 255) >> 3, lpart = tid & 7, wrow = tid >> 4, wpart = tid & 15; const bool lo = tid < 256;
        const bf16_t* pa = (lo ? KR : RR) + hc + lpart * 8; const bf16_t* pb = (lo ? KN : VV) + hc + lpart * 8; const bf16_t* pc = AA + doff + hc + lpart * 8;
        float ka[8];
#pragma unroll
        for (int i = 0; i < 8; ++i) ka[i] = a->in[26][(size_t)jr * D + hc + lpart * 8 + i];
        const float* pw = WDEC + doff + hc + wpart * 4;
        u32x4 ra, rb, rc; f32x4 rw;
        f32x2 S2[4];
#pragma unroll
        for (int i = 0; i < 4; ++i) S2[i] = (f32x2){0.f, 0.f};
#define SCAN_M0(q) (b * TB + (dir == 0 ? 32 * (q) : ((q) < 8 ? 224 - 32 * (q) : 4576 - 32 * (q))))
#define SCAN_LOAD(q) do { const size_t m0_ = (size_t)SCAN_M0(q); ra = *(const u32x4*)(pa + (m0_ + lrow) * D); rb = *(const u32x4*)(pb + (m0_ + lrow) * D); if (lo) rc = *(const u32x4*)(pc + (m0_ + lrow) * D); \
        rw = *(const f32x4*)(pw + (m0_ + wrow) * D); } while (0)
#define SCAN_ST8(off_, t_) do { *(LAS f32x4*)(d_ + (off_)) = (f32x4){t_[0], t_[1], t_[2], t_[3]}; *(LAS f32x4*)(d_ + (off_) + 4) = (f32x4){t_[4], t_[5], t_[6], t_[7]}; } while (0)
#define SCAN_WRITE(bufi) do { LAS float* d_ = L + (bufi) * BUF + lrow * 384 + lpart * 8; float ta_[8], tb_[8]; \
        unpack8(ra, ta_); unpack8(rb, tb_); \
        if (lo) { float tc_[8], kd_[8], bb_[8]; unpack8(rc, tc_); _Pragma("unroll") for (int i_ = 0; i_ < 8; ++i_) { kd_[i_] = ta_[i_] * (1.0f + (tc_[i_] - 1.0f) * ka[i_]); bb_[i_] = tb_[i_] * tc_[i_]; } \
            SCAN_ST8(64, kd_); SCAN_ST8(128, bb_); SCAN_ST8(192, tb_); } \
        else { SCAN_ST8(256, ta_); SCAN_ST8(320, tb_); } \
        *(LAS f32x4*)(L + (bufi) * BUF + wrow * 384 + wpart * 4) = rw; } while (0)
        __syncthreads();
        SCAN_LOAD(0); SCAN_WRITE(0); __syncthreads();
        for (int q = 0; q < 136; ++q) {
            const int bi = q & 1;
            if (q + 1 < 136) SCAN_LOAD(q + 1);
            const LAS float* base = L + bi * BUF + (dir ? 31 * 384 : 0); const int stp = dir ? -384 : 384;
            LAS float* yb = L + YB0 + bi * YBUF + (dir ? 31 * 64 : 0) + vrow; const int ystp = dir ? -64 : 64;
#define SUM2_ROW16(a_, b_) asm volatile("s_nop 1\n\t" \
    "v_add_f32_dpp %0, %0, %0 row_ror:8 row_mask:0xf bank_mask:0xf\n\tv_add_f32_dpp %1, %1, %1 row_ror:8 row_mask:0xf bank_mask:0xf\n\ts_nop 0\n\t" \
    "v_add_f32_dpp %0, %0, %0 row_ror:4 row_mask:0xf bank_mask:0xf\n\tv_add_f32_dpp %1, %1, %1 row_ror:4 row_mask:0xf bank_mask:0xf\n\ts_nop 0\n\t" \
    "v_add_f32_dpp %0, %0, %0 row_ror:2 row_mask:0xf bank_mask:0xf\n\tv_add_f32_dpp %1, %1, %1 row_ror:2 row_mask:0xf bank_mask:0xf\n\ts_nop 0\n\t" \
    "v_add_f32_dpp %0, %0, %0 row_ror:1 row_mask:0xf bank_mask:0xf\n\tv_add_f32_dpp %1, %1, %1 row_ror:1 row_mask:0xf bank_mask:0xf\n\ts_nop 1" : "+v"(a_), "+v"(b_))
            f32x4 nw4 = *(const LAS f32x4*)(base + li4), nd4 = *(const LAS f32x4*)(base + 64 + li4), nb4 = *(const LAS f32x4*)(base + 128 + li4), nn4 = *(const LAS f32x4*)(base + 192 + li4), nr4 = *(const LAS f32x4*)(base + 256 + li4);
            f32x2 nv2 = *(const LAS f32x2*)(base + 320 + vrow);
#pragma unroll 4
            for (int s = 0; s < 32; ++s) {
                const f32x4 w4 = nw4, d4 = nd4, b4 = nb4, n4 = nn4, r4 = nr4; const f32x2 v2 = nv2;
                { const LAS float* p = base + (s < 31 ? s + 1 : s) * stp;
                  nw4 = *(const LAS f32x4*)(p + li4); nd4 = *(const LAS f32x4*)(p + 64 + li4); nb4 = *(const LAS f32x4*)(p + 128 + li4); nn4 = *(const LAS f32x4*)(p + 192 + li4); nr4 = *(const LAS f32x4*)(p + 256 + li4);
                  nv2 = *(const LAS f32x2*)(p + 320 + vrow); }
                f32x2 pk = S2[0] * n4[0]; pk = S2[1] * n4[1] + pk; pk = S2[2] * n4[2] + pk; pk = S2[3] * n4[3] + pk;
                SUM2_ROW16(pk.x, pk.y); const f32x2 nsk = -pk;
#pragma unroll
                for (int qq = 0; qq < 4; ++qq) S2[qq] = S2[qq] * w4[qq] + (v2 * d4[qq] + nsk * b4[qq]);
                f32x2 yk = S2[0] * r4[0]; yk = S2[1] * r4[1] + yk; yk = S2[2] * r4[2] + yk; yk = S2[3] * r4[3] + yk;
                SUM2_ROW16(yk.x, yk.y);
                if ((lane & 15) == 0) *(LAS f32x2*)(yb + s * ystp) = yk;
            }
#undef SUM2_ROW16
            if (q + 1 < 136) SCAN_WRITE(bi ^ 1);
            __syncthreads();
            if (tid < 256) { const LAS float* ys = L + YB0 + bi * YBUF + lrow * 64 + lpart * 8; float t[8];
                const f32x4 y0 = *(const LAS f32x4*)ys, y1 = *(const LAS f32x4*)(ys + 4);
#pragma unroll
                for (int e = 0; e < 4; ++e) { t[e] = y0[e]; t[4 + e] = y1[e]; }
                *(u32x4*)(YS + doff + ((size_t)SCAN_M0(q) + lrow) * D + hc + lpart * 8) = pack8(t); }
        }
        __syncthreads();
#undef SCAN_M0
#undef SCAN_LOAD
#undef SCAN_WRITE
#undef SCAN_ST8
    }
}

__device__ __forceinline__ void outprep_phase(const Frame F, KArgs* a, int jr) {
    const int lane_ = lane_opaque(), tid_ = F.wave * 64 + lane_; (void)tid_; (void)lane_;
    const bf16_t* YS = (const bf16_t*)(a->ws + WS_YS); const bf16_t* AA = (const bf16_t*)(a->ws + WS_AA); const bf16_t* KR = (const bf16_t*)(a->ws + WS_KK_);
    const bf16_t* RR = (const bf16_t*)(a->ws + WS_RR); const bf16_t* VV = (const bf16_t*)(a->ws + WS_VV); const bf16_t* GG = (const bf16_t*)(a->ws + WS_GG);
    bf16_t* PREP = (bf16_t*)(a->ws + WS_PREP);
    const float* lw = a->in[28] + (size_t)jr * D; const float* lb = a->in[29] + (size_t)jr * D; const float* rk = a->in[27] + (size_t)jr * D; const float* kav = a->in[26] + (size_t)jr * D;
    for (int m = F.bid * NWAVES + F.wave; m < M; m += F.G * NWAVES) {
#pragma unroll
        for (int q = 0; q < 4; ++q) { const int e0 = 512 * q + 8 * lane_; const size_t ro = (size_t)m * D + e0;
            float y0[8], y1[8], o[8];
            unpack8(*(const u32x4*)(YS + ro), y0); unpack8(*(const u32x4*)(YS + (size_t)M * D + ro), y1);
            float sm = 0.f;
#pragma unroll
            for (int i = 0; i < 8; ++i) { o[i] = y0[i] + y1[i]; sm += o[i]; }
            const float mean = sum8(sm) * (1.0f / 64.0f);
            float sq = 0.f;
#pragma unroll
            for (int i = 0; i < 8; ++i) { o[i] -= mean; sq += o[i] * o[i]; }
            const float rs = rsqrtf(sum8(sq) * (1.0f / 64.0f) + 64e-5f);
            float r[8], k0[8], k1[8], kr[8], v[8], g[8];
            unpack8(*(const u32x4*)(RR + ro), r); unpack8(*(const u32x4*)(AA + ro), k0); unpack8(*(const u32x4*)(AA + (size_t)M * D + ro), k1); unpack8(*(const u32x4*)(KR + ro), kr);
            unpack8(*(const u32x4*)(VV + ro), v); unpack8(*(const u32x4*)(GG + ro), g);
            float bs = 0.f;
#pragma unroll
            for (int i = 0; i < 8; ++i) bs += r[i] * (kr[i] * (2.0f + (k0[i] + k1[i] - 2.0f) * kav[e0 + i])) * rk[e0 + i];
            bs = sum8(bs);
            float out[8];
#pragma unroll
            for (int i = 0; i < 8; ++i) out[i] = (o[i] * rs * lw[e0 + i] + lb[e0 + i] + bs * v[i]) * g[i];
            *(u32x4*)(PREP + ro) = pack8(out); }
    }
}

__device__ __forceinline__ void attention_phase(const Frame F, KArgs* a) {
    const attn::bf16* Q = (const attn::bf16*)(a->ws + WS_Q); const attn::bf16* K = (const attn::bf16*)(a->ws + WS_K); const attn::bf16* V = (const attn::bf16*)(a->ws + WS_V);
    attn::bf16* O = (attn::bf16*)(a->ws + WS_O);
    for (int u = F.bid; u < 1024 + 64; u += F.G) {
        size_t qoff, koff; int seq;
        if (u < 1024) { const int c = u & 255, i = u >> 8, grp = (c & 7) >> 1, member = (c & 1) * 32 + (c >> 3), bk = i * 4 + grp, b = bk >> 2, kvh = bk & 3, hq = kvh * 4 + (member >> 4), qb = member & 15;
            qoff = (size_t)(b * TB + CTXL + qb * 256) * 2048 + hq * 128; koff = (size_t)b * TB * 512 + kvh * 128; seq = TB; }
        else { const int cu = u - 1024, b = cu >> 4, hq = cu & 15, kvh = hq >> 2;
            qoff = (size_t)(b * TB) * 2048 + hq * 128; koff = (size_t)b * TB * 512 + kvh * 128; seq = CTXL; }
        attn::attn_dense_body<attn::bf16>(Q + qoff, K + koff, V + koff, O + qoff, seq, (char*)F.ldsg, F.wave);
        __syncthreads();
    }
}

#ifndef EN_P0
#define EN_P0 1
#endif
#ifndef EN_THIN
#define EN_THIN 1
#endif
#ifndef EN_QKN
#define EN_QKN 1
#endif
#ifndef EN_ATT
#define EN_ATT 1
#endif
#ifndef EN_MIX
#define EN_MIX 1
#endif
#ifndef EN_SCAN
#define EN_SCAN 1
#endif
#ifndef EN_OPREP
#define EN_OPREP 1
#endif
#ifndef EN_FFN
#define EN_FFN 1
#endif
#ifndef EN_GQKV
#define EN_GQKV 1
#endif
#ifndef EN_GWO
#define EN_GWO 1
#endif
#ifndef EN_RW1
#define EN_RW1 1
#endif
#ifndef EN_RW2
#define EN_RW2 1
#endif
__device__ __forceinline__ KArgs* opaque_k(KArgs* p) { asm volatile("" : "+s"(p)); return p; }
#ifndef DBG_STOP
#define DBG_STOP -1
#endif
__device__ __forceinline__ Frame fresh(const Frame& F) { Frame R = F; asm volatile("" : "+s"(R.bid), "+s"(R.G), "+s"(R.wave)); return R; }
#ifndef GEMM_ALIGN
#define GEMM_ALIGN true
#define GEMM_SP2 true
#endif
#ifndef RW2_ALIGN
#define RW2_ALIGN true
#define RW2_SP2 true
#endif
#ifndef RW1_ALIGN
#define RW1_ALIGN true
#define RW1_SP2 true
#endif
#ifndef REP_THIN
#define REP_THIN 1
#endif
#ifndef REP_OG
#define REP_OG 1
#endif
#ifndef REP_EW
#define REP_EW 1
#endif
#ifndef REP_FFN1
#define REP_FFN1 1
#endif
#ifndef REP_FFN2
#define REP_FFN2 1
#endif
#ifndef REP_P0
#define REP_P0 1
#endif
#ifndef REP_SCAN
#define REP_SCAN 1
#endif
#ifndef REP_ATT
#define REP_ATT 1
#endif
#ifndef REP_RW1
#define REP_RW1 1
#endif
constexpr int NPHASE = 50;
constexpr int STOP_PHASE = (DBG_STOP >= 0) ? DBG_STOP : NPHASE - 1;
__global__ void __launch_bounds__(NTHR, 2) fwd_kernel(Args args) {
    extern __shared__ __attribute__((aligned(16))) unsigned char lds[];
    Frame F;
    F.lds = (LAS unsigned char*)lds; F.ldsg = lds;
    F.wave = __builtin_amdgcn_readfirstlane((int)threadIdx.x >> 6);
    F.G = gridDim.x; F.bid = blockIdx.x;
    for (int u = threadIdx.x; u < (LDS_BYTES - LDSCTL_OFF) / 4; u += NTHR) ((LAS unsigned*)(F.lds + LDSCTL_OFF))[u] = 0u;
    __syncthreads();
    KArgs* const kap = (KArgs*)__builtin_amdgcn_kernarg_segment_ptr();
    XcdBarrier bar = xcd_barrier_post((unsigned*)(kap->ws + WS_CTL) + CW_BAR + kap->li * XCD_BAR_WORDS, (volatile LAS unsigned*)(F.lds + MISC_OFF) + 8);
#define KA (opaque_k(kap))
#define ws (KA->ws)
#define IN(k) ((k) <= STOP_PHASE)
#define SEAM(k) do { if (IN(k) && IN((k) + 1)) { XcdBarrier bb_ = bar; asm volatile("" : "+s"(bb_.x), "+s"(bb_.bar)); xcd_barrier(bb_, fresh(F).wave == 0 && lane_opaque() == 0); } } while (0)
#define Yb ((bf16_t*)(ws + WS_Y))
#define ACTb ((bf16_t*)(ws + WS_ACT))
#define OUTb ((bf16_t*)(ws + WS_OUT))
#define BAR_NOW() do { XcdBarrier bb_ = bar; asm volatile("" : "+s"(bb_.x), "+s"(bb_.bar)); xcd_barrier(bb_, fresh(F).wave == 0 && lane_opaque() == 0); } while (0)
#define FFN_HALF(pk, lh, FINAL, tl, ts, tw, tnl, tns) do { \
    for (int rep_ = 0; rep_ < REP_FFN1; ++rep_) { if (rep_) __syncthreads(); \
    if (EN_FFN && IN(pk)) { const Frame Ff_ = fresh(F); const bf16_t* w1_ = (const bf16_t*)(ws + WS_WB) + (size_t)(lh) * (E_F1 + E_F2); \
        pg8::Gemm g_{Yb, w1_, D}; EpiSwiGLU E_{ACTb}; \
        if (FINAL) { LatentOrder S_; S_.init_lat(2 * FF, Ff_.G, Ff_.bid); pg8::gemm_phase<EpiSwiGLU, LatentOrder, pg8::Gemm, GEMM_ALIGN, GEMM_SP2>(Ff_.lds, g_, S_, E_, Ff_.wave); } \
        else { pg8::StaticOrder S_; S_.init(M, 2 * FF, Ff_.G, Ff_.bid); pg8::gemm_phase<EpiSwiGLU, pg8::StaticOrder, pg8::Gemm, GEMM_ALIGN, GEMM_SP2>(Ff_.lds, g_, S_, E_, Ff_.wave); } } } \
    SEAM(pk); \
    for (int rep_ = 0; rep_ < REP_FFN2; ++rep_) { if (rep_) __syncthreads(); \
    if (EN_FFN && IN((pk) + 1)) { const Frame Ff_ = fresh(F); const bf16_t* w2_ = (const bf16_t*)(ws + WS_WB) + (size_t)(lh) * (E_F1 + E_F2) + E_F1; \
        pg8::Gemm g_{ACTb, w2_, FF}; LatentOrder S_; S_.init_lat(D, Ff_.G, Ff_.bid); EpiPlain E_{OUTb, D}; \
        pg8::gemm_phase<EpiPlain, LatentOrder, pg8::Gemm, GEMM_ALIGN, GEMM_SP2>(Ff_.lds, g_, S_, E_, Ff_.wave); } } \
    SEAM((pk) + 1); \
    if (IN((pk) + 2)) { const Frame Ff_ = fresh(F); \
        if (Ff_.bid < 32) { if (!(FINAL)) { const bf16_t* w2_ = (const bf16_t*)(ws + WS_WB) + (size_t)(lh) * (E_F1 + E_F2) + E_F1; \
            pg8::Gemm g_{ACTb, w2_, FF}; CtxOrder S_{Ff_.bid}; EpiPlain E_{OUTb, D}; \
            pg8::gemm_phase<EpiPlain, CtxOrder, pg8::Gemm, GEMM_ALIGN, GEMM_SP2>(Ff_.lds, g_, S_, E_, Ff_.wave); } } \
        else { for (int rt_ = 1; rt_ < REP_THIN; ++rt_) { if (!(FINAL)) thin_phase<1, 1>(Ff_, KA, tl, ts, 0.f, tnl, tns); } if (FINAL) thin_phase<2, 1>(Ff_, KA, tl, ts, tw, tnl, tns); else thin_phase<1, 1>(Ff_, KA, tl, ts, tw, tnl, tns); } \
        if (!(FINAL)) { BAR_NOW(); thin_phase<1, 2>(fresh(F), KA, tl, ts, tw, tnl, tns); } } \
    SEAM((pk) + 2); } while (0)

    for (int rep_ = 0; rep_ < REP_P0; ++rep_) { if (rep_) __syncthreads(); if (EN_P0 && IN(0)) p0a_phase(fresh(F), KA); }
    SEAM(0);
    if (EN_THIN && IN(1)) thin_phase<0, 0>(fresh(F), KA, 0, 0, 0.f, 0, 0);
    SEAM(1);
    for (int lp = 0; lp < 2; ++lp) {
        const int pb = 2 + 24 * lp, la = 2 * lp, lr = 2 * lp + 1;
        FFN_HALF(pb + 0, la * 2 + 0, 0, la, 0, 0.5f, la, 1);
        for (int rep_ = 0; rep_ < REP_OG; ++rep_) { if (rep_) __syncthreads();
        if (EN_GQKV && IN(pb + 3)) { const Frame Ff = fresh(F); const bf16_t* wq = (const bf16_t*)(ws + WS_WA) + (size_t)lp * (E_QKV + E_SQ);
            pg8::Gemm g{Yb, wq, D}; pg8::StaticOrder S; S.init(M, 3072, Ff.G, Ff.bid); EpiQKV E{ws};
            pg8::gemm_phase<EpiQKV, pg8::StaticOrder, pg8::Gemm, GEMM_ALIGN, GEMM_SP2>(Ff.lds, g, S, E, Ff.wave); } }
        SEAM(pb + 3);
        if (EN_QKN && IN(pb + 4)) qknorm_phase(fresh(F), KA, lp);
        SEAM(pb + 4);
        for (int rep_ = 0; rep_ < REP_ATT; ++rep_) { if (rep_) __syncthreads(); if (EN_ATT && IN(pb + 5)) attention_phase(fresh(F), KA); }
        SEAM(pb + 5);
        for (int rep_ = 0; rep_ < REP_OG; ++rep_) { if (rep_) __syncthreads();
        if (EN_GWO && IN(pb + 6)) { const Frame Ff = fresh(F); const bf16_t* wo = (const bf16_t*)(ws + WS_WA) + (size_t)lp * (E_QKV + E_SQ) + E_QKV;
            pg8::Gemm g{(const bf16_t*)(ws + WS_O), wo, D}; pg8::StaticOrder S; S.init(M, D, Ff.G, Ff.bid); EpiPlain E{OUTb, D};
            pg8::gemm_phase<EpiPlain, pg8::StaticOrder, pg8::Gemm, GEMM_ALIGN, GEMM_SP2>(Ff.lds, g, S, E, Ff.wave); } }
        SEAM(pb + 6);
        if (EN_THIN && IN(pb + 7)) thin_phase<1, 0>(fresh(F), KA, la, 1, 1.0f, la, 2);
        SEAM(pb + 7);
        FFN_HALF(pb + 8, la * 2 + 1, 0, la, 2, 0.5f, lr, 0);
        FFN_HALF(pb + 11, lr * 2 + 0, 0, lr, 0, 0.5f, lr, 1);
        for (int rep_ = 0; rep_ < REP_EW; ++rep_) { if (EN_MIX && IN(pb + 14)) mixes_phase(fresh(F), KA, lp); }
        SEAM(pb + 14);
#ifdef DBG_DOUBLE_BAR
        SEAM(pb + 14);
#endif
#define rw1 ((const bf16_t*)(ws + WS_WR) + (size_t)lp * (E_RW1 + E_RW2 + E_SQ))
        for (int rep_ = 0; rep_ < REP_OG; ++rep_) { if (rep_) __syncthreads();
        if (EN_RW1 && IN(pb + 15)) { const Frame Ff = fresh(F); GemmRw1 g{(const bf16_t*)(ws + WS_MIX6), rw1, D}; pg8::StaticOrder S; S.init(M, 6912, Ff.G, Ff.bid);
            EpiRw1 E{ws, KA->in[25] + (size_t)lp * D};
            pg8::gemm_phase<EpiRw1, pg8::StaticOrder, GemmRw1, RW1_ALIGN, RW1_SP2>(Ff.lds, g, S, E, Ff.wave); } }
        SEAM(pb + 15);
        for (int rep_ = 0; rep_ < REP_OG; ++rep_) { if (rep_) __syncthreads();
        if (EN_RW2 && IN(pb + 16)) { const Frame Ff = fresh(F); int k2_ = 256; asm volatile("" : "+s"(k2_));     GemmRw2 g{ws, rw1 + E_RW1, k2_}; pg8::StaticOrder S; S.init(M, 10240, Ff.G, Ff.bid);
            EpiRw2 E{ws,
                     KA->in[19] + (size_t)lp * 2 * D, KA->in[22] + (size_t)lp * 2 * D, WS_AA};
            pg8::gemm_phase<EpiRw2, pg8::StaticOrder, GemmRw2, RW2_ALIGN, RW2_SP2>(Ff.lds, g, S, E, Ff.wave); } }
        #ifdef DBG_RW2_TWICE
        __syncthreads();
        if (EN_RW2 && IN(pb + 16)) { const Frame Ff = fresh(F); int k2_ = 256; asm volatile("" : "+s"(k2_));     GemmRw2 g{ws, rw1 + E_RW1, k2_}; pg8::StaticOrder S; S.init(M, 10240, Ff.G, Ff.bid);
            EpiRw2 E{ws,
                     KA->in[19] + (size_t)lp * 2 * D, KA->in[22] + (size_t)lp * 2 * D, WS_END};
            pg8::gemm_phase<EpiRw2, pg8::StaticOrder, GemmRw2, RW2_ALIGN, RW2_SP2>(Ff.lds, g, S, E, Ff.wave); }
#endif
        SEAM(pb + 16);
        for (int rep_ = 0; rep_ < REP_SCAN; ++rep_) { if (rep_) __syncthreads(); if (EN_SCAN && IN(pb + 17)) scan_phase(fresh(F), KA, lp); }
        SEAM(pb + 17);
        for (int rep_ = 0; rep_ < REP_EW; ++rep_) { if (EN_OPREP && IN(pb + 18)) outprep_phase(fresh(F), KA, lp); }
        SEAM(pb + 18);
        for (int rep_ = 0; rep_ < REP_OG; ++rep_) { if (rep_) __syncthreads();
        if (EN_GWO && IN(pb + 19)) { const Frame Ff = fresh(F); pg8::Gemm g{(const bf16_t*)(ws + WS_PREP), rw1 + E_RW1 + E_RW2, D}; pg8::StaticOrder S; S.init(M, D, Ff.G, Ff.bid); EpiPlain E{OUTb, D};
            pg8::gemm_phase<EpiPlain, pg8::StaticOrder, pg8::Gemm, GEMM_ALIGN, GEMM_SP2>(Ff.lds, g, S, E, Ff.wave); } }
        SEAM(pb + 19);
        if (EN_THIN && IN(pb + 20)) thin_phase<1, 0>(fresh(F), KA, lr, 1, 1.0f, lr, 2);
        SEAM(pb + 20);
        if (lp == 1) FFN_HALF(pb + 21, lr * 2 + 1, 1, lr, 2, 0.5f, 0, 0); else FFN_HALF(pb + 21, lr * 2 + 1, 0, lr, 2, 0.5f, lr + 1, 0);
    }
    if (DBG_STOP >= 0) { xcd_barrier(bar, fresh(F).wave == 0 && lane_opaque() == 0); copyout_phase(fresh(F), KA); }
#undef IN
#undef SEAM
#undef FFN_HALF
#undef BAR_NOW
#undef rw1
#undef ws
#undef KA
#undef Yb
#undef ACTb
#undef OUTb
}

extern "C" void kernel_launch(void* const* d_in, const int* in_sizes, int n_in, void* d_out, int out_size, void* d_ws, size_t ws_size, hipStream_t stream) {
    static int grid = 0;
    if (grid == 0) {
        if (n_in != 30 || in_sizes[0] != NB * SEQ * D || out_size != NB * SEQ * D || ws_size < WS_END) {
            fprintf(stderr, "kernel_launch: shape mismatch: n_in %d in0 %d out %d ws %zu (need >= %zu)\n", n_in, n_in > 0 ? in_sizes[0] : -1, out_size, ws_size, (size_t)WS_END); grid = -1; return; }
        int dev = 0, cus = 0, per_cu = 0;
        if (hipGetDevice(&dev) != hipSuccess || hipDeviceGetAttribute(&cus, hipDeviceAttributeMultiprocessorCount, dev) != hipSuccess) { fprintf(stderr, "kernel_launch: device query failed\n"); grid = -1; return; }
        if (hipFuncSetAttribute((const void*)fwd_kernel, hipFuncAttributeMaxDynamicSharedMemorySize, LDS_BYTES) != hipSuccess) { fprintf(stderr, "kernel_launch: hipFuncSetAttribute failed\n"); grid = -1; return; }
        if (hipOccupancyMaxActiveBlocksPerMultiprocessor(&per_cu, (const void*)fwd_kernel, NTHR, LDS_BYTES) != hipSuccess || per_cu < 1) { fprintf(stderr, "kernel_launch: occupancy query says %d blocks per CU\n", per_cu); }
        (void)hipGetLastError();
        grid = cus;
        if (grid > 256) grid = 256;
    }
    if (grid < 0) return;
    if (hipMemsetAsync((char*)d_ws + WS_CTL, 0, CTL_ZERO_BYTES, stream) != hipSuccess) { fprintf(stderr, "kernel_launch: memset failed\n"); return; }
    Args a{};
    for (int i = 0; i < 30; ++i) a.in[i] = (const float*)d_in[i];
    a.out = (float*)d_out; a.ws = (unsigned char*)d_ws;
    a.ph_lo = 0; a.ph_hi = NPHASE; a.li = 0; a.dbg = 0;
    hipLaunchKernelGGL(fwd_kernel, dim3(grid), dim3(NTHR), LDS_BYTES, stream, a);
    const hipError_t le = hipPeekAtLastError();
    if (le != hipSuccess) fprintf(stderr, "kernel_launch: launch failed: %s\n", hipGetErrorName(le));
}
```

```cpp
#include <hip/hip_runtime.h>
#include <cstdio>
#include <cstdint>
#include <cmath>
__device__ __forceinline__ int lane_opaque() { int l; asm volatile("v_mbcnt_lo_u32_b32 %0, -1, 0\n\tv_mbcnt_hi_u32_b32 %0, -1, %0" : "=v"(l)); return l; }
namespace pg8 {
#define PG8_LAS __attribute__((address_space(3)))
typedef unsigned short bf16_t;
typedef short bf16x8 __attribute__((ext_vector_type(8)));
typedef float f32x4 __attribute__((ext_vector_type(4)));
typedef unsigned u32x4 __attribute__((ext_vector_type(4)));
constexpr int BM = 256, BK = 64, HALF = 128, HTB = HALF * BK * 2  , STAGE_BYTES = 8 * HTB, NXCD = 8, WGM = 8;

__host__ __device__ __forceinline__ int lds_byte(int r, int c) { const int st = (r >> 4) * 2 + (c >> 5), rr = r & 15, cc = c & 31, ob = rr * 64 + cc * 2; return st * 1024 + (ob ^ (((ob >> 9) & 1) << 5)); }
__host__ __device__ __forceinline__ void stage_rc(int b, int& R, int& C) { const int st = b / 1024, sb = b % 1024, swz = sb ^ (((sb >> 9) & 1) << 5); R = (st >> 1) * 16 + swz / 64; C = (st & 1) * 32 + (swz % 64) / 2; }
__host__ __device__ __forceinline__ int perm32(int rho) { const int n = rho >> 4, i = rho & 15; return 8 * (i >> 2) + 4 * n + (i & 3); }

struct Unit { int pm, pn; };
struct Gemm { const bf16_t* A; const bf16_t* Bt; int K;
    __device__ __forceinline__ const char* a_tile(const Unit& u) const { return (const char*)A + (size_t)u.pm * (size_t)(BM * 2) * K; }
    __device__ __forceinline__ const char* b_tile(const Unit& u) const { return (const char*)Bt + (size_t)u.pn * (size_t)(BM * 2) * K; }
    __device__ __forceinline__ int klen() const { return K; } };

struct StaticOrder {
    int nM, nN, nwg, G, c;
    __host__ __device__ void init(int M, int N, int G_, int c_) { nM = M / BM; nN = N / BM; nwg = nM * nN; G = G_; c = c_; }
    __host__ __device__ bool next(int i, Unit& u) const {
        const long L = (long)i * G + c; if (L >= nwg) return false;
        int wgid = (int)L; { const int q = nwg / NXCD, r = nwg % NXCD, xcd = wgid % NXCD, off = wgid / NXCD; wgid = (xcd < r ? xcd * (q + 1) : r * (q + 1) + (xcd - r) * q) + off; }
        const int nig = WGM * nN, gid = wgid / nig, fm = gid * WGM, gsz = (nM - fm) < WGM ? (nM - fm) : WGM;
        u.pm = fm + ((wgid % nig) % gsz); u.pn = (wgid % nig) / gsz; return true;
    }
    __device__ __forceinline__ void a_ready(const Unit&) const {}
    __device__ __forceinline__ void done(const Unit&) const {}
};

typedef __bf16 bf16x2_cv __attribute__((ext_vector_type(2)));
typedef float f32x2_cv __attribute__((ext_vector_type(2)));
__device__ __forceinline__ unsigned cvt_pk_bf16(float lo, float hi) { const f32x2_cv v = {lo, hi}; const bf16x2_cv b = __builtin_convertvector(v, bf16x2_cv); return __builtin_bit_cast(unsigned, b); }

template <class Epi, class Sched, class GT, bool ALIGN_EPI = false, bool SP2 = false>
__device__ __forceinline__ void gemm_phase(PG8_LAS unsigned char* lds, const GT g, const Sched& S, const Epi& E, const int wid  ) {
    const int lane = lane_opaque(), tid = wid * 64 + lane, wr = wid >> 2, wc = wid & 3, fr = lane & 15, fq = lane >> 4;
    const int K = g.K, nt = g.klen() / BK;
    unsigned voffA[2], voffB[2];
#pragma unroll
    for (int i = 0; i < 2; ++i) { int R, C; stage_rc(tid * 16 + i * 8192, R, C); const int Rb = Epi::PERM ? ((R & ~31) + perm32(R & 31)) : R;
        voffA[i] = (unsigned)(R * K + C) * 2u; voffB[i] = (unsigned)(Rb * K + C) * 2u; }
    asm volatile("" : "+v"(voffA[0]), "+v"(voffA[1]), "+v"(voffB[0]), "+v"(voffB[1]));
    const size_t kstep = (size_t)(BK * 2);
    const size_t hstep = (size_t)HALF * K * 2;
    const unsigned ldsw = (unsigned)wid * 1024u;
    const int aoff = lds_byte(wr * 64 + fr, fq * 8), boff = lds_byte(wc * 32 + fr, fq * 8);
#define PG8_SA(b, h) (((b) * 2 + (h)) * HTB)
#define PG8_SB(b, h) ((4 + (b) * 2 + (h)) * HTB)
#define PG8_STAGE(bufoff, gbase, voff) do { _Pragma("unroll") for (int _i = 0; _i < 2; ++_i) \
        __builtin_amdgcn_global_load_lds((const unsigned*)((const char*)(gbase) + (voff)[_i]), (PG8_LAS unsigned*)(lds + (bufoff) + ldsw + _i * 8192), 16, 0, 0); } while (0)
#define PG8_LDA(dst, b, h) do { _Pragma("unroll") for (int m = 0; m < 4; ++m) _Pragma("unroll") for (int k = 0; k < 2; ++k) dst[m][k] = *(const PG8_LAS bf16x8*)(lds + PG8_SA(b, h) + aoff + m * 2048 + k * 1024); } while (0)
#define PG8_LDB(dst, b, h) do { _Pragma("unroll") for (int n = 0; n < 2; ++n) _Pragma("unroll") for (int k = 0; k < 2; ++k) dst[n][k] = *(const PG8_LAS bf16x8*)(lds + PG8_SB(b, h) + boff + n * 2048 + k * 1024); } while (0)
#define PG8_MMA(ai, bj, At, Bt) do { __builtin_amdgcn_s_setprio(1); _Pragma("unroll") for (int m = 0; m < 4; ++m) _Pragma("unroll") for (int n = 0; n < 2; ++n) _Pragma("unroll") for (int k = 0; k < 2; ++k) \
        acc[ai][bj][m][n] = __builtin_amdgcn_mfma_f32_16x16x32_bf16(Bt[n][k], At[m][k], acc[ai][bj][m][n], 0, 0, 0); __builtin_amdgcn_s_setprio(0); } while (0)
#define PG8_WAIT_V(n) asm volatile("s_waitcnt vmcnt(" #n ")" ::: "memory")
#define PG8_WAIT_L(n) asm volatile("s_waitcnt lgkmcnt(" #n ")" ::: "memory")
#define PG8_BAR __builtin_amdgcn_s_barrier()
#define PG8_SCHED __builtin_amdgcn_sched_barrier(0)
    Unit cur, nxt; int ui = 0;
    if (!S.next(0, cur)) return;
    f32x4 acc[2][2][4][2];
#pragma unroll
    for (int a = 0; a < 2; ++a)
#pragma unroll
        for (int b = 0; b < 2; ++b)
#pragma unroll
            for (int m = 0; m < 4; ++m)
#pragma unroll
                for (int n = 0; n < 2; ++n) acc[a][b][m][n] = (f32x4){0.f, 0.f, 0.f, 0.f};
    bf16x8 At[4][2], B0[2][2], B1[2][2];
    const char* cA = g.a_tile(cur); const char* cB = g.b_tile(cur);
    S.a_ready(cur);
    if constexpr (SP2) {
        PG8_STAGE(PG8_SB(0, 0), cB, voffB); PG8_STAGE(PG8_SB(0, 1), cB + hstep, voffB); PG8_STAGE(PG8_SA(0, 0), cA, voffA); PG8_STAGE(PG8_SA(0, 1), cA + hstep, voffA);
        if (wr == 1) PG8_BAR;
        PG8_WAIT_V(2); PG8_BAR;
        PG8_STAGE(PG8_SB(1, 0), cB + kstep, voffB); PG8_STAGE(PG8_SA(1, 0), cA + kstep, voffA); PG8_STAGE(PG8_SB(1, 1), cB + hstep + kstep, voffB);
        PG8_WAIT_V(6); PG8_BAR;
    } else {
        PG8_STAGE(PG8_SB(0, 0), cB, voffB); PG8_STAGE(PG8_SA(0, 0), cA, voffA); PG8_STAGE(PG8_SB(0, 1), cB + hstep, voffB); PG8_STAGE(PG8_SA(0, 1), cA + hstep, voffA);
        if (wr == 1) PG8_BAR;
        PG8_WAIT_V(4); PG8_BAR;
        PG8_STAGE(PG8_SB(1, 0), cB + kstep, voffB); PG8_STAGE(PG8_SA(1, 0), cA + kstep, voffA); PG8_STAGE(PG8_SB(1, 1), cB + hstep + kstep, voffB);
        PG8_WAIT_V(6); PG8_BAR;
    }
    for (;;) {
        const bool has_next = S.next(ui + 1, nxt);
        const char* nA = has_next ? g.a_tile(nxt) : cA; const char* nB = has_next ? g.b_tile(nxt) : cB;
        for (int t = 0; t < nt; t += 2) {
            const bool last = (t == nt - 2);
            const char* a1 = cA + (size_t)(t + 1) * kstep;
            const char* a2 = last ? nA : cA + (size_t)(t + 2) * kstep; const char* b2 = last ? nB : cB + (size_t)(t + 2) * kstep;
            const char* a3 = a2 + kstep; const char* b3 = b2 + kstep;
            if (last && has_next) S.a_ready(nxt);
            if constexpr (SP2) {
            PG8_LDB(B0, 0, 0); PG8_LDB(B1, 0, 1); PG8_SCHED; PG8_LDA(At, 0, 0); PG8_STAGE(PG8_SA(1, 1), a1 + hstep, voffA);
            PG8_WAIT_V(8); PG8_WAIT_L(0); PG8_BAR; PG8_MMA(0, 0, At, B0); PG8_MMA(0, 1, At, B1); PG8_BAR; PG8_SCHED;
            PG8_LDA(At, 0, 1); PG8_STAGE(PG8_SB(0, 0), b2, voffB); PG8_STAGE(PG8_SB(0, 1), b2 + hstep, voffB); PG8_STAGE(PG8_SA(0, 0), a2, voffA);
            PG8_WAIT_V(8); PG8_WAIT_L(0); PG8_BAR; PG8_MMA(1, 0, At, B0); PG8_MMA(1, 1, At, B1); PG8_BAR; PG8_SCHED;
            PG8_LDB(B0, 1, 0); PG8_LDB(B1, 1, 1); PG8_SCHED; PG8_LDA(At, 1, 0); PG8_STAGE(PG8_SA(0, 1), a2 + hstep, voffA);
            PG8_WAIT_V(8); PG8_WAIT_L(0); PG8_BAR; PG8_MMA(0, 0, At, B0); PG8_MMA(0, 1, At, B1); PG8_BAR; PG8_SCHED;
            PG8_LDA(At, 1, 1); PG8_STAGE(PG8_SB(1, 0), b3, voffB); PG8_STAGE(PG8_SB(1, 1), b3 + hstep, voffB); PG8_STAGE(PG8_SA(1, 0), a3, voffA);
            PG8_WAIT_V(8); PG8_WAIT_L(0); PG8_BAR; PG8_MMA(1, 0, At, B0); PG8_MMA(1, 1, At, B1); PG8_BAR; PG8_SCHED;
            } else {
            PG8_LDB(B0, 0, 0); PG8_SCHED; PG8_LDA(At, 0, 0); PG8_STAGE(PG8_SA(1, 1), a1 + hstep, voffA);
            PG8_WAIT_L(8); PG8_BAR; PG8_WAIT_L(0); PG8_MMA(0, 0, At, B0); PG8_BAR; PG8_SCHED;
            PG8_LDB(B1, 0, 1); PG8_STAGE(PG8_SB(0, 0), b2, voffB);
            PG8_BAR; PG8_WAIT_L(0); PG8_MMA(0, 1, At, B1); PG8_BAR;
            PG8_LDA(At, 0, 1); PG8_STAGE(PG8_SA(0, 0), a2, voffA);
            PG8_BAR; PG8_WAIT_L(0); PG8_MMA(1, 0, At, B0); PG8_BAR; PG8_SCHED;
            PG8_STAGE(PG8_SB(0, 1), b2 + hstep, voffB);
            PG8_WAIT_V(6); PG8_BAR; PG8_MMA(1, 1, At, B1); PG8_BAR;
            PG8_LDB(B0, 1, 0); PG8_SCHED; PG8_LDA(At, 1, 0); PG8_STAGE(PG8_SA(0, 1), a2 + hstep, voffA);
            PG8_WAIT_L(8); PG8_BAR; PG8_WAIT_L(0); PG8_MMA(0, 0, At, B0); PG8_BAR; PG8_SCHED;
            PG8_LDB(B1, 1, 1); PG8_STAGE(PG8_SB(1, 0), b3, voffB);
            PG8_BAR; PG8_WAIT_L(0); PG8_MMA(0, 1, At, B1); PG8_BAR;
            PG8_LDA(At, 1, 1); PG8_STAGE(PG8_SA(1, 0), a3, voffA);
            PG8_BAR; PG8_WAIT_L(0); PG8_MMA(1, 0, At, B0); PG8_BAR; PG8_SCHED;
            PG8_STAGE(PG8_SB(1, 1), b3 + hstep, voffB);
            PG8_WAIT_V(6); PG8_BAR; PG8_MMA(1, 1, At, B1); PG8_BAR;
            }
        }
        if constexpr (ALIGN_EPI) { if (wr == 0) PG8_BAR; }
        if constexpr (!Epi::AFTER_DRAIN) { E(acc, cur, wr, wc, fr, fq); S.done(cur); }
        if (!has_next) break;
#pragma unroll
        for (int a = 0; a < 2; ++a)
#pragma unroll
            for (int b = 0; b < 2; ++b)
#pragma unroll
                for (int m = 0; m < 4; ++m)
#pragma unroll
                    for (int n = 0; n < 2; ++n) acc[a][b][m][n] = (f32x4){0.f, 0.f, 0.f, 0.f};
        cur = nxt; cA = nA; cB = nB; ++ui;
        if constexpr (ALIGN_EPI) { if (wr == 1) PG8_BAR; }
    }
    PG8_WAIT_V(0);
    if constexpr (!ALIGN_EPI) { if (wr == 0) PG8_BAR; }
    PG8_BAR;
    if constexpr (Epi::AFTER_DRAIN) { E.fused(acc, cur, wr, wc, fr, fq, lds, wid, lane); S.done(cur); }
#undef PG8_SA
#undef PG8_SB
#undef PG8_STAGE
#undef PG8_LDA
#undef PG8_LDB
#undef PG8_MMA
#undef PG8_WAIT_V
#undef PG8_WAIT_L
#undef PG8_BAR
#undef PG8_SCHED
}
}

#define LAS __attribute__((address_space(3)))
#define XB_TMO      128
#define XB_XCNT(j)  (256  + 64 * (j))
#define XB_XSUB(j)  (1280 + 64 * (j))
#define XB_XGEN(j)  (2304 + 64 * (j))
#define XB_TOP      3328
#define XB_TOPGEN   3392
#define XCD_BAR_WORDS 3456
#define XB_SPIN_CAP (1u << 20)

__device__ __forceinline__ unsigned xb_ld(unsigned* p)              { return __hip_atomic_load(p, __ATOMIC_RELAXED, __HIP_MEMORY_SCOPE_AGENT); }
__device__ __forceinline__ unsigned xb_add(unsigned* p, unsigned v) { return __hip_atomic_fetch_add(p, v, __ATOMIC_RELAXED, __HIP_MEMORY_SCOPE_AGENT); }
__device__ __forceinline__ unsigned xb_xcc_id() { return (unsigned)__builtin_amdgcn_s_getreg((3 << 11) | 20) & 0xFu; }
#define XB_SPIN(cond, bar) do { unsigned _sp = 0; while (cond) { __builtin_amdgcn_s_sleep(1); \
    if ((++_sp & 255u) == 0u) { if (xb_ld(&(bar)[XB_TMO])) break; if (_sp > XB_SPIN_CAP) { atomicAdd(&(bar)[XB_TMO], 1u); break; } } } } while (0)

struct XcdBarrier {
    unsigned* bar; unsigned x;
    volatile LAS unsigned* st;
};

__device__ __forceinline__ XcdBarrier xcd_barrier_post(unsigned* bar, volatile LAS unsigned* st) {
    XcdBarrier b; b.bar = bar; b.x = xb_xcc_id(); b.st = st;
    if (threadIdx.x == 0) (void)xb_add(&bar[XB_XCNT(b.x)], 1u);
    return b;
}
__device__ __forceinline__ void xcd_barrier_complete(unsigned* bar, unsigned x, unsigned& nloc, unsigned& nx) {
    const unsigned G = gridDim.x * gridDim.y * gridDim.z;
    unsigned sum, cnt, mine, sp = 0u;
    for (;;) {
        sum = 0u; cnt = 0u; mine = 0u;
#pragma unroll
        for (unsigned j = 0; j < 16; ++j) { const unsigned c = xb_ld(&bar[XB_XCNT(j)]); sum += c; cnt += (c > 0u) ? 1u : 0u; mine = (j == x) ? c : mine; }
        if (sum == G) break;
        __builtin_amdgcn_s_sleep(1);
        if ((++sp & 255u) == 0u) { if (xb_ld(&bar[XB_TMO])) break; if (sp > XB_SPIN_CAP) { atomicAdd(&bar[XB_TMO], 1u); break; } }
    }
    nloc = mine > 0u ? mine : 1u; nx = cnt > 0u ? cnt : 1u;
}

__device__ __forceinline__ void xcd_barrier(const XcdBarrier& b, const bool tid0  ) {
    asm volatile("s_waitcnt vmcnt(0)" ::: "memory");
    __syncthreads();
    if (tid0) {
        unsigned* bar = b.bar;
        __builtin_amdgcn_s_waitcnt(0);
        unsigned nloc = b.st[0], nx = b.st[1];
        if (nloc == 0u) { xcd_barrier_complete(bar, b.x, nloc, nx); b.st[0] = nloc; b.st[1] = nx; }
        const unsigned old = xb_add(&bar[XB_XSUB(b.x)], 1u);
        const unsigned gen = old / nloc;
        if (old + 1u == (gen + 1u) * nloc) {
            __builtin_amdgcn_fence(__ATOMIC_RELEASE, "agent");
            asm volatile("s_waitcnt vmcnt(0)" ::: "memory");
            const unsigned og = xb_add(&bar[XB_TOP], 1u);
            const unsigned tg = og / nx;
            if (og + 1u == (tg + 1u) * nx) xb_add(&bar[XB_TOPGEN], 1u);
            else XB_SPIN(xb_ld(&bar[XB_TOPGEN]) == tg, bar);
            __builtin_amdgcn_fence(__ATOMIC_ACQUIRE, "agent");
            xb_add(&bar[XB_XGEN(b.x)], 1u);
            asm volatile("s_waitcnt vmcnt(0)" ::: "memory");
        } else {
            XB_SPIN(xb_ld(&bar[XB_XGEN(b.x)]) == gen, bar);
            __builtin_amdgcn_fence(__ATOMIC_ACQUIRE, "agent");
            asm volatile("s_waitcnt vmcnt(0)" ::: "memory");
        }
    }
    __syncthreads();
}

namespace attn {
using bf16 = unsigned short;
constexpr int   D = 128, NW = 8, QBLK = 32, KVBLK = 64;
constexpr float SCALE = 0.088388347648318440f;
constexpr float THR = 8.f;
constexpr int SDEPTH = 2;
constexpr int LDQ = 2048, LDK = 512, LDO = 2048;
constexpr size_t SHM_V = KVBLK * D * 2, SHM_K = KVBLK * D * 2, SHM_ATTN = 2 * SHM_V + 2 * SHM_K + NW * 64 * 4;
using bf16x8 = __attribute__((ext_vector_type(8))) short;
using s16x4  = __attribute__((ext_vector_type(4))) short;
using f32x16 = __attribute__((ext_vector_type(16))) float;
using f32x8  = __attribute__((ext_vector_type(8))) float;
using u32x4  = __attribute__((ext_vector_type(4))) unsigned;
#define KSWZ(row, colB) ((row) * 256 + ((colB) ^ (((row) & 7) << 4)))
#define SBAR() __builtin_amdgcn_sched_barrier(0)
__device__ __forceinline__ int crow(int r, int hi) { return (r & 3) + 8 * (r >> 2) + 4 * hi; }
__device__ __forceinline__ unsigned cvtpk(float lo, float hi) {
  return pg8::cvt_pk_bf16(lo, hi);
}
template <typename TIn> struct Stage;
__device__ __forceinline__ unsigned f2bf_(float f) { unsigned u = __builtin_bit_cast(unsigned, f); return (u + 0x7fffu + ((u >> 16) & 1u)) >> 16; }
template <> struct Stage<bf16>  { using T = bf16x8;
  __device__ static __forceinline__ T ld8(const bf16* p) { return *reinterpret_cast<const bf16x8*>(p); }
  __device__ static __forceinline__ bf16x8 tobf(T x) { return x; } };
template <> struct Stage<float> { using T = f32x8;
  __device__ static __forceinline__ T ld8(const float* p) { return *reinterpret_cast<const f32x8*>(p); }
  __device__ static __forceinline__ bf16x8 tobf(T x) {
    u32x4 w = {cvtpk(x[0], x[1]), cvtpk(x[2], x[3]), cvtpk(x[4], x[5]), cvtpk(x[6], x[7])}; return *reinterpret_cast<bf16x8*>(&w); } };

__device__ __forceinline__ void partialSM(f32x16& p0, f32x16& p1, float& m_reg, float& mn, float& alpha) {
  constexpr float C = SCALE * 1.4426950408889634f;
  float pmax = p0[0]; for (int r = 1; r < 16; ++r) pmax = fmaxf(pmax, p0[r]); for (int r = 0; r < 16; ++r) pmax = fmaxf(pmax, p1[r]);
  { auto rr = __builtin_amdgcn_permlane32_swap(__float_as_uint(pmax), __float_as_uint(pmax), false, false);
    pmax = fmaxf(__uint_as_float(rr[0]), __uint_as_float(rr[1])); }
  if (__builtin_expect(__all(pmax - m_reg <= THR / SCALE), 1)) { mn = m_reg; alpha = 1.f; }
  else { mn = fmaxf(m_reg, pmax); alpha = __builtin_amdgcn_exp2f((m_reg - mn) * C); m_reg = mn; }
  float mnC = -mn * C;
  for (int r = 0; r < 16; ++r) p0[r] = fmaf(p0[r], C, mnC); for (int r = 0; r < 16; ++r) p1[r] = fmaf(p1[r], C, mnC);
  for (int r = 0; r < 16; ++r) p0[r] = __builtin_amdgcn_exp2f(p0[r]);
}
__device__ __forceinline__ void finishSM(f32x16& p0, f32x16& p1, float alpha, float& l_reg, bf16x8& pa0, bf16x8& pa1, bf16x8& pa2, bf16x8& pa3) {
  for (int r = 0; r < 16; ++r) p1[r] = __builtin_amdgcn_exp2f(p1[r]);
  float ps = 0; for (int r = 0; r < 16; ++r) ps += p0[r]; for (int r = 0; r < 16; ++r) ps += p1[r];
  { auto rr = __builtin_amdgcn_permlane32_swap(__float_as_uint(ps), __float_as_uint(ps), false, false);
    ps = __uint_as_float(rr[0]) + __uint_as_float(rr[1]); }
  l_reg = l_reg * alpha + ps;
#define PK4(P, BASE, OUT) do { unsigned a0 = cvtpk(P[BASE + 0], P[BASE + 1]), a1 = cvtpk(P[BASE + 2], P[BASE + 3]);   \
    unsigned b0 = cvtpk(P[BASE + 4], P[BASE + 5]), b1 = cvtpk(P[BASE + 6], P[BASE + 7]);                              \
    auto r0 = __builtin_amdgcn_permlane32_swap(a0, b0, false, false); auto r1 = __builtin_amdgcn_permlane32_swap(a1, b1, false, false); \
    u32x4 w = {r0[0], r1[0], r0[1], r1[1]}; OUT = *reinterpret_cast<bf16x8*>(&w); } while (0)
  PK4(p0, 0, pa0); PK4(p0, 8, pa1); PK4(p1, 0, pa2); PK4(p1, 8, pa3);
#undef PK4
}
__device__ __forceinline__ void qkt(f32x16& p0, f32x16& p1, const bf16* Ks, const bf16x8* qr, int r32, int hi) {
  p0 = f32x16{}; p1 = f32x16{};
  for (int d0 = 0; d0 < 8; ++d0) { int cb = (d0 * 16 + hi * 8) * 2;
    bf16x8 b0 = *reinterpret_cast<const bf16x8*>((const char*)Ks + KSWZ(r32, cb));
    bf16x8 b1 = *reinterpret_cast<const bf16x8*>((const char*)Ks + KSWZ(32 + r32, cb));
    p0 = __builtin_amdgcn_mfma_f32_32x32x16_bf16(b0, qr[d0], p0, 0, 0, 0);
    p1 = __builtin_amdgcn_mfma_f32_32x32x16_bf16(b1, qr[d0], p1, 0, 0, 0); }
}
__device__ __forceinline__ int v_st(int k, int c) { const int kk = (k & ~0xC) | ((k & 4) << 1) | ((k & 8) >> 1); return ((kk >> 3) * 4 + (c >> 5)) * 512 + ((kk & 7) * 32 + (c & 31)) * 2; }
__device__ __forceinline__ int v_rd_base(int lane) { return ((lane & 3) << 3) | (((lane >> 2) & 3) << 6) | (((lane >> 4) & 1) << 5) | (((lane >> 5) & 1) << 8); }
constexpr int v_rd_off(int d0, int ks, int half) { return d0 * 512 + ks * 4096 + half * 2048; }
template <int OFF> __device__ __forceinline__ s16x4 tr_read(int vb) {
  s16x4 r; asm volatile("ds_read_b64_tr_b16 %0, %1 offset:%2" : "=&v"(r) : "v"(vb), "i"(OFF) : "memory"); return r;
}
template <int D0> __device__ __forceinline__ void pv_one(f32x16& od, int vb, bf16x8 pa0, bf16x8 pa1, bf16x8 pa2, bf16x8 pa3) {
  const s16x4 l0 = tr_read<v_rd_off(D0, 0, 0)>(vb), h0 = tr_read<v_rd_off(D0, 0, 1)>(vb), l1 = tr_read<v_rd_off(D0, 1, 0)>(vb), h1 = tr_read<v_rd_off(D0, 1, 1)>(vb);
  const s16x4 l2 = tr_read<v_rd_off(D0, 2, 0)>(vb), h2 = tr_read<v_rd_off(D0, 2, 1)>(vb), l3 = tr_read<v_rd_off(D0, 3, 0)>(vb), h3 = tr_read<v_rd_off(D0, 3, 1)>(vb);
  asm volatile("s_waitcnt lgkmcnt(0)" ::: "memory"); SBAR();
#define PK(L, H) (bf16x8){L[0], L[1], L[2], L[3], H[0], H[1], H[2], H[3]}
  od = __builtin_amdgcn_mfma_f32_32x32x16_bf16(pa0, PK(l0, h0), od, 0, 0, 0);
  od = __builtin_amdgcn_mfma_f32_32x32x16_bf16(pa1, PK(l1, h1), od, 0, 0, 0);
  od = __builtin_amdgcn_mfma_f32_32x32x16_bf16(pa2, PK(l2, h2), od, 0, 0, 0);
  od = __builtin_amdgcn_mfma_f32_32x32x16_bf16(pa3, PK(l3, h3), od, 0, 0, 0);
#undef PK
}
__device__ __forceinline__ void pv_d0(f32x16* o, int vb, bf16x8 pa0, bf16x8 pa1, bf16x8 pa2, bf16x8 pa3) {
  pv_one<0>(o[0], vb, pa0, pa1, pa2, pa3); pv_one<1>(o[1], vb, pa0, pa1, pa2, pa3); pv_one<2>(o[2], vb, pa0, pa1, pa2, pa3); pv_one<3>(o[3], vb, pa0, pa1, pa2, pa3);
}

template <typename TQ>
__device__ __forceinline__ void attn_dense_body(const TQ* __restrict__ Qb, const bf16* __restrict__ Kh, const bf16* __restrict__ Vh,
                                                bf16* __restrict__ Ob, int seq, char* lds, const int wid) {
  using St = Stage<bf16>; using SQ = Stage<TQ>;
  const int lane = lane_opaque(), tid = wid * 64 + lane, r32 = lane & 31, hi = lane >> 5;
  bf16* V_lds = (bf16*)lds; bf16* K_lds = (bf16*)(lds + 2 * SHM_V);
  float* ws = (float*)(lds + 2 * SHM_V + 2 * SHM_K) + wid * 64; float* li_l = ws; float* al_l = ws + 32;
  float m_reg = -1e30f, l_reg = 0; f32x16 o[4] = {}; bf16x8 qr[8];
  const TQ* Qw = Qb + (long)(wid * QBLK + r32) * LDQ + hi * 8;
#pragma unroll
  for (int d0 = 0; d0 < 8; ++d0) qr[d0] = SQ::tobf(SQ::ld8(Qw + d0 * 16));
  const int sr = tid >> 4, sc = (tid & 15) * 8, vst0 = v_st(sr, sc), vst1 = v_st(32 + sr, sc);
  const int vb0 = (int)(uintptr_t)V_lds + v_rd_base(lane);
  struct { typename St::T vs0, vs1, ks0, ks1; } sr_[SDEPTH];
#define SLOAD(i, k0) do { sr_[i].vs0 = St::ld8(&Vh[(long)((k0) + sr) * LDK + sc]); sr_[i].vs1 = St::ld8(&Vh[(long)((k0) + 32 + sr) * LDK + sc]); \
    sr_[i].ks0 = St::ld8(&Kh[(long)((k0) + sr) * LDK + sc]); sr_[i].ks1 = St::ld8(&Kh[(long)((k0) + 32 + sr) * LDK + sc]); } while (0)
#define SWRITE(b, i) do { *(bf16x8*)((char*)V_lds + (b) * SHM_V + vst0) = St::tobf(sr_[i].vs0);          \
    *(bf16x8*)((char*)V_lds + (b) * SHM_V + vst1) = St::tobf(sr_[i].vs1); int kc = sc * 2;               \
    *(bf16x8*)((char*)K_lds + (b) * SHM_K + KSWZ(sr, kc)) = St::tobf(sr_[i].ks0);                       \
    *(bf16x8*)((char*)K_lds + (b) * SHM_K + KSWZ(32 + sr, kc)) = St::tobf(sr_[i].ks1); } while (0)
#define SWAIT() do { if constexpr (SDEPTH == 2) asm volatile("s_waitcnt vmcnt(4)" ::: "memory"); else asm volatile("s_waitcnt vmcnt(0)" ::: "memory"); } while (0)
#define RESC(a) do { if (__any((a) < 1.f)) { if (hi == 0) al_l[r32] = (a); asm volatile("s_waitcnt lgkmcnt(0)" ::: "memory"); \
    for (int d = 0; d < 4; ++d) for (int r = 0; r < 16; ++r) o[d][r] *= al_l[crow(r, hi)]; } } while (0)
  f32x16 pA0, pA1, pB0, pB1; float mnA, mnB, alA, alB; bf16x8 pa0, pa1, pa2, pa3; const int NT = seq / KVBLK;
  constexpr int SE = 0, SO = SDEPTH - 1;
  SLOAD(SE, 0); asm volatile("s_waitcnt vmcnt(0)" ::: "memory"); SWRITE(0, SE); __syncthreads();
  qkt(pA0, pA1, K_lds, qr, r32, hi); partialSM(pA0, pA1, m_reg, mnA, alA);
  SLOAD(SO, KVBLK); if constexpr (SDEPTH == 2) { if (2 < NT) SLOAD(SE, 2 * KVBLK); }
  SWAIT(); SWRITE(1, SO); __syncthreads();
  for (int j = 1; j + 1 < NT; j += 2) {
    SBAR(); qkt(pB0, pB1, (bf16*)((char*)K_lds + SHM_K), qr, r32, hi);
    finishSM(pA0, pA1, alA, l_reg, pa0, pa1, pa2, pa3); SBAR();
    SLOAD(SO, (j + SDEPTH) * KVBLK); SBAR();
    pv_d0(o, vb0, pa0, pa1, pa2, pa3); partialSM(pB0, pB1, m_reg, mnB, alB);
    __syncthreads(); SWAIT(); SWRITE(0, SE);
    RESC(alB); __syncthreads();
    SBAR(); qkt(pA0, pA1, K_lds, qr, r32, hi);
    finishSM(pB0, pB1, alB, l_reg, pa0, pa1, pa2, pa3); SBAR();
    if (SDEPTH == 1 || j + 3 < NT) SLOAD(SE, (j + 1 + SDEPTH) * KVBLK); SBAR();
    pv_d0(o, vb0 + (int)SHM_V, pa0, pa1, pa2, pa3); partialSM(pA0, pA1, m_reg, mnA, alA);
    __syncthreads(); SWAIT(); SWRITE(1, SO);
    RESC(alA); __syncthreads();
  }
  SBAR(); qkt(pB0, pB1, (bf16*)((char*)K_lds + SHM_K), qr, r32, hi);
  finishSM(pA0, pA1, alA, l_reg, pa0, pa1, pa2, pa3); SBAR();
  pv_d0(o, vb0, pa0, pa1, pa2, pa3); partialSM(pB0, pB1, m_reg, mnB, alB);
  __syncthreads(); RESC(alB);
  finishSM(pB0, pB1, alB, l_reg, pa0, pa1, pa2, pa3); SBAR();
  pv_d0(o, vb0 + (int)SHM_V, pa0, pa1, pa2, pa3);
  if (hi == 0) li_l[r32] = l_reg; asm volatile("s_waitcnt lgkmcnt(0)" ::: "memory");
  float rli[16];
#pragma unroll
  for (int r = 0; r < 16; ++r) rli[r] = __builtin_amdgcn_rcpf(li_l[crow(r, hi)]);
  bf16* Ow = Ob + (long)(wid * QBLK) * LDO;
#pragma unroll
  for (int r = 0; r < 16; ++r) { int orow = crow(r, hi);
    for (int d0 = 0; d0 < 4; ++d0) Ow[(long)orow * LDO + d0 * 32 + r32] = (bf16)f2bf_(o[d0][r] * rli[r]); }
#undef SLOAD
#undef SWRITE
#undef SWAIT
#undef RESC
}
#undef KSWZ
#undef SBAR
}

#define GAS __attribute__((address_space(1)))
typedef unsigned short bf16_t;
typedef unsigned u32x4 __attribute__((ext_vector_type(4)));
typedef unsigned u32x2 __attribute__((ext_vector_type(2)));
typedef float f32x4 __attribute__((ext_vector_type(4)));
typedef float f32x2 __attribute__((ext_vector_type(2)));
typedef short bf16x8 __attribute__((ext_vector_type(8)));

constexpr int D = 2048, NB = 4, SEQ = 4096, CTXL = 256, TB = SEQ + CTXL, M = NB * TB, FF = 5632, DEPTH = 4;
constexpr int NWAVES = 8, NTHR = 512;
constexpr int NCTXWG = 64;
constexpr float NORM_EPS = 1e-6f;
static_assert(M == 17408 && M % 256 == 0 && TB % 256 == 0, "row layout");

constexpr size_t MiB = 1u << 20;
constexpr size_t WS_CTL = 0, CTL_ZERO_BYTES = 4 * MiB;
constexpr size_t WS_MOD = 1 * MiB;
constexpr size_t WS_ROPE = 4 * MiB;
constexpr size_t WS_WB = 8 * MiB;
constexpr size_t E_F1 = (size_t)2 * FF * D, E_F2 = (size_t)D * FF;
constexpr size_t WS_WA = WS_WB + 8 * (E_F1 + E_F2) * 2;
constexpr size_t E_QKV = (size_t)3072 * D, E_SQ = (size_t)D * D;
constexpr size_t WS_WR = WS_WA + 2 * (E_QKV + E_SQ) * 2;
constexpr size_t E_RW1 = (size_t)6912 * D, E_RW2 = (size_t)10240 * 256;
constexpr size_t WS_WEND = WS_WR + 2 * (E_RW1 + E_RW2 + E_SQ) * 2;
static_assert(WS_WEND == 656 * MiB, "weight map");
constexpr size_t SZ_R2 = (size_t)M * D * 2, SZ_R4 = (size_t)M * D * 4;
constexpr size_t WS_X = 656 * MiB;
constexpr size_t WS_Y = WS_X + SZ_R4;
constexpr size_t WS_ACT = WS_Y + SZ_R2;
constexpr size_t WS_OUT = 1048 * MiB;
constexpr size_t WS_MIX = WS_OUT + SZ_R2;
static_assert(WS_ACT + (size_t)M * FF * 2 <= WS_OUT, "act map");
constexpr size_t WS_Q = WS_MIX, WS_K = WS_Q + SZ_R2, WS_V = WS_K + SZ_R2 / 4, WS_O = WS_V + SZ_R2 / 4;
constexpr size_t WS_MIX6 = WS_MIX;
constexpr size_t WS_WDEC = WS_MIX;
constexpr size_t WS_AA = WS_MIX + 2 * SZ_R4;
constexpr size_t WS_RR = WS_MIX + 6 * SZ_R2;
constexpr size_t WS_KK_ = WS_RR + SZ_R2;
constexpr size_t WS_VV = WS_KK_ + SZ_R2;
constexpr size_t WS_KN = WS_VV + SZ_R2;
constexpr size_t WS_GG = WS_KN + SZ_R2;
constexpr size_t WS_GL = WS_GG + SZ_R2;
constexpr size_t WS_WL = WS_GL + 9 * MiB, WS_AL = WS_WL + 9 * MiB;
constexpr size_t WS_PART = WS_AL + 9 * MiB;
constexpr size_t WS_END = WS_PART + 16 * MiB;
constexpr size_t WS_YS = WS_ACT;
constexpr size_t WS_PREP = WS_Y;
static_assert(WS_AA + 2 * SZ_R2 == WS_RR, "rwkv overlay");
static_assert(WS_END <= 2100 * MiB, "ws map");
constexpr int CW_BAR = 4096;
constexpr int MAX_LAUNCH = 64;
static_assert((CW_BAR + MAX_LAUNCH * XCD_BAR_WORDS) * 4 <= (int)WS_MOD, "ctl map");

constexpr int RING_BYTES = 131072, LDSCTL_OFF = RING_BYTES, MISC_OFF = LDSCTL_OFF + 320, LDS_BYTES = 147456;

struct Args { const float* in[30]; float* out; unsigned char* ws; int ph_lo, ph_hi, li, dbg; };
typedef const __attribute__((address_space(4))) Args KArgs;
struct Frame { LAS unsigned char* lds; unsigned char* ldsg; int wave, G, bid; };

#define LDS_WAIT() asm volatile("s_waitcnt lgkmcnt(0)" ::: "memory")
__device__ __forceinline__ unsigned f2bf(float f) { unsigned u = __builtin_bit_cast(unsigned, f); return (u + 0x7fffu + ((u >> 16) & 1u)) >> 16; }
__device__ __forceinline__ unsigned pk2(float lo, float hi) { return pg8::cvt_pk_bf16(lo, hi); }
__device__ __forceinline__ float bflo(unsigned w) { return __builtin_bit_cast(float, w << 16); }
__device__ __forceinline__ float bfhi(unsigned w) { return __builtin_bit_cast(float, w & 0xffff0000u); }
__device__ __forceinline__ void unpack8(const u32x4 w, float (&v)[8]) { v[0] = bflo(w.x); v[1] = bfhi(w.x); v[2] = bflo(w.y); v[3] = bfhi(w.y); v[4] = bflo(w.z); v[5] = bfhi(w.z); v[6] = bflo(w.w); v[7] = bfhi(w.w); }
__device__ __forceinline__ u32x4 pack8(const float (&v)[8]) { u32x4 w; w.x = pk2(v[0], v[1]); w.y = pk2(v[2], v[3]); w.z = pk2(v[4], v[5]); w.w = pk2(v[6], v[7]); return w; }
typedef _Float16 h16x2 __attribute__((ext_vector_type(2)));
__device__ __forceinline__ void unpack8h(const u32x4 w, float (&v)[8]) {
    const unsigned wx = w.x, wy = w.y, wz = w.z, ww = w.w;
    const h16x2 a = __builtin_bit_cast(h16x2, wx), b = __builtin_bit_cast(h16x2, wy), c = __builtin_bit_cast(h16x2, wz), d = __builtin_bit_cast(h16x2, ww);
    v[0] = (float)a.x; v[1] = (float)a.y; v[2] = (float)b.x; v[3] = (float)b.y; v[4] = (float)c.x; v[5] = (float)c.y; v[6] = (float)d.x; v[7] = (float)d.y; }
__device__ __forceinline__ u32x4 pack8h(const float (&v)[8]) {
    h16x2 a, b, c, d; a.x = (_Float16)v[0]; a.y = (_Float16)v[1]; b.x = (_Float16)v[2]; b.y = (_Float16)v[3]; c.x = (_Float16)v[4]; c.y = (_Float16)v[5]; d.x = (_Float16)v[6]; d.y = (_Float16)v[7];
    u32x4 w; w.x = __builtin_bit_cast(unsigned, a); w.y = __builtin_bit_cast(unsigned, b); w.z = __builtin_bit_cast(unsigned, c); w.w = __builtin_bit_cast(unsigned, d); return w; }
__device__ __forceinline__ float wave_sum(float v) {
#pragma unroll
    for (int o = 1; o < 64; o <<= 1) v += __shfl_xor(v, o);
    return v;
}
template <int CTRL> __device__ __forceinline__ float dppf(float x) { return __builtin_bit_cast(float, __builtin_amdgcn_mov_dpp(__builtin_bit_cast(int, x), CTRL, 0xF, 0xF, true)); }
__device__ __forceinline__ float sum8(float v) { v += dppf<0xB1>(v); v += dppf<0x4E>(v); v += dppf<0x141>(v); return v; }
__device__ __forceinline__ float sum16(float v) { v = sum8(v); v += dppf<0x140>(v); return v; }
__device__ __forceinline__ float fsigmoid(float x) { return __builtin_amdgcn_rcpf(1.0f + __builtin_amdgcn_exp2f(-1.4426950408889634f * x)); }
__device__ __forceinline__ float ftanh(float x) { return 1.0f - 2.0f * __builtin_amdgcn_rcpf(1.0f + __builtin_amdgcn_exp2f(2.8853900817779268f * x)); }
__device__ __forceinline__ float fsilu(float x) { return x * fsigmoid(x); }

using pg8::Unit;
typedef float accf32x4 __attribute__((ext_vector_type(4)));
struct EpiPlain {
    static constexpr bool PERM = true, AFTER_DRAIN = false;
    bf16_t* O; int ldc;
    __device__ __forceinline__ void operator()(const accf32x4 (&acc)[2][2][4][2], const Unit& u, int wr, int wc, int fr, int fq) const {
        const int row0 = u.pm * 256 + wr * 64 + fr, col0 = u.pn * 256 + wc * 32 + 8 * fq;
#pragma unroll
        for (int ai = 0; ai < 2; ++ai)
#pragma unroll
            for (int m = 0; m < 4; ++m) { bf16_t* rowp = O + (size_t)(row0 + ai * 128 + m * 16) * ldc + col0;
#pragma unroll
                for (int bj = 0; bj < 2; ++bj) { const accf32x4 v0 = acc[ai][bj][m][0], v1 = acc[ai][bj][m][1];
                    u32x4 w; w.x = pk2(v0[0], v0[1]); w.y = pk2(v0[2], v0[3]); w.z = pk2(v1[0], v1[1]); w.w = pk2(v1[2], v1[3]);
                    *(u32x4*)(rowp + bj * 128) = w; } }
    }
};
struct EpiQKV {
    static constexpr bool PERM = true, AFTER_DRAIN = false;
    unsigned char* wsb;
    __device__ __forceinline__ void operator()(const accf32x4 (&acc)[2][2][4][2], const Unit& u, int wr, int wc, int fr, int fq) const {
        size_t ooff; int ldc, ct;
        if (u.pn < 8) { ooff = WS_Q; ldc = 2048; ct = u.pn; } else if (u.pn < 10) { ooff = WS_K; ldc = 512; ct = u.pn - 8; } else { ooff = WS_V; ldc = 512; ct = u.pn - 10; }
        bf16_t* O = (bf16_t*)(wsb + ooff);
        const int row0 = u.pm * 256 + wr * 64 + fr, col0 = ct * 256 + wc * 32 + 8 * fq;
#pragma unroll
        for (int ai = 0; ai < 2; ++ai)
#pragma unroll
            for (int m = 0; m < 4; ++m) { bf16_t* rowp = O + (size_t)(row0 + ai * 128 + m * 16) * ldc + col0;
#pragma unroll
                for (int bj = 0; bj < 2; ++bj) { const accf32x4 v0 = acc[ai][bj][m][0], v1 = acc[ai][bj][m][1];
                    u32x4 w; w.x = pk2(v0[0], v0[1]); w.y = pk2(v0[2], v0[3]); w.z = pk2(v1[0], v1[1]); w.w = pk2(v1[2], v1[3]);
                    *(u32x4*)(rowp + bj * 128) = w; } }
    }
};
struct EpiSwiGLU {
    static constexpr bool PERM = true, AFTER_DRAIN = false;
    bf16_t* O;
    __device__ __forceinline__ void operator()(const accf32x4 (&acc)[2][2][4][2], const Unit& u, int wr, int wc, int fr, int fq) const {
        const int row0 = u.pm * 256 + wr * 64 + fr, col0 = u.pn * 128 + wc * 32 + 8 * fq;
#pragma unroll
        for (int ai = 0; ai < 2; ++ai)
#pragma unroll
            for (int m = 0; m < 4; ++m) { bf16_t* rowp = O + (size_t)(row0 + ai * 128 + m * 16) * FF + col0;
                float r[8];
#pragma unroll
                for (int n = 0; n < 2; ++n)
#pragma unroll
                    for (int e = 0; e < 4; ++e) { const float g = acc[ai][0][m][n][e], up = acc[ai][1][m][n][e]; r[4 * n + e] = fsilu(g) * up; }
                *(u32x4*)rowp = pack8(r); }
    }
};
struct EpiRw1 {
    static constexpr bool PERM = true, AFTER_DRAIN = false;
    unsigned char* wsb; const float* k_k;
    __device__ __forceinline__ void operator()(const accf32x4 (&acc)[2][2][4][2], const Unit& u, int wr, int wc, int fr, int fq) const {
        const int row0 = u.pm * 256 + wr * 64 + fr, cit = 64 * wc + 8 * fq;
        const int pn = u.pn;
        if (pn >= 8 && pn < 16) {
            bf16_t* K = (bf16_t*)(wsb + WS_KK_); bf16_t* KN = (bf16_t*)(wsb + WS_KN);
            const int colb = (pn - 8) * 256 + cit;
            float kk0[8], kk1[8];
            { const f32x4 a0 = *(const f32x4*)(k_k + colb), a1 = *(const f32x4*)(k_k + colb + 4), b0 = *(const f32x4*)(k_k + colb + 32), b1 = *(const f32x4*)(k_k + colb + 36);
#pragma unroll
              for (int e = 0; e < 4; ++e) { kk0[e] = a0[e]; kk0[4 + e] = a1[e]; kk1[e] = b0[e]; kk1[4 + e] = b1[e]; } }
#pragma unroll
            for (int ai = 0; ai < 2; ++ai)
#pragma unroll
                for (int m = 0; m < 4; ++m) { const size_t ro = (size_t)(row0 + ai * 128 + m * 16) * D + colb;
                    float k0[8], k1[8], q0[8], q1[8]; float ss = 0.f;
#pragma unroll
                    for (int n = 0; n < 2; ++n)
#pragma unroll
                        for (int e = 0; e < 4; ++e) { k0[4 * n + e] = acc[ai][0][m][n][e]; k1[4 * n + e] = acc[ai][1][m][n][e]; }
#pragma unroll
                    for (int i = 0; i < 8; ++i) { q0[i] = k0[i] * kk0[i]; q1[i] = k1[i] * kk1[i]; ss += q0[i] * q0[i] + q1[i] * q1[i]; }
                    ss += __shfl_xor(ss, 16); ss += __shfl_xor(ss, 32);
                    const float rs = rsqrtf(ss + 1e-12f);
#pragma unroll
                    for (int i = 0; i < 8; ++i) { q0[i] *= rs; q1[i] *= rs; }
                    *(u32x4*)(K + ro) = pack8(k0); *(u32x4*)(K + ro + 32) = pack8(k1);
                    *(u32x4*)(KN + ro) = pack8(q0); *(u32x4*)(KN + ro + 32) = pack8(q1); }
        } else if (pn < 24) {
            bf16_t* O = (bf16_t*)(wsb + (pn < 8 ? WS_RR : WS_VV)); const int colb = (pn & 7) * 256 + cit;
#pragma unroll
            for (int ai = 0; ai < 2; ++ai)
#pragma unroll
                for (int m = 0; m < 4; ++m) { const size_t ro = (size_t)(row0 + ai * 128 + m * 16) * D + colb;
#pragma unroll
                    for (int bj = 0; bj < 2; ++bj) { const accf32x4 v0 = acc[ai][bj][m][0], v1 = acc[ai][bj][m][1];
                        u32x4 w; w.x = pk2(v0[0], v0[1]); w.y = pk2(v0[2], v0[3]); w.z = pk2(v1[0], v1[1]); w.w = pk2(v1[2], v1[3]);
                        *(u32x4*)(O + ro + 32 * bj) = w; } }
        } else {
            bf16_t* O = (bf16_t*)(wsb + WS_GL + (size_t)(pn - 24) * (9 * MiB));
#pragma unroll
            for (int ai = 0; ai < 2; ++ai)
#pragma unroll
                for (int m = 0; m < 4; ++m) { const size_t ro = (size_t)(row0 + ai * 128 + m * 16) * 256 + cit;
#pragma unroll
                    for (int bj = 0; bj < 2; ++bj) { float r[8];
#pragma unroll
                        for (int n = 0; n < 2; ++n)
#pragma unroll
                            for (int e = 0; e < 4; ++e) { const float x = acc[ai][bj][m][n][e]; r[4 * n + e] = pn == 24 ? fsigmoid(x) : (pn == 25 ? ftanh(x) : x); }
                        *(u32x4*)(O + ro + 32 * bj) = pack8(r); } }
        }
    }
};
struct EpiRw2 {
    static constexpr bool PERM = true, AFTER_DRAIN = false;
    unsigned char* wsb; const float *w0, *a0; size_t aa_off;
    __device__ __forceinline__ void operator()(const accf32x4 (&acc)[2][2][4][2], const Unit& u, int wr, int wc, int fr, int fq) const {
        const int row0 = u.pm * 256 + wr * 64 + fr, cit = 64 * wc + 8 * fq;
        const int pn = u.pn;
        if (pn < 8) {
            bf16_t* G = (bf16_t*)(wsb + WS_GG);
            const int colb = pn * 256 + cit;
#pragma unroll
            for (int ai = 0; ai < 2; ++ai)
#pragma unroll
                for (int m = 0; m < 4; ++m) { const size_t ro = (size_t)(row0 + ai * 128 + m * 16) * D + colb;
#pragma unroll
                    for (int bj = 0; bj < 2; ++bj) { const accf32x4 v0 = acc[ai][bj][m][0], v1 = acc[ai][bj][m][1];
                        u32x4 w; w.x = pk2(v0[0], v0[1]); w.y = pk2(v0[2], v0[3]); w.z = pk2(v1[0], v1[1]); w.w = pk2(v1[2], v1[3]);
                        *(u32x4*)(G + ro + 32 * bj) = w; } }
        } else if (pn < 24) {
            const int d = (pn - 8) >> 3, colb = ((pn - 8) & 7) * 256 + cit;
            float* Wd = (float*)(wsb + WS_WDEC) + (size_t)d * M * D;
#pragma unroll
            for (int bj = 0; bj < 2; ++bj) {
                const f32x4 b0 = *(const f32x4*)(w0 + d * D + colb + 32 * bj), b1 = *(const f32x4*)(w0 + d * D + colb + 32 * bj + 4);
#pragma unroll
                for (int ai = 0; ai < 2; ++ai)
#pragma unroll
                    for (int m = 0; m < 4; ++m) { const size_t ro = (size_t)(row0 + ai * 128 + m * 16) * D + colb + 32 * bj;
                        f32x4 o0, o1;
#pragma unroll
                        for (int e = 0; e < 4; ++e) { o0[e] = __builtin_amdgcn_exp2f(-0.8750387749f * fsigmoid(acc[ai][bj][m][0][e] + b0[e]));
                                                      o1[e] = __builtin_amdgcn_exp2f(-0.8750387749f * fsigmoid(acc[ai][bj][m][1][e] + b1[e])); }
                        *(f32x4*)(Wd + ro) = o0; *(f32x4*)(Wd + ro + 4) = o1; } }
        } else {
            const int d = (pn - 24) >> 3, colb = ((pn - 24) & 7) * 256 + cit;
            bf16_t* AAd = (bf16_t*)(wsb + aa_off) + (size_t)d * M * D;
#pragma unroll
            for (int bj = 0; bj < 2; ++bj) {
                const int cb = colb + 32 * bj;
                const f32x4 b0 = *(const f32x4*)(a0 + d * D + cb), b1 = *(const f32x4*)(a0 + d * D + cb + 4);
#pragma unroll
                for (int ai = 0; ai < 2; ++ai)
#pragma unroll
                    for (int m = 0; m < 4; ++m) { const size_t ro = (size_t)(row0 + ai * 128 + m * 16) * D + cb;
                        float av[8];
#pragma unroll
                        for (int e = 0; e < 4; ++e) { av[e] = fsigmoid(acc[ai][bj][m][0][e] + b0[e]); av[4 + e] = fsigmoid(acc[ai][bj][m][1][e] + b1[e]); }
                        *(u32x4*)(AAd + ro) = pack8(av); } }
        }
    }
};
struct GemmRw1 { const bf16_t* MIX; const bf16_t* Bt;  int K;
    __device__ __forceinline__ const char* a_tile(const Unit& u) const { int idx = u.pn < 24 ? (u.pn >> 3) : (u.pn - 21);
#ifdef DBG_RW1_SAMEA
        idx = 0;
#endif
        return (const char*)MIX + (size_t)idx * SZ_R2 + (size_t)u.pm * (size_t)(256 * 2) * D; }
    __device__ __forceinline__ const char* b_tile(const Unit& u) const { return (const char*)Bt + (size_t)u.pn * (size_t)(256 * 2) * D; }
    __device__ __forceinline__ int klen() const { return K; } };
struct GemmRw2 { const unsigned char* wsb; const bf16_t* Bt; int K;
    __device__ __forceinline__ const char* a_tile(const Unit& u) const { const size_t ao = u.pn < 8 ? WS_GL : (u.pn < 24 ? WS_WL : WS_AL); return (const char*)wsb + ao + (size_t)u.pm * (size_t)(256 * 2) * 256; }
    __device__ __forceinline__ const char* b_tile(const Unit& u) const { return (const char*)Bt + (size_t)u.pn * (size_t)(256 * 2) * 256; }
    __device__ __forceinline__ int klen() const { return K; } };

__device__ __forceinline__ int hp_row(int c) { return 128 * ((c & 63) >> 5) + 32 * (c >> 6) + (c & 31); }
__device__ __forceinline__ int hp_col(int rho) { return 64 * ((rho & 127) >> 5) + 32 * (rho >> 7) + (rho & 31); }
__device__ __forceinline__ void cvt_item(const float* W, int K, int N, bf16_t* WT, int mode, int row_off, LAS float* scr, int item, int lane) {
    const int nblk = N / 32, kb = item / nblk, nb = item - kb * nblk, k0 = 64 * kb, n0 = 32 * nb;
#pragma unroll 8
    for (int i = 0; i < 32; ++i) { const int kk = 2 * i + (lane >> 5); scr[kk * 33 + (lane & 31)] = W[(size_t)(k0 + kk) * N + n0 + (lane & 31)]; }
    LDS_WAIT(); asm volatile("" ::: "memory");
    int dr;
    if (mode == 0) dr = n0;
    else if (mode == 1) { dr = n0 < FF ? 256 * (n0 / 128) + (n0 % 128) : 256 * ((n0 - FF) / 128) + 128 + ((n0 - FF) % 128); }
    else { dr = (n0 & ~255) + hp_row(n0 & 255); }
    dr += row_off;
    const int c = lane & 7;
#pragma unroll
    for (int j = 0; j < 4; ++j) { const int n = (lane >> 3) + 8 * j; const LAS float* s = scr + (8 * c) * 33 + n;
        u32x4 o; o.x = pk2(s[0 * 33], s[1 * 33]); o.y = pk2(s[2 * 33], s[3 * 33]); o.z = pk2(s[4 * 33], s[5 * 33]); o.w = pk2(s[6 * 33], s[7 * 33]);
        *(u32x4*)(WT + (size_t)(dr + n) * K + k0 + 8 * c) = o; }
    LDS_WAIT(); asm volatile("" ::: "memory");
}
__device__ __forceinline__ void p0a_phase(const Frame F, KArgs* a) {
    const int lane_ = lane_opaque(), tid_ = F.wave * 64 + lane_; (void)tid_; (void)lane_;
    LAS float* scr = (LAS float*)(F.lds + F.wave * 16384);
    const int gw = F.bid * NWAVES + F.wave, NGW = F.G * NWAVES;
    bf16_t* WB = (bf16_t*)(a->ws + WS_WB); bf16_t* WA = (bf16_t*)(a->ws + WS_WA); bf16_t* WR = (bf16_t*)(a->ws + WS_WR);
    constexpr int I_F1 = (D / 64) * (2 * FF / 32), I_F2 = (FF / 64) * (D / 32), I_QKV = (D / 64) * (3072 / 32), I_SQ = (D / 64) * (D / 32), I_G1 = (D / 64) * (256 / 32), I_G2 = (256 / 64) * (D / 32);
    constexpr int N_FFN = 8 * (I_F1 + I_F2), N_ATT = 2 * (I_QKV + I_SQ), N_RW = 2 * (4 * I_SQ + I_G1 + I_G2);
    constexpr int NITEMS = N_FFN + N_ATT + N_RW;
    for (int it = gw; it < NITEMS; it += NGW) {
        int r = it;
        if (r < N_FFN) { const int lh = r / (I_F1 + I_F2); r -= lh * (I_F1 + I_F2);
            bf16_t* base = WB + (size_t)lh * (E_F1 + E_F2);
            if (r < I_F1) cvt_item(a->in[8] + (size_t)lh * D * 2 * FF, D, 2 * FF, base, 1, 0, scr, r, lane_);
            else cvt_item(a->in[9] + (size_t)lh * FF * D, FF, D, base + E_F1, 0, 0, scr, r - I_F1, lane_);
            continue; }
        r -= N_FFN;
        if (r < N_ATT) { const int j = r / (I_QKV + I_SQ); r -= j * (I_QKV + I_SQ);
            bf16_t* base = WA + (size_t)j * (E_QKV + E_SQ);
            if (r < I_QKV) cvt_item(a->in[10] + (size_t)j * D * 3072, D, 3072, base, 0, 0, scr, r, lane_);
            else cvt_item(a->in[11] + (size_t)j * D * D, D, D, base + E_QKV, 0, 0, scr, r - I_QKV, lane_);
            continue; }
        r -= N_ATT;
        { const int per = 4 * I_SQ + I_G1 + I_G2; const int j = r / per; r -= j * per;
          bf16_t* rw1 = WR + (size_t)j * (E_RW1 + E_RW2 + E_SQ); bf16_t* rw2 = rw1 + E_RW1; bf16_t* ro = rw2 + E_RW2;
          if (r < 3 * I_SQ) { const int q = r / I_SQ; cvt_item(a->in[15] + ((size_t)j * 3 + q) * D * D, D, D, rw1, 2, q * 2048, scr, r - q * I_SQ, lane_); continue; }
          r -= 3 * I_SQ;
          if (r < I_SQ) { cvt_item(a->in[16] + (size_t)j * D * D, D, D, ro, 0, 0, scr, r, lane_); continue; }
          r -= I_SQ;
          if (r < I_G1) { cvt_item(a->in[17] + (size_t)j * D * 256, D, 256, rw1, 2, 6144, scr, r, lane_); continue; }
          r -= I_G1;
          cvt_item(a->in[18] + (size_t)j * 256 * D, 256, D, rw2, 2, 0, scr, r, lane_); }
    }
    {
        constexpr int P_A = 256 * 2048 / 2, P_C = 4096 * 256 / 2, P_J = 2 * P_A + 2 * P_C;
        for (int p = F.bid * NTHR + tid_; p < 2 * P_J; p += F.G * NTHR) {
            const int j = p / P_J; int r = p - j * P_J;
            bf16_t* rw1 = WR + (size_t)j * (E_RW1 + E_RW2 + E_SQ); bf16_t* rw2 = rw1 + E_RW1;
            if (r < 2 * P_A) { const int which = r / P_A; r -= which * P_A;
                const int rho = r / 1024, k = (r - rho * 1024) * 2, c = hp_col(rho);
                const float* src = (which == 0 ? a->in[20] : a->in[23]);
                float v0 = 0.f, v1 = 0.f;
                if (c < 192) { const int d = c / 96, jj = c - d * 96; const float* s = src + (((size_t)j * 2 + d) * D + k) * 96 + jj; v0 = s[0]; v1 = s[96]; }
                *(unsigned*)(rw1 + (size_t)(6400 + 256 * which + rho) * D + k) = pk2(v0, v1);
            } else { r -= 2 * P_A; const int which = r / P_C; r -= which * P_C;
                const int nrow = r / 128, k = (r - nrow * 128) * 2;
                const int d = nrow >> 11, np = nrow & 2047, c = (np & ~255) + hp_col(np & 255);
                const float* src = (which == 0 ? a->in[21] : a->in[24]);
                float v0 = 0.f, v1 = 0.f;
                if (k < 192 && (k / 96) == d) { const int kk = k - d * 96; const float* s = src + (((size_t)j * 2 + d) * 96 + kk) * D + c; v0 = s[0]; v1 = s[D]; }
                *(unsigned*)(rw2 + (size_t)(2048 + 4096 * which + nrow) * 256 + k) = pk2(v0, v1);
            }
        }
    }
#ifdef DBG_FILL_WS
    {
        u32x4* p = (u32x4*)(a->ws + WS_X); const size_t n16 = (WS_END - WS_X) / 16;
        for (size_t i = (size_t)F.bid * NTHR + tid_; i < n16; i += (size_t)F.G * NTHR) p[i] = (u32x4){0xAAAAAAAAu, 0xAAAAAAAAu, 0xAAAAAAAAu, 0xAAAAAAAAu};
    }
#endif
    {
        float* COS = (float*)(a->ws + WS_ROPE); float* SIN = COS + 4096 * 64;
        for (int p = F.bid * NTHR + tid_; p < 4096 * 64; p += F.G * NTHR) {
            const int t = p >> 6, f = p & 63; const int pos = f < 32 ? (t >> 6) : (t & 63); const int fi = f & 31;
            const float inv = exp2f(-(float)fi * (13.287712379549449f / 32.0f));
            const float ang = (float)pos * inv;
            COS[p] = cosf(ang); SIN[p] = sinf(ang);
        }
    }
    {
        LAS float* sv = (LAS float*)F.lds;
        LAS float* part = (LAS float*)(F.lds + 65536);
        float* MOD = (float*)(a->ws + WS_MOD);
        __syncthreads();
        for (int idx = tid_; idx < 5 * D; idx += NTHR) { const int cc = idx >> 11, kk = idx & 2047; const float x = cc < 4 ? a->in[1][cc * D + kk] : a->in[3][kk]; sv[kk * 8 + cc] = fsilu(x); }
        __syncthreads();
        for (int u = F.bid; u < 4 * 72; u += F.G) {
            const int l = u / 72, nb = u - l * 72;
            const int n = nb * 256 + lane_ * 4, k0 = F.wave * 256;
            const float* wp = a->in[4] + ((size_t)l * D + k0) * 18432 + n;
            f32x4 acc[5];
#pragma unroll
            for (int c = 0; c < 5; ++c) acc[c] = (f32x4){0.f, 0.f, 0.f, 0.f};
#pragma unroll 8
            for (int kk = 0; kk < 256; ++kk) { const f32x4 w4 = *(const f32x4*)(wp + (size_t)kk * 18432);
                const f32x4 s4 = *(const LAS f32x4*)(sv + (k0 + kk) * 8); const float s5 = sv[(k0 + kk) * 8 + 4];
                acc[0] += w4 * s4[0]; acc[1] += w4 * s4[1]; acc[2] += w4 * s4[2]; acc[3] += w4 * s4[3]; acc[4] += w4 * s5; }
#pragma unroll
            for (int c = 0; c < 5; ++c) *(LAS f32x4*)(part + (F.wave * 5 + c) * 256 + lane_ * 4) = acc[c];
            __syncthreads();
            for (int o = tid_; o < 5 * 256; o += NTHR) { const int c = o >> 8, col = o & 255; float s = a->in[5][(size_t)l * 18432 + nb * 256 + col];
#pragma unroll
                for (int w = 0; w < 8; ++w) s += part[(w * 5 + c) * 256 + col];
                MOD[((size_t)l * 5 + c) * 18432 + nb * 256 + col] = s; }
            __syncthreads();
        }
    }
}

template <int MODE> struct ThinCtx { float PA[4][8], PB[4][8], PC[4][8]; int cur_c; };
template <int MODE, bool CTXP>
__device__ __forceinline__ void thin_row(ThinCtx<MODE>& T, KArgs* a, const int lane, const int m, int l, int s, float wgt, int nl, int ns) {
    const float* MOD = (const float*)(a->ws + WS_MOD);
    bf16_t* X = (bf16_t*)(a->ws + WS_X)  ; bf16_t* Y = (bf16_t*)(a->ws + WS_Y); const bf16_t* OUT = (const bf16_t*)(a->ws + WS_OUT);
    const int b = m / TB, j = m - b * TB, c = j < CTXL ? 4 : b;
    if (MODE == 2 && c == 4) return;
    if (c != T.cur_c) {
        T.cur_c = c;
#pragma unroll
        for (int q = 0; q < 4; ++q) { const int e0 = 512 * q + 8 * lane;
            if (MODE != 0) { const float* gp = MOD + (((size_t)l * 5 + c) * 9 + s * 3 + 2) * D + e0; const float* np = a->in[7] + ((size_t)l * 3 + s) * D + e0;
#pragma unroll
                for (int i = 0; i < 8; ++i) T.PA[q][i] = wgt * gp[i] * np[i]; }
            if (MODE != 2) { const float* sc = MOD + (((size_t)nl * 5 + c) * 9 + ns * 3 + 1) * D + e0; const float* sh = MOD + (((size_t)nl * 5 + c) * 9 + ns * 3 + 0) * D + e0; const float* np = a->in[6] + ((size_t)nl * 3 + ns) * D + e0;
#pragma unroll
                for (int i = 0; i < 8; ++i) { T.PB[q][i] = np[i] * (1.0f + sc[i]); T.PC[q][i] = sh[i]; } } }
    }
    float x[4][8];
    if (MODE == 0) {
        const float* src = j < CTXL ? a->in[2] + ((size_t)b * CTXL + j) * D : a->in[0] + ((size_t)b * SEQ + (j - CTXL)) * D;
#pragma unroll
        for (int q = 0; q < 4; ++q) { const f32x4 v0 = *(const f32x4*)(src + 512 * q + 8 * lane), v1 = *(const f32x4*)(src + 512 * q + 8 * lane + 4);
#pragma unroll
            for (int e = 0; e < 4; ++e) { x[q][e] = v0[e]; x[q][4 + e] = v1[e]; } }
    } else {
        float o[4][8]; float ss = 0.f;
#pragma unroll
        for (int q = 0; q < 4; ++q) {
            if (CTXP) { const float* P0 = (const float*)(a->ws + WS_PART) + (size_t)(b * CTXL + j) * D + 512 * q + 8 * lane; const float* P1 = P0 + (size_t)(NB * CTXL) * D;
                const f32x4 a0 = *(const f32x4*)P0, a1 = *(const f32x4*)(P0 + 4), b0 = *(const f32x4*)P1, b1 = *(const f32x4*)(P1 + 4);
#pragma unroll
                for (int e = 0; e < 4; ++e) { o[q][e] = a0[e] + b0[e]; o[q][4 + e] = a1[e] + b1[e]; } }
            else unpack8(*(const u32x4*)(OUT + (size_t)m * D + 512 * q + 8 * lane), o[q]);
#pragma unroll
            for (int i = 0; i < 8; ++i) ss += o[q][i] * o[q][i]; }
        ss = wave_sum(ss);
        const float r1 = rsqrtf(ss * (1.0f / D) + NORM_EPS);
#pragma unroll
        for (int q = 0; q < 4; ++q) { float xo[8]; unpack8h(*(const u32x4*)(X + (size_t)m * D + 512 * q + 8 * lane), xo);
#pragma unroll
            for (int e = 0; e < 8; ++e) x[q][e] = xo[e] + T.PA[q][e] * (o[q][e] * r1); }
    }
    if (MODE == 2) {
        float* dst = a->out + ((size_t)b * SEQ + (j - CTXL)) * D;
#pragma unroll
        for (int q = 0; q < 4; ++q) { *(f32x4*)(dst + 512 * q + 8 * lane) = (f32x4){x[q][0], x[q][1], x[q][2], x[q][3]}; *(f32x4*)(dst + 512 * q + 8 * lane + 4) = (f32x4){x[q][4], x[q][5], x[q][6], x[q][7]}; }
        return;
    }
    float ss2 = 0.f;
#pragma unroll
    for (int q = 0; q < 4; ++q) { *(u32x4*)(X + (size_t)m * D + 512 * q + 8 * lane) = pack8h(x[q]);
#pragma unroll
        for (int i = 0; i < 8; ++i) ss2 += x[q][i] * x[q][i]; }
    ss2 = wave_sum(ss2);
    const float r2 = rsqrtf(ss2 * (1.0f / D) + NORM_EPS);
#pragma unroll
    for (int q = 0; q < 4; ++q) { float y[8];
#pragma unroll
        for (int i = 0; i < 8; ++i) y[i] = (x[q][i] * r2) * T.PB[q][i] + T.PC[q][i];
        *(u32x4*)(Y + (size_t)m * D + 512 * q + 8 * lane) = pack8(y); }
}
template <int MODE, int ROWSET>
__device__ __forceinline__ void thin_phase(const Frame F, KArgs* a, int l, int s, float wgt, int nl, int ns) {
    const int lane_ = lane_opaque();
    ThinCtx<MODE> T; T.cur_c = -1;
    if (ROWSET == 0) {
        for (int ch = F.bid; ch < M / 68; ch += F.G) {
            const int r0 = ch * 68 + (F.wave < 4 ? 9 * F.wave : 36 + 8 * (F.wave - 4)), nr = F.wave < 4 ? 9 : 8;
            for (int r = 0; r < nr; ++r) thin_row<MODE, false>(T, a, lane_, r0 + r, l, s, wgt, nl, ns);
        }
    } else if (ROWSET == 1) {
        const int nw = (F.G - NCTXWG) * NWAVES, wv = (F.bid - NCTXWG) * NWAVES + F.wave;
        const int l0 = (int)(((long)wv * (NB * SEQ)) / nw), l1 = (int)(((long)(wv + 1) * (NB * SEQ)) / nw);
        for (int li = l0; li < l1; ++li) thin_row<MODE, false>(T, a, lane_, (li >> 12) * TB + CTXL + (li & (SEQ - 1)), l, s, wgt, nl, ns);
    } else {
        for (int c = F.bid * NWAVES + F.wave; c < NB * CTXL; c += F.G * NWAVES) thin_row<MODE, true>(T, a, lane_, (c >> 8) * TB + (c & (CTXL - 1)), l, s, wgt, nl, ns);
    }
}
struct LatentOrder : pg8::StaticOrder {
    __device__ void init_lat(int N, int G_, int c_) { init(64 * 256, N, G_, c_); }
    __device__ bool next(int i, Unit& u) const { if (!pg8::StaticOrder::next(i, u)) return false; u.pm = u.pm + (u.pm >> 4) + 1; return true; }
};
struct CtxOrder2 {
    int c;
    __device__ bool next(int i, Unit& u) const { if (i != 0 || c >= NCTXWG) return false; const int idx = c >> 1; u.pm = (idx >> 3) * 17; u.pn = (idx & 7) + 8 * (c & 1); return true; }
    __device__ __forceinline__ void a_ready(const Unit&) const {}
    __device__ __forceinline__ void done(const Unit&) const {}
};
struct GemmCtxSplit { const bf16_t* A; const bf16_t* Bt; int K;
    __device__ __forceinline__ const char* a_tile(const Unit& u) const { return (const char*)A + (size_t)u.pm * (size_t)(256 * 2) * K + (size_t)(u.pn >> 3) * (size_t)(K / 2) * 2; }
    __device__ __forceinline__ const char* b_tile(const Unit& u) const { return (const char*)Bt + (size_t)(u.pn & 7) * (size_t)(256 * 2) * K + (size_t)(u.pn >> 3) * (size_t)(K / 2) * 2; }
    __device__ __forceinline__ int klen() const { return K / 2; } };
struct EpiCtxPart {
    static constexpr bool PERM = true, AFTER_DRAIN = false;
    float* P;
    __device__ __forceinline__ void operator()(const accf32x4 (&acc)[2][2][4][2], const Unit& u, int wr, int wc, int fr, int fq) const {
        const int row0 = (u.pm / 17) * 256 + wr * 64 + fr, col0 = (u.pn & 7) * 256 + wc * 32 + 8 * fq;
        float* base = P + (size_t)(u.pn >> 3) * (NB * CTXL) * D;
#pragma unroll
        for (int ai = 0; ai < 2; ++ai)
#pragma unroll
            for (int m = 0; m < 4; ++m) { float* rowp = base + (size_t)(row0 + ai * 128 + m * 16) * D + col0;
#pragma unroll
                for (int bj = 0; bj < 2; ++bj) { *(f32x4*)(rowp + bj * 128) = acc[ai][bj][m][0]; *(f32x4*)(rowp + bj * 128 + 4) = acc[ai][bj][m][1]; } }
    }
};
#ifndef DBG_DUMP_OFF
#define DBG_DUMP_OFF WS_X
#define DBG_DUMP_F32 1
#endif
__device__ __forceinline__ void copyout_phase(const Frame F, KArgs* a) {
    const int lane_ = lane_opaque();
    for (int m = F.bid * NWAVES + F.wave; m < M; m += F.G * NWAVES) { const int b = m / TB, j = m - b * TB; if (j < CTXL) continue;
        float* dst = a->out + ((size_t)b * SEQ + (j - CTXL)) * D;
#if defined(DBG_DUMP_P256)
        { const size_t offs[] = {DBG_DUMP_P256}; constexpr int NL = sizeof(offs) / sizeof(offs[0]);
          for (int q = 0; q < 4; ++q) { float acc[8], v[8]; for (int e = 0; e < 8; ++e) acc[e] = 0.f;
              if (q == 0 && lane_ < 32) { for (int t = 0; t < NL; ++t) { unpack8(*(const u32x4*)((const bf16_t*)(a->ws + offs[t]) + (size_t)m * 256 + 8 * lane_), v); for (int e = 0; e < 8; ++e) acc[e] += (1.f + t) * v[e]; } }
              *(f32x4*)(dst + 512 * q + 8 * lane_) = (f32x4){acc[0], acc[1], acc[2], acc[3]}; *(f32x4*)(dst + 512 * q + 8 * lane_ + 4) = (f32x4){acc[4], acc[5], acc[6], acc[7]}; }
          continue; }
#endif
#ifndef DBG_DUMP_W
#define DBG_DUMP_W(t) (1.f + (t))
#endif
#if defined(DBG_DUMP_LIST)
        { const size_t offs[] = {DBG_DUMP_LIST}; constexpr int NL = sizeof(offs) / sizeof(offs[0]);
#pragma unroll
          for (int q = 0; q < 4; ++q) { const size_t ro = (size_t)m * D + 512 * q + 8 * lane_; float acc[8], v[8];
              for (int e = 0; e < 8; ++e) acc[e] = 0.f;
#pragma unroll
              for (int t = 0; t < NL; ++t) { unpack8(*(const u32x4*)((const bf16_t*)(a->ws + offs[t]) + ro), v); for (int e = 0; e < 8; ++e) acc[e] += DBG_DUMP_W(t) * v[e]; }
              *(f32x4*)(dst + 512 * q + 8 * lane_) = (f32x4){acc[0], acc[1], acc[2], acc[3]}; *(f32x4*)(dst + 512 * q + 8 * lane_ + 4) = (f32x4){acc[4], acc[5], acc[6], acc[7]}; }
          continue; }
#endif
        if (DBG_DUMP_F32) { const float* X = (const float*)(a->ws + (DBG_DUMP_OFF));
#pragma unroll
            for (int q = 0; q < 8; ++q) *(f32x4*)(dst + 256 * q + 4 * lane_) = *(const f32x4*)(X + (size_t)m * D + 256 * q + 4 * lane_); }
        else { const bf16_t* Bq = (const bf16_t*)(a->ws + (DBG_DUMP_OFF));
#pragma unroll
            for (int q = 0; q < 4; ++q) { float v[8]; unpack8(*(const u32x4*)(Bq + (size_t)m * D + 512 * q + 8 * lane_), v);
                *(f32x4*)(dst + 512 * q + 8 * lane_) = (f32x4){v[0], v[1], v[2], v[3]}; *(f32x4*)(dst + 512 * q + 8 * lane_ + 4) = (f32x4){v[4], v[5], v[6], v[7]}; } }
    }
}

__device__ __forceinline__ void mixes_phase(const Frame F, KArgs* a, int jr) {
    const int lane_ = lane_opaque(), tid_ = F.wave * 64 + lane_; (void)tid_; (void)lane_;
    const bf16_t* Y = (const bf16_t*)(a->ws + WS_Y); bf16_t* MIX = (bf16_t*)(a->ws + WS_MIX6);
    const int rg = F.wave >> 2, e0 = 512 * (F.wave & 3) + 8 * lane_;
    float mu[6][8];
    { const int muidx[6] = {0, 2, 3, 5, 1, 4};
#pragma unroll
      for (int q = 0; q < 6; ++q) { const float* mp = a->in[14] + ((size_t)jr * 6 + muidx[q]) * D + e0;
#pragma unroll
          for (int i = 0; i < 8; ++i) mu[q][i] = mp[i]; } }
    for (int ch = F.bid; ch < M / 68; ch += F.G) {
        const int r0 = ch * 68 + 34 * rg;
        float yp[8], yc[8], yn[8];
        if (r0 > 0) unpack8(*(const u32x4*)(Y + (size_t)(r0 - 1) * D + e0), yp); else {
#pragma unroll
            for (int i = 0; i < 8; ++i) yp[i] = 0.f; }
        unpack8(*(const u32x4*)(Y + (size_t)r0 * D + e0), yc);
        for (int r = 0; r < 34; ++r) { const int m = r0 + r, j = m % TB;
            if (m + 1 < M) unpack8(*(const u32x4*)(Y + (size_t)(m + 1) * D + e0), yn); else {
#pragma unroll
                for (int i = 0; i < 8; ++i) yn[i] = 0.f; }
            const float pv = (j != 0 && j != CTXL) ? 0.5f : 0.f, nv = (j != CTXL - 1 && j != TB - 1) ? 0.5f : 0.f;
            float xx[8];
#pragma unroll
            for (int i = 0; i < 8; ++i) xx[i] = (pv * yp[i] + nv * yn[i]) - yc[i];
#pragma unroll
            for (int q = 0; q < 6; ++q) { float o[8];
#pragma unroll
                for (int i = 0; i < 8; ++i) o[i] = yc[i] + xx[i] * mu[q][i];
                *(u32x4*)(MIX + (size_t)q * M * D + (size_t)m * D + e0) = pack8(o); }
#pragma unroll
            for (int i = 0; i < 8; ++i) { yp[i] = yc[i]; yc[i] = yn[i]; }
        }
    }
}

__device__ __forceinline__ void qknorm_phase(const Frame F, KArgs* a, int ja) {
    const int lane_ = lane_opaque(), tid_ = F.wave * 64 + lane_; (void)tid_; (void)lane_;
    bf16_t* Q = (bf16_t*)(a->ws + WS_Q); bf16_t* K = (bf16_t*)(a->ws + WS_K);
    const float* COS = (const float*)(a->ws + WS_ROPE); const float* SIN = COS + 4096 * 64;
    const int li = lane_ & 15, hs = lane_ >> 4;
    float gq[8], gk[8];
#pragma unroll
    for (int i = 0; i < 8; ++i) { gq[i] = a->in[12][ja * 128 + 8 * li + i]; gk[i] = a->in[13][ja * 128 + 8 * li + i]; }
    for (int m = F.bid * NWAVES + F.wave; m < M; m += F.G * NWAVES) {
        const int j = m % TB; const bool lat = j >= CTXL; const int pos = lat ? j - CTXL : 0;
        f32x4 cs = (f32x4){1.f, 1.f, 1.f, 1.f}, sn = (f32x4){0.f, 0.f, 0.f, 0.f};
        if (lat) { cs = *(const f32x4*)(COS + (size_t)pos * 64 + 4 * li); sn = *(const f32x4*)(SIN + (size_t)pos * 64 + 4 * li); }
#pragma unroll
        for (int p = 0; p < 5; ++p) {
            bf16_t* ptr = p < 4 ? Q + (size_t)m * D + (4 * p + hs) * 128 + 8 * li : K + (size_t)m * 512 + hs * 128 + 8 * li;
            float v[8]; unpack8(*(const u32x4*)ptr, v);
            float ss = 0.f;
#pragma unroll
            for (int i = 0; i < 8; ++i) ss += v[i] * v[i];
            ss = sum16(ss);
            const float rs = rsqrtf(ss * (1.0f / 128.0f) + NORM_EPS);
            float o[8];
#pragma unroll
            for (int i = 0; i < 4; ++i) { const float x1 = v[2 * i] * rs * (p < 4 ? gq[2 * i] : gk[2 * i]), x2 = v[2 * i + 1] * rs * (p < 4 ? gq[2 * i + 1] : gk[2 * i + 1]);
                o[2 * i] = x1 * cs[i] - x2 * sn[i]; o[2 * i + 1] = x1 * sn[i] + x2 * cs[i]; }
            *(u32x4*)ptr = pack8(o);
        }
    }
}

template <int R> __device__ __forceinline__ float ror16(float x) { return __builtin_bit_cast(float, __builtin_amdgcn_mov_dpp(__builtin_bit_cast(int, x), 0x120 + R, 0xF, 0xF, true)); }
__device__ __forceinline__ float sum_row16(float x) { x += ror16<8>(x); x += ror16<4>(x); x += ror16<2>(x); x += ror16<1>(x); return x; }
__device__ __forceinline__ float sum_rows(float x) {
    x += ror16<8>(x);
    { const unsigned u = __builtin_bit_cast(unsigned, x); auto rr = __builtin_amdgcn_permlane16_swap(u, u, false, false); const unsigned r0 = rr[0], r1 = rr[1];
      x = __builtin_bit_cast(float, r0) + __builtin_bit_cast(float, r1); }
    { const unsigned u = __builtin_bit_cast(unsigned, x); auto rr = __builtin_amdgcn_permlane32_swap(u, u, false, false); const unsigned r0 = rr[0], r1 = rr[1];
      x = __builtin_bit_cast(float, r0) + __builtin_bit_cast(float, r1); }
    return x;
}
__device__ __forceinline__ void scan_phase(const Frame F, KArgs* a, int jr) {
    const int lane_ = lane_opaque(), tid_ = F.wave * 64 + lane_; (void)tid_; (void)lane_;
    LAS float* L = (LAS float*)F.lds;
    constexpr int BUF = 32 * 384, YB0 = 2 * BUF, YBUF = 32 * 64;
    const int tid = tid_, lane = lane_, li4 = (lane & 15) * 4, vrow = 8 * F.wave + 2 * (lane >> 4);
    const float* WDEC = (const float*)(a->ws + WS_WDEC);
    const bf16_t* KR = (const bf16_t*)(a->ws + WS_KK_); const bf16_t* AA = (const bf16_t*)(a->ws + WS_AA);
    const bf16_t* KN = (const bf16_t*)(a->ws + WS_KN); const bf16_t* RR = (const bf16_t*)(a->ws + WS_RR); const bf16_t* VV = (const bf16_t*)(a->ws + WS_VV);
    bf16_t* YS = (bf16_t*)(a->ws + WS_YS);
    for (int chain = F.bid; chain < 256; chain += F.G) {
        const int b = chain >> 6, h = (chain >> 1) & 31, dir = chain & 1;
        const size_t doff = (size_t)dir * M * D;
        const int hc = h * 64;
        const int lrow = (tid & 255) >> 3, lpart = tid & 7, wrow = tid >> 4, wpart = tid & 15; const bool lo = tid < 256;
        const bf16_t* pa = (lo ? KR : RR) + hc + lpart * 8; const bf16_t* pb = (lo ? KN : VV) + hc + lpart * 8; const bf16_t* pc = AA + doff + hc + lpart * 8;
        float ka[8];
#pragma unroll
        for (int i = 0; i < 8; ++i) ka[i] = a->in[26][(size_t)jr * D + hc + lpart * 8 + i];
        const float* pw = WDEC + doff + hc + wpart * 4;
        u32x4 ra, rb, rc; f32x4 rw;
        f32x2 S2[4];
#pragma unroll
        for (int i = 0; i < 4; ++i) S2[i] = (f32x2){0.f, 0.f};
#define SCAN_M0(q) (b * TB + (dir == 0 ? 32 * (q) : ((q) < 8 ? 224 - 32 * (q) : 4576 - 32 * (q))))
#define SCAN_LOAD(q) do { const size_t m0_ = (size_t)SCAN_M0(q); ra = *(const u32x4*)(pa + (m0_ + lrow) * D); rb = *(const u32x4*)(pb + (m0_ + lrow) * D); if (lo) rc = *(const u32x4*)(pc + (m0_ + lrow) * D); \
        rw = *(const f32x4*)(pw + (m0_ + wrow) * D); } while (0)
#define SCAN_ST8(off_, t_) do { *(LAS f32x4*)(d_ + (off_)) = (f32x4){t_[0], t_[1], t_[2], t_[3]}; *(LAS f32x4*)(d_ + (off_) + 4) = (f32x4){t_[4], t_[5], t_[6], t_[7]}; } while (0)
#define SCAN_WRITE(bufi) do { LAS float* d_ = L + (bufi) * BUF + lrow * 384 + lpart * 8; float ta_[8], tb_[8]; \
        unpack8(ra, ta_); unpack8(rb, tb_); \
        if (lo) { float tc_[8], kd_[8], bb_[8]; unpack8(rc, tc_); _Pragma("unroll") for (int i_ = 0; i_ < 8; ++i_) { kd_[i_] = ta_[i_] * (1.0f + (tc_[i_] - 1.0f) * ka[i_]); bb_[i_] = tb_[i_] * tc_[i_]; } \
            SCAN_ST8(64, kd_); SCAN_ST8(128, bb_); SCAN_ST8(192, tb_); } \
        else { SCAN_ST8(256, ta_); SCAN_ST8(320, tb_); } \
        *(LAS f32x4*)(L + (bufi) * BUF + wrow * 384 + wpart * 4) = rw; } while (0)
        __syncthreads();
        SCAN_LOAD(0); SCAN_WRITE(0); __syncthreads();
        for (int q = 0; q < 136; ++q) {
            const int bi = q & 1;
            if (q + 1 < 136) SCAN_LOAD(q + 1);
            const LAS float* base = L + bi * BUF + (dir ? 31 * 384 : 0); const int stp = dir ? -384 : 384;
            LAS float* yb = L + YB0 + bi * YBUF + (dir ? 31 * 64 : 0) + vrow; const int ystp = dir ? -64 : 64;
#define SUM2_ROW16(a_, b_) asm volatile("s_nop 1\n\t" \
    "v_add_f32_dpp %0, %0, %0 row_ror:8 row_mask:0xf bank_mask:0xf\n\tv_add_f32_dpp %1, %1, %1 row_ror:8 row_mask:0xf bank_mask:0xf\n\ts_nop 0\n\t" \
    "v_add_f32_dpp %0, %0, %0 row_ror:4 row_mask:0xf bank_mask:0xf\n\tv_add_f32_dpp %1, %1, %1 row_ror:4 row_mask:0xf bank_mask:0xf\n\ts_nop 0\n\t" \
    "v_add_f32_dpp %0, %0, %0 row_ror:2 row_mask:0xf bank_mask:0xf\n\tv_add_f32_dpp %1, %1, %1 row_ror:2 row_mask:0xf bank_mask:0xf\n\ts_nop 0\n\t" \
    "v_add_f32_dpp %0, %0, %0 row_ror:1 row_mask:0xf bank_mask:0xf\n\tv_add_f32_dpp %1, %1, %1 row_ror:1 row_mask:0xf bank_mask:0xf\n\ts_nop 1" : "+v"(a_), "+v"(b_))
            f32x4 nw4 = *(const LAS f32x4*)(base + li4), nd4 = *(const LAS f32x4*)(base + 64 + li4), nb4 = *(const LAS f32x4*)(base + 128 + li4), nn4 = *(const LAS f32x4*)(base + 192 + li4), nr4 = *(const LAS f32x4*)(base + 256 + li4);
            f32x2 nv2 = *(const LAS f32x2*)(base + 320 + vrow);
#pragma unroll 4
            for (int s = 0; s < 32; ++s) {
                const f32x4 w4 = nw4, d4 = nd4, b4 = nb4, n4 = nn4, r4 = nr4; const f32x2 v2 = nv2;
                { const LAS float* p = base + (s < 31 ? s + 1 : s) * stp;
                  nw4 = *(const LAS f32x4*)(p + li4); nd4 = *(const LAS f32x4*)(p + 64 + li4); nb4 = *(const LAS f32x4*)(p + 128 + li4); nn4 = *(const LAS f32x4*)(p + 192 + li4); nr4 = *(const LAS f32x4*)(p + 256 + li4);
                  nv2 = *(const LAS f32x2*)(p + 320 + vrow); }
                f32x2 pk = S2[0] * n4[0]; pk = S2[1] * n4[1] + pk; pk = S2[2] * n4[2] + pk; pk = S2[3] * n4[3] + pk;
                SUM2_ROW16(pk.x, pk.y); const f32x2 nsk = -pk;
#pragma unroll
                for (int qq = 0; qq < 4; ++qq) S2[qq] = S2[qq] * w4[qq] + (v2 * d4[qq] + nsk * b4[qq]);
                f32x2 yk = S2[0] * r4[0]; yk = S2[1] * r4[1] + yk; yk = S2[2] * r4[2] + yk; yk = S2[3] * r4[3] + yk;
                SUM2_ROW16(yk.x, yk.y);
                if ((lane & 15) == 0) *(LAS f32x2*)(yb + s * ystp) = yk;
            }
#undef SUM2_ROW16
            if (q + 1 < 136) SCAN_WRITE(bi ^ 1);
            __syncthreads();
            if (tid < 256) { const LAS float* ys = L + YB0 + bi * YBUF + lrow * 64 + lpart * 8; float t[8];
                const f32x4 y0 = *(const LAS f32x4*)ys, y1 = *(const LAS f32x4*)(ys + 4);
#pragma unroll
                for (int e = 0; e < 4; ++e) { t[e] = y0[e]; t[4 + e] = y1[e]; }
                *(u32x4*)(YS + doff + ((size_t)SCAN_M0(q) + lrow) * D + hc + lpart * 8) = pack8(t); }
        }
        __syncthreads();
#undef SCAN_M0
#undef SCAN_LOAD
#undef SCAN_WRITE
#undef SCAN_ST8
    }
}

__device__ __forceinline__ void outprep_phase(const Frame F, KArgs* a, int jr) {
    const int lane_ = lane_opaque(), tid_ = F.wave * 64 + lane_; (void)tid_; (void)lane_;
    const bf16_t* YS = (const bf16_t*)(a->ws + WS_YS); const bf16_t* AA = (const bf16_t*)(a->ws + WS_AA); const bf16_t* KR = (const bf16_t*)(a->ws + WS_KK_);
    const bf16_t* RR = (const bf16_t*)(a->ws + WS_RR); const bf16_t* VV = (const bf16_t*)(a->ws + WS_VV); const bf16_t* GG = (const bf16_t*)(a->ws + WS_GG);
    bf16_t* PREP = (bf16_t*)(a->ws + WS_PREP);
    const float* lw = a->in[28] + (size_t)jr * D; const float* lb = a->in[29] + (size_t)jr * D; const float* rk = a->in[27] + (size_t)jr * D; const float* kav = a->in[26] + (size_t)jr * D;
    for (int m = F.bid * NWAVES + F.wave; m < M; m += F.G * NWAVES) {
#pragma unroll
        for (int q = 0; q < 4; ++q) { const int e0 = 512 * q + 8 * lane_; const size_t ro = (size_t)m * D + e0;
            float y0[8], y1[8], o[8];
            unpack8(*(const u32x4*)(YS + ro), y0); unpack8(*(const u32x4*)(YS + (size_t)M * D + ro), y1);
            float sm = 0.f;
#pragma unroll
            for (int i = 0; i < 8; ++i) { o[i] = y0[i] + y1[i]; sm += o[i]; }
            const float mean = sum8(sm) * (1.0f / 64.0f);
            float sq = 0.f;
#pragma unroll
            for (int i = 0; i < 8; ++i) { o[i] -= mean; sq += o[i] * o[i]; }
            const float rs = rsqrtf(sum8(sq) * (1.0f / 64.0f) + 64e-5f);
            float r[8], k0[8], k1[8], kr[8], v[8], g[8];
            unpack8(*(const u32x4*)(RR + ro), r); unpack8(*(const u32x4*)(AA + ro), k0); unpack8(*(const u32x4*)(AA + (size_t)M * D + ro), k1); unpack8(*(const u32x4*)(KR + ro), kr);
            unpack8(*(const u32x4*)(VV + ro), v); unpack8(*(const u32x4*)(GG + ro), g);
            float bs = 0.f;
#pragma unroll
            for (int i = 0; i < 8; ++i) bs += r[i] * (kr[i] * (2.0f + (k0[i] + k1[i] - 2.0f) * kav[e0 + i])) * rk[e0 + i];
            bs = sum8(bs);
            float out[8];
#pragma unroll
            for (int i = 0; i < 8; ++i) out[i] = (o[i] * rs * lw[e0 + i] + lb[e0 + i] + bs * v[i]) * g[i];
            *(u32x4*)(PREP + ro) = pack8(out); }
    }
}

__device__ __forceinline__ void attention_phase(const Frame F, KArgs* a) {
    const attn::bf16* Q = (const attn::bf16*)(a->ws + WS_Q); const attn::bf16* K = (const attn::bf16*)(a->ws + WS_K); const attn::bf16* V = (const attn::bf16*)(a->ws + WS_V);
    attn::bf16* O = (attn::bf16*)(a->ws + WS_O);
    for (int u = F.bid; u < 1024 + 64; u += F.G) {
        size_t qoff, koff; int seq;
        if (u < 1024) { const int c = u & 255, i = u >> 8, grp = (c & 7) >> 1, member = (c & 1) * 32 + (c >> 3), bk = i * 4 + grp, b = bk >> 2, kvh = bk & 3, hq = kvh * 4 + (member >> 4), qb = member & 15;
            qoff = (size_t)(b * TB + CTXL + qb * 256) * 2048 + hq * 128; koff = (size_t)b * TB * 512 + kvh * 128; seq = TB; }
        else { const int cu = u - 1024, b = cu >> 4, hq = cu & 15, kvh = hq >> 2;
            qoff = (size_t)(b * TB) * 2048 + hq * 128; koff = (size_t)b * TB * 512 + kvh * 128; seq = CTXL; }
        attn::attn_dense_body<attn::bf16>(Q + qoff, K + koff, V + koff, O + qoff, seq, (char*)F.ldsg, F.wave);
        __syncthreads();
    }
}

#ifndef EN_P0
#define EN_P0 1
#endif
#ifndef EN_THIN
#define EN_THIN 1
#endif
#ifndef EN_QKN
#define EN_QKN 1
#endif
#ifndef EN_ATT
#define EN_ATT 1
#endif
#ifndef EN_MIX
#define EN_MIX 1
#endif
#ifndef EN_SCAN
#define EN_SCAN 1
#endif
#ifndef EN_OPREP
#define EN_OPREP 1
#endif
#ifndef EN_FFN
#define EN_FFN 1
#endif
#ifndef EN_GQKV
#define EN_GQKV 1
#endif
#ifndef EN_GWO
#define EN_GWO 1
#endif
#ifndef EN_RW1
#define EN_RW1 1
#endif
#ifndef EN_RW2
#define EN_RW2 1
#endif
__device__ __forceinline__ KArgs* opaque_k(KArgs* p) { asm volatile("" : "+s"(p)); return p; }
#ifndef DBG_STOP
#define DBG_STOP -1
#endif
__device__ __forceinline__ Frame fresh(const Frame& F) { Frame R = F; asm volatile("" : "+s"(R.bid), "+s"(R.G), "+s"(R.wave)); return R; }
#ifndef GEMM_ALIGN
#define GEMM_ALIGN true
#define GEMM_SP2 true
#endif
#ifndef RW2_ALIGN
#define RW2_ALIGN true
#define RW2_SP2 true
#endif
#ifndef RW1_ALIGN
#define RW1_ALIGN true
#define RW1_SP2 true
#endif
#ifndef REP_THIN
#define REP_THIN 1
#endif
#ifndef REP_OG
#define REP_OG 1
#endif
#ifndef REP_EW
#define REP_EW 1
#endif
#ifndef REP_FFN1
#define REP_FFN1 1
#endif
#ifndef REP_FFN2
#define REP_FFN2 1
#endif
#ifndef REP_P0
#define REP_P0 1
#endif
#ifndef REP_SCAN
#define REP_SCAN 1
#endif
#ifndef REP_ATT
#define REP_ATT 1
#endif
#ifndef REP_RW1
#define REP_RW1 1
#endif
constexpr int NPHASE = 50;
constexpr int STOP_PHASE = (DBG_STOP >= 0) ? DBG_STOP : NPHASE - 1;
__global__ void __launch_bounds__(NTHR, 2) fwd_kernel(Args args) {
    extern __shared__ __attribute__((aligned(16))) unsigned char lds[];
    Frame F;
    F.lds = (LAS unsigned char*)lds; F.ldsg = lds;
    F.wave = __builtin_amdgcn_readfirstlane((int)threadIdx.x >> 6);
    F.G = gridDim.x; F.bid = blockIdx.x;
    for (int u = threadIdx.x; u < (LDS_BYTES - LDSCTL_OFF) / 4; u += NTHR) ((LAS unsigned*)(F.lds + LDSCTL_OFF))[u] = 0u;
    __syncthreads();
    KArgs* const kap = (KArgs*)__builtin_amdgcn_kernarg_segment_ptr();
    XcdBarrier bar = xcd_barrier_post((unsigned*)(kap->ws + WS_CTL) + CW_BAR + kap->li * XCD_BAR_WORDS, (volatile LAS unsigned*)(F.lds + MISC_OFF) + 8);
#define KA (opaque_k(kap))
#define ws (KA->ws)
#define IN(k) ((k) <= STOP_PHASE)
#define SEAM(k) do { if (IN(k) && IN((k) + 1)) { XcdBarrier bb_ = bar; asm volatile("" : "+s"(bb_.x), "+s"(bb_.bar)); xcd_barrier(bb_, fresh(F).wave == 0 && lane_opaque() == 0); } } while (0)
#define Yb ((bf16_t*)(ws + WS_Y))
#define ACTb ((bf16_t*)(ws + WS_ACT))
#define OUTb ((bf16_t*)(ws + WS_OUT))
#define BAR_NOW() do { XcdBarrier bb_ = bar; asm volatile("" : "+s"(bb_.x), "+s"(bb_.bar)); xcd_barrier(bb_, fresh(F).wave == 0 && lane_opaque() == 0); } while (0)
#define FFN_HALF(pk, lh, FINAL, tl, ts, tw, tnl, tns) do { \
    for (int rep_ = 0; rep_ < REP_FFN1; ++rep_) { if (rep_) __syncthreads(); \
    if (EN_FFN && IN(pk)) { const Frame Ff_ = fresh(F); const bf16_t* w1_ = (const bf16_t*)(ws + WS_WB) + (size_t)(lh) * (E_F1 + E_F2); \
        pg8::Gemm g_{Yb, w1_, D}; EpiSwiGLU E_{ACTb}; \
        if (FINAL) { LatentOrder S_; S_.init_lat(2 * FF, Ff_.G, Ff_.bid); pg8::gemm_phase<EpiSwiGLU, LatentOrder, pg8::Gemm, GEMM_ALIGN, GEMM_SP2>(Ff_.lds, g_, S_, E_, Ff_.wave); } \
        else { pg8::StaticOrder S_; S_.init(M, 2 * FF, Ff_.G, Ff_.bid); pg8::gemm_phase<EpiSwiGLU, pg8::StaticOrder, pg8::Gemm, GEMM_ALIGN, GEMM_SP2>(Ff_.lds, g_, S_, E_, Ff_.wave); } } } \
    SEAM(pk); \
    for (int rep_ = 0; rep_ < REP_FFN2; ++rep_) { if (rep_) __syncthreads(); \
    if (EN_FFN && IN((pk) + 1)) { const Frame Ff_ = fresh(F); const bf16_t* w2_ = (const bf16_t*)(ws + WS_WB) + (size_t)(lh) * (E_F1 + E_F2) + E_F1; \
        pg8::Gemm g_{ACTb, w2_, FF}; LatentOrder S_; S_.init_lat(D, Ff_.G, Ff_.bid); EpiPlain E_{OUTb, D}; \
        pg8::gemm_phase<EpiPlain, LatentOrder, pg8::Gemm, GEMM_ALIGN, GEMM_SP2>(Ff_.lds, g_, S_, E_, Ff_.wave); } } \
    SEAM((pk) + 1); \
    if (IN((pk) + 2)) { const Frame Ff_ = fresh(F); \
        if (Ff_.bid < NCTXWG) { if (!(FINAL)) { const bf16_t* w2_ = (const bf16_t*)(ws + WS_WB) + (size_t)(lh) * (E_F1 + E_F2) + E_F1; \
            GemmCtxSplit g_{ACTb, w2_, FF}; CtxOrder2 S_{Ff_.bid}; EpiCtxPart E_{(float*)(ws + WS_PART)}; \
            pg8::gemm_phase<EpiCtxPart, CtxOrder2, GemmCtxSplit, GEMM_ALIGN, GEMM_SP2>(Ff_.lds, g_, S_, E_, Ff_.wave); } } \
        else { for (int rt_ = 1; rt_ < REP_THIN; ++rt_) { if (!(FINAL)) thin_phase<1, 1>(Ff_, KA, tl, ts, 0.f, tnl, tns); } if (FINAL) thin_phase<2, 1>(Ff_, KA, tl, ts, tw, tnl, tns); else thin_phase<1, 1>(Ff_, KA, tl, ts, tw, tnl, tns); } \
        if (!(FINAL)) { BAR_NOW(); thin_phase<1, 2>(fresh(F), KA, tl, ts, tw, tnl, tns); } } \
    SEAM((pk) + 2); } while (0)

    for (int rep_ = 0; rep_ < REP_P0; ++rep_) { if (rep_) __syncthreads(); if (EN_P0 && IN(0)) p0a_phase(fresh(F), KA); }
    SEAM(0);
    if (EN_THIN && IN(1)) thin_phase<0, 0>(fresh(F), KA, 0, 0, 0.f, 0, 0);
    SEAM(1);
    for (int lp = 0; lp < 2; ++lp) {
        const int pb = 2 + 24 * lp, la = 2 * lp, lr = 2 * lp + 1;
        FFN_HALF(pb + 0, la * 2 + 0, 0, la, 0, 0.5f, la, 1);
        for (int rep_ = 0; rep_ < REP_OG; ++rep_) { if (rep_) __syncthreads();
        if (EN_GQKV && IN(pb + 3)) { const Frame Ff = fresh(F); const bf16_t* wq = (const bf16_t*)(ws + WS_WA) + (size_t)lp * (E_QKV + E_SQ);
            pg8::Gemm g{Yb, wq, D}; pg8::StaticOrder S; S.init(M, 3072, Ff.G, Ff.bid); EpiQKV E{ws};
            pg8::gemm_phase<EpiQKV, pg8::StaticOrder, pg8::Gemm, GEMM_ALIGN, GEMM_SP2>(Ff.lds, g, S, E, Ff.wave); } }
        SEAM(pb + 3);
        if (EN_QKN && IN(pb + 4)) qknorm_phase(fresh(F), KA, lp);
        SEAM(pb + 4);
        for (int rep_ = 0; rep_ < REP_ATT; ++rep_) { if (rep_) __syncthreads(); if (EN_ATT && IN(pb + 5)) attention_phase(fresh(F), KA); }
        SEAM(pb + 5);
        for (int rep_ = 0; rep_ < REP_OG; ++rep_) { if (rep_) __syncthreads();
        if (EN_GWO && IN(pb + 6)) { const Frame Ff = fresh(F); const bf16_t* wo = (const bf16_t*)(ws + WS_WA) + (size_t)lp * (E_QKV + E_SQ) + E_QKV;
            pg8::Gemm g{(const bf16_t*)(ws + WS_O), wo, D}; pg8::StaticOrder S; S.init(M, D, Ff.G, Ff.bid); EpiPlain E{OUTb, D};
            pg8::gemm_phase<EpiPlain, pg8::StaticOrder, pg8::Gemm, GEMM_ALIGN, GEMM_SP2>(Ff.lds, g, S, E, Ff.wave); } }
        SEAM(pb + 6);
        if (EN_THIN && IN(pb + 7)) thin_phase<1, 0>(fresh(F), KA, la, 1, 1.0f, la, 2);
        SEAM(pb + 7);
        FFN_HALF(pb + 8, la * 2 + 1, 0, la, 2, 0.5f, lr, 0);
        FFN_HALF(pb + 11, lr * 2 + 0, 0, lr, 0, 0.5f, lr, 1);
        for (int rep_ = 0; rep_ < REP_EW; ++rep_) { if (EN_MIX && IN(pb + 14)) mixes_phase(fresh(F), KA, lp); }
        SEAM(pb + 14);
#ifdef DBG_DOUBLE_BAR
        SEAM(pb + 14);
#endif
#define rw1 ((const bf16_t*)(ws + WS_WR) + (size_t)lp * (E_RW1 + E_RW2 + E_SQ))
        for (int rep_ = 0; rep_ < REP_OG; ++rep_) { if (rep_) __syncthreads();
        if (EN_RW1 && IN(pb + 15)) { const Frame Ff = fresh(F); GemmRw1 g{(const bf16_t*)(ws + WS_MIX6), rw1, D}; pg8::StaticOrder S; S.init(M, 6912, Ff.G, Ff.bid);
            EpiRw1 E{ws, KA->in[25] + (size_t)lp * D};
            pg8::gemm_phase<EpiRw1, pg8::StaticOrder, GemmRw1, RW1_ALIGN, RW1_SP2>(Ff.lds, g, S, E, Ff.wave); } }
        SEAM(pb + 15);
        for (int rep_ = 0; rep_ < REP_OG; ++rep_) { if (rep_) __syncthreads();
        if (EN_RW2 && IN(pb + 16)) { const Frame Ff = fresh(F); int k2_ = 256; asm volatile("" : "+s"(k2_));     GemmRw2 g{ws, rw1 + E_RW1, k2_}; pg8::StaticOrder S; S.init(M, 10240, Ff.G, Ff.bid);
            EpiRw2 E{ws,
                     KA->in[19] + (size_t)lp * 2 * D, KA->in[22] + (size_t)lp * 2 * D, WS_AA};
            pg8::gemm_phase<EpiRw2, pg8::StaticOrder, GemmRw2, RW2_ALIGN, RW2_SP2>(Ff.lds, g, S, E, Ff.wave); } }
        #ifdef DBG_RW2_TWICE
        __syncthreads();
        if (EN_RW2 && IN(pb + 16)) { const Frame Ff = fresh(F); int k2_ = 256; asm volatile("" : "+s"(k2_));     GemmRw2 g{ws, rw1 + E_RW1, k2_}; pg8::StaticOrder S; S.init(M, 10240, Ff.G, Ff.bid);
            EpiRw2 E{ws,
                     KA->in[19] + (size_t)lp * 2 * D, KA->in[22] + (size_t)lp * 2 * D, WS_END};
            pg8::gemm_phase<EpiRw2, pg8::StaticOrder, GemmRw2, RW2_ALIGN, RW2_SP2>(Ff.lds, g, S, E, Ff.wave); }
#endif
        SEAM(pb + 16);
        for (int rep_ = 0; rep_ < REP_SCAN; ++rep_) { if (rep_) __syncthreads(); if (EN_SCAN && IN(pb + 17)) scan_phase(fresh(F), KA, lp); }
        SEAM(pb + 17);
        for (int rep_ = 0; rep_ < REP_EW; ++rep_) { if (EN_OPREP && IN(pb + 18)) outprep_phase(fresh(F), KA, lp); }
        SEAM(pb + 18);
        for (int rep_ = 0; rep_ < REP_OG; ++rep_) { if (rep_) __syncthreads();
        if (EN_GWO && IN(pb + 19)) { const Frame Ff = fresh(F); pg8::Gemm g{(const bf16_t*)(ws + WS_PREP), rw1 + E_RW1 + E_RW2, D}; pg8::StaticOrder S; S.init(M, D, Ff.G, Ff.bid); EpiPlain E{OUTb, D};
            pg8::gemm_phase<EpiPlain, pg8::StaticOrder, pg8::Gemm, GEMM_ALIGN, GEMM_SP2>(Ff.lds, g, S, E, Ff.wave); } }
        SEAM(pb + 19);
        if (EN_THIN && IN(pb + 20)) thin_phase<1, 0>(fresh(F), KA, lr, 1, 1.0f, lr, 2);
        SEAM(pb + 20);
        if (lp == 1) FFN_HALF(pb + 21, lr * 2 + 1, 1, lr, 2, 0.5f, 0, 0); else FFN_HALF(pb + 21, lr * 2 + 1, 0, lr, 2, 0.5f, lr + 1, 0);
    }
    if (DBG_STOP >= 0) { xcd_barrier(bar, fresh(F).wave == 0 && lane_opaque() == 0); copyout_phase(fresh(F), KA); }
#undef IN
#undef SEAM
#undef FFN_HALF
#undef BAR_NOW
#undef rw1
#undef ws
#undef KA
#undef Yb
#undef ACTb
#undef OUTb
}

extern "C" void kernel_launch(void* const* d_in, const int* in_sizes, int n_in, void* d_out, int out_size, void* d_ws, size_t ws_size, hipStream_t stream) {
    static int grid = 0;
    if (grid == 0) {
        if (n_in != 30 || in_sizes[0] != NB * SEQ * D || out_size != NB * SEQ * D || ws_size < WS_END) {
            fprintf(stderr, "kernel_launch: shape mismatch: n_in %d in0 %d out %d ws %zu (need >= %zu)\n", n_in, n_in > 0 ? in_sizes[0] : -1, out_size, ws_size, (size_t)WS_END); grid = -1; return; }
        int dev = 0, cus = 0, per_cu = 0;
        if (hipGetDevice(&dev) != hipSuccess || hipDeviceGetAttribute(&cus, hipDeviceAttributeMultiprocessorCount, dev) != hipSuccess) { fprintf(stderr, "kernel_launch: device query failed\n"); grid = -1; return; }
        if (hipFuncSetAttribute((const void*)fwd_kernel, hipFuncAttributeMaxDynamicSharedMemorySize, LDS_BYTES) != hipSuccess) { fprintf(stderr, "kernel_launch: hipFuncSetAttribute failed\n"); grid = -1; return; }
        if (hipOccupancyMaxActiveBlocksPerMultiprocessor(&per_cu, (const void*)fwd_kernel, NTHR, LDS_BYTES) != hipSuccess || per_cu < 1) { fprintf(stderr, "kernel_launch: occupancy query says %d blocks per CU\n", per_cu); }
        (void)hipGetLastError();
        grid = cus;
        if (grid > 256) grid = 256;
    }
    if (grid < 0) return;
    if (hipMemsetAsync((char*)d_ws + WS_CTL, 0, CTL_ZERO_BYTES, stream) != hipSuccess) { fprintf(stderr, "kernel_launch: memset failed\n"); return; }
    Args a{};
    for (int i = 0; i < 30; ++i) a.in[i] = (const float*)d_in[i];
    a.out = (float*)d_out; a.ws = (unsigned char*)d_ws;
    a.ph_lo = 0; a.ph_hi = NPHASE; a.li = 0; a.dbg = 0;
    hipLaunchKernelGGL(fwd_kernel, dim3(grid), dim3(NTHR), LDS_BYTES, stream, a);
    const hipError_t le = hipPeekAtLastError();
    if (le != hipSuccess) fprintf(stderr, "kernel_launch: launch failed: %s\n", hipGetErrorName(le));
}
```

```cpp
#include <hip/hip_runtime.h>
#include <cstdio>
#include <cstdint>
#include <cmath>
__device__ __forceinline__ int lane_opaque() { int l; asm volatile("v_mbcnt_lo_u32_b32 %0, -1, 0\n\tv_mbcnt_hi_u32_b32 %0, -1, %0" : "=v"(l)); return l; }
namespace pg8 {
#define PG8_LAS __attribute__((address_space(3)))
typedef unsigned short bf16_t;
typedef short bf16x8 __attribute__((ext_vector_type(8)));
typedef float f32x4 __attribute__((ext_vector_type(4)));
typedef unsigned u32x4 __attribute__((ext_vector_type(4)));
constexpr int BM = 256, BK = 64, HALF = 128, HTB = HALF * BK * 2  , STAGE_BYTES = 8 * HTB, NXCD = 8, WGM = 8;

__host__ __device__ __forceinline__ int lds_byte(int r, int c) { const int st = (r >> 4) * 2 + (c >> 5), rr = r & 15, cc = c & 31, ob = rr * 64 + cc * 2; return st * 1024 + (ob ^ (((ob >> 9) & 1) << 5)); }
__host__ __device__ __forceinline__ void stage_rc(int b, int& R, int& C) { const int st = b / 1024, sb = b % 1024, swz = sb ^ (((sb >> 9) & 1) << 5); R = (st >> 1) * 16 + swz / 64; C = (st & 1) * 32 + (swz % 64) / 2; }
__host__ __device__ __forceinline__ int perm32(int rho) { const int n = rho >> 4, i = rho & 15; return 8 * (i >> 2) + 4 * n + (i & 3); }

struct Unit { int pm, pn; };
struct Gemm { const bf16_t* A; const bf16_t* Bt; int K;
    __device__ __forceinline__ const char* a_tile(const Unit& u) const { return (const char*)A + (size_t)u.pm * (size_t)(BM * 2) * K; }
    __device__ __forceinline__ const char* b_tile(const Unit& u) const { return (const char*)Bt + (size_t)u.pn * (size_t)(BM * 2) * K; }
    __device__ __forceinline__ int klen() const { return K; } };

struct StaticOrder {
    int nM, nN, nwg, G, c;
    __host__ __device__ void init(int M, int N, int G_, int c_) { nM = M / BM; nN = N / BM; nwg = nM * nN; G = G_; c = c_; }
    __host__ __device__ bool next(int i, Unit& u) const {
        const long L = (long)i * G + c; if (L >= nwg) return false;
        int wgid = (int)L; { const int q = nwg / NXCD, r = nwg % NXCD, xcd = wgid % NXCD, off = wgid / NXCD; wgid = (xcd < r ? xcd * (q + 1) : r * (q + 1) + (xcd - r) * q) + off; }
        const int nig = WGM * nN, gid = wgid / nig, fm = gid * WGM, gsz = (nM - fm) < WGM ? (nM - fm) : WGM;
        u.pm = fm + ((wgid % nig) % gsz); u.pn = (wgid % nig) / gsz; return true;
    }
    __device__ __forceinline__ void a_ready(const Unit&) const {}
    __device__ __forceinline__ void done(const Unit&) const {}
};

typedef __bf16 bf16x2_cv __attribute__((ext_vector_type(2)));
typedef float f32x2_cv __attribute__((ext_vector_type(2)));
__device__ __forceinline__ unsigned cvt_pk_bf16(float lo, float hi) { const f32x2_cv v = {lo, hi}; const bf16x2_cv b = __builtin_convertvector(v, bf16x2_cv); return __builtin_bit_cast(unsigned, b); }

template <class Epi, class Sched, class GT, bool ALIGN_EPI = false, bool SP2 = false>
__device__ __forceinline__ void gemm_phase(PG8_LAS unsigned char* lds, const GT g, const Sched& S, const Epi& E, const int wid  ) {
    const int lane = lane_opaque(), tid = wid * 64 + lane, wr = wid >> 2, wc = wid & 3, fr = lane & 15, fq = lane >> 4;
    const int K = g.K, nt = g.klen() / BK;
    unsigned voffA[2], voffB[2];
#pragma unroll
    for (int i = 0; i < 2; ++i) { int R, C; stage_rc(tid * 16 + i * 8192, R, C); const int Rb = Epi::PERM ? ((R & ~31) + perm32(R & 31)) : R;
        voffA[i] = (unsigned)(R * K + C) * 2u; voffB[i] = (unsigned)(Rb * K + C) * 2u; }
    asm volatile("" : "+v"(voffA[0]), "+v"(voffA[1]), "+v"(voffB[0]), "+v"(voffB[1]));
    const size_t kstep = (size_t)(BK * 2);
    const size_t hstep = (size_t)HALF * K * 2;
    const unsigned ldsw = (unsigned)wid * 1024u;
    const int aoff = lds_byte(wr * 64 + fr, fq * 8), boff = lds_byte(wc * 32 + fr, fq * 8);
#define PG8_SA(b, h) (((b) * 2 + (h)) * HTB)
#define PG8_SB(b, h) ((4 + (b) * 2 + (h)) * HTB)
#define PG8_STAGE(bufoff, gbase, voff) do { _Pragma("unroll") for (int _i = 0; _i < 2; ++_i) \
        __builtin_amdgcn_global_load_lds((const unsigned*)((const char*)(gbase) + (voff)[_i]), (PG8_LAS unsigned*)(lds + (bufoff) + ldsw + _i * 8192), 16, 0, 0); } while (0)
#define PG8_LDA(dst, b, h) do { _Pragma("unroll") for (int m = 0; m < 4; ++m) _Pragma("unroll") for (int k = 0; k < 2; ++k) dst[m][k] = *(const PG8_LAS bf16x8*)(lds + PG8_SA(b, h) + aoff + m * 2048 + k * 1024); } while (0)
#define PG8_LDB(dst, b, h) do { _Pragma("unroll") for (int n = 0; n < 2; ++n) _Pragma("unroll") for (int k = 0; k < 2; ++k) dst[n][k] = *(const PG8_LAS bf16x8*)(lds + PG8_SB(b, h) + boff + n * 2048 + k * 1024); } while (0)
#define PG8_MMA(ai, bj, At, Bt) do { __builtin_amdgcn_s_setprio(1); _Pragma("unroll") for (int m = 0; m < 4; ++m) _Pragma("unroll") for (int n = 0; n < 2; ++n) _Pragma("unroll") for (int k = 0; k < 2; ++k) \
        acc[ai][bj][m][n] = __builtin_amdgcn_mfma_f32_16x16x32_bf16(Bt[n][k], At[m][k], acc[ai][bj][m][n], 0, 0, 0); __builtin_amdgcn_s_setprio(0); } while (0)
#define PG8_WAIT_V(n) asm volatile("s_waitcnt vmcnt(" #n ")" ::: "memory")
#define PG8_WAIT_L(n) asm volatile("s_waitcnt lgkmcnt(" #n ")" ::: "memory")
#define PG8_BAR __builtin_amdgcn_s_barrier()
#define PG8_SCHED __builtin_amdgcn_sched_barrier(0)
    Unit cur, nxt; int ui = 0;
    if (!S.next(0, cur)) return;
    f32x4 acc[2][2][4][2];
#pragma unroll
    for (int a = 0; a < 2; ++a)
#pragma unroll
        for (int b = 0; b < 2; ++b)
#pragma unroll
            for (int m = 0; m < 4; ++m)
#pragma unroll
                for (int n = 0; n < 2; ++n) acc[a][b][m][n] = (f32x4){0.f, 0.f, 0.f, 0.f};
    bf16x8 At[4][2], B0[2][2], B1[2][2];
    const char* cA = g.a_tile(cur); const char* cB = g.b_tile(cur);
    S.a_ready(cur);
    if constexpr (SP2) {
        PG8_STAGE(PG8_SB(0, 0), cB, voffB); PG8_STAGE(PG8_SB(0, 1), cB + hstep, voffB); PG8_STAGE(PG8_SA(0, 0), cA, voffA); PG8_STAGE(PG8_SA(0, 1), cA + hstep, voffA);
        if (wr == 1) PG8_BAR;
        PG8_WAIT_V(2); PG8_BAR;
        PG8_STAGE(PG8_SB(1, 0), cB + kstep, voffB); PG8_STAGE(PG8_SA(1, 0), cA + kstep, voffA); PG8_STAGE(PG8_SB(1, 1), cB + hstep + kstep, voffB);
        PG8_WAIT_V(6); PG8_BAR;
    } else {
        PG8_STAGE(PG8_SB(0, 0), cB, voffB); PG8_STAGE(PG8_SA(0, 0), cA, voffA); PG8_STAGE(PG8_SB(0, 1), cB + hstep, voffB); PG8_STAGE(PG8_SA(0, 1), cA + hstep, voffA);
        if (wr == 1) PG8_BAR;
        PG8_WAIT_V(4); PG8_BAR;
        PG8_STAGE(PG8_SB(1, 0), cB + kstep, voffB); PG8_STAGE(PG8_SA(1, 0), cA + kstep, voffA); PG8_STAGE(PG8_SB(1, 1), cB + hstep + kstep, voffB);
        PG8_WAIT_V(6); PG8_BAR;
    }
    for (;;) {
        const bool has_next = S.next(ui + 1, nxt);
        const char* nA = has_next ? g.a_tile(nxt) : cA; const char* nB = has_next ? g.b_tile(nxt) : cB;
        for (int t = 0; t < nt; t += 2) {
            const bool last = (t == nt - 2);
            const char* a1 = cA + (size_t)(t + 1) * kstep;
            const char* a2 = last ? nA : cA + (size_t)(t + 2) * kstep; const char* b2 = last ? nB : cB + (size_t)(t + 2) * kstep;
            const char* a3 = a2 + kstep; const char* b3 = b2 + kstep;
            if (last && has_next) S.a_ready(nxt);
            if constexpr (SP2) {
            PG8_LDB(B0, 0, 0); PG8_LDB(B1, 0, 1); PG8_SCHED; PG8_LDA(At, 0, 0); PG8_STAGE(PG8_SA(1, 1), a1 + hstep, voffA);
            PG8_WAIT_V(8); PG8_WAIT_L(0); PG8_BAR; PG8_MMA(0, 0, At, B0); PG8_MMA(0, 1, At, B1); PG8_BAR; PG8_SCHED;
            PG8_LDA(At, 0, 1); PG8_STAGE(PG8_SB(0, 0), b2, voffB); PG8_STAGE(PG8_SB(0, 1), b2 + hstep, voffB); PG8_STAGE(PG8_SA(0, 0), a2, voffA);
            PG8_WAIT_V(8); PG8_WAIT_L(0); PG8_BAR; PG8_MMA(1, 0, At, B0); PG8_MMA(1, 1, At, B1); PG8_BAR; PG8_SCHED;
            PG8_LDB(B0, 1, 0); PG8_LDB(B1, 1, 1); PG8_SCHED; PG8_LDA(At, 1, 0); PG8_STAGE(PG8_SA(0, 1), a2 + hstep, voffA);
            PG8_WAIT_V(8); PG8_WAIT_L(0); PG8_BAR; PG8_MMA(0, 0, At, B0); PG8_MMA(0, 1, At, B1); PG8_BAR; PG8_SCHED;
            PG8_LDA(At, 1, 1); PG8_STAGE(PG8_SB(1, 0), b3, voffB); PG8_STAGE(PG8_SB(1, 1), b3 + hstep, voffB); PG8_STAGE(PG8_SA(1, 0), a3, voffA);
            PG8_WAIT_V(8); PG8_WAIT_L(0); PG8_BAR; PG8_MMA(1, 0, At, B0); PG8_MMA(1, 1, At, B1); PG8_BAR; PG8_SCHED;
            } else {
            PG8_LDB(B0, 0, 0); PG8_SCHED; PG8_LDA(At, 0, 0); PG8_STAGE(PG8_SA(1, 1), a1 + hstep, voffA);
            PG8_WAIT_L(8); PG8_BAR; PG8_WAIT_L(0); PG8_MMA(0, 0, At, B0); PG8_BAR; PG8_SCHED;
            PG8_LDB(B1, 0, 1); PG8_STAGE(PG8_SB(0, 0), b2, voffB);
            PG8_BAR; PG8_WAIT_L(0); PG8_MMA(0, 1, At, B1); PG8_BAR;
            PG8_LDA(At, 0, 1); PG8_STAGE(PG8_SA(0, 0), a2, voffA);
            PG8_BAR; PG8_WAIT_L(0); PG8_MMA(1, 0, At, B0); PG8_BAR; PG8_SCHED;
            PG8_STAGE(PG8_SB(0, 1), b2 + hstep, voffB);
            PG8_WAIT_V(6); PG8_BAR; PG8_MMA(1, 1, At, B1); PG8_BAR;
            PG8_LDB(B0, 1, 0); PG8_SCHED; PG8_LDA(At, 1, 0); PG8_STAGE(PG8_SA(0, 1), a2 + hstep, voffA);
            PG8_WAIT_L(8); PG8_BAR; PG8_WAIT_L(0); PG8_MMA(0, 0, At, B0); PG8_BAR; PG8_SCHED;
            PG8_LDB(B1, 1, 1); PG8_STAGE(PG8_SB(1, 0), b3, voffB);
            PG8_BAR; PG8_WAIT_L(0); PG8_MMA(0, 1, At, B1); PG8_BAR;
            PG8_LDA(At, 1, 1); PG8_STAGE(PG8_SA(1, 0), a3, voffA);
            PG8_BAR; PG8_WAIT_L(0); PG8_MMA(1, 0, At, B0); PG8_BAR; PG8_SCHED;
            PG8_STAGE(PG8_SB(1, 1), b3 + hstep, voffB);
            PG8_WAIT_V(6); PG8_BAR; PG8_MMA(1, 1, At, B1); PG8_BAR;
            }
        }
        if constexpr (ALIGN_EPI) { if (wr == 0) PG8_BAR; }
        if constexpr (!Epi::AFTER_DRAIN) { E(acc, cur, wr, wc, fr, fq); S.done(cur); }
        if (!has_next) break;
#pragma unroll
        for (int a = 0; a < 2; ++a)
#pragma unroll
            for (int b = 0; b < 2; ++b)
#pragma unroll
                for (int m = 0; m < 4; ++m)
#pragma unroll
                    for (int n = 0; n < 2; ++n) acc[a][b][m][n] = (f32x4){0.f, 0.f, 0.f, 0.f};
        cur = nxt; cA = nA; cB = nB; ++ui;
        if constexpr (ALIGN_EPI) { if (wr == 1) PG8_BAR; }
    }
    PG8_WAIT_V(0);
    if constexpr (!ALIGN_EPI) { if (wr == 0) PG8_BAR; }
    PG8_BAR;
    if constexpr (Epi::AFTER_DRAIN) { E.fused(acc, cur, wr, wc, fr, fq, lds, wid, lane); S.done(cur); }
#undef PG8_SA
#undef PG8_SB
#undef PG8_STAGE
#undef PG8_LDA
#undef PG8_LDB
#undef PG8_MMA
#undef PG8_WAIT_V
#undef PG8_WAIT_L
#undef PG8_BAR
#undef PG8_SCHED
}
}

#define LAS __attribute__((address_space(3)))
#define XB_TMO      128
#define XB_XCNT(j)  (256  + 64 * (j))
#define XB_XSUB(j)  (1280 + 64 * (j))
#define XB_XGEN(j)  (2304 + 64 * (j))
#define XB_TOP      3328
#define XB_TOPGEN   3392
#define XCD_BAR_WORDS 3456
#define XB_SPIN_CAP (1u << 20)

__device__ __forceinline__ unsigned xb_ld(unsigned* p)              { return __hip_atomic_load(p, __ATOMIC_RELAXED, __HIP_MEMORY_SCOPE_AGENT); }
__device__ __forceinline__ unsigned xb_add(unsigned* p, unsigned v) { return __hip_atomic_fetch_add(p, v, __ATOMIC_RELAXED, __HIP_MEMORY_SCOPE_AGENT); }
__device__ __forceinline__ unsigned xb_xcc_id() { return (unsigned)__builtin_amdgcn_s_getreg((3 << 11) | 20) & 0xFu; }
#define XB_SPIN(cond, bar) do { unsigned _sp = 0; while (cond) { __builtin_amdgcn_s_sleep(1); \
    if ((++_sp & 255u) == 0u) { if (xb_ld(&(bar)[XB_TMO])) break; if (_sp > XB_SPIN_CAP) { atomicAdd(&(bar)[XB_TMO], 1u); break; } } } } while (0)

struct XcdBarrier {
    unsigned* bar; unsigned x;
    volatile LAS unsigned* st;
};

__device__ __forceinline__ XcdBarrier xcd_barrier_post(unsigned* bar, volatile LAS unsigned* st) {
    XcdBarrier b; b.bar = bar; b.x = xb_xcc_id(); b.st = st;
    if (threadIdx.x == 0) (void)xb_add(&bar[XB_XCNT(b.x)], 1u);
    return b;
}
__device__ __forceinline__ void xcd_barrier_complete(unsigned* bar, unsigned x, unsigned& nloc, unsigned& nx) {
    const unsigned G = gridDim.x * gridDim.y * gridDim.z;
    unsigned sum, cnt, mine, sp = 0u;
    for (;;) {
        sum = 0u; cnt = 0u; mine = 0u;
#pragma unroll
        for (unsigned j = 0; j < 16; ++j) { const unsigned c = xb_ld(&bar[XB_XCNT(j)]); sum += c; cnt += (c > 0u) ? 1u : 0u; mine = (j == x) ? c : mine; }
        if (sum == G) break;
        __builtin_amdgcn_s_sleep(1);
        if ((++sp & 255u) == 0u) { if (xb_ld(&bar[XB_TMO])) break; if (sp > XB_SPIN_CAP) { atomicAdd(&bar[XB_TMO], 1u); break; } }
    }
    nloc = mine > 0u ? mine : 1u; nx = cnt > 0u ? cnt : 1u;
}

__device__ __forceinline__ void xcd_barrier(const XcdBarrier& b, const bool tid0  ) {
    asm volatile("s_waitcnt vmcnt(0)" ::: "memory");
    __syncthreads();
    if (tid0) {
        unsigned* bar = b.bar;
        __builtin_amdgcn_s_waitcnt(0);
        unsigned nloc = b.st[0], nx = b.st[1];
        if (nloc == 0u) { xcd_barrier_complete(bar, b.x, nloc, nx); b.st[0] = nloc; b.st[1] = nx; }
        const unsigned old = xb_add(&bar[XB_XSUB(b.x)], 1u);
        const unsigned gen = old / nloc;
        if (old + 1u == (gen + 1u) * nloc) {
            __builtin_amdgcn_fence(__ATOMIC_RELEASE, "agent");
            asm volatile("s_waitcnt vmcnt(0)" ::: "memory");
            const unsigned og = xb_add(&bar[XB_TOP], 1u);
            const unsigned tg = og / nx;
            if (og + 1u == (tg + 1u) * nx) xb_add(&bar[XB_TOPGEN], 1u);
            else XB_SPIN(xb_ld(&bar[XB_TOPGEN]) == tg, bar);
            __builtin_amdgcn_fence(__ATOMIC_ACQUIRE, "agent");
            xb_add(&bar[XB_XGEN(b.x)], 1u);
            asm volatile("s_waitcnt vmcnt(0)" ::: "memory");
        } else {
            XB_SPIN(xb_ld(&bar[XB_XGEN(b.x)]) == gen, bar);
            __builtin_amdgcn_fence(__ATOMIC_ACQUIRE, "agent");
            asm volatile("s_waitcnt vmcnt(0)" ::: "memory");
        }
    }
    __syncthreads();
}

namespace attn {
using bf16 = unsigned short;
constexpr int   D = 128, NW = 8, QBLK = 32, KVBLK = 64;
constexpr float SCALE = 0.088388347648318440f;
constexpr float THR = 8.f;
constexpr int SDEPTH = 2;
constexpr int LDQ = 2048, LDK = 512, LDO = 2048;
constexpr size_t SHM_V = KVBLK * D * 2, SHM_K = KVBLK * D * 2, SHM_ATTN = 2 * SHM_V + 2 * SHM_K + NW * 64 * 4;
using bf16x8 = __attribute__((ext_vector_type(8))) short;
using s16x4  = __attribute__((ext_vector_type(4))) short;
using f32x16 = __attribute__((ext_vector_type(16))) float;
using f32x8  = __attribute__((ext_vector_type(8))) float;
using u32x4  = __attribute__((ext_vector_type(4))) unsigned;
#define KSWZ(row, colB) ((row) * 256 + ((colB) ^ (((row) & 7) << 4)))
#define SBAR() __builtin_amdgcn_sched_barrier(0)
__device__ __forceinline__ int crow(int r, int hi) { return (r & 3) + 8 * (r >> 2) + 4 * hi; }
__device__ __forceinline__ unsigned cvtpk(float lo, float hi) {
  return pg8::cvt_pk_bf16(lo, hi);
}
template <typename TIn> struct Stage;
__device__ __forceinline__ unsigned f2bf_(float f) { unsigned u = __builtin_bit_cast(unsigned, f); return (u + 0x7fffu + ((u >> 16) & 1u)) >> 16; }
template <> struct Stage<bf16>  { using T = bf16x8;
  __device__ static __forceinline__ T ld8(const bf16* p) { return *reinterpret_cast<const bf16x8*>(p); }
  __device__ static __forceinline__ bf16x8 tobf(T x) { return x; } };
template <> struct Stage<float> { using T = f32x8;
  __device__ static __forceinline__ T ld8(const float* p) { return *reinterpret_cast<const f32x8*>(p); }
  __device__ static __forceinline__ bf16x8 tobf(T x) {
    u32x4 w = {cvtpk(x[0], x[1]), cvtpk(x[2], x[3]), cvtpk(x[4], x[5]), cvtpk(x[6], x[7])}; return *reinterpret_cast<bf16x8*>(&w); } };

__device__ __forceinline__ void partialSM(f32x16& p0, f32x16& p1, float& m_reg, float& mn, float& alpha) {
  constexpr float C = SCALE * 1.4426950408889634f;
  float pmax = p0[0]; for (int r = 1; r < 16; ++r) pmax = fmaxf(pmax, p0[r]); for (int r = 0; r < 16; ++r) pmax = fmaxf(pmax, p1[r]);
  { auto rr = __builtin_amdgcn_permlane32_swap(__float_as_uint(pmax), __float_as_uint(pmax), false, false);
    pmax = fmaxf(__uint_as_float(rr[0]), __uint_as_float(rr[1])); }
  if (__builtin_expect(__all(pmax - m_reg <= THR / SCALE), 1)) { mn = m_reg; alpha = 1.f; }
  else { mn = fmaxf(m_reg, pmax); alpha = __builtin_amdgcn_exp2f((m_reg - mn) * C); m_reg = mn; }
  float mnC = -mn * C;
  for (int r = 0; r < 16; ++r) p0[r] = fmaf(p0[r], C, mnC); for (int r = 0; r < 16; ++r) p1[r] = fmaf(p1[r], C, mnC);
  for (int r = 0; r < 16; ++r) p0[r] = __builtin_amdgcn_exp2f(p0[r]);
}
__device__ __forceinline__ void finishSM(f32x16& p0, f32x16& p1, float alpha, float& l_reg, bf16x8& pa0, bf16x8& pa1, bf16x8& pa2, bf16x8& pa3) {
  for (int r = 0; r < 16; ++r) p1[r] = __builtin_amdgcn_exp2f(p1[r]);
  float ps = 0; for (int r = 0; r < 16; ++r) ps += p0[r]; for (int r = 0; r < 16; ++r) ps += p1[r];
  { auto rr = __builtin_amdgcn_permlane32_swap(__float_as_uint(ps), __float_as_uint(ps), false, false);
    ps = __uint_as_float(rr[0]) + __uint_as_float(rr[1]); }
  l_reg = l_reg * alpha + ps;
#define PK4(P, BASE, OUT) do { unsigned a0 = cvtpk(P[BASE + 0], P[BASE + 1]), a1 = cvtpk(P[BASE + 2], P[BASE + 3]);   \
    unsigned b0 = cvtpk(P[BASE + 4], P[BASE + 5]), b1 = cvtpk(P[BASE + 6], P[BASE + 7]);                              \
    auto r0 = __builtin_amdgcn_permlane32_swap(a0, b0, false, false); auto r1 = __builtin_amdgcn_permlane32_swap(a1, b1, false, false); \
    u32x4 w = {r0[0], r1[0], r0[1], r1[1]}; OUT = *reinterpret_cast<bf16x8*>(&w); } while (0)
  PK4(p0, 0, pa0); PK4(p0, 8, pa1); PK4(p1, 0, pa2); PK4(p1, 8, pa3);
#undef PK4
}
__device__ __forceinline__ void qkt(f32x16& p0, f32x16& p1, const bf16* Ks, const bf16x8* qr, int r32, int hi) {
  p0 = f32x16{}; p1 = f32x16{};
  for (int d0 = 0; d0 < 8; ++d0) { int cb = (d0 * 16 + hi * 8) * 2;
    bf16x8 b0 = *reinterpret_cast<const bf16x8*>((const char*)Ks + KSWZ(r32, cb));
    bf16x8 b1 = *reinterpret_cast<const bf16x8*>((const char*)Ks + KSWZ(32 + r32, cb));
    p0 = __builtin_amdgcn_mfma_f32_32x32x16_bf16(b0, qr[d0], p0, 0, 0, 0);
    p1 = __builtin_amdgcn_mfma_f32_32x32x16_bf16(b1, qr[d0], p1, 0, 0, 0); }
}
__device__ __forceinline__ int v_st(int k, int c) { const int kk = (k & ~0xC) | ((k & 4) << 1) | ((k & 8) >> 1); return ((kk >> 3) * 4 + (c >> 5)) * 512 + ((kk & 7) * 32 + (c & 31)) * 2; }
__device__ __forceinline__ int v_rd_base(int lane) { return ((lane & 3) << 3) | (((lane >> 2) & 3) << 6) | (((lane >> 4) & 1) << 5) | (((lane >> 5) & 1) << 8); }
constexpr int v_rd_off(int d0, int ks, int half) { return d0 * 512 + ks * 4096 + half * 2048; }
template <int OFF> __device__ __forceinline__ s16x4 tr_read(int vb) {
  s16x4 r; asm volatile("ds_read_b64_tr_b16 %0, %1 offset:%2" : "=&v"(r) : "v"(vb), "i"(OFF) : "memory"); return r;
}
template <int D0> __device__ __forceinline__ void pv_one(f32x16& od, int vb, bf16x8 pa0, bf16x8 pa1, bf16x8 pa2, bf16x8 pa3) {
  const s16x4 l0 = tr_read<v_rd_off(D0, 0, 0)>(vb), h0 = tr_read<v_rd_off(D0, 0, 1)>(vb), l1 = tr_read<v_rd_off(D0, 1, 0)>(vb), h1 = tr_read<v_rd_off(D0, 1, 1)>(vb);
  const s16x4 l2 = tr_read<v_rd_off(D0, 2, 0)>(vb), h2 = tr_read<v_rd_off(D0, 2, 1)>(vb), l3 = tr_read<v_rd_off(D0, 3, 0)>(vb), h3 = tr_read<v_rd_off(D0, 3, 1)>(vb);
  asm volatile("s_waitcnt lgkmcnt(0)" ::: "memory"); SBAR();
#define PK(L, H) (bf16x8){L[0], L[1], L[2], L[3], H[0], H[1], H[2], H[3]}
  od = __builtin_amdgcn_mfma_f32_32x32x16_bf16(pa0, PK(l0, h0), od, 0, 0, 0);
  od = __builtin_amdgcn_mfma_f32_32x32x16_bf16(pa1, PK(l1, h1), od, 0, 0, 0);
  od = __builtin_amdgcn_mfma_f32_32x32x16_bf16(pa2, PK(l2, h2), od, 0, 0, 0);
  od = __builtin_amdgcn_mfma_f32_32x32x16_bf16(pa3, PK(l3, h3), od, 0, 0, 0);
#undef PK
}
__device__ __forceinline__ void pv_d0(f32x16* o, int vb, bf16x8 pa0, bf16x8 pa1, bf16x8 pa2, bf16x8 pa3) {
  pv_one<0>(o[0], vb, pa0, pa1, pa2, pa3); pv_one<1>(o[1], vb, pa0, pa1, pa2, pa3); pv_one<2>(o[2], vb, pa0, pa1, pa2, pa3); pv_one<3>(o[3], vb, pa0, pa1, pa2, pa3);
}

template <typename TQ>
__device__ __forceinline__ void attn_dense_body(const TQ* __restrict__ Qb, const bf16* __restrict__ Kh, const bf16* __restrict__ Vh,
                                                bf16* __restrict__ Ob, int seq, char* lds, const int wid) {
  using St = Stage<bf16>; using SQ = Stage<TQ>;
  const int lane = lane_opaque(), tid = wid * 64 + lane, r32 = lane & 31, hi = lane >> 5;
  bf16* V_lds = (bf16*)lds; bf16* K_lds = (bf16*)(lds + 2 * SHM_V);
  float* ws = (float*)(lds + 2 * SHM_V + 2 * SHM_K) + wid * 64; float* li_l = ws; float* al_l = ws + 32;
  float m_reg = -1e30f, l_reg = 0; f32x16 o[4] = {}; bf16x8 qr[8];
  const TQ* Qw = Qb + (long)(wid * QBLK + r32) * LDQ + hi * 8;
#pragma unroll
  for (int d0 = 0; d0 < 8; ++d0) qr[d0] = SQ::tobf(SQ::ld8(Qw + d0 * 16));
  const int sr = tid >> 4, sc = (tid & 15) * 8, vst0 = v_st(sr, sc), vst1 = v_st(32 + sr, sc);
  const int vb0 = (int)(uintptr_t)V_lds + v_rd_base(lane);
  struct { typename St::T vs0, vs1, ks0, ks1; } sr_[SDEPTH];
#define SLOAD(i, k0) do { sr_[i].vs0 = St::ld8(&Vh[(long)((k0) + sr) * LDK + sc]); sr_[i].vs1 = St::ld8(&Vh[(long)((k0) + 32 + sr) * LDK + sc]); \
    sr_[i].ks0 = St::ld8(&Kh[(long)((k0) + sr) * LDK + sc]); sr_[i].ks1 = St::ld8(&Kh[(long)((k0) + 32 + sr) * LDK + sc]); } while (0)
#define SWRITE(b, i) do { *(bf16x8*)((char*)V_lds + (b) * SHM_V + vst0) = St::tobf(sr_[i].vs0);          \
    *(bf16x8*)((char*)V_lds + (b) * SHM_V + vst1) = St::tobf(sr_[i].vs1); int kc = sc * 2;               \
    *(bf16x8*)((char*)K_lds + (b) * SHM_K + KSWZ(sr, kc)) = St::tobf(sr_[i].ks0);                       \
    *(bf16x8*)((char*)K_lds + (b) * SHM_K + KSWZ(32 + sr, kc)) = St::tobf(sr_[i].ks1); } while (0)
#define SWAIT() do { if constexpr (SDEPTH == 2) asm volatile("s_waitcnt vmcnt(4)" ::: "memory"); else asm volatile("s_waitcnt vmcnt(0)" ::: "memory"); } while (0)
#define RESC(a) do { if (__any((a) < 1.f)) { if (hi == 0) al_l[r32] = (a); asm volatile("s_waitcnt lgkmcnt(0)" ::: "memory"); \
    for (int d = 0; d < 4; ++d) for (int r = 0; r < 16; ++r) o[d][r] *= al_l[crow(r, hi)]; } } while (0)
  f32x16 pA0, pA1, pB0, pB1; float mnA, mnB, alA, alB; bf16x8 pa0, pa1, pa2, pa3; const int NT = seq / KVBLK;
  constexpr int SE = 0, SO = SDEPTH - 1;
  SLOAD(SE, 0); asm volatile("s_waitcnt vmcnt(0)" ::: "memory"); SWRITE(0, SE); __syncthreads();
  qkt(pA0, pA1, K_lds, qr, r32, hi); partialSM(pA0, pA1, m_reg, mnA, alA);
  SLOAD(SO, KVBLK); if constexpr (SDEPTH == 2) { if (2 < NT) SLOAD(SE, 2 * KVBLK); }
  SWAIT(); SWRITE(1, SO); __syncthreads();
  for (int j = 1; j + 1 < NT; j += 2) {
    SBAR(); qkt(pB0, pB1, (bf16*)((char*)K_lds + SHM_K), qr, r32, hi);
    finishSM(pA0, pA1, alA, l_reg, pa0, pa1, pa2, pa3); SBAR();
    SLOAD(SO, (j + SDEPTH) * KVBLK); SBAR();
    pv_d0(o, vb0, pa0, pa1, pa2, pa3); partialSM(pB0, pB1, m_reg, mnB, alB);
    __syncthreads(); SWAIT(); SWRITE(0, SE);
    RESC(alB); __syncthreads();
    SBAR(); qkt(pA0, pA1, K_lds, qr, r32, hi);
    finishSM(pB0, pB1, alB, l_reg, pa0, pa1, pa2, pa3); SBAR();
    if (SDEPTH == 1 || j + 3 < NT) SLOAD(SE, (j + 1 + SDEPTH) * KVBLK); SBAR();
    pv_d0(o, vb0 + (int)SHM_V, pa0, pa1, pa2, pa3); partialSM(pA0, pA1, m_reg, mnA, alA);
    __syncthreads(); SWAIT(); SWRITE(1, SO);
    RESC(alA); __syncthreads();
  }
  SBAR(); qkt(pB0, pB1, (bf16*)((char*)K_lds + SHM_K), qr, r32, hi);
  finishSM(pA0, pA1, alA, l_reg, pa0, pa1, pa2, pa3); SBAR();
  pv_d0(o, vb0, pa0, pa1, pa2, pa3); partialSM(pB0, pB1, m_reg, mnB, alB);
  __syncthreads(); RESC(alB);
  finishSM(pB0, pB1, alB, l_reg, pa0, pa1, pa2, pa3); SBAR();
  pv_d0(o, vb0 + (int)SHM_V, pa0, pa1, pa2, pa3);
  if (hi == 0) li_l[r32] = l_reg; asm volatile("s_waitcnt lgkmcnt(0)" ::: "memory");
  float rli[16];
#pragma unroll
  for (int r = 0; r < 16; ++r) rli[r] = __builtin_amdgcn_rcpf(li_l[crow(r, hi)]);
  bf16* Ow = Ob + (long)(wid * QBLK) * LDO;
#pragma unroll
  for (int r = 0; r < 16; ++r) { int orow = crow(r, hi);
    for (int d0 = 0; d0 < 4; ++d0) Ow[(long)orow * LDO + d0 * 32 + r32] = (bf16)f2bf_(o[d0][r] * rli[r]); }
#undef SLOAD
#undef SWRITE
#undef SWAIT
#undef RESC
}
#undef KSWZ
#undef SBAR
}

#define GAS __attribute__((address_space(1)))
typedef unsigned short bf16_t;
typedef unsigned u32x4 __attribute__((ext_vector_type(4)));
typedef unsigned u32x2 __attribute__((ext_vector_type(2)));
typedef float f32x4 __attribute__((ext_vector_type(4)));
typedef float f32x2 __attribute__((ext_vector_type(2)));
typedef short bf16x8 __attribute__((ext_vector_type(8)));

constexpr int D = 2048, NB = 4, SEQ = 4096, CTXL = 256, TB = SEQ + CTXL, M = NB * TB, FF = 5632, DEPTH = 4;
constexpr int NWAVES = 8, NTHR = 512;
constexpr int NCTXWG = 64;
constexpr float NORM_EPS = 1e-6f;
static_assert(M == 17408 && M % 256 == 0 && TB % 256 == 0, "row layout");

constexpr size_t MiB = 1u << 20;
constexpr size_t WS_CTL = 0, CTL_ZERO_BYTES = 4 * MiB;
constexpr size_t WS_MOD = 1 * MiB;
constexpr size_t WS_ROPE = 4 * MiB;
constexpr size_t WS_WB = 8 * MiB;
constexpr size_t E_F1 = (size_t)2 * FF * D, E_F2 = (size_t)D * FF;
constexpr size_t WS_WA = WS_WB + 8 * (E_F1 + E_F2) * 2;
constexpr size_t E_QKV = (size_t)3072 * D, E_SQ = (size_t)D * D;
constexpr size_t WS_WR = WS_WA + 2 * (E_QKV + E_SQ) * 2;
constexpr size_t E_RW1 = (size_t)6912 * D, E_RW2 = (size_t)10240 * 256;
constexpr size_t WS_WEND = WS_WR + 2 * (E_RW1 + E_RW2 + E_SQ) * 2;
static_assert(WS_WEND == 656 * MiB, "weight map");
constexpr size_t SZ_R2 = (size_t)M * D * 2, SZ_R4 = (size_t)M * D * 4;
constexpr size_t WS_X = 656 * MiB;
constexpr size_t WS_Y = WS_X + SZ_R4;
constexpr size_t WS_ACT = WS_Y + SZ_R2;
constexpr size_t WS_OUT = 1048 * MiB;
constexpr size_t WS_MIX = WS_OUT + SZ_R2;
static_assert(WS_ACT + (size_t)M * FF * 2 <= WS_OUT, "act map");
constexpr size_t WS_Q = WS_MIX, WS_K = WS_Q + SZ_R2, WS_V = WS_K + SZ_R2 / 4, WS_O = WS_V + SZ_R2 / 4;
constexpr size_t WS_MIX6 = WS_MIX;
constexpr size_t WS_WDEC = WS_MIX;
constexpr size_t WS_AA = WS_MIX + 2 * SZ_R4;
constexpr size_t WS_RR = WS_MIX + 6 * SZ_R2;
constexpr size_t WS_KK_ = WS_RR + SZ_R2;
constexpr size_t WS_VV = WS_KK_ + SZ_R2;
constexpr size_t WS_KN = WS_VV + SZ_R2;
constexpr size_t WS_GG = WS_KN + SZ_R2;
constexpr size_t WS_GL = WS_GG + SZ_R2;
constexpr size_t WS_WL = WS_GL + 9 * MiB, WS_AL = WS_WL + 9 * MiB;
constexpr size_t WS_PART = WS_AL + 9 * MiB;
constexpr size_t WS_BON = WS_PART + 16 * MiB;
constexpr size_t WS_END = WS_BON + 5 * MiB;
constexpr size_t WS_YS = WS_ACT;
constexpr size_t WS_PREP = WS_Y;
static_assert(WS_AA + 2 * SZ_R2 == WS_RR, "rwkv overlay");
static_assert(WS_END <= 2100 * MiB, "ws map");
constexpr int CW_BAR = 4096;
constexpr int MAX_LAUNCH = 64;
static_assert((CW_BAR + MAX_LAUNCH * XCD_BAR_WORDS) * 4 <= (int)WS_MOD, "ctl map");

constexpr int RING_BYTES = 131072, LDSCTL_OFF = RING_BYTES, MISC_OFF = LDSCTL_OFF + 320, LDS_BYTES = 147456;

struct Args { const float* in[30]; float* out; unsigned char* ws; int ph_lo, ph_hi, li, dbg; };
typedef const __attribute__((address_space(4))) Args KArgs;
struct Frame { LAS unsigned char* lds; unsigned char* ldsg; int wave, G, bid; };

#define LDS_WAIT() asm volatile("s_waitcnt lgkmcnt(0)" ::: "memory")
__device__ __forceinline__ unsigned f2bf(float f) { unsigned u = __builtin_bit_cast(unsigned, f); return (u + 0x7fffu + ((u >> 16) & 1u)) >> 16; }
__device__ __forceinline__ unsigned pk2(float lo, float hi) { return pg8::cvt_pk_bf16(lo, hi); }
__device__ __forceinline__ float bflo(unsigned w) { return __builtin_bit_cast(float, w << 16); }
__device__ __forceinline__ float bfhi(unsigned w) { return __builtin_bit_cast(float, w & 0xffff0000u); }
__device__ __forceinline__ void unpack8(const u32x4 w, float (&v)[8]) { v[0] = bflo(w.x); v[1] = bfhi(w.x); v[2] = bflo(w.y); v[3] = bfhi(w.y); v[4] = bflo(w.z); v[5] = bfhi(w.z); v[6] = bflo(w.w); v[7] = bfhi(w.w); }
__device__ __forceinline__ u32x4 pack8(const float (&v)[8]) { u32x4 w; w.x = pk2(v[0], v[1]); w.y = pk2(v[2], v[3]); w.z = pk2(v[4], v[5]); w.w = pk2(v[6], v[7]); return w; }
typedef _Float16 h16x2 __attribute__((ext_vector_type(2)));
__device__ __forceinline__ void unpack8h(const u32x4 w, float (&v)[8]) {
    const unsigned wx = w.x, wy = w.y, wz = w.z, ww = w.w;
    const h16x2 a = __builtin_bit_cast(h16x2, wx), b = __builtin_bit_cast(h16x2, wy), c = __builtin_bit_cast(h16x2, wz), d = __builtin_bit_cast(h16x2, ww);
    v[0] = (float)a.x; v[1] = (float)a.y; v[2] = (float)b.x; v[3] = (float)b.y; v[4] = (float)c.x; v[5] = (float)c.y; v[6] = (float)d.x; v[7] = (float)d.y; }
__device__ __forceinline__ u32x4 pack8h(const float (&v)[8]) {
    h16x2 a, b, c, d; a.x = (_Float16)v[0]; a.y = (_Float16)v[1]; b.x = (_Float16)v[2]; b.y = (_Float16)v[3]; c.x = (_Float16)v[4]; c.y = (_Float16)v[5]; d.x = (_Float16)v[6]; d.y = (_Float16)v[7];
    u32x4 w; w.x = __builtin_bit_cast(unsigned, a); w.y = __builtin_bit_cast(unsigned, b); w.z = __builtin_bit_cast(unsigned, c); w.w = __builtin_bit_cast(unsigned, d); return w; }
__device__ __forceinline__ float wave_sum(float v) {
#pragma unroll
    for (int o = 1; o < 64; o <<= 1) v += __shfl_xor(v, o);
    return v;
}
template <int CTRL> __device__ __forceinline__ float dppf(float x) { return __builtin_bit_cast(float, __builtin_amdgcn_mov_dpp(__builtin_bit_cast(int, x), CTRL, 0xF, 0xF, true)); }
__device__ __forceinline__ float sum8(float v) { v += dppf<0xB1>(v); v += dppf<0x4E>(v); v += dppf<0x141>(v); return v; }
__device__ __forceinline__ float sum16(float v) { v = sum8(v); v += dppf<0x140>(v); return v; }
__device__ __forceinline__ float fsigmoid(float x) { return __builtin_amdgcn_rcpf(1.0f + __builtin_amdgcn_exp2f(-1.4426950408889634f * x)); }
__device__ __forceinline__ float ftanh(float x) { return 1.0f - 2.0f * __builtin_amdgcn_rcpf(1.0f + __builtin_amdgcn_exp2f(2.8853900817779268f * x)); }
__device__ __forceinline__ float fsilu(float x) { return x * fsigmoid(x); }

using pg8::Unit;
typedef float accf32x4 __attribute__((ext_vector_type(4)));
struct EpiPlain {
    static constexpr bool PERM = true, AFTER_DRAIN = false;
    bf16_t* O; int ldc;
    __device__ __forceinline__ void operator()(const accf32x4 (&acc)[2][2][4][2], const Unit& u, int wr, int wc, int fr, int fq) const {
        const int row0 = u.pm * 256 + wr * 64 + fr, col0 = u.pn * 256 + wc * 32 + 8 * fq;
#pragma unroll
        for (int ai = 0; ai < 2; ++ai)
#pragma unroll
            for (int m = 0; m < 4; ++m) { bf16_t* rowp = O + (size_t)(row0 + ai * 128 + m * 16) * ldc + col0;
#pragma unroll
                for (int bj = 0; bj < 2; ++bj) { const accf32x4 v0 = acc[ai][bj][m][0], v1 = acc[ai][bj][m][1];
                    u32x4 w; w.x = pk2(v0[0], v0[1]); w.y = pk2(v0[2], v0[3]); w.z = pk2(v1[0], v1[1]); w.w = pk2(v1[2], v1[3]);
                    *(u32x4*)(rowp + bj * 128) = w; } }
    }
};
struct EpiQKV {
    static constexpr bool PERM = true, AFTER_DRAIN = false;
    unsigned char* wsb;
    __device__ __forceinline__ void operator()(const accf32x4 (&acc)[2][2][4][2], const Unit& u, int wr, int wc, int fr, int fq) const {
        size_t ooff; int ldc, ct;
        if (u.pn < 8) { ooff = WS_Q; ldc = 2048; ct = u.pn; } else if (u.pn < 10) { ooff = WS_K; ldc = 512; ct = u.pn - 8; } else { ooff = WS_V; ldc = 512; ct = u.pn - 10; }
        bf16_t* O = (bf16_t*)(wsb + ooff);
        const int row0 = u.pm * 256 + wr * 64 + fr, col0 = ct * 256 + wc * 32 + 8 * fq;
#pragma unroll
        for (int ai = 0; ai < 2; ++ai)
#pragma unroll
            for (int m = 0; m < 4; ++m) { bf16_t* rowp = O + (size_t)(row0 + ai * 128 + m * 16) * ldc + col0;
#pragma unroll
                for (int bj = 0; bj < 2; ++bj) { const accf32x4 v0 = acc[ai][bj][m][0], v1 = acc[ai][bj][m][1];
                    u32x4 w; w.x = pk2(v0[0], v0[1]); w.y = pk2(v0[2], v0[3]); w.z = pk2(v1[0], v1[1]); w.w = pk2(v1[2], v1[3]);
                    *(u32x4*)(rowp + bj * 128) = w; } }
    }
};
struct EpiSwiGLU {
    static constexpr bool PERM = true, AFTER_DRAIN = false;
    bf16_t* O;
    __device__ __forceinline__ void operator()(const accf32x4 (&acc)[2][2][4][2], const Unit& u, int wr, int wc, int fr, int fq) const {
        const int row0 = u.pm * 256 + wr * 64 + fr, col0 = u.pn * 128 + wc * 32 + 8 * fq;
#pragma unroll
        for (int ai = 0; ai < 2; ++ai)
#pragma unroll
            for (int m = 0; m < 4; ++m) { bf16_t* rowp = O + (size_t)(row0 + ai * 128 + m * 16) * FF + col0;
                float r[8];
#pragma unroll
                for (int n = 0; n < 2; ++n)
#pragma unroll
                    for (int e = 0; e < 4; ++e) { const float g = acc[ai][0][m][n][e], up = acc[ai][1][m][n][e]; r[4 * n + e] = fsilu(g) * up; }
                *(u32x4*)rowp = pack8(r); }
    }
};
struct EpiRw1 {
    static constexpr bool PERM = true, AFTER_DRAIN = false;
    unsigned char* wsb; const float* k_k;
    __device__ __forceinline__ void operator()(const accf32x4 (&acc)[2][2][4][2], const Unit& u, int wr, int wc, int fr, int fq) const {
        const int row0 = u.pm * 256 + wr * 64 + fr, cit = 64 * wc + 8 * fq;
        const int pn = u.pn;
        if (pn >= 8 && pn < 16) {
            bf16_t* K = (bf16_t*)(wsb + WS_KK_); bf16_t* KN = (bf16_t*)(wsb + WS_KN);
            const int colb = (pn - 8) * 256 + cit;
            float kk0[8], kk1[8];
            { const f32x4 a0 = *(const f32x4*)(k_k + colb), a1 = *(const f32x4*)(k_k + colb + 4), b0 = *(const f32x4*)(k_k + colb + 32), b1 = *(const f32x4*)(k_k + colb + 36);
#pragma unroll
              for (int e = 0; e < 4; ++e) { kk0[e] = a0[e]; kk0[4 + e] = a1[e]; kk1[e] = b0[e]; kk1[4 + e] = b1[e]; } }
#pragma unroll
            for (int ai = 0; ai < 2; ++ai)
#pragma unroll
                for (int m = 0; m < 4; ++m) { const size_t ro = (size_t)(row0 + ai * 128 + m * 16) * D + colb;
                    float k0[8], k1[8], q0[8], q1[8]; float ss = 0.f;
#pragma unroll
                    for (int n = 0; n < 2; ++n)
#pragma unroll
                        for (int e = 0; e < 4; ++e) { k0[4 * n + e] = acc[ai][0][m][n][e]; k1[4 * n + e] = acc[ai][1][m][n][e]; }
#pragma unroll
                    for (int i = 0; i < 8; ++i) { q0[i] = k0[i] * kk0[i]; q1[i] = k1[i] * kk1[i]; ss += q0[i] * q0[i] + q1[i] * q1[i]; }
                    ss += __shfl_xor(ss, 16); ss += __shfl_xor(ss, 32);
                    const float rs = rsqrtf(ss + 1e-12f);
#pragma unroll
                    for (int i = 0; i < 8; ++i) { q0[i] *= rs; q1[i] *= rs; }
                    *(u32x4*)(K + ro) = pack8(k0); *(u32x4*)(K + ro + 32) = pack8(k1);
                    *(u32x4*)(KN + ro) = pack8(q0); *(u32x4*)(KN + ro + 32) = pack8(q1); }
        } else if (pn < 24) {
            bf16_t* O = (bf16_t*)(wsb + (pn < 8 ? WS_RR : WS_VV)); const int colb = (pn & 7) * 256 + cit;
#pragma unroll
            for (int ai = 0; ai < 2; ++ai)
#pragma unroll
                for (int m = 0; m < 4; ++m) { const size_t ro = (size_t)(row0 + ai * 128 + m * 16) * D + colb;
#pragma unroll
                    for (int bj = 0; bj < 2; ++bj) { const accf32x4 v0 = acc[ai][bj][m][0], v1 = acc[ai][bj][m][1];
                        u32x4 w; w.x = pk2(v0[0], v0[1]); w.y = pk2(v0[2], v0[3]); w.z = pk2(v1[0], v1[1]); w.w = pk2(v1[2], v1[3]);
                        *(u32x4*)(O + ro + 32 * bj) = w; } }
        } else {
            bf16_t* O = (bf16_t*)(wsb + WS_GL + (size_t)(pn - 24) * (9 * MiB));
#pragma unroll
            for (int ai = 0; ai < 2; ++ai)
#pragma unroll
                for (int m = 0; m < 4; ++m) { const size_t ro = (size_t)(row0 + ai * 128 + m * 16) * 256 + cit;
#pragma unroll
                    for (int bj = 0; bj < 2; ++bj) { float r[8];
#pragma unroll
                        for (int n = 0; n < 2; ++n)
#pragma unroll
                            for (int e = 0; e < 4; ++e) { const float x = acc[ai][bj][m][n][e]; r[4 * n + e] = pn == 24 ? fsigmoid(x) : (pn == 25 ? ftanh(x) : x); }
                        *(u32x4*)(O + ro + 32 * bj) = pack8(r); } }
        }
    }
};
struct EpiRw2 {
    static constexpr bool PERM = true, AFTER_DRAIN = false;
    unsigned char* wsb; const float *w0, *a0; size_t aa_off;
    __device__ __forceinline__ void operator()(const accf32x4 (&acc)[2][2][4][2], const Unit& u, int wr, int wc, int fr, int fq) const {
        const int row0 = u.pm * 256 + wr * 64 + fr, cit = 64 * wc + 8 * fq;
        const int pn = u.pn;
        if (pn < 8) {
            bf16_t* G = (bf16_t*)(wsb + WS_GG);
            const int colb = pn * 256 + cit;
#pragma unroll
            for (int ai = 0; ai < 2; ++ai)
#pragma unroll
                for (int m = 0; m < 4; ++m) { const size_t ro = (size_t)(row0 + ai * 128 + m * 16) * D + colb;
#pragma unroll
                    for (int bj = 0; bj < 2; ++bj) { const accf32x4 v0 = acc[ai][bj][m][0], v1 = acc[ai][bj][m][1];
                        u32x4 w; w.x = pk2(v0[0], v0[1]); w.y = pk2(v0[2], v0[3]); w.z = pk2(v1[0], v1[1]); w.w = pk2(v1[2], v1[3]);
                        *(u32x4*)(G + ro + 32 * bj) = w; } }
        } else if (pn < 24) {
            const int d = (pn - 8) >> 3, colb = ((pn - 8) & 7) * 256 + cit;
            bf16_t* Wd = (bf16_t*)(wsb + WS_WDEC) + (size_t)d * M * D;
#pragma unroll
            for (int bj = 0; bj < 2; ++bj) {
                const f32x4 b0 = *(const f32x4*)(w0 + d * D + colb + 32 * bj), b1 = *(const f32x4*)(w0 + d * D + colb + 32 * bj + 4);
#pragma unroll
                for (int ai = 0; ai < 2; ++ai)
#pragma unroll
                    for (int m = 0; m < 4; ++m) { const size_t ro = (size_t)(row0 + ai * 128 + m * 16) * D + colb + 32 * bj;
                        float lw[8];
#pragma unroll
                        for (int e = 0; e < 4; ++e) { lw[e] = -0.8750387749f * fsigmoid(acc[ai][bj][m][0][e] + b0[e]);
                                                      lw[4 + e] = -0.8750387749f * fsigmoid(acc[ai][bj][m][1][e] + b1[e]); }
                        *(u32x4*)(Wd + ro) = pack8(lw); } }
        } else {
            const int d = (pn - 24) >> 3, colb = ((pn - 24) & 7) * 256 + cit;
            bf16_t* AAd = (bf16_t*)(wsb + aa_off) + (size_t)d * M * D;
#pragma unroll
            for (int bj = 0; bj < 2; ++bj) {
                const int cb = colb + 32 * bj;
                const f32x4 b0 = *(const f32x4*)(a0 + d * D + cb), b1 = *(const f32x4*)(a0 + d * D + cb + 4);
#pragma unroll
                for (int ai = 0; ai < 2; ++ai)
#pragma unroll
                    for (int m = 0; m < 4; ++m) { const size_t ro = (size_t)(row0 + ai * 128 + m * 16) * D + cb;
                        float av[8];
#pragma unroll
                        for (int e = 0; e < 4; ++e) { av[e] = fsigmoid(acc[ai][bj][m][0][e] + b0[e]); av[4 + e] = fsigmoid(acc[ai][bj][m][1][e] + b1[e]); }
                        *(u32x4*)(AAd + ro) = pack8(av); } }
        }
    }
};
struct GemmRw1 { const bf16_t* MIX; const bf16_t* Bt;  int K;
    __device__ __forceinline__ const char* a_tile(const Unit& u) const { int idx = u.pn < 24 ? (u.pn >> 3) : (u.pn - 21);
#ifdef DBG_RW1_SAMEA
        idx = 0;
#endif
        return (const char*)MIX + (size_t)idx * SZ_R2 + (size_t)u.pm * (size_t)(256 * 2) * D; }
    __device__ __forceinline__ const char* b_tile(const Unit& u) const { return (const char*)Bt + (size_t)u.pn * (size_t)(256 * 2) * D; }
    __device__ __forceinline__ int klen() const { return K; } };
struct GemmRw2 { const unsigned char* wsb; const bf16_t* Bt; int K;
    __device__ __forceinline__ const char* a_tile(const Unit& u) const { const size_t ao = u.pn < 8 ? WS_GL : (u.pn < 24 ? WS_WL : WS_AL); return (const char*)wsb + ao + (size_t)u.pm * (size_t)(256 * 2) * 256; }
    __device__ __forceinline__ const char* b_tile(const Unit& u) const { return (const char*)Bt + (size_t)u.pn * (size_t)(256 * 2) * 256; }
    __device__ __forceinline__ int klen() const { return K; } };

__device__ __forceinline__ int hp_row(int c) { return 128 * ((c & 63) >> 5) + 32 * (c >> 6) + (c & 31); }
__device__ __forceinline__ int hp_col(int rho) { return 64 * ((rho & 127) >> 5) + 32 * (rho >> 7) + (rho & 31); }
__device__ __forceinline__ void cvt_item(const float* W, int K, int N, bf16_t* WT, int mode, int row_off, LAS float* scr, int item, int lane) {
    const int nblk = N / 32, kb = item / nblk, nb = item - kb * nblk, k0 = 64 * kb, n0 = 32 * nb;
#pragma unroll 8
    for (int i = 0; i < 32; ++i) { const int kk = 2 * i + (lane >> 5); scr[kk * 33 + (lane & 31)] = W[(size_t)(k0 + kk) * N + n0 + (lane & 31)]; }
    LDS_WAIT(); asm volatile("" ::: "memory");
    int dr;
    if (mode == 0) dr = n0;
    else if (mode == 1) { dr = n0 < FF ? 256 * (n0 / 128) + (n0 % 128) : 256 * ((n0 - FF) / 128) + 128 + ((n0 - FF) % 128); }
    else { dr = (n0 & ~255) + hp_row(n0 & 255); }
    dr += row_off;
    const int c = lane & 7;
#pragma unroll
    for (int j = 0; j < 4; ++j) { const int n = (lane >> 3) + 8 * j; const LAS float* s = scr + (8 * c) * 33 + n;
        u32x4 o; o.x = pk2(s[0 * 33], s[1 * 33]); o.y = pk2(s[2 * 33], s[3 * 33]); o.z = pk2(s[4 * 33], s[5 * 33]); o.w = pk2(s[6 * 33], s[7 * 33]);
        *(u32x4*)(WT + (size_t)(dr + n) * K + k0 + 8 * c) = o; }
    LDS_WAIT(); asm volatile("" ::: "memory");
}
__device__ __forceinline__ void p0a_phase(const Frame F, KArgs* a) {
    const int lane_ = lane_opaque(), tid_ = F.wave * 64 + lane_; (void)tid_; (void)lane_;
    LAS float* scr = (LAS float*)(F.lds + F.wave * 16384);
    const int gw = F.bid * NWAVES + F.wave, NGW = F.G * NWAVES;
    bf16_t* WB = (bf16_t*)(a->ws + WS_WB); bf16_t* WA = (bf16_t*)(a->ws + WS_WA); bf16_t* WR = (bf16_t*)(a->ws + WS_WR);
    constexpr int I_F1 = (D / 64) * (2 * FF / 32), I_F2 = (FF / 64) * (D / 32), I_QKV = (D / 64) * (3072 / 32), I_SQ = (D / 64) * (D / 32), I_G1 = (D / 64) * (256 / 32), I_G2 = (256 / 64) * (D / 32);
    constexpr int N_FFN = 8 * (I_F1 + I_F2), N_ATT = 2 * (I_QKV + I_SQ), N_RW = 2 * (4 * I_SQ + I_G1 + I_G2);
    constexpr int NITEMS = N_FFN + N_ATT + N_RW;
    for (int it = gw; it < NITEMS; it += NGW) {
        int r = it;
        if (r < N_FFN) { const int lh = r / (I_F1 + I_F2); r -= lh * (I_F1 + I_F2);
            bf16_t* base = WB + (size_t)lh * (E_F1 + E_F2);
            if (r < I_F1) cvt_item(a->in[8] + (size_t)lh * D * 2 * FF, D, 2 * FF, base, 1, 0, scr, r, lane_);
            else cvt_item(a->in[9] + (size_t)lh * FF * D, FF, D, base + E_F1, 0, 0, scr, r - I_F1, lane_);
            continue; }
        r -= N_FFN;
        if (r < N_ATT) { const int j = r / (I_QKV + I_SQ); r -= j * (I_QKV + I_SQ);
            bf16_t* base = WA + (size_t)j * (E_QKV + E_SQ);
            if (r < I_QKV) cvt_item(a->in[10] + (size_t)j * D * 3072, D, 3072, base, 0, 0, scr, r, lane_);
            else cvt_item(a->in[11] + (size_t)j * D * D, D, D, base + E_QKV, 0, 0, scr, r - I_QKV, lane_);
            continue; }
        r -= N_ATT;
        { const int per = 4 * I_SQ + I_G1 + I_G2; const int j = r / per; r -= j * per;
          bf16_t* rw1 = WR + (size_t)j * (E_RW1 + E_RW2 + E_SQ); bf16_t* rw2 = rw1 + E_RW1; bf16_t* ro = rw2 + E_RW2;
          if (r < 3 * I_SQ) { const int q = r / I_SQ; cvt_item(a->in[15] + ((size_t)j * 3 + q) * D * D, D, D, rw1, 2, q * 2048, scr, r - q * I_SQ, lane_); continue; }
          r -= 3 * I_SQ;
          if (r < I_SQ) { cvt_item(a->in[16] + (size_t)j * D * D, D, D, ro, 0, 0, scr, r, lane_); continue; }
          r -= I_SQ;
          if (r < I_G1) { cvt_item(a->in[17] + (size_t)j * D * 256, D, 256, rw1, 2, 6144, scr, r, lane_); continue; }
          r -= I_G1;
          cvt_item(a->in[18] + (size_t)j * 256 * D, 256, D, rw2, 2, 0, scr, r, lane_); }
    }
    {
        constexpr int P_A = 256 * 2048 / 2, P_C = 4096 * 256 / 2, P_J = 2 * P_A + 2 * P_C;
        for (int p = F.bid * NTHR + tid_; p < 2 * P_J; p += F.G * NTHR) {
            const int j = p / P_J; int r = p - j * P_J;
            bf16_t* rw1 = WR + (size_t)j * (E_RW1 + E_RW2 + E_SQ); bf16_t* rw2 = rw1 + E_RW1;
            if (r < 2 * P_A) { const int which = r / P_A; r -= which * P_A;
                const int rho = r / 1024, k = (r - rho * 1024) * 2, c = hp_col(rho);
                const float* src = (which == 0 ? a->in[20] : a->in[23]);
                float v0 = 0.f, v1 = 0.f;
                if (c < 192) { const int d = c / 96, jj = c - d * 96; const float* s = src + (((size_t)j * 2 + d) * D + k) * 96 + jj; v0 = s[0]; v1 = s[96]; }
                *(unsigned*)(rw1 + (size_t)(6400 + 256 * which + rho) * D + k) = pk2(v0, v1);
            } else { r -= 2 * P_A; const int which = r / P_C; r -= which * P_C;
                const int nrow = r / 128, k = (r - nrow * 128) * 2;
                const int d = nrow >> 11, np = nrow & 2047, c = (np & ~255) + hp_col(np & 255);
                const float* src = (which == 0 ? a->in[21] : a->in[24]);
                float v0 = 0.f, v1 = 0.f;
                if (k < 192 && (k / 96) == d) { const int kk = k - d * 96; const float* s = src + (((size_t)j * 2 + d) * 96 + kk) * D + c; v0 = s[0]; v1 = s[D]; }
                *(unsigned*)(rw2 + (size_t)(2048 + 4096 * which + nrow) * 256 + k) = pk2(v0, v1);
            }
        }
    }
#ifdef DBG_FILL_WS
    {
        u32x4* p = (u32x4*)(a->ws + WS_X); const size_t n16 = (WS_END - WS_X) / 16;
        for (size_t i = (size_t)F.bid * NTHR + tid_; i < n16; i += (size_t)F.G * NTHR) p[i] = (u32x4){0xAAAAAAAAu, 0xAAAAAAAAu, 0xAAAAAAAAu, 0xAAAAAAAAu};
    }
#endif
    {
        float* COS = (float*)(a->ws + WS_ROPE); float* SIN = COS + 4096 * 64;
        for (int p = F.bid * NTHR + tid_; p < 4096 * 64; p += F.G * NTHR) {
            const int t = p >> 6, f = p & 63; const int pos = f < 32 ? (t >> 6) : (t & 63); const int fi = f & 31;
            const float inv = exp2f(-(float)fi * (13.287712379549449f / 32.0f));
            const float ang = (float)pos * inv;
            COS[p] = cosf(ang); SIN[p] = sinf(ang);
        }
    }
    {
        LAS float* sv = (LAS float*)F.lds;
        LAS float* part = (LAS float*)(F.lds + 65536);
        float* MOD = (float*)(a->ws + WS_MOD);
        __syncthreads();
        for (int idx = tid_; idx < 5 * D; idx += NTHR) { const int cc = idx >> 11, kk = idx & 2047; const float x = cc < 4 ? a->in[1][cc * D + kk] : a->in[3][kk]; sv[kk * 8 + cc] = fsilu(x); }
        __syncthreads();
        for (int u = F.bid; u < 4 * 72; u += F.G) {
            const int l = u / 72, nb = u - l * 72;
            const int n = nb * 256 + lane_ * 4, k0 = F.wave * 256;
            const float* wp = a->in[4] + ((size_t)l * D + k0) * 18432 + n;
            f32x4 acc[5];
#pragma unroll
            for (int c = 0; c < 5; ++c) acc[c] = (f32x4){0.f, 0.f, 0.f, 0.f};
#pragma unroll 8
            for (int kk = 0; kk < 256; ++kk) { const f32x4 w4 = *(const f32x4*)(wp + (size_t)kk * 18432);
                const f32x4 s4 = *(const LAS f32x4*)(sv + (k0 + kk) * 8); const float s5 = sv[(k0 + kk) * 8 + 4];
                acc[0] += w4 * s4[0]; acc[1] += w4 * s4[1]; acc[2] += w4 * s4[2]; acc[3] += w4 * s4[3]; acc[4] += w4 * s5; }
#pragma unroll
            for (int c = 0; c < 5; ++c) *(LAS f32x4*)(part + (F.wave * 5 + c) * 256 + lane_ * 4) = acc[c];
            __syncthreads();
            for (int o = tid_; o < 5 * 256; o += NTHR) { const int c = o >> 8, col = o & 255; float s = a->in[5][(size_t)l * 18432 + nb * 256 + col];
#pragma unroll
                for (int w = 0; w < 8; ++w) s += part[(w * 5 + c) * 256 + col];
                MOD[((size_t)l * 5 + c) * 18432 + nb * 256 + col] = s; }
            __syncthreads();
        }
    }
}

template <int MODE> struct ThinCtx { float PA[4][8], PB[4][8], PC[4][8]; int cur_c; };
template <int MODE, bool CTXP>
__device__ __forceinline__ void thin_row(ThinCtx<MODE>& T, KArgs* a, const int lane, const int m, int l, int s, float wgt, int nl, int ns) {
    const float* MOD = (const float*)(a->ws + WS_MOD);
    bf16_t* X = (bf16_t*)(a->ws + WS_X)  ; bf16_t* Y = (bf16_t*)(a->ws + WS_Y); const bf16_t* OUT = (const bf16_t*)(a->ws + WS_OUT);
    const int b = m / TB, j = m - b * TB, c = j < CTXL ? 4 : b;
    if (MODE == 2 && c == 4) return;
    if (c != T.cur_c) {
        T.cur_c = c;
#pragma unroll
        for (int q = 0; q < 4; ++q) { const int e0 = 512 * q + 8 * lane;
            if (MODE != 0) { const float* gp = MOD + (((size_t)l * 5 + c) * 9 + s * 3 + 2) * D + e0; const float* np = a->in[7] + ((size_t)l * 3 + s) * D + e0;
#pragma unroll
                for (int i = 0; i < 8; ++i) T.PA[q][i] = wgt * gp[i] * np[i]; }
            if (MODE != 2) { const float* sc = MOD + (((size_t)nl * 5 + c) * 9 + ns * 3 + 1) * D + e0; const float* sh = MOD + (((size_t)nl * 5 + c) * 9 + ns * 3 + 0) * D + e0; const float* np = a->in[6] + ((size_t)nl * 3 + ns) * D + e0;
#pragma unroll
                for (int i = 0; i < 8; ++i) { T.PB[q][i] = np[i] * (1.0f + sc[i]); T.PC[q][i] = sh[i]; } } }
    }
    float x[4][8];
    if (MODE == 0) {
        const float* src = j < CTXL ? a->in[2] + ((size_t)b * CTXL + j) * D : a->in[0] + ((size_t)b * SEQ + (j - CTXL)) * D;
#pragma unroll
        for (int q = 0; q < 4; ++q) { const f32x4 v0 = *(const f32x4*)(src + 512 * q + 8 * lane), v1 = *(const f32x4*)(src + 512 * q + 8 * lane + 4);
#pragma unroll
            for (int e = 0; e < 4; ++e) { x[q][e] = v0[e]; x[q][4 + e] = v1[e]; } }
    } else {
        float o[4][8]; float ss = 0.f;
#pragma unroll
        for (int q = 0; q < 4; ++q) {
            if (CTXP) { const float* P0 = (const float*)(a->ws + WS_PART) + (size_t)(b * CTXL + j) * D + 512 * q + 8 * lane; const float* P1 = P0 + (size_t)(NB * CTXL) * D;
                const f32x4 a0 = *(const f32x4*)P0, a1 = *(const f32x4*)(P0 + 4), b0 = *(const f32x4*)P1, b1 = *(const f32x4*)(P1 + 4);
#pragma unroll
                for (int e = 0; e < 4; ++e) { o[q][e] = a0[e] + b0[e]; o[q][4 + e] = a1[e] + b1[e]; } }
            else unpack8(*(const u32x4*)(OUT + (size_t)m * D + 512 * q + 8 * lane), o[q]);
#pragma unroll
            for (int i = 0; i < 8; ++i) ss += o[q][i] * o[q][i]; }
        ss = wave_sum(ss);
        const float r1 = rsqrtf(ss * (1.0f / D) + NORM_EPS);
#pragma unroll
        for (int q = 0; q < 4; ++q) { float xo[8]; unpack8h(*(const u32x4*)(X + (size_t)m * D + 512 * q + 8 * lane), xo);
#pragma unroll
            for (int e = 0; e < 8; ++e) x[q][e] = xo[e] + T.PA[q][e] * (o[q][e] * r1); }
    }
    if (MODE == 2) {
        float* dst = a->out + ((size_t)b * SEQ + (j - CTXL)) * D;
#pragma unroll
        for (int q = 0; q < 4; ++q) { *(f32x4*)(dst + 512 * q + 8 * lane) = (f32x4){x[q][0], x[q][1], x[q][2], x[q][3]}; *(f32x4*)(dst + 512 * q + 8 * lane + 4) = (f32x4){x[q][4], x[q][5], x[q][6], x[q][7]}; }
        return;
    }
    float ss2 = 0.f;
#pragma unroll
    for (int q = 0; q < 4; ++q) { *(u32x4*)(X + (size_t)m * D + 512 * q + 8 * lane) = pack8h(x[q]);
#pragma unroll
        for (int i = 0; i < 8; ++i) ss2 += x[q][i] * x[q][i]; }
    ss2 = wave_sum(ss2);
    const float r2 = rsqrtf(ss2 * (1.0f / D) + NORM_EPS);
#pragma unroll
    for (int q = 0; q < 4; ++q) { float y[8];
#pragma unroll
        for (int i = 0; i < 8; ++i) y[i] = (x[q][i] * r2) * T.PB[q][i] + T.PC[q][i];
        *(u32x4*)(Y + (size_t)m * D + 512 * q + 8 * lane) = pack8(y); }
}
template <int MODE, int ROWSET>
__device__ __forceinline__ void thin_phase(const Frame F, KArgs* a, int l, int s, float wgt, int nl, int ns) {
    const int lane_ = lane_opaque();
    ThinCtx<MODE> T; T.cur_c = -1;
    if (ROWSET == 0) {
        for (int ch = F.bid; ch < M / 68; ch += F.G) {
            const int r0 = ch * 68 + (F.wave < 4 ? 9 * F.wave : 36 + 8 * (F.wave - 4)), nr = F.wave < 4 ? 9 : 8;
            for (int r = 0; r < nr; ++r) thin_row<MODE, false>(T, a, lane_, r0 + r, l, s, wgt, nl, ns);
        }
    } else if (ROWSET == 1) {
        const int nw = (F.G - NCTXWG) * NWAVES, wv = (F.bid - NCTXWG) * NWAVES + F.wave;
        const int l0 = (int)(((long)wv * (NB * SEQ)) / nw), l1 = (int)(((long)(wv + 1) * (NB * SEQ)) / nw);
        for (int li = l0; li < l1; ++li) thin_row<MODE, false>(T, a, lane_, (li >> 12) * TB + CTXL + (li & (SEQ - 1)), l, s, wgt, nl, ns);
    } else {
        for (int c = F.bid * NWAVES + F.wave; c < NB * CTXL; c += F.G * NWAVES) thin_row<MODE, true>(T, a, lane_, (c >> 8) * TB + (c & (CTXL - 1)), l, s, wgt, nl, ns);
    }
}
struct LatentOrder : pg8::StaticOrder {
    __device__ void init_lat(int N, int G_, int c_) { init(64 * 256, N, G_, c_); }
    __device__ bool next(int i, Unit& u) const { if (!pg8::StaticOrder::next(i, u)) return false; u.pm = u.pm + (u.pm >> 4) + 1; return true; }
};
struct CtxOrder2 {
    int c;
    __device__ bool next(int i, Unit& u) const { if (i != 0 || c >= NCTXWG) return false; const int idx = c >> 1; u.pm = (idx >> 3) * 17; u.pn = (idx & 7) + 8 * (c & 1); return true; }
    __device__ __forceinline__ void a_ready(const Unit&) const {}
    __device__ __forceinline__ void done(const Unit&) const {}
};
struct GemmCtxSplit { const bf16_t* A; const bf16_t* Bt; int K;
    __device__ __forceinline__ const char* a_tile(const Unit& u) const { return (const char*)A + (size_t)u.pm * (size_t)(256 * 2) * K + (size_t)(u.pn >> 3) * (size_t)(K / 2) * 2; }
    __device__ __forceinline__ const char* b_tile(const Unit& u) const { return (const char*)Bt + (size_t)(u.pn & 7) * (size_t)(256 * 2) * K + (size_t)(u.pn >> 3) * (size_t)(K / 2) * 2; }
    __device__ __forceinline__ int klen() const { return K / 2; } };
struct EpiCtxPart {
    static constexpr bool PERM = true, AFTER_DRAIN = false;
    float* P;
    __device__ __forceinline__ void operator()(const accf32x4 (&acc)[2][2][4][2], const Unit& u, int wr, int wc, int fr, int fq) const {
        const int row0 = (u.pm / 17) * 256 + wr * 64 + fr, col0 = (u.pn & 7) * 256 + wc * 32 + 8 * fq;
        float* base = P + (size_t)(u.pn >> 3) * (NB * CTXL) * D;
#pragma unroll
        for (int ai = 0; ai < 2; ++ai)
#pragma unroll
            for (int m = 0; m < 4; ++m) { float* rowp = base + (size_t)(row0 + ai * 128 + m * 16) * D + col0;
#pragma unroll
                for (int bj = 0; bj < 2; ++bj) { *(f32x4*)(rowp + bj * 128) = acc[ai][bj][m][0]; *(f32x4*)(rowp + bj * 128 + 4) = acc[ai][bj][m][1]; } }
    }
};
#ifndef DBG_DUMP_OFF
#define DBG_DUMP_OFF WS_X
#define DBG_DUMP_F32 1
#endif
__device__ __forceinline__ void copyout_phase(const Frame F, KArgs* a) {
    const int lane_ = lane_opaque();
    for (int m = F.bid * NWAVES + F.wave; m < M; m += F.G * NWAVES) { const int b = m / TB, j = m - b * TB; if (j < CTXL) continue;
        float* dst = a->out + ((size_t)b * SEQ + (j - CTXL)) * D;
#if defined(DBG_DUMP_P256)
        { const size_t offs[] = {DBG_DUMP_P256}; constexpr int NL = sizeof(offs) / sizeof(offs[0]);
          for (int q = 0; q < 4; ++q) { float acc[8], v[8]; for (int e = 0; e < 8; ++e) acc[e] = 0.f;
              if (q == 0 && lane_ < 32) { for (int t = 0; t < NL; ++t) { unpack8(*(const u32x4*)((const bf16_t*)(a->ws + offs[t]) + (size_t)m * 256 + 8 * lane_), v); for (int e = 0; e < 8; ++e) acc[e] += (1.f + t) * v[e]; } }
              *(f32x4*)(dst + 512 * q + 8 * lane_) = (f32x4){acc[0], acc[1], acc[2], acc[3]}; *(f32x4*)(dst + 512 * q + 8 * lane_ + 4) = (f32x4){acc[4], acc[5], acc[6], acc[7]}; }
          continue; }
#endif
#ifndef DBG_DUMP_W
#define DBG_DUMP_W(t) (1.f + (t))
#endif
#if defined(DBG_DUMP_LIST)
        { const size_t offs[] = {DBG_DUMP_LIST}; constexpr int NL = sizeof(offs) / sizeof(offs[0]);
#pragma unroll
          for (int q = 0; q < 4; ++q) { const size_t ro = (size_t)m * D + 512 * q + 8 * lane_; float acc[8], v[8];
              for (int e = 0; e < 8; ++e) acc[e] = 0.f;
#pragma unroll
              for (int t = 0; t < NL; ++t) { unpack8(*(const u32x4*)((const bf16_t*)(a->ws + offs[t]) + ro), v); for (int e = 0; e < 8; ++e) acc[e] += DBG_DUMP_W(t) * v[e]; }
              *(f32x4*)(dst + 512 * q + 8 * lane_) = (f32x4){acc[0], acc[1], acc[2], acc[3]}; *(f32x4*)(dst + 512 * q + 8 * lane_ + 4) = (f32x4){acc[4], acc[5], acc[6], acc[7]}; }
          continue; }
#endif
        if (DBG_DUMP_F32) { const float* X = (const float*)(a->ws + (DBG_DUMP_OFF));
#pragma unroll
            for (int q = 0; q < 8; ++q) *(f32x4*)(dst + 256 * q + 4 * lane_) = *(const f32x4*)(X + (size_t)m * D + 256 * q + 4 * lane_); }
        else { const bf16_t* Bq = (const bf16_t*)(a->ws + (DBG_DUMP_OFF));
#pragma unroll
            for (int q = 0; q < 4; ++q) { float v[8]; unpack8(*(const u32x4*)(Bq + (size_t)m * D + 512 * q + 8 * lane_), v);
                *(f32x4*)(dst + 512 * q + 8 * lane_) = (f32x4){v[0], v[1], v[2], v[3]}; *(f32x4*)(dst + 512 * q + 8 * lane_ + 4) = (f32x4){v[4], v[5], v[6], v[7]}; } }
    }
}

__device__ __forceinline__ void mixes_phase(const Frame F, KArgs* a, int jr) {
    const int lane_ = lane_opaque(), tid_ = F.wave * 64 + lane_; (void)tid_; (void)lane_;
    const bf16_t* Y = (const bf16_t*)(a->ws + WS_Y); bf16_t* MIX = (bf16_t*)(a->ws + WS_MIX6);
    const int rg = F.wave >> 2, e0 = 512 * (F.wave & 3) + 8 * lane_;
    float mu[6][8];
    { const int muidx[6] = {0, 2, 3, 5, 1, 4};
#pragma unroll
      for (int q = 0; q < 6; ++q) { const float* mp = a->in[14] + ((size_t)jr * 6 + muidx[q]) * D + e0;
#pragma unroll
          for (int i = 0; i < 8; ++i) mu[q][i] = mp[i]; } }
    for (int ch = F.bid; ch < M / 68; ch += F.G) {
        const int r0 = ch * 68 + 34 * rg;
        float yp[8], yc[8], yn[8];
        if (r0 > 0) unpack8(*(const u32x4*)(Y + (size_t)(r0 - 1) * D + e0), yp); else {
#pragma unroll
            for (int i = 0; i < 8; ++i) yp[i] = 0.f; }
        unpack8(*(const u32x4*)(Y + (size_t)r0 * D + e0), yc);
        for (int r = 0; r < 34; ++r) { const int m = r0 + r, j = m % TB;
            if (m + 1 < M) unpack8(*(const u32x4*)(Y + (size_t)(m + 1) * D + e0), yn); else {
#pragma unroll
                for (int i = 0; i < 8; ++i) yn[i] = 0.f; }
            const float pv = (j != 0 && j != CTXL) ? 0.5f : 0.f, nv = (j != CTXL - 1 && j != TB - 1) ? 0.5f : 0.f;
            float xx[8];
#pragma unroll
            for (int i = 0; i < 8; ++i) xx[i] = (pv * yp[i] + nv * yn[i]) - yc[i];
#pragma unroll
            for (int q = 0; q < 6; ++q) { float o[8];
#pragma unroll
                for (int i = 0; i < 8; ++i) o[i] = yc[i] + xx[i] * mu[q][i];
                *(u32x4*)(MIX + (size_t)q * M * D + (size_t)m * D + e0) = pack8(o); }
#pragma unroll
            for (int i = 0; i < 8; ++i) { yp[i] = yc[i]; yc[i] = yn[i]; }
        }
    }
}

__device__ __forceinline__ void qknorm_phase(const Frame F, KArgs* a, int ja) {
    const int lane_ = lane_opaque(), tid_ = F.wave * 64 + lane_; (void)tid_; (void)lane_;
    bf16_t* Q = (bf16_t*)(a->ws + WS_Q); bf16_t* K = (bf16_t*)(a->ws + WS_K);
    const float* COS = (const float*)(a->ws + WS_ROPE); const float* SIN = COS + 4096 * 64;
    const int li = lane_ & 15, hs = lane_ >> 4;
    float gq[8], gk[8];
#pragma unroll
    for (int i = 0; i < 8; ++i) { gq[i] = a->in[12][ja * 128 + 8 * li + i]; gk[i] = a->in[13][ja * 128 + 8 * li + i]; }
    for (int m = F.bid * NWAVES + F.wave; m < M; m += F.G * NWAVES) {
        const int j = m % TB; const bool lat = j >= CTXL; const int pos = lat ? j - CTXL : 0;
        f32x4 cs = (f32x4){1.f, 1.f, 1.f, 1.f}, sn = (f32x4){0.f, 0.f, 0.f, 0.f};
        if (lat) { cs = *(const f32x4*)(COS + (size_t)pos * 64 + 4 * li); sn = *(const f32x4*)(SIN + (size_t)pos * 64 + 4 * li); }
#pragma unroll
        for (int p = 0; p < 5; ++p) {
            bf16_t* ptr = p < 4 ? Q + (size_t)m * D + (4 * p + hs) * 128 + 8 * li : K + (size_t)m * 512 + hs * 128 + 8 * li;
            float v[8]; unpack8(*(const u32x4*)ptr, v);
            float ss = 0.f;
#pragma unroll
            for (int i = 0; i < 8; ++i) ss += v[i] * v[i];
            ss = sum16(ss);
            const float rs = rsqrtf(ss * (1.0f / 128.0f) + NORM_EPS);
            float o[8];
#pragma unroll
            for (int i = 0; i < 4; ++i) { const float x1 = v[2 * i] * rs * (p < 4 ? gq[2 * i] : gk[2 * i]), x2 = v[2 * i + 1] * rs * (p < 4 ? gq[2 * i + 1] : gk[2 * i + 1]);
                o[2 * i] = x1 * cs[i] - x2 * sn[i]; o[2 * i + 1] = x1 * sn[i] + x2 * cs[i]; }
            *(u32x4*)ptr = pack8(o);
        }
    }
}

template <int R> __device__ __forceinline__ float ror16(float x) { return __builtin_bit_cast(float, __builtin_amdgcn_mov_dpp(__builtin_bit_cast(int, x), 0x120 + R, 0xF, 0xF, true)); }
__device__ __forceinline__ float sum_row16(float x) { x += ror16<8>(x); x += ror16<4>(x); x += ror16<2>(x); x += ror16<1>(x); return x; }
__device__ __forceinline__ float sum_rows(float x) {
    x += ror16<8>(x);
    { const unsigned u = __builtin_bit_cast(unsigned, x); auto rr = __builtin_amdgcn_permlane16_swap(u, u, false, false); const unsigned r0 = rr[0], r1 = rr[1];
      x = __builtin_bit_cast(float, r0) + __builtin_bit_cast(float, r1); }
    { const unsigned u = __builtin_bit_cast(unsigned, x); auto rr = __builtin_amdgcn_permlane32_swap(u, u, false, false); const unsigned r0 = rr[0], r1 = rr[1];
      x = __builtin_bit_cast(float, r0) + __builtin_bit_cast(float, r1); }
    return x;
}
__device__ __forceinline__ void scan_phase(const Frame F, KArgs* a, int jr) {
    const int lane_ = lane_opaque(), tid_ = F.wave * 64 + lane_; (void)tid_; (void)lane_;
    LAS float* L = (LAS float*)F.lds;
    constexpr int BUF = 32 * 384, YB0 = 2 * BUF, YBUF = 32 * 64;
    const int tid = tid_, lane = lane_, li4 = (lane & 15) * 4, vrow = 8 * F.wave + 2 * (lane >> 4);
    const bf16_t* KR = (const bf16_t*)(a->ws + WS_KK_); const bf16_t* AA = (const bf16_t*)(a->ws + WS_AA);
    const bf16_t* KN = (const bf16_t*)(a->ws + WS_KN); const bf16_t* RR = (const bf16_t*)(a->ws + WS_RR); const bf16_t* VV = (const bf16_t*)(a->ws + WS_VV);
    bf16_t* YS = (bf16_t*)(a->ws + WS_YS);
    for (int chain = F.bid; chain < 256; chain += F.G) {
        const int b = chain >> 6, h = (chain >> 1) & 31, dir = chain & 1;
        const size_t doff = (size_t)dir * M * D;
        const int hc = h * 64;
        const int lrow = (tid & 255) >> 3, lpart = tid & 7; const bool lo = tid < 256;
        const bf16_t* pa = (lo ? KR : RR) + hc + lpart * 8; const bf16_t* pb = (lo ? KN : VV) + hc + lpart * 8; const bf16_t* pc = (lo ? AA : (const bf16_t*)(a->ws + WS_WDEC)) + doff + hc + lpart * 8;
        float ka[8];
#pragma unroll
        for (int i = 0; i < 8; ++i) ka[i] = lo ? a->in[26][(size_t)jr * D + hc + lpart * 8 + i] : a->in[27][(size_t)jr * D + hc + lpart * 8 + i];
        float* BON = (float*)(a->ws + WS_BON) + (size_t)dir * M * 32 + h;
        u32x4 ra, rb, rc;
        f32x2 S2[4];
#pragma unroll
        for (int i = 0; i < 4; ++i) S2[i] = (f32x2){0.f, 0.f};
#define SCAN_M0(q) (b * TB + (dir == 0 ? 32 * (q) : ((q) < 8 ? 224 - 32 * (q) : 4576 - 32 * (q))))
#define SCAN_LOAD(q) do { const size_t m0_ = (size_t)SCAN_M0(q); ra = *(const u32x4*)(pa + (m0_ + lrow) * D); rb = *(const u32x4*)(pb + (m0_ + lrow) * D); rc = *(const u32x4*)(pc + (m0_ + lrow) * D); } while (0)
#define SCAN_ST8(off_, t_) do { *(LAS f32x4*)(d_ + (off_)) = (f32x4){t_[0], t_[1], t_[2], t_[3]}; *(LAS f32x4*)(d_ + (off_) + 4) = (f32x4){t_[4], t_[5], t_[6], t_[7]}; } while (0)
#define SCAN_WRITE(bufi) do { LAS float* d_ = L + (bufi) * BUF + lrow * 384 + lpart * 8; float ta_[8], tb_[8]; \
        unpack8(ra, ta_); unpack8(rb, tb_); float tc_[8]; unpack8(rc, tc_); \
        if (lo) { float kd_[8], bb_[8]; _Pragma("unroll") for (int i_ = 0; i_ < 8; ++i_) { kd_[i_] = ta_[i_] * (1.0f + (tc_[i_] - 1.0f) * ka[i_]); bb_[i_] = tb_[i_] * tc_[i_]; } \
            SCAN_ST8(64, kd_); SCAN_ST8(128, bb_); SCAN_ST8(192, tb_); } \
        else { _Pragma("unroll") for (int i_ = 0; i_ < 8; ++i_) tc_[i_] = __builtin_amdgcn_exp2f(tc_[i_]); SCAN_ST8(0, tc_); SCAN_ST8(256, ta_); SCAN_ST8(320, tb_); } } while (0)
        __syncthreads();
        SCAN_LOAD(0); SCAN_WRITE(0); __syncthreads();
        for (int q = 0; q < 136; ++q) {
            const int bi = q & 1;
            if (q + 1 < 136) SCAN_LOAD(q + 1);
            const LAS float* base = L + bi * BUF + (dir ? 31 * 384 : 0); const int stp = dir ? -384 : 384;
            LAS float* yb = L + YB0 + bi * YBUF + (dir ? 31 * 64 : 0) + vrow; const int ystp = dir ? -64 : 64;
#define SUM2_ROW16(a_, b_) asm volatile("s_nop 1\n\t" \
    "v_add_f32_dpp %0, %0, %0 row_ror:8 row_mask:0xf bank_mask:0xf\n\tv_add_f32_dpp %1, %1, %1 row_ror:8 row_mask:0xf bank_mask:0xf\n\ts_nop 0\n\t" \
    "v_add_f32_dpp %0, %0, %0 row_ror:4 row_mask:0xf bank_mask:0xf\n\tv_add_f32_dpp %1, %1, %1 row_ror:4 row_mask:0xf bank_mask:0xf\n\ts_nop 0\n\t" \
    "v_add_f32_dpp %0, %0, %0 row_ror:2 row_mask:0xf bank_mask:0xf\n\tv_add_f32_dpp %1, %1, %1 row_ror:2 row_mask:0xf bank_mask:0xf\n\ts_nop 0\n\t" \
    "v_add_f32_dpp %0, %0, %0 row_ror:1 row_mask:0xf bank_mask:0xf\n\tv_add_f32_dpp %1, %1, %1 row_ror:1 row_mask:0xf bank_mask:0xf\n\ts_nop 1" : "+v"(a_), "+v"(b_))
            f32x4 nw4 = *(const LAS f32x4*)(base + li4), nd4 = *(const LAS f32x4*)(base + 64 + li4), nb4 = *(const LAS f32x4*)(base + 128 + li4), nn4 = *(const LAS f32x4*)(base + 192 + li4), nr4 = *(const LAS f32x4*)(base + 256 + li4);
            f32x2 nv2 = *(const LAS f32x2*)(base + 320 + vrow);
#pragma unroll 4
            for (int s = 0; s < 32; ++s) {
                const f32x4 w4 = nw4, d4 = nd4, b4 = nb4, n4 = nn4, r4 = nr4; const f32x2 v2 = nv2;
                { const LAS float* p = base + (s < 31 ? s + 1 : s) * stp;
                  nw4 = *(const LAS f32x4*)(p + li4); nd4 = *(const LAS f32x4*)(p + 64 + li4); nb4 = *(const LAS f32x4*)(p + 128 + li4); nn4 = *(const LAS f32x4*)(p + 192 + li4); nr4 = *(const LAS f32x4*)(p + 256 + li4);
                  nv2 = *(const LAS f32x2*)(p + 320 + vrow); }
                f32x2 pk = S2[0] * n4[0]; pk = S2[1] * n4[1] + pk; pk = S2[2] * n4[2] + pk; pk = S2[3] * n4[3] + pk;
                SUM2_ROW16(pk.x, pk.y); const f32x2 nsk = -pk;
#pragma unroll
                for (int qq = 0; qq < 4; ++qq) S2[qq] = S2[qq] * w4[qq] + (v2 * d4[qq] + nsk * b4[qq]);
                f32x2 yk = S2[0] * r4[0]; yk = S2[1] * r4[1] + yk; yk = S2[2] * r4[2] + yk; yk = S2[3] * r4[3] + yk;
                SUM2_ROW16(yk.x, yk.y);
                if ((lane & 15) == 0) *(LAS f32x2*)(yb + s * ystp) = yk;
            }
#undef SUM2_ROW16
            if (!lo) {
                const LAS float* pr = L + bi * BUF + lrow * 384 + lpart * 8; const f32x4 r0 = *(const LAS f32x4*)(pr + 256), r1 = *(const LAS f32x4*)(pr + 260), k0 = *(const LAS f32x4*)(pr + 64), k1 = *(const LAS f32x4*)(pr + 68);
                float sb = 0.f;
#pragma unroll
                for (int e = 0; e < 4; ++e) sb += r0[e] * k0[e] * ka[e] + r1[e] * k1[e] * ka[4 + e];
                sb = sum8(sb);
                if (lpart == 0) BON[((size_t)SCAN_M0(q) + lrow) * 32] = sb; }
            if (q + 1 < 136) SCAN_WRITE(bi ^ 1);
            __syncthreads();
            if (tid < 256) { const LAS float* ys = L + YB0 + bi * YBUF + lrow * 64 + lpart * 8; float t[8];
                const f32x4 y0 = *(const LAS f32x4*)ys, y1 = *(const LAS f32x4*)(ys + 4);
#pragma unroll
                for (int e = 0; e < 4; ++e) { t[e] = y0[e]; t[4 + e] = y1[e]; }
                *(u32x4*)(YS + doff + ((size_t)SCAN_M0(q) + lrow) * D + hc + lpart * 8) = pack8(t); }
        }
        __syncthreads();
#undef SCAN_M0
#undef SCAN_LOAD
#undef SCAN_WRITE
#undef SCAN_ST8
    }
}

__device__ __forceinline__ void outprep_phase(const Frame F, KArgs* a, int jr) {
    const int lane_ = lane_opaque(), tid_ = F.wave * 64 + lane_; (void)tid_; (void)lane_;
    const bf16_t* YS = (const bf16_t*)(a->ws + WS_YS); const float* BON = (const float*)(a->ws + WS_BON);
    const bf16_t* VV = (const bf16_t*)(a->ws + WS_VV); const bf16_t* GG = (const bf16_t*)(a->ws + WS_GG);
    bf16_t* PREP = (bf16_t*)(a->ws + WS_PREP);
    const float* lw = a->in[28] + (size_t)jr * D; const float* lb = a->in[29] + (size_t)jr * D;
    for (int m = F.bid * NWAVES + F.wave; m < M; m += F.G * NWAVES) {
#pragma unroll
        for (int q = 0; q < 4; ++q) { const int e0 = 512 * q + 8 * lane_; const size_t ro = (size_t)m * D + e0;
            float y0[8], y1[8], o[8];
            unpack8(*(const u32x4*)(YS + ro), y0); unpack8(*(const u32x4*)(YS + (size_t)M * D + ro), y1);
            float sm = 0.f;
#pragma unroll
            for (int i = 0; i < 8; ++i) { o[i] = y0[i] + y1[i]; sm += o[i]; }
            const float mean = sum8(sm) * (1.0f / 64.0f);
            float sq = 0.f;
#pragma unroll
            for (int i = 0; i < 8; ++i) { o[i] -= mean; sq += o[i] * o[i]; }
            const float rs = rsqrtf(sum8(sq) * (1.0f / 64.0f) + 64e-5f);
            float v[8], g[8];
            unpack8(*(const u32x4*)(VV + ro), v); unpack8(*(const u32x4*)(GG + ro), g);
            const int hd = e0 >> 6;
            const float bs = BON[(size_t)m * 32 + hd] + BON[(size_t)M * 32 + (size_t)m * 32 + hd];
            float out[8];
#pragma unroll
            for (int i = 0; i < 8; ++i) out[i] = (o[i] * rs * lw[e0 + i] + lb[e0 + i] + bs * v[i]) * g[i];
            *(u32x4*)(PREP + ro) = pack8(out); }
    }
}

__device__ __forceinline__ void attention_phase(const Frame F, KArgs* a) {
    const attn::bf16* Q = (const attn::bf16*)(a->ws + WS_Q); const attn::bf16* K = (const attn::bf16*)(a->ws + WS_K); const attn::bf16* V = (const attn::bf16*)(a->ws + WS_V);
    attn::bf16* O = (attn::bf16*)(a->ws + WS_O);
    for (int u = F.bid; u < 1024 + 64; u += F.G) {
        size_t qoff, koff; int seq;
        if (u < 1024) { const int c = u & 255, i = u >> 8, grp = (c & 7) >> 1, member = (c & 1) * 32 + (c >> 3), bk = i * 4 + grp, b = bk >> 2, kvh = bk & 3, hq = kvh * 4 + (member >> 4), qb = member & 15;
            qoff = (size_t)(b * TB + CTXL + qb * 256) * 2048 + hq * 128; koff = (size_t)b * TB * 512 + kvh * 128; seq = TB; }
        else { const int cu = u - 1024, b = cu >> 4, hq = cu & 15, kvh = hq >> 2;
            qoff = (size_t)(b * TB) * 2048 + hq * 128; koff = (size_t)b * TB * 512 + kvh * 128; seq = CTXL; }
        attn::attn_dense_body<attn::bf16>(Q + qoff, K + koff, V + koff, O + qoff, seq, (char*)F.ldsg, F.wave);
        __syncthreads();
    }
}

#ifndef EN_P0
#define EN_P0 1
#endif
#ifndef EN_THIN
#define EN_THIN 1
#endif
#ifndef EN_QKN
#define EN_QKN 1
#endif
#ifndef EN_ATT
#define EN_ATT 1
#endif
#ifndef EN_MIX
#define EN_MIX 1
#endif
#ifndef EN_SCAN
#define EN_SCAN 1
#endif
#ifndef EN_OPREP
#define EN_OPREP 1
#endif
#ifndef EN_FFN
#define EN_FFN 1
#endif
#ifndef EN_GQKV
#define EN_GQKV 1
#endif
#ifndef EN_GWO
#define EN_GWO 1
#endif
#ifndef EN_RW1
#define EN_RW1 1
#endif
#ifndef EN_RW2
#define EN_RW2 1
#endif
__device__ __forceinline__ KArgs* opaque_k(KArgs* p) { asm volatile("" : "+s"(p)); return p; }
#ifndef DBG_STOP
#define DBG_STOP -1
#endif
__device__ __forceinline__ Frame fresh(const Frame& F) { Frame R = F; asm volatile("" : "+s"(R.bid), "+s"(R.G), "+s"(R.wave)); return R; }
#ifndef GEMM_ALIGN
#define GEMM_ALIGN true
#define GEMM_SP2 true
#endif
#ifndef RW2_ALIGN
#define RW2_ALIGN true
#define RW2_SP2 true
#endif
#ifndef RW1_ALIGN
#define RW1_ALIGN true
#define RW1_SP2 true
#endif
#ifndef REP_THIN
#define REP_THIN 1
#endif
#ifndef REP_OG
#define REP_OG 1
#endif
#ifndef REP_EW
#define REP_EW 1
#endif
#ifndef REP_FFN1
#define REP_FFN1 1
#endif
#ifndef REP_FFN2
#define REP_FFN2 1
#endif
#ifndef REP_P0
#define REP_P0 1
#endif
#ifndef REP_SCAN
#define REP_SCAN 1
#endif
#ifndef REP_ATT
#define REP_ATT 1
#endif
#ifndef REP_RW1
#define REP_RW1 1
#endif
constexpr int NPHASE = 50;
constexpr int STOP_PHASE = (DBG_STOP >= 0) ? DBG_STOP : NPHASE - 1;
__global__ void __launch_bounds__(NTHR, 2) fwd_kernel(Args args) {
    extern __shared__ __attribute__((aligned(16))) unsigned char lds[];
    Frame F;
    F.lds = (LAS unsigned char*)lds; F.ldsg = lds;
    F.wave = __builtin_amdgcn_readfirstlane((int)threadIdx.x >> 6);
    F.G = gridDim.x; F.bid = blockIdx.x;
    for (int u = threadIdx.x; u < (LDS_BYTES - LDSCTL_OFF) / 4; u += NTHR) ((LAS unsigned*)(F.lds + LDSCTL_OFF))[u] = 0u;
    __syncthreads();
    KArgs* const kap = (KArgs*)__builtin_amdgcn_kernarg_segment_ptr();
    XcdBarrier bar = xcd_barrier_post((unsigned*)(kap->ws + WS_CTL) + CW_BAR + kap->li * XCD_BAR_WORDS, (volatile LAS unsigned*)(F.lds + MISC_OFF) + 8);
#define KA (opaque_k(kap))
#define ws (KA->ws)
#define IN(k) ((k) <= STOP_PHASE)
#define SEAM(k) do { if (IN(k) && IN((k) + 1)) { XcdBarrier bb_ = bar; asm volatile("" : "+s"(bb_.x), "+s"(bb_.bar)); xcd_barrier(bb_, fresh(F).wave == 0 && lane_opaque() == 0); } } while (0)
#define Yb ((bf16_t*)(ws + WS_Y))
#define ACTb ((bf16_t*)(ws + WS_ACT))
#define OUTb ((bf16_t*)(ws + WS_OUT))
#define BAR_NOW() do { XcdBarrier bb_ = bar; asm volatile("" : "+s"(bb_.x), "+s"(bb_.bar)); xcd_barrier(bb_, fresh(F).wave == 0 && lane_opaque() == 0); } while (0)
#define FFN_HALF(pk, lh, FINAL, tl, ts, tw, tnl, tns) do { \
    for (int rep_ = 0; rep_ < REP_FFN1; ++rep_) { if (rep_) __syncthreads(); \
    if (EN_FFN && IN(pk)) { const Frame Ff_ = fresh(F); const bf16_t* w1_ = (const bf16_t*)(ws + WS_WB) + (size_t)(lh) * (E_F1 + E_F2); \
        pg8::Gemm g_{Yb, w1_, D}; EpiSwiGLU E_{ACTb}; \
        if (FINAL) { LatentOrder S_; S_.init_lat(2 * FF, Ff_.G, Ff_.bid); pg8::gemm_phase<EpiSwiGLU, LatentOrder, pg8::Gemm, GEMM_ALIGN, GEMM_SP2>(Ff_.lds, g_, S_, E_, Ff_.wave); } \
        else { pg8::StaticOrder S_; S_.init(M, 2 * FF, Ff_.G, Ff_.bid); pg8::gemm_phase<EpiSwiGLU, pg8::StaticOrder, pg8::Gemm, GEMM_ALIGN, GEMM_SP2>(Ff_.lds, g_, S_, E_, Ff_.wave); } } } \
    SEAM(pk); \
    for (int rep_ = 0; rep_ < REP_FFN2; ++rep_) { if (rep_) __syncthreads(); \
    if (EN_FFN && IN((pk) + 1)) { const Frame Ff_ = fresh(F); const bf16_t* w2_ = (const bf16_t*)(ws + WS_WB) + (size_t)(lh) * (E_F1 + E_F2) + E_F1; \
        pg8::Gemm g_{ACTb, w2_, FF}; LatentOrder S_; S_.init_lat(D, Ff_.G, Ff_.bid); EpiPlain E_{OUTb, D}; \
        pg8::gemm_phase<EpiPlain, LatentOrder, pg8::Gemm, GEMM_ALIGN, GEMM_SP2>(Ff_.lds, g_, S_, E_, Ff_.wave); } } \
    SEAM((pk) + 1); \
    if (IN((pk) + 2)) { const Frame Ff_ = fresh(F); \
        if (Ff_.bid < NCTXWG) { if (!(FINAL)) { const bf16_t* w2_ = (const bf16_t*)(ws + WS_WB) + (size_t)(lh) * (E_F1 + E_F2) + E_F1; \
            GemmCtxSplit g_{ACTb, w2_, FF}; CtxOrder2 S_{Ff_.bid}; EpiCtxPart E_{(float*)(ws + WS_PART)}; \
            pg8::gemm_phase<EpiCtxPart, CtxOrder2, GemmCtxSplit, GEMM_ALIGN, GEMM_SP2>(Ff_.lds, g_, S_, E_, Ff_.wave); } } \
        else { for (int rt_ = 1; rt_ < REP_THIN; ++rt_) { if (!(FINAL)) thin_phase<1, 1>(Ff_, KA, tl, ts, 0.f, tnl, tns); } if (FINAL) thin_phase<2, 1>(Ff_, KA, tl, ts, tw, tnl, tns); else thin_phase<1, 1>(Ff_, KA, tl, ts, tw, tnl, tns); } \
        if (!(FINAL)) { BAR_NOW(); thin_phase<1, 2>(fresh(F), KA, tl, ts, tw, tnl, tns); } } \
    SEAM((pk) + 2); } while (0)

    for (int rep_ = 0; rep_ < REP_P0; ++rep_) { if (rep_) __syncthreads(); if (EN_P0 && IN(0)) p0a_phase(fresh(F), KA); }
    SEAM(0);
    if (EN_THIN && IN(1)) thin_phase<0, 0>(fresh(F), KA, 0, 0, 0.f, 0, 0);
    SEAM(1);
    for (int lp = 0; lp < 2; ++lp) {
        const int pb = 2 + 24 * lp, la = 2 * lp, lr = 2 * lp + 1;
        FFN_HALF(pb + 0, la * 2 + 0, 0, la, 0, 0.5f, la, 1);
        for (int rep_ = 0; rep_ < REP_OG; ++rep_) { if (rep_) __syncthreads();
        if (EN_GQKV && IN(pb + 3)) { const Frame Ff = fresh(F); const bf16_t* wq = (const bf16_t*)(ws + WS_WA) + (size_t)lp * (E_QKV + E_SQ);
            pg8::Gemm g{Yb, wq, D}; pg8::StaticOrder S; S.init(M, 3072, Ff.G, Ff.bid); EpiQKV E{ws};
            pg8::gemm_phase<EpiQKV, pg8::StaticOrder, pg8::Gemm, GEMM_ALIGN, GEMM_SP2>(Ff.lds, g, S, E, Ff.wave); } }
        SEAM(pb + 3);
        if (EN_QKN && IN(pb + 4)) qknorm_phase(fresh(F), KA, lp);
        SEAM(pb + 4);
        for (int rep_ = 0; rep_ < REP_ATT; ++rep_) { if (rep_) __syncthreads(); if (EN_ATT && IN(pb + 5)) attention_phase(fresh(F), KA); }
        SEAM(pb + 5);
        for (int rep_ = 0; rep_ < REP_OG; ++rep_) { if (rep_) __syncthreads();
        if (EN_GWO && IN(pb + 6)) { const Frame Ff = fresh(F); const bf16_t* wo = (const bf16_t*)(ws + WS_WA) + (size_t)lp * (E_QKV + E_SQ) + E_QKV;
            pg8::Gemm g{(const bf16_t*)(ws + WS_O), wo, D}; pg8::StaticOrder S; S.init(M, D, Ff.G, Ff.bid); EpiPlain E{OUTb, D};
            pg8::gemm_phase<EpiPlain, pg8::StaticOrder, pg8::Gemm, GEMM_ALIGN, GEMM_SP2>(Ff.lds, g, S, E, Ff.wave); } }
        SEAM(pb + 6);
        if (EN_THIN && IN(pb + 7)) thin_phase<1, 0>(fresh(F), KA, la, 1, 1.0f, la, 2);
        SEAM(pb + 7);
        FFN_HALF(pb + 8, la * 2 + 1, 0, la, 2, 0.5f, lr, 0);
        FFN_HALF(pb + 11, lr * 2 + 0, 0, lr, 0, 0.5f, lr, 1);
        for (int rep_ = 0; rep_ < REP_EW; ++rep_) { if (EN_MIX && IN(pb + 14)) mixes_phase(fresh(F), KA, lp); }
        SEAM(pb + 14);
#ifdef DBG_DOUBLE_BAR
        SEAM(pb + 14);
#endif
#define rw1 ((const bf16_t*)(ws + WS_WR) + (size_t)lp * (E_RW1 + E_RW2 + E_SQ))
        for (int rep_ = 0; rep_ < REP_OG; ++rep_) { if (rep_) __syncthreads();
        if (EN_RW1 && IN(pb + 15)) { const Frame Ff = fresh(F); GemmRw1 g{(const bf16_t*)(ws + WS_MIX6), rw1, D}; pg8::StaticOrder S; S.init(M, 6912, Ff.G, Ff.bid);
            EpiRw1 E{ws, KA->in[25] + (size_t)lp * D};
            pg8::gemm_phase<EpiRw1, pg8::StaticOrder, GemmRw1, RW1_ALIGN, RW1_SP2>(Ff.lds, g, S, E, Ff.wave); } }
        SEAM(pb + 15);
        for (int rep_ = 0; rep_ < REP_OG; ++rep_) { if (rep_) __syncthreads();
        if (EN_RW2 && IN(pb + 16)) { const Frame Ff = fresh(F); int k2_ = 256; asm volatile("" : "+s"(k2_));     GemmRw2 g{ws, rw1 + E_RW1, k2_}; pg8::StaticOrder S; S.init(M, 10240, Ff.G, Ff.bid);
            EpiRw2 E{ws,
                     KA->in[19] + (size_t)lp * 2 * D, KA->in[22] + (size_t)lp * 2 * D, WS_AA};
            pg8::gemm_phase<EpiRw2, pg8::StaticOrder, GemmRw2, RW2_ALIGN, RW2_SP2>(Ff.lds, g, S, E, Ff.wave); } }
        #ifdef DBG_RW2_TWICE
        __syncthreads();
        if (EN_RW2 && IN(pb + 16)) { const Frame Ff = fresh(F); int k2_ = 256; asm volatile("" : "+s"(k2_));     GemmRw2 g{ws, rw1 + E_RW1, k2_}; pg8::StaticOrder S; S.init(M, 10240, Ff.G, Ff.bid);
            EpiRw2 E{ws,
                     KA->in[19] + (size_t)lp * 2 * D, KA->in[22] + (size_t)lp * 2 * D, WS_END};
            pg8::gemm_phase<EpiRw2, pg8::StaticOrder, GemmRw2, RW2_ALIGN, RW2_SP2>(Ff.lds, g, S, E, Ff.wave); }
#endif
        SEAM(pb + 16);
        for (int rep_ = 0; rep_ < REP_SCAN; ++rep_) { if (rep_) __syncthreads(); if (EN_SCAN && IN(pb + 17)) scan_phase(fresh(F), KA, lp); }
        SEAM(pb + 17);
        for (int rep_ = 0; rep_ < REP_EW; ++rep_) { if (EN_OPREP && IN(pb + 18)) outprep_phase(fresh(F), KA, lp); }
        SEAM(pb + 18);
        for (int rep_ = 0; rep_ < REP_OG; ++rep_) { if (rep_) __syncthreads();
        if (EN_GWO && IN(pb + 19)) { const Frame Ff = fresh(F); pg8::Gemm g{(const bf16_t*)(ws + WS_PREP), rw1 + E_RW1 + E_RW2, D}; pg8::StaticOrder S; S.init(M, D, Ff.G, Ff.bid); EpiPlain E{OUTb, D};
            pg8::gemm_phase<EpiPlain, pg8::StaticOrder, pg8::Gemm, GEMM_ALIGN, GEMM_SP2>(Ff.lds, g, S, E, Ff.wave); } }
        SEAM(pb + 19);
        if (EN_THIN && IN(pb + 20)) thin_phase<1, 0>(fresh(F), KA, lr, 1, 1.0f, lr, 2);
        SEAM(pb + 20);
        if (lp == 1) FFN_HALF(pb + 21, lr * 2 + 1, 1, lr, 2, 0.5f, 0, 0); else FFN_HALF(pb + 21, lr * 2 + 1, 0, lr, 2, 0.5f, lr + 1, 0);
    }
    if (DBG_STOP >= 0) { xcd_barrier(bar, fresh(F).wave == 0 && lane_opaque() == 0); copyout_phase(fresh(F), KA); }
#undef IN
#undef SEAM
#undef FFN_HALF
#undef BAR_NOW
#undef rw1
#undef ws
#undef KA
#undef Yb
#undef ACTb
#undef OUTb
}

extern "C" void kernel_launch(void* const* d_in, const int* in_sizes, int n_in, void* d_out, int out_size, void* d_ws, size_t ws_size, hipStream_t stream) {
    static int grid = 0;
    if (grid == 0) {
        if (n_in != 30 || in_sizes[0] != NB * SEQ * D || out_size != NB * SEQ * D || ws_size < WS_END) {
            fprintf(stderr, "kernel_launch: shape mismatch: n_in %d in0 %d out %d ws %zu (need >= %zu)\n", n_in, n_in > 0 ? in_sizes[0] : -1, out_size, ws_size, (size_t)WS_END); grid = -1; return; }
        int dev = 0, cus = 0, per_cu = 0;
        if (hipGetDevice(&dev) != hipSuccess || hipDeviceGetAttribute(&cus, hipDeviceAttributeMultiprocessorCount, dev) != hipSuccess) { fprintf(stderr, "kernel_launch: device query failed\n"); grid = -1; return; }
        if (hipFuncSetAttribute((const void*)fwd_kernel, hipFuncAttributeMaxDynamicSharedMemorySize, LDS_BYTES) != hipSuccess) { fprintf(stderr, "kernel_launch: hipFuncSetAttribute failed\n"); grid = -1; return; }
        if (hipOccupancyMaxActiveBlocksPerMultiprocessor(&per_cu, (const void*)fwd_kernel, NTHR, LDS_BYTES) != hipSuccess || per_cu < 1) { fprintf(stderr, "kernel_launch: occupancy query says %d blocks per CU\n", per_cu); }
        (void)hipGetLastError();
        grid = cus;
        if (grid > 256) grid = 256;
    }
    if (grid < 0) return;
    if (hipMemsetAsync((char*)d_ws + WS_CTL, 0, CTL_ZERO_BYTES, stream) != hipSuccess) { fprintf(stderr, "kernel_launch: memset failed\n"); return; }
    Args a{};
    for (int i = 0; i < 30; ++i) a.in[i] = (const float*)d_in[i];
    a.out = (float*)d_out; a.ws = (unsigned char*)d_ws;
    a.ph_lo = 0; a.ph_hi = NPHASE; a.li = 0; a.dbg = 0;
    hipLaunchKernelGGL(fwd_kernel, dim3(grid), dim3(NTHR), LDS_BYTES, stream, a);
    const hipError_t le = hipPeekAtLastError();
    if (le != hipSuccess) fprintf(stderr, "kernel_launch: launch failed: %s\n", hipGetErrorName(le));
}
```

```cpp
#include <hip/hip_runtime.h>
#include <cstdio>
#include <cstdint>
#include <cmath>
__device__ __forceinline__ int lane_opaque() { int l; asm volatile("v_mbcnt_lo_u32_b32 %0, -1, 0\n\tv_mbcnt_hi_u32_b32 %0, -1, %0" : "=v"(l)); return l; }
namespace pg8 {
#define PG8_LAS __attribute__((address_space(3)))
typedef unsigned short bf16_t;
typedef short bf16x8 __attribute__((ext_vector_type(8)));
typedef float f32x4 __attribute__((ext_vector_type(4)));
typedef unsigned u32x4 __attribute__((ext_vector_type(4)));
constexpr int BM = 256, BK = 64, HALF = 128, HTB = HALF * BK * 2  , STAGE_BYTES = 8 * HTB, NXCD = 8, WGM = 8;

__host__ __device__ __forceinline__ int lds_byte(int r, int c) { const int st = (r >> 4) * 2 + (c >> 5), rr = r & 15, cc = c & 31, ob = rr * 64 + cc * 2; return st * 1024 + (ob ^ (((ob >> 9) & 1) << 5)); }
__host__ __device__ __forceinline__ void stage_rc(int b, int& R, int& C) { const int st = b / 1024, sb = b % 1024, swz = sb ^ (((sb >> 9) & 1) << 5); R = (st >> 1) * 16 + swz / 64; C = (st & 1) * 32 + (swz % 64) / 2; }
__host__ __device__ __forceinline__ int perm32(int rho) { const int n = rho >> 4, i = rho & 15; return 8 * (i >> 2) + 4 * n + (i & 3); }

struct Unit { int pm, pn; };
struct Gemm { const bf16_t* A; const bf16_t* Bt; int K;
    __device__ __forceinline__ const char* a_tile(const Unit& u) const { return (const char*)A + (size_t)u.pm * (size_t)(BM * 2) * K; }
    __device__ __forceinline__ const char* b_tile(const Unit& u) const { return (const char*)Bt + (size_t)u.pn * (size_t)(BM * 2) * K; }
    __device__ __forceinline__ int klen() const { return K; } };

struct StaticOrder {
    int nM, nN, nwg, G, c;
    __host__ __device__ void init(int M, int N, int G_, int c_) { nM = M / BM; nN = N / BM; nwg = nM * nN; G = G_; c = c_; }
    __host__ __device__ bool next(int i, Unit& u) const {
        const long L = (long)i * G + c; if (L >= nwg) return false;
        int wgid = (int)L; { const int q = nwg / NXCD, r = nwg % NXCD, xcd = wgid % NXCD, off = wgid / NXCD; wgid = (xcd < r ? xcd * (q + 1) : r * (q + 1) + (xcd - r) * q) + off; }
        const int nig = WGM * nN, gid = wgid / nig, fm = gid * WGM, gsz = (nM - fm) < WGM ? (nM - fm) : WGM;
        u.pm = fm + ((wgid % nig) % gsz); u.pn = (wgid % nig) / gsz; return true;
    }
    __device__ __forceinline__ void a_ready(const Unit&) const {}
    __device__ __forceinline__ void done(const Unit&) const {}
};

typedef __bf16 bf16x2_cv __attribute__((ext_vector_type(2)));
typedef float f32x2_cv __attribute__((ext_vector_type(2)));
__device__ __forceinline__ unsigned cvt_pk_bf16(float lo, float hi) { const f32x2_cv v = {lo, hi}; const bf16x2_cv b = __builtin_convertvector(v, bf16x2_cv); return __builtin_bit_cast(unsigned, b); }

template <class Epi, class Sched, class GT, bool ALIGN_EPI = false, bool SP2 = false>
__device__ __forceinline__ void gemm_phase(PG8_LAS unsigned char* lds, const GT g, const Sched& S, const Epi& E, const int wid  ) {
    const int lane = lane_opaque(), tid = wid * 64 + lane, wr = wid >> 2, wc = wid & 3, fr = lane & 15, fq = lane >> 4;
    const int K = g.K, nt = g.klen() / BK;
    unsigned voffA[2], voffB[2];
#pragma unroll
    for (int i = 0; i < 2; ++i) { int R, C; stage_rc(tid * 16 + i * 8192, R, C); const int Rb = Epi::PERM ? ((R & ~31) + perm32(R & 31)) : R;
        voffA[i] = (unsigned)(R * K + C) * 2u; voffB[i] = (unsigned)(Rb * K + C) * 2u; }
    asm volatile("" : "+v"(voffA[0]), "+v"(voffA[1]), "+v"(voffB[0]), "+v"(voffB[1]));
    const size_t kstep = (size_t)(BK * 2);
    const size_t hstep = (size_t)HALF * K * 2;
    const unsigned ldsw = (unsigned)wid * 1024u;
    const int aoff = lds_byte(wr * 64 + fr, fq * 8), boff = lds_byte(wc * 32 + fr, fq * 8);
#define PG8_SA(b, h) (((b) * 2 + (h)) * HTB)
#define PG8_SB(b, h) ((4 + (b) * 2 + (h)) * HTB)
#define PG8_STAGE(bufoff, gbase, voff) do { _Pragma("unroll") for (int _i = 0; _i < 2; ++_i) \
        __builtin_amdgcn_global_load_lds((const unsigned*)((const char*)(gbase) + (voff)[_i]), (PG8_LAS unsigned*)(lds + (bufoff) + ldsw + _i * 8192), 16, 0, 0); } while (0)
#define PG8_LDA(dst, b, h) do { _Pragma("unroll") for (int m = 0; m < 4; ++m) _Pragma("unroll") for (int k = 0; k < 2; ++k) dst[m][k] = *(const PG8_LAS bf16x8*)(lds + PG8_SA(b, h) + aoff + m * 2048 + k * 1024); } while (0)
#define PG8_LDB(dst, b, h) do { _Pragma("unroll") for (int n = 0; n < 2; ++n) _Pragma("unroll") for (int k = 0; k < 2; ++k) dst[n][k] = *(const PG8_LAS bf16x8*)(lds + PG8_SB(b, h) + boff + n * 2048 + k * 1024); } while (0)
#define PG8_MMA(ai, bj, At, Bt) do { __builtin_amdgcn_s_setprio(1); _Pragma("unroll") for (int m = 0; m < 4; ++m) _Pragma("unroll") for (int n = 0; n < 2; ++n) _Pragma("unroll") for (int k = 0; k < 2; ++k) \
        acc[ai][bj][m][n] = __builtin_amdgcn_mfma_f32_16x16x32_bf16(Bt[n][k], At[m][k], acc[ai][bj][m][n], 0, 0, 0); __builtin_amdgcn_s_setprio(0); } while (0)
#define PG8_WAIT_V(n) asm volatile("s_waitcnt vmcnt(" #n ")" ::: "memory")
#define PG8_WAIT_L(n) asm volatile("s_waitcnt lgkmcnt(" #n ")" ::: "memory")
#define PG8_BAR __builtin_amdgcn_s_barrier()
#define PG8_SCHED __builtin_amdgcn_sched_barrier(0)
    Unit cur, nxt; int ui = 0;
    if (!S.next(0, cur)) return;
    f32x4 acc[2][2][4][2];
#pragma unroll
    for (int a = 0; a < 2; ++a)
#pragma unroll
        for (int b = 0; b < 2; ++b)
#pragma unroll
            for (int m = 0; m < 4; ++m)
#pragma unroll
                for (int n = 0; n < 2; ++n) acc[a][b][m][n] = (f32x4){0.f, 0.f, 0.f, 0.f};
    bf16x8 At[4][2], B0[2][2], B1[2][2];
    const char* cA = g.a_tile(cur); const char* cB = g.b_tile(cur);
    S.a_ready(cur);
    if constexpr (SP2) {
        PG8_STAGE(PG8_SB(0, 0), cB, voffB); PG8_STAGE(PG8_SB(0, 1), cB + hstep, voffB); PG8_STAGE(PG8_SA(0, 0), cA, voffA); PG8_STAGE(PG8_SA(0, 1), cA + hstep, voffA);
        if (wr == 1) PG8_BAR;
        PG8_WAIT_V(2); PG8_BAR;
        PG8_STAGE(PG8_SB(1, 0), cB + kstep, voffB); PG8_STAGE(PG8_SA(1, 0), cA + kstep, voffA); PG8_STAGE(PG8_SB(1, 1), cB + hstep + kstep, voffB);
        PG8_WAIT_V(6); PG8_BAR;
    } else {
        PG8_STAGE(PG8_SB(0, 0), cB, voffB); PG8_STAGE(PG8_SA(0, 0), cA, voffA); PG8_STAGE(PG8_SB(0, 1), cB + hstep, voffB); PG8_STAGE(PG8_SA(0, 1), cA + hstep, voffA);
        if (wr == 1) PG8_BAR;
        PG8_WAIT_V(4); PG8_BAR;
        PG8_STAGE(PG8_SB(1, 0), cB + kstep, voffB); PG8_STAGE(PG8_SA(1, 0), cA + kstep, voffA); PG8_STAGE(PG8_SB(1, 1), cB + hstep + kstep, voffB);
        PG8_WAIT_V(6); PG8_BAR;
    }
    for (;;) {
        const bool has_next = S.next(ui + 1, nxt);
        const char* nA = has_next ? g.a_tile(nxt) : cA; const char* nB = has_next ? g.b_tile(nxt) : cB;
        for (int t = 0; t < nt; t += 2) {
            const bool last = (t == nt - 2);
            const char* a1 = cA + (size_t)(t + 1) * kstep;
            const char* a2 = last ? nA : cA + (size_t)(t + 2) * kstep; const char* b2 = last ? nB : cB + (size_t)(t + 2) * kstep;
            const char* a3 = a2 + kstep; const char* b3 = b2 + kstep;
            if (last && has_next) S.a_ready(nxt);
            if constexpr (SP2) {
            PG8_LDB(B0, 0, 0); PG8_LDB(B1, 0, 1); PG8_SCHED; PG8_LDA(At, 0, 0); PG8_STAGE(PG8_SA(1, 1), a1 + hstep, voffA);
            PG8_WAIT_V(8); PG8_WAIT_L(0); PG8_BAR; PG8_MMA(0, 0, At, B0); PG8_MMA(0, 1, At, B1); PG8_BAR; PG8_SCHED;
            PG8_LDA(At, 0, 1); PG8_STAGE(PG8_SB(0, 0), b2, voffB); PG8_STAGE(PG8_SB(0, 1), b2 + hstep, voffB); PG8_STAGE(PG8_SA(0, 0), a2, voffA);
            PG8_WAIT_V(8); PG8_WAIT_L(0); PG8_BAR; PG8_MMA(1, 0, At, B0); PG8_MMA(1, 1, At, B1); PG8_BAR; PG8_SCHED;
            PG8_LDB(B0, 1, 0); PG8_LDB(B1, 1, 1); PG8_SCHED; PG8_LDA(At, 1, 0); PG8_STAGE(PG8_SA(0, 1), a2 + hstep, voffA);
            PG8_WAIT_V(8); PG8_WAIT_L(0); PG8_BAR; PG8_MMA(0, 0, At, B0); PG8_MMA(0, 1, At, B1); PG8_BAR; PG8_SCHED;
            PG8_LDA(At, 1, 1); PG8_STAGE(PG8_SB(1, 0), b3, voffB); PG8_STAGE(PG8_SB(1, 1), b3 + hstep, voffB); PG8_STAGE(PG8_SA(1, 0), a3, voffA);
            PG8_WAIT_V(8); PG8_WAIT_L(0); PG8_BAR; PG8_MMA(1, 0, At, B0); PG8_MMA(1, 1, At, B1); PG8_BAR; PG8_SCHED;
            } else {
            PG8_LDB(B0, 0, 0); PG8_SCHED; PG8_LDA(At, 0, 0); PG8_STAGE(PG8_SA(1, 1), a1 + hstep, voffA);
            PG8_WAIT_L(8); PG8_BAR; PG8_WAIT_L(0); PG8_MMA(0, 0, At, B0); PG8_BAR; PG8_SCHED;
            PG8_LDB(B1, 0, 1); PG8_STAGE(PG8_SB(0, 0), b2, voffB);
            PG8_BAR; PG8_WAIT_L(0); PG8_MMA(0, 1, At, B1); PG8_BAR;
            PG8_LDA(At, 0, 1); PG8_STAGE(PG8_SA(0, 0), a2, voffA);
            PG8_BAR; PG8_WAIT_L(0); PG8_MMA(1, 0, At, B0); PG8_BAR; PG8_SCHED;
            PG8_STAGE(PG8_SB(0, 1), b2 + hstep, voffB);
            PG8_WAIT_V(6); PG8_BAR; PG8_MMA(1, 1, At, B1); PG8_BAR;
            PG8_LDB(B0, 1, 0); PG8_SCHED; PG8_LDA(At, 1, 0); PG8_STAGE(PG8_SA(0, 1), a2 + hstep, voffA);
            PG8_WAIT_L(8); PG8_BAR; PG8_WAIT_L(0); PG8_MMA(0, 0, At, B0); PG8_BAR; PG8_SCHED;
            PG8_LDB(B1, 1, 1); PG8_STAGE(PG8_SB(1, 0), b3, voffB);
            PG8_BAR; PG8_WAIT_L(0); PG8_MMA(0, 1, At, B1); PG8_BAR;
            PG8_LDA(At, 1, 1); PG8_STAGE(PG8_SA(1, 0), a3, voffA);
            PG8_BAR; PG8_WAIT_L(0); PG8_MMA(1, 0, At, B0); PG8_BAR; PG8_SCHED;
            PG8_STAGE(PG8_SB(1, 1), b3 + hstep, voffB);
            PG8_WAIT_V(6); PG8_BAR; PG8_MMA(1, 1, At, B1); PG8_BAR;
            }
        }
        if constexpr (ALIGN_EPI) { if (wr == 0) PG8_BAR; }
        if constexpr (!Epi::AFTER_DRAIN) { E(acc, cur, wr, wc, fr, fq); S.done(cur); }
        if (!has_next) break;
#pragma unroll
        for (int a = 0; a < 2; ++a)
#pragma unroll
            for (int b = 0; b < 2; ++b)
#pragma unroll
                for (int m = 0; m < 4; ++m)
#pragma unroll
                    for (int n = 0; n < 2; ++n) acc[a][b][m][n] = (f32x4){0.f, 0.f, 0.f, 0.f};
        cur = nxt; cA = nA; cB = nB; ++ui;
        if constexpr (ALIGN_EPI) { if (wr == 1) PG8_BAR; }
    }
    PG8_WAIT_V(0);
    if constexpr (!ALIGN_EPI) { if (wr == 0) PG8_BAR; }
    PG8_BAR;
    if constexpr (Epi::AFTER_DRAIN) { E.fused(acc, cur, wr, wc, fr, fq, lds, wid, lane); S.done(cur); }
#undef PG8_SA
#undef PG8_SB
#undef PG8_STAGE
#undef PG8_LDA
#undef PG8_LDB
#undef PG8_MMA
#undef PG8_WAIT_V
#undef PG8_WAIT_L
#undef PG8_BAR
#undef PG8_SCHED
}
}

#define LAS __attribute__((address_space(3)))
#define XB_TMO      128
#define XB_XCNT(j)  (256  + 64 * (j))
#define XB_XSUB(j)  (1280 + 64 * (j))
#define XB_XGEN(j)  (2304 + 64 * (j))
#define XB_TOP      3328
#define XB_TOPGEN   3392
#define XCD_BAR_WORDS 3456
#define XB_SPIN_CAP (1u << 20)

__device__ __forceinline__ unsigned xb_ld(unsigned* p)              { return __hip_atomic_load(p, __ATOMIC_RELAXED, __HIP_MEMORY_SCOPE_AGENT); }
__device__ __forceinline__ unsigned xb_add(unsigned* p, unsigned v) { return __hip_atomic_fetch_add(p, v, __ATOMIC_RELAXED, __HIP_MEMORY_SCOPE_AGENT); }
__device__ __forceinline__ unsigned xb_xcc_id() { return (unsigned)__builtin_amdgcn_s_getreg((3 << 11) | 20) & 0xFu; }
#define XB_SPIN(cond, bar) do { unsigned _sp = 0; while (cond) { __builtin_amdgcn_s_sleep(1); \
    if ((++_sp & 255u) == 0u) { if (xb_ld(&(bar)[XB_TMO])) break; if (_sp > XB_SPIN_CAP) { atomicAdd(&(bar)[XB_TMO], 1u); break; } } } } while (0)

struct XcdBarrier {
    unsigned* bar; unsigned x;
    volatile LAS unsigned* st;
};

__device__ __forceinline__ XcdBarrier xcd_barrier_post(unsigned* bar, volatile LAS unsigned* st) {
    XcdBarrier b; b.bar = bar; b.x = xb_xcc_id(); b.st = st;
    if (threadIdx.x == 0) (void)xb_add(&bar[XB_XCNT(b.x)], 1u);
    return b;
}
__device__ __forceinline__ void xcd_barrier_complete(unsigned* bar, unsigned x, unsigned& nloc, unsigned& nx) {
    const unsigned G = gridDim.x * gridDim.y * gridDim.z;
    unsigned sum, cnt, mine, sp = 0u;
    for (;;) {
        sum = 0u; cnt = 0u; mine = 0u;
#pragma unroll
        for (unsigned j = 0; j < 16; ++j) { const unsigned c = xb_ld(&bar[XB_XCNT(j)]); sum += c; cnt += (c > 0u) ? 1u : 0u; mine = (j == x) ? c : mine; }
        if (sum == G) break;
        __builtin_amdgcn_s_sleep(1);
        if ((++sp & 255u) == 0u) { if (xb_ld(&bar[XB_TMO])) break; if (sp > XB_SPIN_CAP) { atomicAdd(&bar[XB_TMO], 1u); break; } }
    }
    nloc = mine > 0u ? mine : 1u; nx = cnt > 0u ? cnt : 1u;
}

__device__ __forceinline__ void xcd_barrier(const XcdBarrier& b, const bool tid0  ) {
    asm volatile("s_waitcnt vmcnt(0)" ::: "memory");
    __syncthreads();
    if (tid0) {
        unsigned* bar = b.bar;
        __builtin_amdgcn_s_waitcnt(0);
        unsigned nloc = b.st[0], nx = b.st[1];
        if (nloc == 0u) { xcd_barrier_complete(bar, b.x, nloc, nx); b.st[0] = nloc; b.st[1] = nx; }
        const unsigned old = xb_add(&bar[XB_XSUB(b.x)], 1u);
        const unsigned gen = old / nloc;
        if (old + 1u == (gen + 1u) * nloc) {
            __builtin_amdgcn_fence(__ATOMIC_RELEASE, "agent");
            asm volatile("s_waitcnt vmcnt(0)" ::: "memory");
            const unsigned og = xb_add(&bar[XB_TOP], 1u);
            const unsigned tg = og / nx;
            if (og + 1u == (tg + 1u) * nx) xb_add(&bar[XB_TOPGEN], 1u);
            else XB_SPIN(xb_ld(&bar[XB_TOPGEN]) == tg, bar);
            __builtin_amdgcn_fence(__ATOMIC_ACQUIRE, "agent");
            xb_add(&bar[XB_XGEN(b.x)], 1u);
            asm volatile("s_waitcnt vmcnt(0)" ::: "memory");
        } else {
            XB_SPIN(xb_ld(&bar[XB_XGEN(b.x)]) == gen, bar);
            __builtin_amdgcn_fence(__ATOMIC_ACQUIRE, "agent");
            asm volatile("s_waitcnt vmcnt(0)" ::: "memory");
        }
    }
    __syncthreads();
}

namespace attn {
using bf16 = unsigned short;
constexpr int   D = 128, NW = 8, QBLK = 32, KVBLK = 64;
constexpr float SCALE = 0.088388347648318440f;
constexpr float THR = 8.f;
constexpr int SDEPTH = 2;
constexpr int LDQ = 2048, LDK = 512, LDO = 2048;
constexpr size_t SHM_V = KVBLK * D * 2, SHM_K = KVBLK * D * 2, SHM_ATTN = 2 * SHM_V + 2 * SHM_K + NW * 64 * 4;
using bf16x8 = __attribute__((ext_vector_type(8))) short;
using s16x4  = __attribute__((ext_vector_type(4))) short;
using f32x16 = __attribute__((ext_vector_type(16))) float;
using f32x8  = __attribute__((ext_vector_type(8))) float;
using u32x4  = __attribute__((ext_vector_type(4))) unsigned;
#define KSWZ(row, colB) ((row) * 256 + ((colB) ^ (((row) & 7) << 4)))
#define SBAR() __builtin_amdgcn_sched_barrier(0)
__device__ __forceinline__ int crow(int r, int hi) { return (r & 3) + 8 * (r >> 2) + 4 * hi; }
__device__ __forceinline__ unsigned cvtpk(float lo, float hi) {
  return pg8::cvt_pk_bf16(lo, hi);
}
template <typename TIn> struct Stage;
__device__ __forceinline__ unsigned f2bf_(float f) { unsigned u = __builtin_bit_cast(unsigned, f); return (u + 0x7fffu + ((u >> 16) & 1u)) >> 16; }
template <> struct Stage<bf16>  { using T = bf16x8;
  __device__ static __forceinline__ T ld8(const bf16* p) { return *reinterpret_cast<const bf16x8*>(p); }
  __device__ static __forceinline__ bf16x8 tobf(T x) { return x; } };
template <> struct Stage<float> { using T = f32x8;
  __device__ static __forceinline__ T ld8(const float* p) { return *reinterpret_cast<const f32x8*>(p); }
  __device__ static __forceinline__ bf16x8 tobf(T x) {
    u32x4 w = {cvtpk(x[0], x[1]), cvtpk(x[2], x[3]), cvtpk(x[4], x[5]), cvtpk(x[6], x[7])}; return *reinterpret_cast<bf16x8*>(&w); } };

__device__ __forceinline__ void partialSM(f32x16& p0, f32x16& p1, float& m_reg, float& mn, float& alpha) {
  constexpr float C = SCALE * 1.4426950408889634f;
  float pmax = p0[0]; for (int r = 1; r < 16; ++r) pmax = fmaxf(pmax, p0[r]); for (int r = 0; r < 16; ++r) pmax = fmaxf(pmax, p1[r]);
  { auto rr = __builtin_amdgcn_permlane32_swap(__float_as_uint(pmax), __float_as_uint(pmax), false, false);
    pmax = fmaxf(__uint_as_float(rr[0]), __uint_as_float(rr[1])); }
  if (__builtin_expect(__all(pmax - m_reg <= THR / SCALE), 1)) { mn = m_reg; alpha = 1.f; }
  else { mn = fmaxf(m_reg, pmax); alpha = __builtin_amdgcn_exp2f((m_reg - mn) * C); m_reg = mn; }
  float mnC = -mn * C;
  for (int r = 0; r < 16; ++r) p0[r] = fmaf(p0[r], C, mnC); for (int r = 0; r < 16; ++r) p1[r] = fmaf(p1[r], C, mnC);
  for (int r = 0; r < 16; ++r) p0[r] = __builtin_amdgcn_exp2f(p0[r]);
}
__device__ __forceinline__ void partialSM_fix(f32x16& p0, f32x16& p1, const float mnC) {
  (void)p1; (void)mnC;
  for (int r = 0; r < 16; ++r) p0[r] = __builtin_amdgcn_exp2f(p0[r]);
}
__device__ __forceinline__ void finishSM(f32x16& p0, f32x16& p1, float alpha, float& l_reg, bf16x8& pa0, bf16x8& pa1, bf16x8& pa2, bf16x8& pa3) {
  for (int r = 0; r < 16; ++r) p1[r] = __builtin_amdgcn_exp2f(p1[r]);
  float ps = 0; for (int r = 0; r < 16; ++r) ps += p0[r]; for (int r = 0; r < 16; ++r) ps += p1[r];
  { auto rr = __builtin_amdgcn_permlane32_swap(__float_as_uint(ps), __float_as_uint(ps), false, false);
    ps = __uint_as_float(rr[0]) + __uint_as_float(rr[1]); }
  l_reg = l_reg * alpha + ps;
#define PK4(P, BASE, OUT) do { unsigned a0 = cvtpk(P[BASE + 0], P[BASE + 1]), a1 = cvtpk(P[BASE + 2], P[BASE + 3]);   \
    unsigned b0 = cvtpk(P[BASE + 4], P[BASE + 5]), b1 = cvtpk(P[BASE + 6], P[BASE + 7]);                              \
    auto r0 = __builtin_amdgcn_permlane32_swap(a0, b0, false, false); auto r1 = __builtin_amdgcn_permlane32_swap(a1, b1, false, false); \
    u32x4 w = {r0[0], r1[0], r0[1], r1[1]}; OUT = *reinterpret_cast<bf16x8*>(&w); } while (0)
  PK4(p0, 0, pa0); PK4(p0, 8, pa1); PK4(p1, 0, pa2); PK4(p1, 8, pa3);
#undef PK4
}
__device__ __forceinline__ void qkt(f32x16& p0, f32x16& p1, const bf16* Ks, const bf16x8* qr, int r32, int hi) {
  p0 = f32x16{}; p1 = f32x16{};
  for (int d0 = 0; d0 < 8; ++d0) { int cb = (d0 * 16 + hi * 8) * 2;
    bf16x8 b0 = *reinterpret_cast<const bf16x8*>((const char*)Ks + KSWZ(r32, cb));
    bf16x8 b1 = *reinterpret_cast<const bf16x8*>((const char*)Ks + KSWZ(32 + r32, cb));
    p0 = __builtin_amdgcn_mfma_f32_32x32x16_bf16(b0, qr[d0], p0, 0, 0, 0);
    p1 = __builtin_amdgcn_mfma_f32_32x32x16_bf16(b1, qr[d0], p1, 0, 0, 0); }
}
__device__ __forceinline__ int v_st(int k, int c) { const int kk = (k & ~0xC) | ((k & 4) << 1) | ((k & 8) >> 1); return ((kk >> 3) * 4 + (c >> 5)) * 512 + ((kk & 7) * 32 + (c & 31)) * 2; }
__device__ __forceinline__ int v_rd_base(int lane) { return ((lane & 3) << 3) | (((lane >> 2) & 3) << 6) | (((lane >> 4) & 1) << 5) | (((lane >> 5) & 1) << 8); }
constexpr int v_rd_off(int d0, int ks, int half) { return d0 * 512 + ks * 4096 + half * 2048; }
template <int OFF> __device__ __forceinline__ s16x4 tr_read(int vb) {
  s16x4 r; asm volatile("ds_read_b64_tr_b16 %0, %1 offset:%2" : "=&v"(r) : "v"(vb), "i"(OFF) : "memory"); return r;
}
template <int D0> __device__ __forceinline__ void pv_one(f32x16& od, int vb, bf16x8 pa0, bf16x8 pa1, bf16x8 pa2, bf16x8 pa3) {
  const s16x4 l0 = tr_read<v_rd_off(D0, 0, 0)>(vb), h0 = tr_read<v_rd_off(D0, 0, 1)>(vb), l1 = tr_read<v_rd_off(D0, 1, 0)>(vb), h1 = tr_read<v_rd_off(D0, 1, 1)>(vb);
  const s16x4 l2 = tr_read<v_rd_off(D0, 2, 0)>(vb), h2 = tr_read<v_rd_off(D0, 2, 1)>(vb), l3 = tr_read<v_rd_off(D0, 3, 0)>(vb), h3 = tr_read<v_rd_off(D0, 3, 1)>(vb);
  asm volatile("s_waitcnt lgkmcnt(0)" ::: "memory"); SBAR();
#define PK(L, H) (bf16x8){L[0], L[1], L[2], L[3], H[0], H[1], H[2], H[3]}
  od = __builtin_amdgcn_mfma_f32_32x32x16_bf16(pa0, PK(l0, h0), od, 0, 0, 0);
  od = __builtin_amdgcn_mfma_f32_32x32x16_bf16(pa1, PK(l1, h1), od, 0, 0, 0);
  od = __builtin_amdgcn_mfma_f32_32x32x16_bf16(pa2, PK(l2, h2), od, 0, 0, 0);
  od = __builtin_amdgcn_mfma_f32_32x32x16_bf16(pa3, PK(l3, h3), od, 0, 0, 0);
#undef PK
}
__device__ __forceinline__ void pv_d0(f32x16* o, int vb, bf16x8 pa0, bf16x8 pa1, bf16x8 pa2, bf16x8 pa3) {
  pv_one<0>(o[0], vb, pa0, pa1, pa2, pa3); pv_one<1>(o[1], vb, pa0, pa1, pa2, pa3); pv_one<2>(o[2], vb, pa0, pa1, pa2, pa3); pv_one<3>(o[3], vb, pa0, pa1, pa2, pa3);
}

template <typename TQ, bool FIXM = false>
__device__ __forceinline__ void attn_dense_body(const TQ* __restrict__ Qb, const bf16* __restrict__ Kh, const bf16* __restrict__ Vh,
                                                bf16* __restrict__ Ob, int seq, char* lds, const int wid, const float mfix = 0.f) {
  using St = Stage<bf16>; using SQ = Stage<TQ>;
  const int lane = lane_opaque(), tid = wid * 64 + lane, r32 = lane & 31, hi = lane >> 5;
  bf16* V_lds = (bf16*)lds; bf16* K_lds = (bf16*)(lds + 2 * SHM_V);
  float* ws = (float*)(lds + 2 * SHM_V + 2 * SHM_K) + wid * 64; float* li_l = ws; float* al_l = ws + 32;
  float m_reg = -1e30f, l_reg = 0; f32x16 o[4] = {}; bf16x8 qr[8]; const float mnCf = -mfix * (SCALE * 1.4426950408889634f); (void)mnCf; (void)m_reg;
  const TQ* Qw = Qb + (long)(wid * QBLK + r32) * LDQ + hi * 8;
#pragma unroll
  for (int d0 = 0; d0 < 8; ++d0) qr[d0] = SQ::tobf(SQ::ld8(Qw + d0 * 16));
  const int sr = tid >> 4, sc = (tid & 15) * 8, vst0 = v_st(sr, sc), vst1 = v_st(32 + sr, sc);
  const int vb0 = (int)(uintptr_t)V_lds + v_rd_base(lane);
  struct { typename St::T vs0, vs1, ks0, ks1; } sr_[SDEPTH];
#define SLOAD(i, k0) do { sr_[i].vs0 = St::ld8(&Vh[(long)((k0) + sr) * LDK + sc]); sr_[i].vs1 = St::ld8(&Vh[(long)((k0) + 32 + sr) * LDK + sc]); \
    sr_[i].ks0 = St::ld8(&Kh[(long)((k0) + sr) * LDK + sc]); sr_[i].ks1 = St::ld8(&Kh[(long)((k0) + 32 + sr) * LDK + sc]); } while (0)
#define SWRITE(b, i) do { *(bf16x8*)((char*)V_lds + (b) * SHM_V + vst0) = St::tobf(sr_[i].vs0);          \
    *(bf16x8*)((char*)V_lds + (b) * SHM_V + vst1) = St::tobf(sr_[i].vs1); int kc = sc * 2;               \
    *(bf16x8*)((char*)K_lds + (b) * SHM_K + KSWZ(sr, kc)) = St::tobf(sr_[i].ks0);                       \
    *(bf16x8*)((char*)K_lds + (b) * SHM_K + KSWZ(32 + sr, kc)) = St::tobf(sr_[i].ks1); } while (0)
#define SWAIT() do { if constexpr (SDEPTH == 2) asm volatile("s_waitcnt vmcnt(4)" ::: "memory"); else asm volatile("s_waitcnt vmcnt(0)" ::: "memory"); } while (0)
#define RESC(a) do { if (__any((a) < 1.f)) { if (hi == 0) al_l[r32] = (a); asm volatile("s_waitcnt lgkmcnt(0)" ::: "memory"); \
    for (int d = 0; d < 4; ++d) for (int r = 0; r < 16; ++r) o[d][r] *= al_l[crow(r, hi)]; } } while (0)
  f32x16 pA0, pA1, pB0, pB1; float mnA, mnB, alA, alB; bf16x8 pa0, pa1, pa2, pa3; const int NT = seq / KVBLK;
  constexpr int SE = 0, SO = SDEPTH - 1;
  SLOAD(SE, 0); asm volatile("s_waitcnt vmcnt(0)" ::: "memory"); SWRITE(0, SE); __syncthreads();
  qkt(pA0, pA1, K_lds, qr, r32, hi); do { if constexpr (FIXM) { partialSM_fix(pA0, pA1, mnCf); alA = 1.f; } else partialSM(pA0, pA1, m_reg, mnA, alA); } while (0);
  SLOAD(SO, KVBLK); if constexpr (SDEPTH == 2) { if (2 < NT) SLOAD(SE, 2 * KVBLK); }
  SWAIT(); SWRITE(1, SO); __syncthreads();
  for (int j = 1; j + 1 < NT; j += 2) {
    SBAR(); qkt(pB0, pB1, (bf16*)((char*)K_lds + SHM_K), qr, r32, hi);
    finishSM(pA0, pA1, FIXM ? 1.f : alA, l_reg, pa0, pa1, pa2, pa3); SBAR();
    SLOAD(SO, (j + SDEPTH) * KVBLK); SBAR();
    pv_d0(o, vb0, pa0, pa1, pa2, pa3); do { if constexpr (FIXM) { partialSM_fix(pB0, pB1, mnCf); alB = 1.f; } else partialSM(pB0, pB1, m_reg, mnB, alB); } while (0);
    __syncthreads(); SWAIT(); SWRITE(0, SE);
    do { if constexpr (!FIXM) RESC(alB); } while (0); __syncthreads();
    SBAR(); qkt(pA0, pA1, K_lds, qr, r32, hi);
    finishSM(pB0, pB1, FIXM ? 1.f : alB, l_reg, pa0, pa1, pa2, pa3); SBAR();
    if (SDEPTH == 1 || j + 3 < NT) SLOAD(SE, (j + 1 + SDEPTH) * KVBLK); SBAR();
    pv_d0(o, vb0 + (int)SHM_V, pa0, pa1, pa2, pa3); do { if constexpr (FIXM) { partialSM_fix(pA0, pA1, mnCf); alA = 1.f; } else partialSM(pA0, pA1, m_reg, mnA, alA); } while (0);
    __syncthreads(); SWAIT(); SWRITE(1, SO);
    do { if constexpr (!FIXM) RESC(alA); } while (0); __syncthreads();
  }
  SBAR(); qkt(pB0, pB1, (bf16*)((char*)K_lds + SHM_K), qr, r32, hi);
  finishSM(pA0, pA1, FIXM ? 1.f : alA, l_reg, pa0, pa1, pa2, pa3); SBAR();
  pv_d0(o, vb0, pa0, pa1, pa2, pa3); do { if constexpr (FIXM) { partialSM_fix(pB0, pB1, mnCf); alB = 1.f; } else partialSM(pB0, pB1, m_reg, mnB, alB); } while (0);
  __syncthreads(); do { if constexpr (!FIXM) RESC(alB); } while (0);
  finishSM(pB0, pB1, FIXM ? 1.f : alB, l_reg, pa0, pa1, pa2, pa3); SBAR();
  pv_d0(o, vb0 + (int)SHM_V, pa0, pa1, pa2, pa3);
  if (hi == 0) li_l[r32] = l_reg; asm volatile("s_waitcnt lgkmcnt(0)" ::: "memory");
  float rli[16];
#pragma unroll
  for (int r = 0; r < 16; ++r) rli[r] = __builtin_amdgcn_rcpf(li_l[crow(r, hi)]);
  bf16* Ow = Ob + (long)(wid * QBLK) * LDO;
  char* stg = (char*)K_lds + wid * 4096;
#pragma unroll
  for (int half = 0; half < 2; ++half) {
#pragma unroll
    for (int r = 0; r < 16; ++r) { const unsigned w = cvtpk(o[2 * half][r] * rli[r], o[2 * half + 1][r] * rli[r]); char* pr = stg + crow(r, hi) * 128 + r32 * 2;
      *reinterpret_cast<unsigned short*>(pr) = (unsigned short)w; *reinterpret_cast<unsigned short*>(pr + 64) = (unsigned short)(w >> 16); }
    asm volatile("s_waitcnt lgkmcnt(0)" ::: "memory");
#pragma unroll
    for (int k = 0; k < 4; ++k) { const int row = 8 * k + (lane >> 3), ch = lane & 7;
      const u32x4 v = *reinterpret_cast<const u32x4*>(stg + row * 128 + ch * 16);
      *reinterpret_cast<u32x4*>(Ow + (long)row * LDO + half * 64 + ch * 8) = v; }
    asm volatile("s_waitcnt lgkmcnt(0)" ::: "memory");
  }
#undef SLOAD
#undef SWRITE
#undef SWAIT
#undef RESC
}
#undef KSWZ
#undef SBAR
}

#define GAS __attribute__((address_space(1)))
typedef unsigned short bf16_t;
typedef unsigned u32x4 __attribute__((ext_vector_type(4)));
typedef unsigned u32x2 __attribute__((ext_vector_type(2)));
typedef float f32x4 __attribute__((ext_vector_type(4)));
typedef float f32x2 __attribute__((ext_vector_type(2)));
typedef short bf16x8 __attribute__((ext_vector_type(8)));

constexpr int D = 2048, NB = 4, SEQ = 4096, CTXL = 256, TB = SEQ + CTXL, M = NB * TB, FF = 5632, DEPTH = 4;
constexpr int NWAVES = 8, NTHR = 512;
constexpr int NCTXWG = 64;
constexpr float NORM_EPS = 1e-6f;
static_assert(M == 17408 && M % 256 == 0 && TB % 256 == 0, "row layout");

constexpr size_t MiB = 1u << 20;
constexpr size_t WS_CTL = 0, CTL_ZERO_BYTES = 1 * MiB;
constexpr size_t WS_MOD = 1 * MiB;
constexpr size_t WS_ROPE = 4 * MiB;
constexpr size_t WS_WB = 8 * MiB;
constexpr size_t E_F1 = (size_t)2 * FF * D, E_F2 = (size_t)D * FF;
constexpr size_t WS_WA = WS_WB + 8 * (E_F1 + E_F2) * 2;
constexpr size_t E_QKV = (size_t)3072 * D, E_SQ = (size_t)D * D;
constexpr size_t WS_WR = WS_WA + 2 * (E_QKV + E_SQ) * 2;
constexpr size_t E_RW1 = (size_t)6912 * D, E_RW2 = (size_t)10240 * 256;
constexpr size_t WS_WEND = WS_WR + 2 * (E_RW1 + E_RW2 + E_SQ) * 2;
static_assert(WS_WEND == 656 * MiB, "weight map");
constexpr size_t SZ_R2 = (size_t)M * D * 2, SZ_R4 = (size_t)M * D * 4;
constexpr size_t WS_X = 656 * MiB;
constexpr size_t WS_Y = WS_X + SZ_R4;
constexpr size_t WS_ACT = WS_Y + SZ_R2;
constexpr size_t WS_OUT = 1048 * MiB;
constexpr size_t WS_MIX = WS_OUT + SZ_R2;
static_assert(WS_ACT + (size_t)M * FF * 2 <= WS_OUT, "act map");
constexpr size_t WS_Q = WS_MIX, WS_K = WS_Q + SZ_R2, WS_V = WS_K + SZ_R2 / 4, WS_O = WS_V + SZ_R2 / 4;
constexpr size_t WS_MIX6 = WS_MIX;
constexpr size_t WS_WDEC = WS_MIX;
constexpr size_t WS_AA = WS_MIX + 2 * SZ_R4;
constexpr size_t WS_RR = WS_MIX + 6 * SZ_R2;
constexpr size_t WS_KK_ = WS_RR + SZ_R2;
constexpr size_t WS_VV = WS_KK_ + SZ_R2;
constexpr size_t WS_KN = WS_VV + SZ_R2;
constexpr size_t WS_GG = WS_KN + SZ_R2;
constexpr size_t WS_GL = WS_GG + SZ_R2;
constexpr size_t WS_WL = WS_GL + 9 * MiB, WS_AL = WS_WL + 9 * MiB;
constexpr size_t WS_PART = WS_AL + 9 * MiB;
constexpr size_t WS_BON = WS_PART + 16 * MiB;
constexpr size_t WS_END = WS_BON + 5 * MiB;
constexpr size_t WS_YS = WS_ACT;
constexpr size_t WS_PREP = WS_Y;
static_assert(WS_AA + 2 * SZ_R2 == WS_RR, "rwkv overlay");
static_assert(WS_END <= 2100 * MiB, "ws map");
constexpr int CW_BAR = 4096;
constexpr int MAX_LAUNCH = 64;
constexpr int CW_GRP = CW_BAR + MAX_LAUNCH * XCD_BAR_WORDS;
constexpr int CW_FC = CW_GRP + 16 * 4 * 64 + 2 * 128 * 64;
static_assert((CW_FC + 8 * 64) * 4 <= (int)WS_MOD, "ctl map (context tile counters)");
constexpr int CW_PAIR = CW_GRP + 16 * 4 * 64;
static_assert((CW_PAIR + 2 * 128 * 64) * 4 <= (int)WS_MOD, "ctl map (pair counters)");
static_assert((CW_GRP + 16 * 4 * 64) * 4 <= (int)WS_MOD, "ctl map (group counters)");
static_assert((CW_BAR + MAX_LAUNCH * XCD_BAR_WORDS) * 4 <= (int)WS_MOD, "ctl map");

constexpr int RING_BYTES = 131072, LDSCTL_OFF = RING_BYTES, MISC_OFF = LDSCTL_OFF + 320, LDS_BYTES = 163840;

struct Args { const float* in[30]; float* out; unsigned char* ws; int ph_lo, ph_hi, li, dbg; };
typedef const __attribute__((address_space(4))) Args KArgs;
struct Frame { LAS unsigned char* lds; unsigned char* ldsg; int wave, G, bid; };

#define LDS_WAIT() asm volatile("s_waitcnt lgkmcnt(0)" ::: "memory")
__device__ __forceinline__ unsigned f2bf(float f) { unsigned u = __builtin_bit_cast(unsigned, f); return (u + 0x7fffu + ((u >> 16) & 1u)) >> 16; }
__device__ __forceinline__ unsigned pk2(float lo, float hi) { return pg8::cvt_pk_bf16(lo, hi); }
__device__ __forceinline__ float bflo(unsigned w) { return __builtin_bit_cast(float, w << 16); }
__device__ __forceinline__ float bfhi(unsigned w) { return __builtin_bit_cast(float, w & 0xffff0000u); }
__device__ __forceinline__ void unpack8(const u32x4 w, float (&v)[8]) { v[0] = bflo(w.x); v[1] = bfhi(w.x); v[2] = bflo(w.y); v[3] = bfhi(w.y); v[4] = bflo(w.z); v[5] = bfhi(w.z); v[6] = bflo(w.w); v[7] = bfhi(w.w); }
__device__ __forceinline__ u32x4 pack8(const float (&v)[8]) { u32x4 w; w.x = pk2(v[0], v[1]); w.y = pk2(v[2], v[3]); w.z = pk2(v[4], v[5]); w.w = pk2(v[6], v[7]); return w; }
typedef _Float16 h16x2 __attribute__((ext_vector_type(2)));
__device__ __forceinline__ void unpack8h(const u32x4 w, float (&v)[8]) {
    const unsigned wx = w.x, wy = w.y, wz = w.z, ww = w.w;
    const h16x2 a = __builtin_bit_cast(h16x2, wx), b = __builtin_bit_cast(h16x2, wy), c = __builtin_bit_cast(h16x2, wz), d = __builtin_bit_cast(h16x2, ww);
    v[0] = (float)a.x; v[1] = (float)a.y; v[2] = (float)b.x; v[3] = (float)b.y; v[4] = (float)c.x; v[5] = (float)c.y; v[6] = (float)d.x; v[7] = (float)d.y; }
__device__ __forceinline__ u32x4 pack8h(const float (&v)[8]) {
    h16x2 a, b, c, d; a.x = (_Float16)v[0]; a.y = (_Float16)v[1]; b.x = (_Float16)v[2]; b.y = (_Float16)v[3]; c.x = (_Float16)v[4]; c.y = (_Float16)v[5]; d.x = (_Float16)v[6]; d.y = (_Float16)v[7];
    u32x4 w; w.x = __builtin_bit_cast(unsigned, a); w.y = __builtin_bit_cast(unsigned, b); w.z = __builtin_bit_cast(unsigned, c); w.w = __builtin_bit_cast(unsigned, d); return w; }
__device__ __forceinline__ float wave_sum(float v) {
#pragma unroll
    for (int o = 1; o < 64; o <<= 1) v += __shfl_xor(v, o);
    return v;
}
template <int CTRL> __device__ __forceinline__ float dppf(float x) { return __builtin_bit_cast(float, __builtin_amdgcn_mov_dpp(__builtin_bit_cast(int, x), CTRL, 0xF, 0xF, true)); }
__device__ __forceinline__ float sum8(float v) { v += dppf<0xB1>(v); v += dppf<0x4E>(v); v += dppf<0x141>(v); return v; }
__device__ __forceinline__ float sum16(float v) { v = sum8(v); v += dppf<0x140>(v); return v; }
__device__ __forceinline__ float fsigmoid(float x) { return __builtin_amdgcn_rcpf(1.0f + __builtin_amdgcn_exp2f(-1.4426950408889634f * x)); }
__device__ __forceinline__ float ftanh(float x) { return 1.0f - 2.0f * __builtin_amdgcn_rcpf(1.0f + __builtin_amdgcn_exp2f(2.8853900817779268f * x)); }
__device__ __forceinline__ float fsilu(float x) { return x * fsigmoid(x); }

using pg8::Unit;
typedef float accf32x4 __attribute__((ext_vector_type(4)));
struct EpiPlain {
    static constexpr bool PERM = true, AFTER_DRAIN = false;
    bf16_t* O; int ldc;
    __device__ __forceinline__ void operator()(const accf32x4 (&acc)[2][2][4][2], const Unit& u, int wr, int wc, int fr, int fq) const {
        const int row0 = u.pm * 256 + wr * 64 + fr, col0 = u.pn * 256 + wc * 32 + 8 * fq;
#pragma unroll
        for (int ai = 0; ai < 2; ++ai)
#pragma unroll
            for (int m = 0; m < 4; ++m) { bf16_t* rowp = O + (size_t)(row0 + ai * 128 + m * 16) * ldc + col0;
#pragma unroll
                for (int bj = 0; bj < 2; ++bj) { const accf32x4 v0 = acc[ai][bj][m][0], v1 = acc[ai][bj][m][1];
                    u32x4 w; w.x = pk2(v0[0], v0[1]); w.y = pk2(v0[2], v0[3]); w.z = pk2(v1[0], v1[1]); w.w = pk2(v1[2], v1[3]);
                    *(u32x4*)(rowp + bj * 128) = w; } }
    }
};
struct EpiQKV {
    static constexpr bool PERM = true, AFTER_DRAIN = false;
    unsigned char* wsb;
    __device__ __forceinline__ void operator()(const accf32x4 (&acc)[2][2][4][2], const Unit& u, int wr, int wc, int fr, int fq) const {
        size_t ooff; int ldc, ct;
        if (u.pn < 8) { ooff = WS_Q; ldc = 2048; ct = u.pn; } else if (u.pn < 10) { ooff = WS_K; ldc = 512; ct = u.pn - 8; } else { ooff = WS_V; ldc = 512; ct = u.pn - 10; }
        bf16_t* O = (bf16_t*)(wsb + ooff);
        const int row0 = u.pm * 256 + wr * 64 + fr, col0 = ct * 256 + wc * 32 + 8 * fq;
#pragma unroll
        for (int ai = 0; ai < 2; ++ai)
#pragma unroll
            for (int m = 0; m < 4; ++m) { bf16_t* rowp = O + (size_t)(row0 + ai * 128 + m * 16) * ldc + col0;
#pragma unroll
                for (int bj = 0; bj < 2; ++bj) { const accf32x4 v0 = acc[ai][bj][m][0], v1 = acc[ai][bj][m][1];
                    u32x4 w; w.x = pk2(v0[0], v0[1]); w.y = pk2(v0[2], v0[3]); w.z = pk2(v1[0], v1[1]); w.w = pk2(v1[2], v1[3]);
                    *(u32x4*)(rowp + bj * 128) = w; } }
    }
};
struct EpiQKVN {
    static constexpr bool PERM = true, AFTER_DRAIN = false;
    unsigned char* wsb; const float* gq; const float* gk; LAS float* xch; float qscale;
    __device__ __forceinline__ void operator()(const accf32x4 (&acc)[2][2][4][2], const Unit& u, int wr, int wc, int fr, int fq) const {
        size_t ooff; int ldc, ct;
        if (u.pn < 8) { ooff = WS_Q; ldc = 2048; ct = u.pn; } else if (u.pn < 10) { ooff = WS_K; ldc = 512; ct = u.pn - 8; } else { ooff = WS_V; ldc = 512; ct = u.pn - 10; }
        bf16_t* O = (bf16_t*)(wsb + ooff);
        const int row0 = u.pm * 256 + wr * 64 + fr, col0 = ct * 256 + wc * 32 + 8 * fq;
        if (u.pn >= 10) {
#pragma unroll
            for (int ai = 0; ai < 2; ++ai)
#pragma unroll
                for (int m = 0; m < 4; ++m) { bf16_t* rowp = O + (size_t)(row0 + ai * 128 + m * 16) * ldc + col0;
#pragma unroll
                    for (int bj = 0; bj < 2; ++bj) { const accf32x4 v0 = acc[ai][bj][m][0], v1 = acc[ai][bj][m][1];
                        u32x4 w; w.x = pk2(v0[0], v0[1]); w.y = pk2(v0[2], v0[3]); w.z = pk2(v1[0], v1[1]); w.w = pk2(v1[2], v1[3]);
                        *(u32x4*)(rowp + bj * 128) = w; } }
            return;
        }
#pragma unroll
        for (int ai = 0; ai < 2; ++ai)
#pragma unroll
            for (int m = 0; m < 4; ++m)
#pragma unroll
                for (int bj = 0; bj < 2; ++bj) { const accf32x4 v0 = acc[ai][bj][m][0], v1 = acc[ai][bj][m][1];
                    float x = v0[0] * v0[0] + v0[1] * v0[1] + v0[2] * v0[2] + v0[3] * v0[3] + v1[0] * v1[0] + v1[1] * v1[1] + v1[2] * v1[2] + v1[3] * v1[3];
                    { const unsigned ub = __builtin_bit_cast(unsigned, x); auto rr = __builtin_amdgcn_permlane16_swap(ub, ub, false, false); const unsigned r0 = rr[0], r1 = rr[1];
                      x = __builtin_bit_cast(float, r0) + __builtin_bit_cast(float, r1); }
                    { const unsigned ub = __builtin_bit_cast(unsigned, x); auto rr = __builtin_amdgcn_permlane32_swap(ub, ub, false, false); const unsigned r0 = rr[0], r1 = rr[1];
                      x = __builtin_bit_cast(float, r0) + __builtin_bit_cast(float, r1); }
                    if (fq == 0) xch[((wr * 128 + ai * 64 + m * 16 + fr) * 2 + bj) * 4 + wc] = x; }
        asm volatile("s_waitcnt lgkmcnt(0)" ::: "memory");
        __builtin_amdgcn_s_barrier();
        asm volatile("" ::: "memory");
        const float* gp = (u.pn < 8 ? gq : gk) + wc * 32 + 8 * fq;
        const f32x4 g0 = *(const f32x4*)gp, g1 = *(const f32x4*)(gp + 4);
        const bool lat = (u.pm % 17) != 0;
        const float* COS = (const float*)(wsb + WS_ROPE); const float* SIN = COS + 4096 * 64;
#pragma unroll
        for (int ai = 0; ai < 2; ++ai)
#pragma unroll
            for (int m = 0; m < 4; ++m) { const int row = row0 + ai * 128 + m * 16; bf16_t* rowp = O + (size_t)row * ldc + col0;
                f32x4 cs = (f32x4){1.f, 1.f, 1.f, 1.f}, sn = (f32x4){0.f, 0.f, 0.f, 0.f};
                if (lat) { const int pos = row % TB - CTXL; cs = *(const f32x4*)(COS + (size_t)pos * 64 + wc * 16 + 4 * fq); sn = *(const f32x4*)(SIN + (size_t)pos * 64 + wc * 16 + 4 * fq); }
#pragma unroll
                for (int bj = 0; bj < 2; ++bj) {
                    const f32x4 pp = *(const LAS f32x4*)(xch + ((wr * 128 + ai * 64 + m * 16 + fr) * 2 + bj) * 4);
                    const float rs = rsqrtf((pp[0] + pp[1] + pp[2] + pp[3]) * (1.0f / 128.0f) + NORM_EPS) * (u.pn < 8 ? qscale : 1.0f);
                    const accf32x4 v0 = acc[ai][bj][m][0], v1 = acc[ai][bj][m][1];
                    const float a0 = v0[0] * rs * g0[0], a1 = v0[1] * rs * g0[1], a2 = v0[2] * rs * g0[2], a3 = v0[3] * rs * g0[3];
                    const float b0 = v1[0] * rs * g1[0], b1 = v1[1] * rs * g1[1], b2 = v1[2] * rs * g1[2], b3 = v1[3] * rs * g1[3];
                    u32x4 w;
                    w.x = pk2(a0 * cs[0] - a1 * sn[0], a0 * sn[0] + a1 * cs[0]); w.y = pk2(a2 * cs[1] - a3 * sn[1], a2 * sn[1] + a3 * cs[1]);
                    w.z = pk2(b0 * cs[2] - b1 * sn[2], b0 * sn[2] + b1 * cs[2]); w.w = pk2(b2 * cs[3] - b3 * sn[3], b2 * sn[3] + b3 * cs[3]);
                    *(u32x4*)(rowp + bj * 128) = w; } }
    }
};
struct EpiSwiGLU {
    static constexpr bool PERM = true, AFTER_DRAIN = false;
    bf16_t* O;
    __device__ __forceinline__ void operator()(const accf32x4 (&acc)[2][2][4][2], const Unit& u, int wr, int wc, int fr, int fq) const {
        const int row0 = u.pm * 256 + wr * 64 + fr, col0 = u.pn * 128 + wc * 32 + 8 * fq;
#pragma unroll
        for (int ai = 0; ai < 2; ++ai)
#pragma unroll
            for (int m = 0; m < 4; ++m) { bf16_t* rowp = O + (size_t)(row0 + ai * 128 + m * 16) * FF + col0;
                float r[8];
#pragma unroll
                for (int n = 0; n < 2; ++n)
#pragma unroll
                    for (int e = 0; e < 4; ++e) { const float g = acc[ai][0][m][n][e], up = acc[ai][1][m][n][e]; r[4 * n + e] = fsilu(g) * up; }
                *(u32x4*)rowp = pack8(r); }
    }
};
struct EpiRw1 {
    static constexpr bool PERM = true, AFTER_DRAIN = false;
    unsigned char* wsb; const float* k_k;
    __device__ __forceinline__ void operator()(const accf32x4 (&acc)[2][2][4][2], const Unit& u, int wr, int wc, int fr, int fq) const {
        const int row0 = u.pm * 256 + wr * 64 + fr, cit = 64 * wc + 8 * fq;
        const int pn = u.pn;
        if (pn >= 8 && pn < 16) {
            bf16_t* K = (bf16_t*)(wsb + WS_KK_); bf16_t* KN = (bf16_t*)(wsb + WS_KN);
            const int colb = (pn - 8) * 256 + cit;
            float kk0[8], kk1[8];
            { const f32x4 a0 = *(const f32x4*)(k_k + colb), a1 = *(const f32x4*)(k_k + colb + 4), b0 = *(const f32x4*)(k_k + colb + 32), b1 = *(const f32x4*)(k_k + colb + 36);
#pragma unroll
              for (int e = 0; e < 4; ++e) { kk0[e] = a0[e]; kk0[4 + e] = a1[e]; kk1[e] = b0[e]; kk1[4 + e] = b1[e]; } }
#pragma unroll
            for (int ai = 0; ai < 2; ++ai)
#pragma unroll
                for (int m = 0; m < 4; ++m) { const size_t ro = (size_t)(row0 + ai * 128 + m * 16) * D + colb;
                    float k0[8], k1[8], q0[8], q1[8]; float ss = 0.f;
#pragma unroll
                    for (int n = 0; n < 2; ++n)
#pragma unroll
                        for (int e = 0; e < 4; ++e) { k0[4 * n + e] = acc[ai][0][m][n][e]; k1[4 * n + e] = acc[ai][1][m][n][e]; }
#pragma unroll
                    for (int i = 0; i < 8; ++i) { q0[i] = k0[i] * kk0[i]; q1[i] = k1[i] * kk1[i]; ss += q0[i] * q0[i] + q1[i] * q1[i]; }
                    ss += __shfl_xor(ss, 16); ss += __shfl_xor(ss, 32);
                    const float rs = rsqrtf(ss + 1e-12f);
#pragma unroll
                    for (int i = 0; i < 8; ++i) { q0[i] *= rs; q1[i] *= rs; }
                    *(u32x4*)(K + ro) = pack8(k0); *(u32x4*)(K + ro + 32) = pack8(k1);
                    *(u32x4*)(KN + ro) = pack8(q0); *(u32x4*)(KN + ro + 32) = pack8(q1); }
        } else if (pn < 24) {
            bf16_t* O = (bf16_t*)(wsb + (pn < 8 ? WS_RR : WS_VV)); const int colb = (pn & 7) * 256 + cit;
#pragma unroll
            for (int ai = 0; ai < 2; ++ai)
#pragma unroll
                for (int m = 0; m < 4; ++m) { const size_t ro = (size_t)(row0 + ai * 128 + m * 16) * D + colb;
#pragma unroll
                    for (int bj = 0; bj < 2; ++bj) { const accf32x4 v0 = acc[ai][bj][m][0], v1 = acc[ai][bj][m][1];
                        u32x4 w; w.x = pk2(v0[0], v0[1]); w.y = pk2(v0[2], v0[3]); w.z = pk2(v1[0], v1[1]); w.w = pk2(v1[2], v1[3]);
                        *(u32x4*)(O + ro + 32 * bj) = w; } }
        } else {
            bf16_t* O = (bf16_t*)(wsb + WS_GL + (size_t)(pn - 24) * (9 * MiB));
#pragma unroll
            for (int ai = 0; ai < 2; ++ai)
#pragma unroll
                for (int m = 0; m < 4; ++m) { const size_t ro = (size_t)(row0 + ai * 128 + m * 16) * 256 + cit;
#pragma unroll
                    for (int bj = 0; bj < 2; ++bj) { float r[8];
#pragma unroll
                        for (int n = 0; n < 2; ++n)
#pragma unroll
                            for (int e = 0; e < 4; ++e) { const float x = acc[ai][bj][m][n][e]; r[4 * n + e] = pn == 24 ? fsigmoid(x) : (pn == 25 ? ftanh(x) : x); }
                        *(u32x4*)(O + ro + 32 * bj) = pack8(r); } }
        }
    }
};
struct EpiRw2 {
    static constexpr bool PERM = true, AFTER_DRAIN = false;
    unsigned char* wsb; const float *w0, *a0; size_t aa_off;
    __device__ __forceinline__ void operator()(const accf32x4 (&acc)[2][2][4][2], const Unit& u, int wr, int wc, int fr, int fq) const {
        const int row0 = u.pm * 256 + wr * 64 + fr, cit = 64 * wc + 8 * fq;
        const int pn = u.pn;
        if (pn < 8) {
            bf16_t* G = (bf16_t*)(wsb + WS_GG);
            const int colb = pn * 256 + cit;
#pragma unroll
            for (int ai = 0; ai < 2; ++ai)
#pragma unroll
                for (int m = 0; m < 4; ++m) { const size_t ro = (size_t)(row0 + ai * 128 + m * 16) * D + colb;
#pragma unroll
                    for (int bj = 0; bj < 2; ++bj) { const accf32x4 v0 = acc[ai][bj][m][0], v1 = acc[ai][bj][m][1];
                        u32x4 w; w.x = pk2(v0[0], v0[1]); w.y = pk2(v0[2], v0[3]); w.z = pk2(v1[0], v1[1]); w.w = pk2(v1[2], v1[3]);
                        *(u32x4*)(G + ro + 32 * bj) = w; } }
        } else if (pn < 24) {
            const int d = (pn - 8) >> 3, colb = ((pn - 8) & 7) * 256 + cit;
            bf16_t* Wd = (bf16_t*)(wsb + WS_WDEC) + (size_t)d * M * D;
#pragma unroll
            for (int bj = 0; bj < 2; ++bj) {
                const f32x4 b0 = *(const f32x4*)(w0 + d * D + colb + 32 * bj), b1 = *(const f32x4*)(w0 + d * D + colb + 32 * bj + 4);
#pragma unroll
                for (int ai = 0; ai < 2; ++ai)
#pragma unroll
                    for (int m = 0; m < 4; ++m) { const size_t ro = (size_t)(row0 + ai * 128 + m * 16) * D + colb + 32 * bj;
                        float lw[8];
#pragma unroll
                        for (int e = 0; e < 4; ++e) { lw[e] = -0.8750387749f * fsigmoid(acc[ai][bj][m][0][e] + b0[e]);
                                                      lw[4 + e] = -0.8750387749f * fsigmoid(acc[ai][bj][m][1][e] + b1[e]); }
                        *(u32x4*)(Wd + ro) = pack8(lw); } }
        } else {
            const int d = (pn - 24) >> 3, colb = ((pn - 24) & 7) * 256 + cit;
            bf16_t* AAd = (bf16_t*)(wsb + aa_off) + (size_t)d * M * D;
#pragma unroll
            for (int bj = 0; bj < 2; ++bj) {
                const int cb = colb + 32 * bj;
                const f32x4 b0 = *(const f32x4*)(a0 + d * D + cb), b1 = *(const f32x4*)(a0 + d * D + cb + 4);
#pragma unroll
                for (int ai = 0; ai < 2; ++ai)
#pragma unroll
                    for (int m = 0; m < 4; ++m) { const size_t ro = (size_t)(row0 + ai * 128 + m * 16) * D + cb;
                        float av[8];
#pragma unroll
                        for (int e = 0; e < 4; ++e) { av[e] = fsigmoid(acc[ai][bj][m][0][e] + b0[e]); av[4 + e] = fsigmoid(acc[ai][bj][m][1][e] + b1[e]); }
                        *(u32x4*)(AAd + ro) = pack8(av); } }
        }
    }
};
struct GemmRw1 { const bf16_t* MIX; const bf16_t* Bt;  int K;
    __device__ __forceinline__ const char* a_tile(const Unit& u) const { int idx = u.pn < 24 ? (u.pn >> 3) : (u.pn - 21);
#ifdef DBG_RW1_SAMEA
        idx = 0;
#endif
        return (const char*)MIX + (size_t)idx * SZ_R2 + (size_t)u.pm * (size_t)(256 * 2) * D; }
    __device__ __forceinline__ const char* b_tile(const Unit& u) const { return (const char*)Bt + (size_t)u.pn * (size_t)(256 * 2) * D; }
    __device__ __forceinline__ int klen() const { return K; } };
struct GemmRw2 { const unsigned char* wsb; const bf16_t* Bt; int K;
    __device__ __forceinline__ const char* a_tile(const Unit& u) const { const size_t ao = u.pn < 8 ? WS_GL : (u.pn < 24 ? WS_WL : WS_AL); return (const char*)wsb + ao + (size_t)u.pm * (size_t)(256 * 2) * 256; }
    __device__ __forceinline__ const char* b_tile(const Unit& u) const { return (const char*)Bt + (size_t)u.pn * (size_t)(256 * 2) * 256; }
    __device__ __forceinline__ int klen() const { return K; } };

__device__ __forceinline__ int hp_row(int c) { return 128 * ((c & 63) >> 5) + 32 * (c >> 6) + (c & 31); }
__device__ __forceinline__ int hp_col(int rho) { return 64 * ((rho & 127) >> 5) + 32 * (rho >> 7) + (rho & 31); }
__device__ __forceinline__ void cvt_item(const float* W, int K, int N, bf16_t* WT, int mode, int row_off, LAS float* scr, int item, int lane) {
    const int nblk = N / 32, kb = item / nblk, nb = item - kb * nblk, k0 = 64 * kb, n0 = 32 * nb;
#pragma unroll 8
    for (int i = 0; i < 32; ++i) { const int kk = 2 * i + (lane >> 5); scr[kk * 33 + (lane & 31)] = W[(size_t)(k0 + kk) * N + n0 + (lane & 31)]; }
    LDS_WAIT(); asm volatile("" ::: "memory");
    int dr;
    if (mode == 0) dr = n0;
    else if (mode == 1) { dr = n0 < FF ? 256 * (n0 / 128) + (n0 % 128) : 256 * ((n0 - FF) / 128) + 128 + ((n0 - FF) % 128); }
    else { dr = (n0 & ~255) + hp_row(n0 & 255); }
    dr += row_off;
    const int c = lane & 7;
#pragma unroll
    for (int j = 0; j < 4; ++j) { const int n = (lane >> 3) + 8 * j; const LAS float* s = scr + (8 * c) * 33 + n;
        u32x4 o; o.x = pk2(s[0 * 33], s[1 * 33]); o.y = pk2(s[2 * 33], s[3 * 33]); o.z = pk2(s[4 * 33], s[5 * 33]); o.w = pk2(s[6 * 33], s[7 * 33]);
        *(u32x4*)(WT + (size_t)(dr + n) * K + k0 + 8 * c) = o; }
    LDS_WAIT(); asm volatile("" ::: "memory");
}
constexpr int I_F1 = (D / 64) * (2 * FF / 32), I_F2 = (FF / 64) * (D / 32), I_QKV = (D / 64) * (3072 / 32), I_SQ = (D / 64) * (D / 32), I_G1 = (D / 64) * (256 / 32), I_G2 = (256 / 64) * (D / 32);
constexpr int CVT_FFN = 4 * (I_F1 + I_F2), CVT_ATT = I_QKV + I_SQ, CVT_RW = 4 * I_SQ + I_G1 + I_G2, CVT_HALF = CVT_FFN + CVT_ATT + CVT_RW;
__device__ __forceinline__ void cvt_big_item(KArgs* a, int r, int late, LAS float* scr, int lane_) {
    bf16_t* WB = (bf16_t*)(a->ws + WS_WB); bf16_t* WA = (bf16_t*)(a->ws + WS_WA); bf16_t* WR = (bf16_t*)(a->ws + WS_WR);
    if (r < CVT_FFN) { const int lq = r / (I_F1 + I_F2), lh = 4 * late + lq; r -= lq * (I_F1 + I_F2);
        bf16_t* base = WB + (size_t)lh * (E_F1 + E_F2);
        if (r < I_F1) cvt_item(a->in[8] + (size_t)lh * D * 2 * FF, D, 2 * FF, base, 1, 0, scr, r, lane_);
        else cvt_item(a->in[9] + (size_t)lh * FF * D, FF, D, base + E_F1, 0, 0, scr, r - I_F1, lane_);
        return; }
    r -= CVT_FFN;
    const int j = late;
    if (r < CVT_ATT) {
        bf16_t* base = WA + (size_t)j * (E_QKV + E_SQ);
        if (r < I_QKV) cvt_item(a->in[10] + (size_t)j * D * 3072, D, 3072, base, 0, 0, scr, r, lane_);
        else cvt_item(a->in[11] + (size_t)j * D * D, D, D, base + E_QKV, 0, 0, scr, r - I_QKV, lane_);
        return; }
    r -= CVT_ATT;
    { bf16_t* rw1 = WR + (size_t)j * (E_RW1 + E_RW2 + E_SQ); bf16_t* rw2 = rw1 + E_RW1; bf16_t* ro = rw2 + E_RW2;
      if (r < 3 * I_SQ) { const int q = r / I_SQ; cvt_item(a->in[15] + ((size_t)j * 3 + q) * D * D, D, D, rw1, 2, q * 2048, scr, r - q * I_SQ, lane_); return; }
      r -= 3 * I_SQ;
      if (r < I_SQ) { cvt_item(a->in[16] + (size_t)j * D * D, D, D, ro, 0, 0, scr, r, lane_); return; }
      r -= I_SQ;
      if (r < I_G1) { cvt_item(a->in[17] + (size_t)j * D * 256, D, 256, rw1, 2, 6144, scr, r, lane_); return; }
      r -= I_G1;
      cvt_item(a->in[18] + (size_t)j * 256 * D, 256, D, rw2, 2, 0, scr, r, lane_); }
}
struct CvtJob { const float* W; bf16_t* WT; int K, N, mode, row_off, item; };
constexpr int CVT_N0 = 3 * (I_F1 + I_F2) + CVT_ATT + (3 * I_SQ + I_G1 + I_G2), CVT_N1 = 5 * (I_F1 + I_F2) + CVT_ATT + CVT_RW + I_SQ;
__device__ __forceinline__ CvtJob cvt_decode(KArgs* a, int r, int g) {
    bf16_t* WB = (bf16_t*)(a->ws + WS_WB); bf16_t* WA = (bf16_t*)(a->ws + WS_WA); bf16_t* WR = (bf16_t*)(a->ws + WS_WR);
    CvtJob j; j.row_off = 0; j.mode = 0;
    const int nffn = (g ? 5 : 3) * (I_F1 + I_F2);
    if (r < nffn) { const int lq = r / (I_F1 + I_F2), lh = (g ? 3 : 0) + lq; r -= lq * (I_F1 + I_F2);
        bf16_t* base = WB + (size_t)lh * (E_F1 + E_F2);
        if (r < I_F1) { j.W = a->in[8] + (size_t)lh * D * 2 * FF; j.K = D; j.N = 2 * FF; j.WT = base; j.mode = 1; j.item = r; }
        else { j.W = a->in[9] + (size_t)lh * FF * D; j.K = FF; j.N = D; j.WT = base + E_F1; j.item = r - I_F1; }
        return j; }
    r -= nffn;
    int l = g;
    if (r < CVT_ATT) {
        bf16_t* base = WA + (size_t)l * (E_QKV + E_SQ);
        if (r < I_QKV) { j.W = a->in[10] + (size_t)l * D * 3072; j.K = D; j.N = 3072; j.WT = base; j.item = r; }
        else { j.W = a->in[11] + (size_t)l * D * D; j.K = D; j.N = D; j.WT = base + E_QKV; j.item = r - I_QKV; }
        return j; }
    r -= CVT_ATT;
    if (r < 3 * I_SQ) { bf16_t* rw1 = WR + (size_t)l * (E_RW1 + E_RW2 + E_SQ);
        const int q = r / I_SQ; j.W = a->in[15] + ((size_t)l * 3 + q) * D * D; j.K = D; j.N = D; j.WT = rw1; j.mode = 2; j.row_off = q * 2048; j.item = r - q * I_SQ; return j; }
    r -= 3 * I_SQ;
    if (r < I_G1) { bf16_t* rw1 = WR + (size_t)l * (E_RW1 + E_RW2 + E_SQ); j.W = a->in[17] + (size_t)l * D * 256; j.K = D; j.N = 256; j.WT = rw1; j.mode = 2; j.row_off = 6144; j.item = r; return j; }
    r -= I_G1;
    if (r < I_G2) { bf16_t* rw2 = WR + (size_t)l * (E_RW1 + E_RW2 + E_SQ) + E_RW1; j.W = a->in[18] + (size_t)l * 256 * D; j.K = 256; j.N = D; j.WT = rw2; j.mode = 2; j.item = r; return j; }
    r -= I_G2;
    l = r < I_SQ ? 1 : 0; r -= (1 - l) * I_SQ;
    { bf16_t* ro = WR + (size_t)l * (E_RW1 + E_RW2 + E_SQ) + E_RW1 + E_RW2; j.W = a->in[16] + (size_t)l * D * D; j.K = D; j.N = D; j.WT = ro; j.item = r; }
    return j;
}
__device__ __forceinline__ void cvt_job_load(const CvtJob& j, int lane, float (&v)[32]) {
    const int nblk = j.N / 32, kb = j.item / nblk, nb = j.item - kb * nblk, k0 = 64 * kb, n0 = 32 * nb;
    const float* p = j.W + (size_t)(k0 + (lane >> 5)) * j.N + n0 + (lane & 31);
#pragma unroll
    for (int i = 0; i < 32; ++i) v[i] = p[(size_t)(2 * i) * j.N];
}
__device__ __forceinline__ void cvt_job_store(const CvtJob& j, LAS float* scr, int lane, const float (&v)[32]) {
    const int nblk = j.N / 32, kb = j.item / nblk, nb = j.item - kb * nblk, k0 = 64 * kb, n0 = 32 * nb;
#pragma unroll
    for (int i = 0; i < 32; ++i) scr[(2 * i + (lane >> 5)) * 33 + (lane & 31)] = v[i];
    LDS_WAIT(); asm volatile("" ::: "memory");
    int dr;
    if (j.mode == 0) dr = n0;
    else if (j.mode == 1) { dr = n0 < FF ? 256 * (n0 / 128) + (n0 % 128) : 256 * ((n0 - FF) / 128) + 128 + ((n0 - FF) % 128); }
    else { dr = (n0 & ~255) + hp_row(n0 & 255); }
    dr += j.row_off;
    const int c = lane & 7;
#pragma unroll
    for (int q = 0; q < 4; ++q) { const int n = (lane >> 3) + 8 * q; const LAS float* sp = scr + (8 * c) * 33 + n;
        u32x4 o; o.x = pk2(sp[0 * 33], sp[1 * 33]); o.y = pk2(sp[2 * 33], sp[3 * 33]); o.z = pk2(sp[4 * 33], sp[5 * 33]); o.w = pk2(sp[6 * 33], sp[7 * 33]);
        *(u32x4*)(j.WT + (size_t)(dr + n) * j.K + k0 + 8 * c) = o; }
    LDS_WAIT(); asm volatile("" ::: "memory");
}
__device__ __forceinline__ void p0a_phase(const Frame F, KArgs* a) {
    const int lane_ = lane_opaque(), tid_ = F.wave * 64 + lane_; (void)tid_; (void)lane_;
    LAS float* scr = (LAS float*)(F.lds + F.wave * 16384);
    const int gw = F.bid * NWAVES + F.wave, NGW = F.G * NWAVES;
    bf16_t* WR = (bf16_t*)(a->ws + WS_WR);
    for (int it = gw; it < CVT_N0; it += NGW) { const CvtJob j = cvt_decode(a, it, 0); float v[32]; cvt_job_load(j, lane_, v); cvt_job_store(j, scr, lane_, v); }
    {
        constexpr int P_A = 256 * 2048 / 2, P_C = 4096 * 256 / 2, P_J = 2 * P_A + 2 * P_C;
        for (int p = F.bid * NTHR + tid_; p < 2 * P_J; p += F.G * NTHR) {
            const int j = p / P_J; int r = p - j * P_J;
            bf16_t* rw1 = WR + (size_t)j * (E_RW1 + E_RW2 + E_SQ); bf16_t* rw2 = rw1 + E_RW1;
            if (r < 2 * P_A) { const int which = r / P_A; r -= which * P_A;
                const int rho = r / 1024, k = (r - rho * 1024) * 2, c = hp_col(rho);
                const float* src = (which == 0 ? a->in[20] : a->in[23]);
                float v0 = 0.f, v1 = 0.f;
                if (c < 192) { const int d = c / 96, jj = c - d * 96; const float* s = src + (((size_t)j * 2 + d) * D + k) * 96 + jj; v0 = s[0]; v1 = s[96]; }
                *(unsigned*)(rw1 + (size_t)(6400 + 256 * which + rho) * D + k) = pk2(v0, v1);
            } else { r -= 2 * P_A; const int which = r / P_C; r -= which * P_C;
                const int nrow = r / 128, k = (r - nrow * 128) * 2;
                const int d = nrow >> 11, np = nrow & 2047, c = (np & ~255) + hp_col(np & 255);
                const float* src = (which == 0 ? a->in[21] : a->in[24]);
                float v0 = 0.f, v1 = 0.f;
                if (k < 192 && (k / 96) == d) { const int kk = k - d * 96; const float* s = src + (((size_t)j * 2 + d) * 96 + kk) * D + c; v0 = s[0]; v1 = s[D]; }
                *(unsigned*)(rw2 + (size_t)(2048 + 4096 * which + nrow) * 256 + k) = pk2(v0, v1);
            }
        }
    }
#ifdef DBG_FILL_WS
    {
        u32x4* p = (u32x4*)(a->ws + WS_X); const size_t n16 = (WS_END - WS_X) / 16;
        for (size_t i = (size_t)F.bid * NTHR + tid_; i < n16; i += (size_t)F.G * NTHR) p[i] = (u32x4){0xAAAAAAAAu, 0xAAAAAAAAu, 0xAAAAAAAAu, 0xAAAAAAAAu};
    }
#endif
    {
        float* COS = (float*)(a->ws + WS_ROPE); float* SIN = COS + 4096 * 64;
        for (int p = F.bid * NTHR + tid_; p < 4096 * 64; p += F.G * NTHR) {
            const int t = p >> 6, f = p & 63; const int pos = f < 32 ? (t >> 6) : (t & 63); const int fi = f & 31;
            const float inv = exp2f(-(float)fi * (13.287712379549449f / 32.0f));
            const float ang = (float)pos * inv;
            COS[p] = cosf(ang); SIN[p] = sinf(ang);
        }
    }
    {
        LAS float* sv = (LAS float*)F.lds;
        LAS float* part = (LAS float*)(F.lds + 65536);
        float* MOD = (float*)(a->ws + WS_MOD);
        __syncthreads();
        for (int idx = tid_; idx < 5 * D; idx += NTHR) { const int cc = idx >> 11, kk = idx & 2047; const float x = cc < 4 ? a->in[1][cc * D + kk] : a->in[3][kk]; sv[kk * 8 + cc] = fsilu(x); }
        __syncthreads();
        for (int u = F.bid; u < 4 * 72; u += F.G) {
            const int l = u / 72, nb = u - l * 72;
            const int n = nb * 256 + lane_ * 4, k0 = F.wave * 256;
            const float* wp = a->in[4] + ((size_t)l * D + k0) * 18432 + n;
            f32x4 acc[5];
#pragma unroll
            for (int c = 0; c < 5; ++c) acc[c] = (f32x4){0.f, 0.f, 0.f, 0.f};
#pragma unroll 8
            for (int kk = 0; kk < 256; ++kk) { const f32x4 w4 = *(const f32x4*)(wp + (size_t)kk * 18432);
                const f32x4 s4 = *(const LAS f32x4*)(sv + (k0 + kk) * 8); const float s5 = sv[(k0 + kk) * 8 + 4];
                acc[0] += w4 * s4[0]; acc[1] += w4 * s4[1]; acc[2] += w4 * s4[2]; acc[3] += w4 * s4[3]; acc[4] += w4 * s5; }
#pragma unroll
            for (int c = 0; c < 5; ++c) *(LAS f32x4*)(part + (F.wave * 5 + c) * 256 + lane_ * 4) = acc[c];
            __syncthreads();
            for (int o = tid_; o < 5 * 256; o += NTHR) { const int c = o >> 8, col = o & 255; float s = a->in[5][(size_t)l * 18432 + nb * 256 + col];
#pragma unroll
                for (int w = 0; w < 8; ++w) s += part[(w * 5 + c) * 256 + col];
                MOD[((size_t)l * 5 + c) * 18432 + nb * 256 + col] = s; }
            __syncthreads();
        }
    }
}

template <int MODE> struct ThinCtx { float PA[4][8], PB[4][8], PC[4][8]; int cur_c; };
template <int MODE, bool CTXP>
__device__ __forceinline__ void thin_row(ThinCtx<MODE>& T, KArgs* a, const int lane, const int m, int l, int s, float wgt, int nl, int ns) {
    const float* MOD = (const float*)(a->ws + WS_MOD);
    bf16_t* X = (bf16_t*)(a->ws + WS_X)  ; bf16_t* Y = (bf16_t*)(a->ws + WS_Y); const bf16_t* OUT = (const bf16_t*)(a->ws + WS_OUT);
    const int b = m / TB, j = m - b * TB, c = j < CTXL ? 4 : b;
    if (MODE == 2 && c == 4) return;
    if (c != T.cur_c) {
        T.cur_c = c;
#pragma unroll
        for (int q = 0; q < 4; ++q) { const int e0 = 512 * q + 8 * lane;
            if (MODE != 0) { const float* gp = MOD + (((size_t)l * 5 + c) * 9 + s * 3 + 2) * D + e0; const float* np = a->in[7] + ((size_t)l * 3 + s) * D + e0;
#pragma unroll
                for (int i = 0; i < 8; ++i) T.PA[q][i] = wgt * gp[i] * np[i]; }
            if (MODE != 2) { const float* sc = MOD + (((size_t)nl * 5 + c) * 9 + ns * 3 + 1) * D + e0; const float* sh = MOD + (((size_t)nl * 5 + c) * 9 + ns * 3 + 0) * D + e0; const float* np = a->in[6] + ((size_t)nl * 3 + ns) * D + e0;
#pragma unroll
                for (int i = 0; i < 8; ++i) { T.PB[q][i] = np[i] * (1.0f + sc[i]); T.PC[q][i] = sh[i]; } } }
    }
    float x[4][8];
    if (MODE == 0) {
        const float* src = j < CTXL ? a->in[2] + ((size_t)b * CTXL + j) * D : a->in[0] + ((size_t)b * SEQ + (j - CTXL)) * D;
#pragma unroll
        for (int q = 0; q < 4; ++q) { const f32x4 v0 = *(const f32x4*)(src + 512 * q + 8 * lane), v1 = *(const f32x4*)(src + 512 * q + 8 * lane + 4);
#pragma unroll
            for (int e = 0; e < 4; ++e) { x[q][e] = v0[e]; x[q][4 + e] = v1[e]; } }
    } else {
        float o[4][8]; float ss = 0.f;
#pragma unroll
        for (int q = 0; q < 4; ++q) {
            if (CTXP) { const float* P0 = (const float*)(a->ws + WS_PART) + (size_t)(b * CTXL + j) * D + 512 * q + 8 * lane; const float* P1 = P0 + (size_t)(NB * CTXL) * D;
                const f32x4 a0 = *(const f32x4*)P0, a1 = *(const f32x4*)(P0 + 4), b0 = *(const f32x4*)P1, b1 = *(const f32x4*)(P1 + 4);
#pragma unroll
                for (int e = 0; e < 4; ++e) { o[q][e] = a0[e] + b0[e]; o[q][4 + e] = a1[e] + b1[e]; } }
            else unpack8(*(const u32x4*)(OUT + (size_t)m * D + 512 * q + 8 * lane), o[q]);
#pragma unroll
            for (int i = 0; i < 8; ++i) ss += o[q][i] * o[q][i]; }
        ss = wave_sum(ss);
        const float r1 = rsqrtf(ss * (1.0f / D) + NORM_EPS);
#pragma unroll
        for (int q = 0; q < 4; ++q) { float xo[8]; unpack8h(*(const u32x4*)(X + (size_t)m * D + 512 * q + 8 * lane), xo);
#pragma unroll
            for (int e = 0; e < 8; ++e) x[q][e] = xo[e] + T.PA[q][e] * (o[q][e] * r1); }
    }
    if (MODE == 2) {
        float* dst = a->out + ((size_t)b * SEQ + (j - CTXL)) * D;
#pragma unroll
        for (int q = 0; q < 4; ++q) { *(f32x4*)(dst + 512 * q + 8 * lane) = (f32x4){x[q][0], x[q][1], x[q][2], x[q][3]}; *(f32x4*)(dst + 512 * q + 8 * lane + 4) = (f32x4){x[q][4], x[q][5], x[q][6], x[q][7]}; }
        return;
    }
    float ss2 = 0.f;
#pragma unroll
    for (int q = 0; q < 4; ++q) { *(u32x4*)(X + (size_t)m * D + 512 * q + 8 * lane) = pack8h(x[q]);
#pragma unroll
        for (int i = 0; i < 8; ++i) ss2 += x[q][i] * x[q][i]; }
    ss2 = wave_sum(ss2);
    const float r2 = rsqrtf(ss2 * (1.0f / D) + NORM_EPS);
#pragma unroll
    for (int q = 0; q < 4; ++q) { float y[8];
#pragma unroll
        for (int i = 0; i < 8; ++i) y[i] = (x[q][i] * r2) * T.PB[q][i] + T.PC[q][i];
        *(u32x4*)(Y + (size_t)m * D + 512 * q + 8 * lane) = pack8(y); }
}
template <int MODE, int ROWSET, int NX = NCTXWG, int WX = 0>
__device__ __forceinline__ void thin_phase(const Frame F, KArgs* a, int l, int s, float wgt, int nl, int ns) {
    const int lane_ = lane_opaque();
    ThinCtx<MODE> T; T.cur_c = -1;
    if (ROWSET == 0) {
        for (int ch = F.bid; ch < M / 68; ch += F.G) {
            const int r0 = ch * 68 + (F.wave < 4 ? 9 * F.wave : 36 + 8 * (F.wave - 4)), nr = F.wave < 4 ? 9 : 8;
            for (int r = 0; r < nr; ++r) thin_row<MODE, false>(T, a, lane_, r0 + r, l, s, wgt, nl, ns);
        }
    } else if (ROWSET == 1) {
        const long tot = (long)NX * NWAVES * WX + (long)(F.G - NX) * NWAVES * 8;
        const long st = F.bid < NX ? (long)(F.bid * NWAVES + F.wave) * WX : (long)NX * NWAVES * WX + (long)((F.bid - NX) * NWAVES + F.wave) * 8, en = st + (F.bid < NX ? WX : 8);
        const int l0 = (int)((st * (NB * SEQ)) / tot), l1 = (int)((en * (NB * SEQ)) / tot);
        for (int li = l0; li < l1; ++li) thin_row<MODE, false>(T, a, lane_, (li >> 12) * TB + CTXL + (li & (SEQ - 1)), l, s, wgt, nl, ns);
    } else {
        for (int c = F.bid * NWAVES + F.wave; c < NB * CTXL; c += F.G * NWAVES) thin_row<MODE, true>(T, a, lane_, (c >> 8) * TB + (c & (CTXL - 1)), l, s, wgt, nl, ns);
    }
}
__device__ __forceinline__ void ctx_group_thin(const Frame F, KArgs* a, unsigned* bar, int site, int l, int s, float wgt, int nl, int ns) {
    asm volatile("s_waitcnt vmcnt(0)" ::: "memory");
    __syncthreads();
    const int lane_ = lane_opaque();
    if (F.wave == 0 && lane_ == 0) {
        unsigned* c = (unsigned*)(a->ws + WS_CTL) + CW_GRP + (site * 4 + (F.bid >> 4)) * 64;
        __builtin_amdgcn_fence(__ATOMIC_RELEASE, "agent");
        asm volatile("s_waitcnt vmcnt(0)" ::: "memory");
        (void)xb_add(c, 1u);
        XB_SPIN(xb_ld(c) < 16u, bar);
        __builtin_amdgcn_fence(__ATOMIC_ACQUIRE, "agent");
        asm volatile("s_waitcnt vmcnt(0)" ::: "memory");
    }
    __syncthreads();
    ThinCtx<1> T; T.cur_c = -1;
    const int b = F.bid >> 4, r0 = (F.bid & 15) * 16 + F.wave * 2;
    thin_row<1, true>(T, a, lane_, b * TB + r0, l, s, wgt, nl, ns);
    thin_row<1, true>(T, a, lane_, b * TB + r0 + 1, l, s, wgt, nl, ns);
}
__device__ __forceinline__ void ctx_group_sync(const Frame F, KArgs* a, unsigned* bar, int site, int panel, unsigned n) {
    asm volatile("s_waitcnt vmcnt(0)" ::: "memory");
    __syncthreads();
    if (F.wave == 0 && lane_opaque() == 0) {
        unsigned* c = (unsigned*)(a->ws + WS_CTL) + CW_GRP + (site * 4 + panel) * 64;
        __builtin_amdgcn_fence(__ATOMIC_RELEASE, "agent");
        asm volatile("s_waitcnt vmcnt(0)" ::: "memory");
        (void)xb_add(c, 1u);
        XB_SPIN(xb_ld(c) < n, bar);
        __builtin_amdgcn_fence(__ATOMIC_ACQUIRE, "agent");
        asm volatile("s_waitcnt vmcnt(0)" ::: "memory");
    }
    __syncthreads();
}
struct CtxOrder8 {
    int c;
    __device__ bool next(int i, Unit& u) const { if (i != 0 || c >= 32) return false; u.pm = (c >> 3) * 17; u.pn = c & 7; return true; }
    __device__ __forceinline__ void a_ready(const Unit&) const {}
    __device__ __forceinline__ void done(const Unit&) const {}
};
__device__ __forceinline__ void ctx_mixer_thin(const Frame F, KArgs* a, unsigned* bar, int site, int l, int s, float wgt, int nl, int ns) {
    ctx_group_sync(F, a, bar, site, F.bid >> 3, 8u);
    const int lane_ = lane_opaque();
    ThinCtx<1> T; T.cur_c = -1;
    const int b = F.bid >> 3, r0 = (F.bid & 7) * 32 + F.wave * 4;
#pragma unroll 1
    for (int r = 0; r < 4; ++r) thin_row<1, false>(T, a, lane_, b * TB + r0 + r, l, s, wgt, nl, ns);
}
struct Ffn1Order {
    int G, c; unsigned* ctr;
    __device__ bool next(int i, Unit& u) const {
        const int L = i * G + c; if (L >= 68 * 44) return false;
        if (L < 176) { const int p = L / 44; u.pm = p * 17; u.pn = L - p * 44; return true; }
        constexpr int nM = 64, nN = 44, nwg = nM * nN;
        int wgid = L - 176; { const int q = nwg / pg8::NXCD, r = nwg % pg8::NXCD, xcd = wgid % pg8::NXCD, off = wgid / pg8::NXCD; wgid = (xcd < r ? xcd * (q + 1) : r * (q + 1) + (xcd - r) * q) + off; }
        const int nig = pg8::WGM * nN, gid = wgid / nig, fm = gid * pg8::WGM, gsz = (nM - fm) < pg8::WGM ? (nM - fm) : pg8::WGM;
        const int pl = fm + ((wgid % nig) % gsz); u.pm = pl + (pl >> 4) + 1; u.pn = (wgid % nig) / gsz; return true;
    }
    __device__ __forceinline__ void a_ready(const Unit&) const {}
    __device__ __forceinline__ void done(const Unit& u) const {
        if (u.pm % 17 == 0) {
            asm volatile("s_waitcnt vmcnt(0)" ::: "memory");
            __builtin_amdgcn_s_barrier();
            if (threadIdx.x == 0) { __builtin_amdgcn_fence(__ATOMIC_RELEASE, "agent"); asm volatile("s_waitcnt vmcnt(0)" ::: "memory"); (void)xb_add(ctr, 1u); }
        }
    }
};
struct LatentOrder : pg8::StaticOrder {
    __device__ void init_lat(int N, int G_, int c_) { init(64 * 256, N, G_, c_); }
    __device__ bool next(int i, Unit& u) const { if (!pg8::StaticOrder::next(i, u)) return false; u.pm = u.pm + (u.pm >> 4) + 1; return true; }
};
struct CtxOrder2 {
    int c;
    __device__ bool next(int i, Unit& u) const { if (i != 0 || c >= NCTXWG) return false; const int idx = c >> 1; u.pm = (idx >> 3) * 17; u.pn = (idx & 7) + 8 * (c & 1); return true; }
    __device__ __forceinline__ void a_ready(const Unit&) const {}
    __device__ __forceinline__ void done(const Unit&) const {}
};
struct GemmCtxSplit { const bf16_t* A; const bf16_t* Bt; int K;
    __device__ __forceinline__ const char* a_tile(const Unit& u) const { return (const char*)A + (size_t)u.pm * (size_t)(256 * 2) * K + (size_t)(u.pn >> 3) * (size_t)(K / 2) * 2; }
    __device__ __forceinline__ const char* b_tile(const Unit& u) const { return (const char*)Bt + (size_t)(u.pn & 7) * (size_t)(256 * 2) * K + (size_t)(u.pn >> 3) * (size_t)(K / 2) * 2; }
    __device__ __forceinline__ int klen() const { return K / 2; } };
struct EpiCtxPart {
    static constexpr bool PERM = true, AFTER_DRAIN = false;
    float* P;
    __device__ __forceinline__ void operator()(const accf32x4 (&acc)[2][2][4][2], const Unit& u, int wr, int wc, int fr, int fq) const {
        const int row0 = (u.pm / 17) * 256 + wr * 64 + fr, col0 = (u.pn & 7) * 256 + wc * 32 + 8 * fq;
        float* base = P + (size_t)(u.pn >> 3) * (NB * CTXL) * D;
#pragma unroll
        for (int ai = 0; ai < 2; ++ai)
#pragma unroll
            for (int m = 0; m < 4; ++m) { float* rowp = base + (size_t)(row0 + ai * 128 + m * 16) * D + col0;
#pragma unroll
                for (int bj = 0; bj < 2; ++bj) { *(f32x4*)(rowp + bj * 128) = acc[ai][bj][m][0]; *(f32x4*)(rowp + bj * 128 + 4) = acc[ai][bj][m][1]; } }
    }
};
#ifndef DBG_DUMP_OFF
#define DBG_DUMP_OFF WS_X
#define DBG_DUMP_F32 1
#endif
__device__ __forceinline__ void copyout_phase(const Frame F, KArgs* a) {
    const int lane_ = lane_opaque();
    for (int m = F.bid * NWAVES + F.wave; m < M; m += F.G * NWAVES) { const int b = m / TB, j = m - b * TB; if (j < CTXL) continue;
        float* dst = a->out + ((size_t)b * SEQ + (j - CTXL)) * D;
#if defined(DBG_DUMP_P256)
        { const size_t offs[] = {DBG_DUMP_P256}; constexpr int NL = sizeof(offs) / sizeof(offs[0]);
          for (int q = 0; q < 4; ++q) { float acc[8], v[8]; for (int e = 0; e < 8; ++e) acc[e] = 0.f;
              if (q == 0 && lane_ < 32) { for (int t = 0; t < NL; ++t) { unpack8(*(const u32x4*)((const bf16_t*)(a->ws + offs[t]) + (size_t)m * 256 + 8 * lane_), v); for (int e = 0; e < 8; ++e) acc[e] += (1.f + t) * v[e]; } }
              *(f32x4*)(dst + 512 * q + 8 * lane_) = (f32x4){acc[0], acc[1], acc[2], acc[3]}; *(f32x4*)(dst + 512 * q + 8 * lane_ + 4) = (f32x4){acc[4], acc[5], acc[6], acc[7]}; }
          continue; }
#endif
#ifndef DBG_DUMP_W
#define DBG_DUMP_W(t) (1.f + (t))
#endif
#if defined(DBG_DUMP_LIST)
        { const size_t offs[] = {DBG_DUMP_LIST}; constexpr int NL = sizeof(offs) / sizeof(offs[0]);
#pragma unroll
          for (int q = 0; q < 4; ++q) { const size_t ro = (size_t)m * D + 512 * q + 8 * lane_; float acc[8], v[8];
              for (int e = 0; e < 8; ++e) acc[e] = 0.f;
#pragma unroll
              for (int t = 0; t < NL; ++t) { unpack8(*(const u32x4*)((const bf16_t*)(a->ws + offs[t]) + ro), v); for (int e = 0; e < 8; ++e) acc[e] += DBG_DUMP_W(t) * v[e]; }
              *(f32x4*)(dst + 512 * q + 8 * lane_) = (f32x4){acc[0], acc[1], acc[2], acc[3]}; *(f32x4*)(dst + 512 * q + 8 * lane_ + 4) = (f32x4){acc[4], acc[5], acc[6], acc[7]}; }
          continue; }
#endif
        if (DBG_DUMP_F32) { const float* X = (const float*)(a->ws + (DBG_DUMP_OFF));
#pragma unroll
            for (int q = 0; q < 8; ++q) *(f32x4*)(dst + 256 * q + 4 * lane_) = *(const f32x4*)(X + (size_t)m * D + 256 * q + 4 * lane_); }
        else { const bf16_t* Bq = (const bf16_t*)(a->ws + (DBG_DUMP_OFF));
#pragma unroll
            for (int q = 0; q < 4; ++q) { float v[8]; unpack8(*(const u32x4*)(Bq + (size_t)m * D + 512 * q + 8 * lane_), v);
                *(f32x4*)(dst + 512 * q + 8 * lane_) = (f32x4){v[0], v[1], v[2], v[3]}; *(f32x4*)(dst + 512 * q + 8 * lane_ + 4) = (f32x4){v[4], v[5], v[6], v[7]}; } }
    }
}

__device__ __forceinline__ void mixes_phase(const Frame F, KArgs* a, int jr) {
    const int lane_ = lane_opaque(), tid_ = F.wave * 64 + lane_; (void)tid_; (void)lane_;
    const bf16_t* Y = (const bf16_t*)(a->ws + WS_Y); bf16_t* MIX = (bf16_t*)(a->ws + WS_MIX6);
    const int rg = F.wave >> 2, e0 = 512 * (F.wave & 3) + 8 * lane_;
    float mu[6][8];
    { const int muidx[6] = {0, 2, 3, 5, 1, 4};
#pragma unroll
      for (int q = 0; q < 6; ++q) { const float* mp = a->in[14] + ((size_t)jr * 6 + muidx[q]) * D + e0;
#pragma unroll
          for (int i = 0; i < 8; ++i) mu[q][i] = mp[i]; } }
    for (int ch = F.bid; ch < M / 68; ch += F.G) {
        const int r0 = ch * 68 + 34 * rg;
        float yp[8], yc[8], yn[8];
        if (r0 > 0) unpack8(*(const u32x4*)(Y + (size_t)(r0 - 1) * D + e0), yp); else {
#pragma unroll
            for (int i = 0; i < 8; ++i) yp[i] = 0.f; }
        unpack8(*(const u32x4*)(Y + (size_t)r0 * D + e0), yc);
        for (int r = 0; r < 34; ++r) { const int m = r0 + r, j = m % TB;
            if (m + 1 < M) unpack8(*(const u32x4*)(Y + (size_t)(m + 1) * D + e0), yn); else {
#pragma unroll
                for (int i = 0; i < 8; ++i) yn[i] = 0.f; }
            const float pv = (j != 0 && j != CTXL) ? 0.5f : 0.f, nv = (j != CTXL - 1 && j != TB - 1) ? 0.5f : 0.f;
            float xx[8];
#pragma unroll
            for (int i = 0; i < 8; ++i) xx[i] = (pv * yp[i] + nv * yn[i]) - yc[i];
#pragma unroll
            for (int q = 0; q < 6; ++q) { float o[8];
#pragma unroll
                for (int i = 0; i < 8; ++i) o[i] = yc[i] + xx[i] * mu[q][i];
                *(u32x4*)(MIX + (size_t)q * M * D + (size_t)m * D + e0) = pack8(o); }
#pragma unroll
            for (int i = 0; i < 8; ++i) { yp[i] = yc[i]; yc[i] = yn[i]; }
        }
    }
}

__device__ __forceinline__ void qknorm_phase(const Frame F, KArgs* a, int ja) {
    const int lane_ = lane_opaque(), tid_ = F.wave * 64 + lane_; (void)tid_; (void)lane_;
    bf16_t* Q = (bf16_t*)(a->ws + WS_Q); bf16_t* K = (bf16_t*)(a->ws + WS_K);
    const float* COS = (const float*)(a->ws + WS_ROPE); const float* SIN = COS + 4096 * 64;
    const int li = lane_ & 15, hs = lane_ >> 4;
    float gq[8], gk[8];
#pragma unroll
    for (int i = 0; i < 8; ++i) { gq[i] = a->in[12][ja * 128 + 8 * li + i]; gk[i] = a->in[13][ja * 128 + 8 * li + i]; }
    for (int m = F.bid * NWAVES + F.wave; m < M; m += F.G * NWAVES) {
        const int j = m % TB; const bool lat = j >= CTXL; const int pos = lat ? j - CTXL : 0;
        f32x4 cs = (f32x4){1.f, 1.f, 1.f, 1.f}, sn = (f32x4){0.f, 0.f, 0.f, 0.f};
        if (lat) { cs = *(const f32x4*)(COS + (size_t)pos * 64 + 4 * li); sn = *(const f32x4*)(SIN + (size_t)pos * 64 + 4 * li); }
#pragma unroll
        for (int p = 0; p < 5; ++p) {
            bf16_t* ptr = p < 4 ? Q + (size_t)m * D + (4 * p + hs) * 128 + 8 * li : K + (size_t)m * 512 + hs * 128 + 8 * li;
            float v[8]; unpack8(*(const u32x4*)ptr, v);
            float ss = 0.f;
#pragma unroll
            for (int i = 0; i < 8; ++i) ss += v[i] * v[i];
            ss = sum16(ss);
            const float rs = rsqrtf(ss * (1.0f / 128.0f) + NORM_EPS);
            float o[8];
#pragma unroll
            for (int i = 0; i < 4; ++i) { const float x1 = v[2 * i] * rs * (p < 4 ? gq[2 * i] : gk[2 * i]), x2 = v[2 * i + 1] * rs * (p < 4 ? gq[2 * i + 1] : gk[2 * i + 1]);
                o[2 * i] = x1 * cs[i] - x2 * sn[i]; o[2 * i + 1] = x1 * sn[i] + x2 * cs[i]; }
            *(u32x4*)ptr = pack8(o);
        }
    }
}

template <int R> __device__ __forceinline__ float ror16(float x) { return __builtin_bit_cast(float, __builtin_amdgcn_mov_dpp(__builtin_bit_cast(int, x), 0x120 + R, 0xF, 0xF, true)); }
__device__ __forceinline__ float sum_row16(float x) { x += ror16<8>(x); x += ror16<4>(x); x += ror16<2>(x); x += ror16<1>(x); return x; }
__device__ __forceinline__ float sum_rows(float x) {
    x += ror16<8>(x);
    { const unsigned u = __builtin_bit_cast(unsigned, x); auto rr = __builtin_amdgcn_permlane16_swap(u, u, false, false); const unsigned r0 = rr[0], r1 = rr[1];
      x = __builtin_bit_cast(float, r0) + __builtin_bit_cast(float, r1); }
    { const unsigned u = __builtin_bit_cast(unsigned, x); auto rr = __builtin_amdgcn_permlane32_swap(u, u, false, false); const unsigned r0 = rr[0], r1 = rr[1];
      x = __builtin_bit_cast(float, r0) + __builtin_bit_cast(float, r1); }
    return x;
}
template <bool HI> __device__ __forceinline__ f32x2 pk_mul_bc(f32x2 a, f32x2 b) { f32x2 d;
    if (HI) asm("v_pk_mul_f32 %0, %1, %2 op_sel:[0,1] op_sel_hi:[1,1]" : "=v"(d) : "v"(a), "v"(b)); else asm("v_pk_mul_f32 %0, %1, %2 op_sel_hi:[1,0]" : "=v"(d) : "v"(a), "v"(b)); return d; }
template <bool HI> __device__ __forceinline__ f32x2 pk_fma_bc(f32x2 a, f32x2 b, f32x2 c) { f32x2 d;
    if (HI) asm("v_pk_fma_f32 %0, %1, %2, %3 op_sel:[0,1,0] op_sel_hi:[1,1,1]" : "=v"(d) : "v"(a), "v"(b), "v"(c)); else asm("v_pk_fma_f32 %0, %1, %2, %3 op_sel_hi:[1,0,1]" : "=v"(d) : "v"(a), "v"(b), "v"(c)); return d; }
template <bool HI> __device__ __forceinline__ f32x2 pk_nfma_bc(f32x2 a, f32x2 b, f32x2 c) { f32x2 d;
    if (HI) asm("v_pk_fma_f32 %0, %1, %2, %3 op_sel:[0,1,0] op_sel_hi:[1,1,1] neg_lo:[1,0,0] neg_hi:[1,0,0]" : "=v"(d) : "v"(a), "v"(b), "v"(c));
    else asm("v_pk_fma_f32 %0, %1, %2, %3 op_sel_hi:[1,0,1] neg_lo:[1,0,0] neg_hi:[1,0,0]" : "=v"(d) : "v"(a), "v"(b), "v"(c)); return d; }
__device__ __forceinline__ void scan_phase(const Frame F, KArgs* a, int jr, const bool cvt_late, unsigned* bar) {
    const int lane_ = lane_opaque(), tid_ = F.wave * 64 + lane_; (void)tid_; (void)lane_;
    LAS float* L = (LAS float*)F.lds;
    constexpr int BUF = 32 * 384, YB0 = 2 * BUF, YBUF = 32 * 64;
    const int lane = lane_, li8 = (lane & 7) * 8, vrow = 16 * (F.wave & 3) + 2 * (lane >> 3);
    const bool comp = F.wave < 4;
    const bf16_t* KR = (const bf16_t*)(a->ws + WS_KK_); const bf16_t* AA = (const bf16_t*)(a->ws + WS_AA);
    const bf16_t* KN = (const bf16_t*)(a->ws + WS_KN); const bf16_t* RR = (const bf16_t*)(a->ws + WS_RR); const bf16_t* VV = (const bf16_t*)(a->ws + WS_VV);
    bf16_t* YS = (bf16_t*)(a->ws + WS_YS);
    for (int chain = F.bid; chain < 256; chain += F.G) {
        const int b = chain >> 6, h = (chain >> 1) & 31, dir = chain & 1;
        const size_t doff = (size_t)dir * M * D;
        const int hc = h * 64;
#define SCAN_M0(q) (b * TB + (dir == 0 ? 32 * (q) : ((q) < 8 ? 224 - 32 * (q) : 4576 - 32 * (q))))
        __syncthreads();
        if (!comp) {
            const int t = tid_ - 256, lrow = t >> 3, lpart = t & 7, trow = dir ? 31 - lrow : lrow;
            const bf16_t* pk_ = KR + hc + lpart * 8; const bf16_t* pn_ = KN + hc + lpart * 8; const bf16_t* pa_ = AA + doff + hc + lpart * 8;
            const bf16_t* pr_ = RR + hc + lpart * 8; const bf16_t* pv_ = VV + hc + lpart * 8; const bf16_t* pw_ = (const bf16_t*)(a->ws + WS_WDEC) + doff + hc + lpart * 8;
            float ka[8], rk[8];
#pragma unroll
            for (int i = 0; i < 8; ++i) { ka[i] = a->in[26][(size_t)jr * D + hc + lpart * 8 + i]; rk[i] = a->in[27][(size_t)jr * D + hc + lpart * 8 + i]; }
            float* BON = (float*)(a->ws + WS_BON) + (size_t)dir * M * 32 + h;
            const bf16_t* YSo = YS + (size_t)(1 - dir) * M * D + hc + lpart * 8; const float* BONo = (const float*)(a->ws + WS_BON) + (size_t)(1 - dir) * M * 32 + h;
            const bf16_t* GGp = (const bf16_t*)(a->ws + WS_GG) + hc + lpart * 8; bf16_t* PREPp = (bf16_t*)(a->ws + WS_PREP) + hc + lpart * 8;
            float lnw8[8], lnb8[8]; float sb_prev = 0.f;
#pragma unroll
            for (int i = 0; i < 8; ++i) { lnw8[i] = a->in[28][(size_t)jr * D + hc + lpart * 8 + i]; lnb8[i] = a->in[29][(size_t)jr * D + hc + lpart * 8 + i]; }
#define SCAN_PREP(m_, o_, v_, bs_) do { float sm_ = 0.f; _Pragma("unroll") for (int i_ = 0; i_ < 8; ++i_) sm_ += o_[i_]; const float mean_ = sum8(sm_) * (1.0f / 64.0f); float sq_ = 0.f; \
        _Pragma("unroll") for (int i_ = 0; i_ < 8; ++i_) { o_[i_] -= mean_; sq_ += o_[i_] * o_[i_]; } const float rs_ = rsqrtf(sum8(sq_) * (1.0f / 64.0f) + 64e-5f); \
        float g_[8], out_[8]; unpack8(*(const u32x4*)(GGp + (size_t)(m_) * D), g_); \
        _Pragma("unroll") for (int i_ = 0; i_ < 8; ++i_) out_[i_] = (o_[i_] * rs_ * lnw8[i_] + lnb8[i_] + (bs_) * v_[i_]) * g_[i_]; \
        *(u32x4*)(PREPp + (size_t)(m_) * D) = pack8(out_); } while (0)
            u32x4 gk, gn, ga, gr, gv, gw;
#define SCAN_LOAD(q) do { const size_t ro_ = ((size_t)SCAN_M0(q) + trow) * D; gk = *(const u32x4*)(pk_ + ro_); gn = *(const u32x4*)(pn_ + ro_); ga = *(const u32x4*)(pa_ + ro_); \
        gr = *(const u32x4*)(pr_ + ro_); gv = *(const u32x4*)(pv_ + ro_); gw = *(const u32x4*)(pw_ + ro_); } while (0)
#define SCAN_ST8(off_, t_) do { *(LAS f32x4*)(d_ + (off_)) = (f32x4){t_[0], t_[1], t_[2], t_[3]}; *(LAS f32x4*)(d_ + (off_) + 4) = (f32x4){t_[4], t_[5], t_[6], t_[7]}; } while (0)
#define SCAN_WRITE(bufi) do { LAS float* d_ = L + (bufi) * BUF + lrow * 384 + lpart * 8; \
        { float ta_[8], tb_[8], tc_[8]; unpack8(gk, ta_); unpack8(gn, tb_); unpack8(ga, tc_); float kd_[8], bb_[8]; \
          _Pragma("unroll") for (int i_ = 0; i_ < 8; ++i_) { kd_[i_] = ta_[i_] * (1.0f + (tc_[i_] - 1.0f) * ka[i_]); bb_[i_] = tb_[i_] * tc_[i_]; } \
          SCAN_ST8(64, kd_); SCAN_ST8(128, bb_); SCAN_ST8(192, tb_); } \
        { float ta_[8], tb_[8], tc_[8]; unpack8(gr, ta_); unpack8(gv, tb_); unpack8(gw, tc_); \
          _Pragma("unroll") for (int i_ = 0; i_ < 8; ++i_) tc_[i_] = __builtin_amdgcn_exp2f(tc_[i_]); SCAN_ST8(0, tc_); SCAN_ST8(256, ta_); SCAN_ST8(320, tb_); } } while (0)
            SCAN_LOAD(0); SCAN_WRITE(0);
            float cv[32]; CvtJob cv_job; bool cv_have = false;
            cv_job.W = nullptr; cv_job.WT = nullptr; cv_job.K = cv_job.N = 32; cv_job.mode = cv_job.row_off = cv_job.item = 0;
#pragma unroll
            for (int i = 0; i < 32; ++i) cv[i] = 0.f;
            __syncthreads();
            for (int q = 0; q < 136; ++q) {
                const int bi = q & 1;
                if (q + 1 < 136) SCAN_LOAD(q + 1);
                if (cvt_late && chain == F.bid) {
                    LAS float* scr = (LAS float*)(F.lds + (F.wave == 4 ? 116736 : 132096 + (F.wave - 5) * 8448));
                    if (cv_have) { cvt_job_store(cv_job, scr, lane_, cv); cv_have = false; }
                    const int gwl = F.bid * 4 + (F.wave - 4), ngwl = F.G * 4, nper = (CVT_N1 + ngwl - 1) / ngwl;
                    const int k = (q * nper) / 136;
                    if (k < ((q + 1) * nper) / 136) { const int it = gwl + k * ngwl; if (it < CVT_N1) { cv_job = cvt_decode(a, it, 1); cvt_job_load(cv_job, lane_, cv); cv_have = true; } } }
                if (q > 0) {
                    const LAS float* ys = L + YB0 + (bi ^ 1) * YBUF + lrow * 64 + lpart * 8; float t8[8];
                    const f32x4 y0 = *(const LAS f32x4*)ys, y1 = *(const LAS f32x4*)(ys + 4);
#pragma unroll
                    for (int e = 0; e < 4; ++e) { t8[e] = y0[e]; t8[4 + e] = y1[e]; }
                    const size_t mrow = (size_t)SCAN_M0(q - 1) + trow;
                    if (q - 1 < 72) *(u32x4*)(YS + doff + mrow * D + hc + lpart * 8) = pack8(t8);
                    else { float yp[8], vv[8]; unpack8(*(const u32x4*)(YSo + mrow * D), yp);
                        const LAS float* pv = L + (bi ^ 1) * BUF + lrow * 384 + 320 + lpart * 8; const f32x4 v0 = *(const LAS f32x4*)pv, v1 = *(const LAS f32x4*)(pv + 4);
#pragma unroll
                        for (int e = 0; e < 4; ++e) { vv[e] = v0[e]; vv[4 + e] = v1[e]; }
#pragma unroll
                        for (int e = 0; e < 8; ++e) t8[e] += yp[e];
                        const float bs = sb_prev + BONo[mrow * 32];
                        SCAN_PREP(mrow, t8, vv, bs); } }
                if (q == 72) {
                    asm volatile("s_waitcnt vmcnt(0)" ::: "memory");
                    LAS unsigned* lc = (LAS unsigned*)(F.lds + 157696);
                    if (lane_ == 0) (void)__hip_atomic_fetch_add(lc, 1u, __ATOMIC_RELAXED, __HIP_MEMORY_SCOPE_WORKGROUP);
                    if (F.wave == 4) { unsigned sp_ = 0; while (__hip_atomic_load(lc, __ATOMIC_RELAXED, __HIP_MEMORY_SCOPE_WORKGROUP) < 4u && ++sp_ < (1u << 22)) __builtin_amdgcn_s_sleep(1);
                        if (lane_ == 0) { unsigned* pc = (unsigned*)(a->ws + WS_CTL) + CW_PAIR + (jr * 128 + (chain >> 1)) * 64;
                            __builtin_amdgcn_fence(__ATOMIC_RELEASE, "agent"); asm volatile("s_waitcnt vmcnt(0)" ::: "memory");
                            (void)xb_add(pc, 1u); XB_SPIN(xb_ld(pc) < 2u, bar);
                            __builtin_amdgcn_fence(__ATOMIC_ACQUIRE, "agent"); asm volatile("s_waitcnt vmcnt(0)" ::: "memory");
                            __hip_atomic_store(lc, 0u, __ATOMIC_RELAXED, __HIP_MEMORY_SCOPE_WORKGROUP); } } }
                if (dir == 0 && q >= 73 && q < 81) {
                    const size_t mrow = (size_t)(b * TB + 32 * (q - 73) + lrow); float o8[8], y1[8], vv[8];
                    unpack8(*(const u32x4*)(YS + mrow * D + hc + lpart * 8), o8); unpack8(*(const u32x4*)(YSo + mrow * D), y1); unpack8(*(const u32x4*)(VV + mrow * D + hc + lpart * 8), vv);
#pragma unroll
                    for (int e = 0; e < 8; ++e) o8[e] += y1[e];
                    const float bs = BON[mrow * 32] + BONo[mrow * 32];
                    SCAN_PREP(mrow, o8, vv, bs); }
                {
                    const LAS float* pr = L + bi * BUF + lrow * 384 + lpart * 8; const f32x4 r0 = *(const LAS f32x4*)(pr + 256), r1 = *(const LAS f32x4*)(pr + 260), k0 = *(const LAS f32x4*)(pr + 64), k1 = *(const LAS f32x4*)(pr + 68);
                    float sb = 0.f;
#pragma unroll
                    for (int e = 0; e < 4; ++e) sb += r0[e] * k0[e] * rk[e] + r1[e] * k1[e] * rk[4 + e];
                    sb = sum8(sb);
                    if (lpart == 0 && q < 72) BON[((size_t)SCAN_M0(q) + trow) * 32] = sb;
                    sb_prev = sb; }
                if (q + 1 < 136) SCAN_WRITE(bi ^ 1);
                __syncthreads();
            }
            if (cv_have) { LAS float* scr = (LAS float*)(F.lds + (F.wave == 4 ? 116736 : 132096 + (F.wave - 5) * 8448)); cvt_job_store(cv_job, scr, lane_, cv); }
            {   const LAS float* ys = L + YB0 + 1 * YBUF + lrow * 64 + lpart * 8; float t8[8];
                const f32x4 y0 = *(const LAS f32x4*)ys, y1 = *(const LAS f32x4*)(ys + 4);
#pragma unroll
                for (int e = 0; e < 4; ++e) { t8[e] = y0[e]; t8[4 + e] = y1[e]; }
                const size_t mrow = (size_t)SCAN_M0(135) + trow; float yp[8], vv[8]; unpack8(*(const u32x4*)(YSo + mrow * D), yp);
                const LAS float* pv = L + 1 * BUF + lrow * 384 + 320 + lpart * 8; const f32x4 v0 = *(const LAS f32x4*)pv, v1 = *(const LAS f32x4*)(pv + 4);
#pragma unroll
                for (int e = 0; e < 4; ++e) { vv[e] = v0[e]; vv[4 + e] = v1[e]; }
#pragma unroll
                for (int e = 0; e < 8; ++e) t8[e] += yp[e];
                const float bs = sb_prev + BONo[mrow * 32];
                SCAN_PREP(mrow, t8, vv, bs); }
#undef SCAN_PREP
#undef SCAN_LOAD
#undef SCAN_WRITE
#undef SCAN_ST8
        } else {
            f32x2 S2[8];
#pragma unroll
            for (int i = 0; i < 8; ++i) S2[i] = (f32x2){0.f, 0.f};
            __syncthreads();
            for (int q = 0; q < 136; ++q) {
                const int bi = q & 1;
                const LAS float* base = L + bi * BUF; constexpr int stp = 384;
                const bool lead = (lane & 7) == 0; const int ystp = lead ? 64 : 0;
                LAS float* yaddr = lead ? L + YB0 + bi * YBUF + vrow : L + YB0 + 2 * YBUF + ((F.wave & 3) * 64 + lane) * 2;
#define SCAN_LD8(dst_, p_, off_) do { const f32x4 lo_ = *(const LAS f32x4*)((p_) + (off_) + li8), hi_ = *(const LAS f32x4*)((p_) + (off_) + li8 + 4); \
        dst_[0] = (f32x2){lo_[0], lo_[1]}; dst_[1] = (f32x2){lo_[2], lo_[3]}; dst_[2] = (f32x2){hi_[0], hi_[1]}; dst_[3] = (f32x2){hi_[2], hi_[3]}; } while (0)
#define PKM_LO(d, a, b) "v_pk_mul_f32 " d ", " a ", " b " op_sel_hi:[1,0]\n\t"
#define PKM_HI(d, a, b) "v_pk_mul_f32 " d ", " a ", " b " op_sel:[0,1] op_sel_hi:[1,1]\n\t"
#define PKF_LO(d, a, b, c) "v_pk_fma_f32 " d ", " a ", " b ", " c " op_sel_hi:[1,0,1]\n\t"
#define PKF_HI(d, a, b, c) "v_pk_fma_f32 " d ", " a ", " b ", " c " op_sel:[0,1,0] op_sel_hi:[1,1,1]\n\t"
#define PKN_LO(d, a, b, c) "v_pk_fma_f32 " d ", " a ", " b ", " c " op_sel_hi:[1,0,1] neg_lo:[1,0,0] neg_hi:[1,0,0]\n\t"
#define PKN_HI(d, a, b, c) "v_pk_fma_f32 " d ", " a ", " b ", " c " op_sel:[0,1,0] op_sel_hi:[1,1,1] neg_lo:[1,0,0] neg_hi:[1,0,0]\n\t"
#define DPPA(r, ctl) "v_add_f32_dpp " r ", " r ", " r " " ctl " row_mask:0xf bank_mask:0xf\n\t"
#define DPP_1 "quad_perm:[1,0,3,2]"
#define DPP_2 "quad_perm:[2,3,0,1]"
#define DPP_3 "row_half_mirror"
#define SA_SUM(pk_, t_, v_, d_) asm volatile( \
        PKM_LO("%2", "%10", "%11") PKM_HI("%3", "%10", "%11") DPPA("%0", DPP_1) DPPA("%1", DPP_1) PKM_LO("%4", "%10", "%12") DPPA("%0", DPP_2) DPPA("%1", DPP_2) PKM_HI("%5", "%10", "%12") \
        DPPA("%0", DPP_3) DPPA("%1", DPP_3) PKM_LO("%6", "%10", "%13") PKM_HI("%7", "%10", "%13") PKM_LO("%8", "%10", "%14") PKM_HI("%9", "%10", "%14") \
        : "+v"(pk_.x), "+v"(pk_.y), "=&v"(t_[0]), "=&v"(t_[1]), "=&v"(t_[2]), "=&v"(t_[3]), "=&v"(t_[4]), "=&v"(t_[5]), "=&v"(t_[6]), "=&v"(t_[7]) \
        : "v"(v_), "v"(d_[0]), "v"(d_[1]), "v"(d_[2]), "v"(d_[3]))
#define UPD(S_, t_, pk_, b_, w_) asm volatile( \
        PKN_LO("%8", "%16", "%17", "%8") PKN_HI("%9", "%16", "%17", "%9") PKN_LO("%10", "%16", "%18", "%10") PKN_HI("%11", "%16", "%18", "%11") \
        PKN_LO("%12", "%16", "%19", "%12") PKN_HI("%13", "%16", "%19", "%13") PKN_LO("%14", "%16", "%20", "%14") PKN_HI("%15", "%16", "%20", "%15") \
        PKF_LO("%0", "%0", "%21", "%8") PKF_HI("%1", "%1", "%21", "%9") PKF_LO("%2", "%2", "%22", "%10") PKF_HI("%3", "%3", "%22", "%11") \
        PKF_LO("%4", "%4", "%23", "%12") PKF_HI("%5", "%5", "%23", "%13") PKF_LO("%6", "%6", "%24", "%14") PKF_HI("%7", "%7", "%24", "%15") \
        : "+v"(S_[0]), "+v"(S_[1]), "+v"(S_[2]), "+v"(S_[3]), "+v"(S_[4]), "+v"(S_[5]), "+v"(S_[6]), "+v"(S_[7]), \
          "+v"(t_[0]), "+v"(t_[1]), "+v"(t_[2]), "+v"(t_[3]), "+v"(t_[4]), "+v"(t_[5]), "+v"(t_[6]), "+v"(t_[7]) \
        : "v"(pk_), "v"(b_[0]), "v"(b_[1]), "v"(b_[2]), "v"(b_[3]), "v"(w_[0]), "v"(w_[1]), "v"(w_[2]), "v"(w_[3]))
#define DOT8(o_, o1_, S_, x_) asm volatile( \
        PKM_LO("%0", "%2", "%10") PKM_HI("%1", "%3", "%10") PKF_LO("%0", "%4", "%11", "%0") PKF_HI("%1", "%5", "%11", "%1") PKF_LO("%0", "%6", "%12", "%0") PKF_HI("%1", "%7", "%12", "%1") \
        PKF_LO("%0", "%8", "%13", "%0") PKF_HI("%1", "%9", "%13", "%1") "v_pk_add_f32 %0, %0, %1\n\t" \
        : "=&v"(o_), "=&v"(o1_) : "v"(S_[0]), "v"(S_[1]), "v"(S_[2]), "v"(S_[3]), "v"(S_[4]), "v"(S_[5]), "v"(S_[6]), "v"(S_[7]), "v"(x_[0]), "v"(x_[1]), "v"(x_[2]), "v"(x_[3]))
#define YSUM(yk_, o_, o1_, S_, x_) asm volatile( \
        PKM_LO("%2", "%4", "%12") PKM_HI("%3", "%5", "%12") DPPA("%0", DPP_1) DPPA("%1", DPP_1) PKF_LO("%2", "%6", "%13", "%2") DPPA("%0", DPP_2) DPPA("%1", DPP_2) PKF_HI("%3", "%7", "%13", "%3") \
        DPPA("%0", DPP_3) DPPA("%1", DPP_3) PKF_LO("%2", "%8", "%14", "%2") PKF_HI("%3", "%9", "%14", "%3") PKF_LO("%2", "%10", "%15", "%2") PKF_HI("%3", "%11", "%15", "%3") "v_pk_add_f32 %2, %2, %3\n\t" \
        : "+v"(yk_.x), "+v"(yk_.y), "=&v"(o_), "=&v"(o1_) : "v"(S_[0]), "v"(S_[1]), "v"(S_[2]), "v"(S_[3]), "v"(S_[4]), "v"(S_[5]), "v"(S_[6]), "v"(S_[7]), "v"(x_[0]), "v"(x_[1]), "v"(x_[2]), "v"(x_[3]))
                f32x2 nw[4], nd[4], nb[4], nn[4], nr[4]; f32x2 nv2;
                SCAN_LD8(nw, base, 0); SCAN_LD8(nd, base, 64); SCAN_LD8(nb, base, 128); SCAN_LD8(nn, base, 192); SCAN_LD8(nr, base, 256); nv2 = *(const LAS f32x2*)(base + 320 + vrow);
                f32x2 pk, pk1; DOT8(pk, pk1, S2, nn);
#pragma unroll 8
                for (int s = 0; s < 32; ++s) {
                    f32x2 w8[4], d8[4], b8[4], r8[4]; const f32x2 v2 = nv2;
#pragma unroll
                    for (int c = 0; c < 4; ++c) { w8[c] = nw[c]; d8[c] = nd[c]; b8[c] = nb[c]; r8[c] = nr[c]; }
                    { const LAS float* p = base + (s + 1) * stp;
                      SCAN_LD8(nw, p, 0); SCAN_LD8(nd, p, 64); SCAN_LD8(nb, p, 128); SCAN_LD8(nn, p, 192); SCAN_LD8(nr, p, 256); nv2 = *(const LAS f32x2*)(p + 320 + vrow); }
                    f32x2 t8[8];
                    SA_SUM(pk, t8, v2, d8);
                    UPD(S2, t8, pk, b8, w8);
                    f32x2 yk, yk1; DOT8(yk, yk1, S2, r8);
                    f32x2 npk, npk1; YSUM(yk, npk, npk1, S2, nn);
                    *(LAS f32x2*)(yaddr + s * ystp) = yk;
                    pk = npk;
                }
#undef PKM_LO
#undef PKM_HI
#undef PKF_LO
#undef PKF_HI
#undef PKN_LO
#undef PKN_HI
#undef DPPA
#undef SA_SUM
#undef UPD
#undef DOT8
#undef YSUM
#undef SCAN_LD8
                __syncthreads();
            }
        }
        __syncthreads();
#undef SCAN_M0
    }
}

__device__ __forceinline__ void outprep_phase(const Frame F, KArgs* a, int jr) {
    const int lane_ = lane_opaque(), tid_ = F.wave * 64 + lane_; (void)tid_; (void)lane_;
    const bf16_t* YS = (const bf16_t*)(a->ws + WS_YS); const float* BON = (const float*)(a->ws + WS_BON);
    const bf16_t* VV = (const bf16_t*)(a->ws + WS_VV); const bf16_t* GG = (const bf16_t*)(a->ws + WS_GG);
    bf16_t* PREP = (bf16_t*)(a->ws + WS_PREP);
    const float* lw = a->in[28] + (size_t)jr * D; const float* lb = a->in[29] + (size_t)jr * D;
    for (int m = F.bid * NWAVES + F.wave; m < M; m += F.G * NWAVES) {
#pragma unroll
        for (int q = 0; q < 4; ++q) { const int e0 = 512 * q + 8 * lane_; const size_t ro = (size_t)m * D + e0;
            float y0[8], y1[8], o[8];
            unpack8(*(const u32x4*)(YS + ro), y0); unpack8(*(const u32x4*)(YS + (size_t)M * D + ro), y1);
            float sm = 0.f;
#pragma unroll
            for (int i = 0; i < 8; ++i) { o[i] = y0[i] + y1[i]; sm += o[i]; }
            const float mean = sum8(sm) * (1.0f / 64.0f);
            float sq = 0.f;
#pragma unroll
            for (int i = 0; i < 8; ++i) { o[i] -= mean; sq += o[i] * o[i]; }
            const float rs = rsqrtf(sum8(sq) * (1.0f / 64.0f) + 64e-5f);
            float v[8], g[8];
            unpack8(*(const u32x4*)(VV + ro), v); unpack8(*(const u32x4*)(GG + ro), g);
            const int hd = e0 >> 6;
            const float bs = BON[(size_t)m * 32 + hd] + BON[(size_t)M * 32 + (size_t)m * 32 + hd];
            float out[8];
#pragma unroll
            for (int i = 0; i < 8; ++i) out[i] = (o[i] * rs * lw[e0 + i] + lb[e0 + i] + bs * v[i]) * g[i];
            *(u32x4*)(PREP + ro) = pack8(out); }
    }
}

__device__ __forceinline__ float attn_score_bound(KArgs* a, int ja) {
    const int ln = lane_opaque(); float mq = fmaxf(fabsf(a->in[12][ja * 128 + ln]), fabsf(a->in[12][ja * 128 + 64 + ln])), mk = fmaxf(fabsf(a->in[13][ja * 128 + ln]), fabsf(a->in[13][ja * 128 + 64 + ln]));
#pragma unroll
    for (int o = 1; o < 64; o <<= 1) { mq = fmaxf(mq, __shfl_xor(mq, o)); mk = fmaxf(mk, __shfl_xor(mk, o)); }
    return __builtin_bit_cast(float, __builtin_amdgcn_readfirstlane(__builtin_bit_cast(int, 128.0f * 1.02f * mq * mk)));
}
__device__ __forceinline__ void attention_phase(const Frame F, KArgs* a, int ja) {
    const attn::bf16* Q = (const attn::bf16*)(a->ws + WS_Q); const attn::bf16* K = (const attn::bf16*)(a->ws + WS_K); const attn::bf16* V = (const attn::bf16*)(a->ws + WS_V);
    attn::bf16* O = (attn::bf16*)(a->ws + WS_O);
    const float mfix = attn_score_bound(a, ja);
    const bool fixm = mfix * attn::SCALE <= 30.0f;
    for (int u = F.bid; u < 1024 + 64; u += F.G) {
        size_t qoff, koff; int seq;
        if (u < 1024) { const int c = u & 255, i = u >> 8, grp = (c & 7) >> 1, member = (c & 1) * 32 + (c >> 3), bk = i * 4 + grp, b = bk >> 2, kvh = bk & 3, hq = kvh * 4 + (member >> 4), qb = member & 15;
            qoff = (size_t)(b * TB + CTXL + qb * 256) * 2048 + hq * 128; koff = (size_t)b * TB * 512 + kvh * 128; seq = TB; }
        else { const int cu = u - 1024, b = cu >> 4, hq = cu & 15, kvh = hq >> 2;
            qoff = (size_t)(b * TB) * 2048 + hq * 128; koff = (size_t)b * TB * 512 + kvh * 128; seq = CTXL; }
        if (fixm) attn::attn_dense_body<attn::bf16, true>(Q + qoff, K + koff, V + koff, O + qoff, seq, (char*)F.ldsg, F.wave, mfix);
        else attn::attn_dense_body<attn::bf16, false>(Q + qoff, K + koff, V + koff, O + qoff, seq, (char*)F.ldsg, F.wave);
        __syncthreads();
    }
}

#ifndef EN_P0
#define EN_P0 1
#endif
#ifndef EN_THIN
#define EN_THIN 1
#endif
#ifndef EN_QKN
#define EN_QKN 1
#endif
#ifndef EN_ATT
#define EN_ATT 1
#endif
#ifndef EN_MIX
#define EN_MIX 1
#endif
#ifndef EN_SCAN
#define EN_SCAN 1
#endif
#ifndef EN_OPREP
#define EN_OPREP 1
#endif
#ifndef EN_FFN
#define EN_FFN 1
#endif
#ifndef EN_GQKV
#define EN_GQKV 1
#endif
#ifndef EN_GWO
#define EN_GWO 1
#endif
#ifndef EN_RW1
#define EN_RW1 1
#endif
#ifndef EN_RW2
#define EN_RW2 1
#endif
__device__ __forceinline__ KArgs* opaque_k(KArgs* p) { asm volatile("" : "+s"(p)); return p; }
#ifndef DBG_STOP
#define DBG_STOP -1
#endif
__device__ __forceinline__ Frame fresh(const Frame& F) { Frame R = F; asm volatile("" : "+s"(R.bid), "+s"(R.G), "+s"(R.wave)); return R; }
#ifndef GEMM_ALIGN
#define GEMM_ALIGN true
#define GEMM_SP2 true
#endif
#ifndef RW2_ALIGN
#define RW2_ALIGN true
#define RW2_SP2 true
#endif
#ifndef RW1_ALIGN
#define RW1_ALIGN true
#define RW1_SP2 true
#endif
#ifndef REP_THIN
#define REP_THIN 1
#endif
#ifndef REP_OG
#define REP_OG 1
#endif
#ifndef REP_EW
#define REP_EW 1
#endif
#ifndef REP_FFN1
#define REP_FFN1 1
#endif
#ifndef REP_FFN2
#define REP_FFN2 1
#endif
#ifndef REP_P0
#define REP_P0 1
#endif
#ifndef REP_SCAN
#define REP_SCAN 1
#endif
#ifndef REP_ATT
#define REP_ATT 1
#endif
#ifndef REP_RW1
#define REP_RW1 1
#endif
constexpr int NPHASE = 50;
constexpr int STOP_PHASE = (DBG_STOP >= 0) ? DBG_STOP : NPHASE - 1;
__global__ void __launch_bounds__(NTHR, 2) fwd_kernel(Args args) {
    extern __shared__ __attribute__((aligned(16))) unsigned char lds[];
    Frame F;
    F.lds = (LAS unsigned char*)lds; F.ldsg = lds;
    F.wave = __builtin_amdgcn_readfirstlane((int)threadIdx.x >> 6);
    F.G = gridDim.x; F.bid = blockIdx.x;
    for (int u = threadIdx.x; u < (LDS_BYTES - LDSCTL_OFF) / 4; u += NTHR) ((LAS unsigned*)(F.lds + LDSCTL_OFF))[u] = 0u;
    __syncthreads();
    KArgs* const kap = (KArgs*)__builtin_amdgcn_kernarg_segment_ptr();
    XcdBarrier bar = xcd_barrier_post((unsigned*)(kap->ws + WS_CTL) + CW_BAR + kap->li * XCD_BAR_WORDS, (volatile LAS unsigned*)(F.lds + MISC_OFF) + 8);
#define KA (opaque_k(kap))
#define ws (KA->ws)
#define IN(k) ((k) <= STOP_PHASE)
#define SEAM(k) do { if (IN(k) && IN((k) + 1)) { XcdBarrier bb_ = bar; asm volatile("" : "+s"(bb_.x), "+s"(bb_.bar)); xcd_barrier(bb_, fresh(F).wave == 0 && lane_opaque() == 0); } } while (0)
#define Yb ((bf16_t*)(ws + WS_Y))
#define ACTb ((bf16_t*)(ws + WS_ACT))
#define OUTb ((bf16_t*)(ws + WS_OUT))
#define BAR_NOW() do { XcdBarrier bb_ = bar; asm volatile("" : "+s"(bb_.x), "+s"(bb_.bar)); xcd_barrier(bb_, fresh(F).wave == 0 && lane_opaque() == 0); } while (0)
#define FFN_HALF(pk, lh, FINAL, tl, ts, tw, tnl, tns) do { \
    for (int rep_ = 0; rep_ < REP_FFN1; ++rep_) { if (rep_) __syncthreads(); \
    if (EN_FFN && IN(pk)) { const Frame Ff_ = fresh(F); const bf16_t* w1_ = (const bf16_t*)(ws + WS_WB) + (size_t)(lh) * (E_F1 + E_F2); \
        pg8::Gemm g_{Yb, w1_, D}; EpiSwiGLU E_{ACTb}; \
        if (FINAL) { LatentOrder S_; S_.init_lat(2 * FF, Ff_.G, Ff_.bid); pg8::gemm_phase<EpiSwiGLU, LatentOrder, pg8::Gemm, GEMM_ALIGN, GEMM_SP2>(Ff_.lds, g_, S_, E_, Ff_.wave); } \
        else { Ffn1Order S_{Ff_.G, Ff_.bid, (unsigned*)(ws + WS_CTL) + CW_FC + (lh) * 64}; pg8::gemm_phase<EpiSwiGLU, Ffn1Order, pg8::Gemm, true, GEMM_SP2>(Ff_.lds, g_, S_, E_, Ff_.wave); \
            if (rep_ == REP_FFN1 - 1 && Ff_.G == 256 && Ff_.bid >= 176 && Ff_.bid < 176 + NCTXWG) {     \
                const Frame Fc_ = fresh(F); XcdBarrier bg_ = bar; asm volatile("" : "+s"(bg_.bar)); \
                asm volatile("s_waitcnt vmcnt(0)" ::: "memory"); __syncthreads(); \
                if (Fc_.wave == 0 && lane_opaque() == 0) { unsigned* pc_ = (unsigned*)(ws + WS_CTL) + CW_FC + (lh) * 64; XB_SPIN(xb_ld(pc_) < 176u, bg_.bar); __builtin_amdgcn_fence(__ATOMIC_ACQUIRE, "agent"); asm volatile("s_waitcnt vmcnt(0)" ::: "memory"); } \
                __syncthreads(); \
                const bf16_t* w2c_ = (const bf16_t*)(ws + WS_WB) + (size_t)(lh) * (E_F1 + E_F2) + E_F1; \
                GemmCtxSplit gc_{ACTb, w2c_, FF}; CtxOrder2 Sc_{Fc_.bid - 176}; EpiCtxPart Ec_{(float*)(ws + WS_PART)}; \
                pg8::gemm_phase<EpiCtxPart, CtxOrder2, GemmCtxSplit, GEMM_ALIGN, GEMM_SP2>(Fc_.lds, gc_, Sc_, Ec_, Fc_.wave); } } } } \
    SEAM(pk); \
    for (int rep_ = 0; rep_ < REP_FFN2; ++rep_) { if (rep_) __syncthreads(); \
    if (EN_FFN && IN((pk) + 1)) { const Frame Ff_ = fresh(F); const bf16_t* w2_ = (const bf16_t*)(ws + WS_WB) + (size_t)(lh) * (E_F1 + E_F2) + E_F1; \
        pg8::Gemm g_{ACTb, w2_, FF}; LatentOrder S_; S_.init_lat(D, Ff_.G, Ff_.bid); EpiPlain E_{OUTb, D}; \
        pg8::gemm_phase<EpiPlain, LatentOrder, pg8::Gemm, GEMM_ALIGN, GEMM_SP2>(Ff_.lds, g_, S_, E_, Ff_.wave); } } \
    SEAM((pk) + 1); \
    if (IN((pk) + 2)) { const Frame Ff_ = fresh(F); \
        if (FINAL) thin_phase<2, 1, 0>(Ff_, KA, tl, ts, tw, tnl, tns); \
        else { for (int rt_ = 1; rt_ < REP_THIN; ++rt_) thin_phase<1, 1, 0>(Ff_, KA, tl, ts, 0.f, tnl, tns); thin_phase<1, 1, 0>(Ff_, KA, tl, ts, tw, tnl, tns); thin_phase<1, 2>(fresh(F), KA, tl, ts, tw, tnl, tns); } \
        } \
    SEAM((pk) + 2); } while (0)

    for (int rep_ = 0; rep_ < REP_P0; ++rep_) { if (rep_) __syncthreads(); if (EN_P0 && IN(0)) p0a_phase(fresh(F), KA); }
    SEAM(0);
    if (EN_THIN && IN(1)) thin_phase<0, 0>(fresh(F), KA, 0, 0, 0.f, 0, 0);
    SEAM(1);
    for (int lp = 0; lp < 2; ++lp) {
        const int pb = 2 + 24 * lp, la = 2 * lp, lr = 2 * lp + 1;
        FFN_HALF(pb + 0, la * 2 + 0, 0, la, 0, 0.5f, la, 1);
        for (int rep_ = 0; rep_ < REP_OG; ++rep_) { if (rep_) __syncthreads();
        if (EN_GQKV && IN(pb + 3)) { const Frame Ff = fresh(F); const bf16_t* wq = (const bf16_t*)(ws + WS_WA) + (size_t)lp * (E_QKV + E_SQ);
            pg8::Gemm g{Yb, wq, D}; pg8::StaticOrder S; S.init(M, 3072, Ff.G, Ff.bid); EpiQKVN E{ws, KA->in[12] + lp * 128, KA->in[13] + lp * 128, (LAS float*)(Ff.lds + 132096), attn_score_bound(KA, lp) * attn::SCALE <= 30.0f ? attn::SCALE * 1.4426950408889634f : 1.0f};
            pg8::gemm_phase<EpiQKVN, pg8::StaticOrder, pg8::Gemm, true, GEMM_SP2>(Ff.lds, g, S, E, Ff.wave); } }
        SEAM(pb + 3);
        for (int rep_ = 0; rep_ < REP_ATT; ++rep_) { if (rep_) __syncthreads(); if (EN_ATT && IN(pb + 5)) attention_phase(fresh(F), KA, lp); }
        SEAM(pb + 5);
        for (int rep_ = 0; rep_ < REP_OG; ++rep_) { if (rep_) __syncthreads();
        if (EN_GWO && IN(pb + 6)) { const Frame Ff = fresh(F); const bf16_t* wo = (const bf16_t*)(ws + WS_WA) + (size_t)lp * (E_QKV + E_SQ) + E_QKV;
            pg8::Gemm g{(const bf16_t*)(ws + WS_O), wo, D}; LatentOrder S; S.init_lat(D, Ff.G, Ff.bid); EpiPlain E{OUTb, D};
            pg8::gemm_phase<EpiPlain, LatentOrder, pg8::Gemm, GEMM_ALIGN, GEMM_SP2>(Ff.lds, g, S, E, Ff.wave); } }
        SEAM(pb + 6);
        if (EN_THIN && IN(pb + 7)) { const Frame Ff = fresh(F);
            if (Ff.bid < 32) { const bf16_t* wo = (const bf16_t*)(ws + WS_WA) + (size_t)lp * (E_QKV + E_SQ) + E_QKV;
                pg8::Gemm g{(const bf16_t*)(ws + WS_O), wo, D}; CtxOrder8 S{Ff.bid}; EpiPlain E{OUTb, D};
                pg8::gemm_phase<EpiPlain, CtxOrder8, pg8::Gemm, GEMM_ALIGN, GEMM_SP2>(Ff.lds, g, S, E, Ff.wave);
                { XcdBarrier bg = bar; asm volatile("" : "+s"(bg.bar)); ctx_mixer_thin(fresh(F), KA, bg.bar, 8 + lp, la, 1, 1.0f, la, 2); } }
            else thin_phase<1, 1, 32, 0>(Ff, KA, la, 1, 1.0f, la, 2); }
        SEAM(pb + 7);
        FFN_HALF(pb + 8, la * 2 + 1, 0, la, 2, 0.5f, lr, 0);
        FFN_HALF(pb + 11, lr * 2 + 0, 0, lr, 0, 0.5f, lr, 1);
        for (int rep_ = 0; rep_ < REP_EW; ++rep_) { if (EN_MIX && IN(pb + 14)) mixes_phase(fresh(F), KA, lp); }
        SEAM(pb + 14);
#ifdef DBG_DOUBLE_BAR
        SEAM(pb + 14);
#endif
#define rw1 ((const bf16_t*)(ws + WS_WR) + (size_t)lp * (E_RW1 + E_RW2 + E_SQ))
        for (int rep_ = 0; rep_ < REP_OG; ++rep_) { if (rep_) __syncthreads();
        if (EN_RW1 && IN(pb + 15)) { const Frame Ff = fresh(F); GemmRw1 g{(const bf16_t*)(ws + WS_MIX6), rw1, D}; pg8::StaticOrder S; S.init(M, 6912, Ff.G, Ff.bid);
            EpiRw1 E{ws, KA->in[25] + (size_t)lp * D};
            pg8::gemm_phase<EpiRw1, pg8::StaticOrder, GemmRw1, RW1_ALIGN, RW1_SP2>(Ff.lds, g, S, E, Ff.wave); } }
        SEAM(pb + 15);
        for (int rep_ = 0; rep_ < REP_OG; ++rep_) { if (rep_) __syncthreads();
        if (EN_RW2 && IN(pb + 16)) { const Frame Ff = fresh(F); int k2_ = 256; asm volatile("" : "+s"(k2_));     GemmRw2 g{ws, rw1 + E_RW1, k2_}; pg8::StaticOrder S; S.init(M, 10240, Ff.G, Ff.bid);
            EpiRw2 E{ws,
                     KA->in[19] + (size_t)lp * 2 * D, KA->in[22] + (size_t)lp * 2 * D, WS_AA};
            pg8::gemm_phase<EpiRw2, pg8::StaticOrder, GemmRw2, RW2_ALIGN, RW2_SP2>(Ff.lds, g, S, E, Ff.wave); } }
        #ifdef DBG_RW2_TWICE
        __syncthreads();
        if (EN_RW2 && IN(pb + 16)) { const Frame Ff = fresh(F); int k2_ = 256; asm volatile("" : "+s"(k2_));     GemmRw2 g{ws, rw1 + E_RW1, k2_}; pg8::StaticOrder S; S.init(M, 10240, Ff.G, Ff.bid);
            EpiRw2 E{ws,
                     KA->in[19] + (size_t)lp * 2 * D, KA->in[22] + (size_t)lp * 2 * D, WS_END};
            pg8::gemm_phase<EpiRw2, pg8::StaticOrder, GemmRw2, RW2_ALIGN, RW2_SP2>(Ff.lds, g, S, E, Ff.wave); }
#endif
        SEAM(pb + 16);
        for (int rep_ = 0; rep_ < REP_SCAN; ++rep_) { if (rep_) __syncthreads(); if (EN_SCAN && IN(pb + 17)) { XcdBarrier bg = bar; asm volatile("" : "+s"(bg.bar)); scan_phase(fresh(F), KA, lp, lp == 0 && rep_ == 0, bg.bar); } }
        SEAM(pb + 17);
        for (int rep_ = 0; rep_ < REP_OG; ++rep_) { if (rep_) __syncthreads();
        if (EN_GWO && IN(pb + 19)) { const Frame Ff = fresh(F); pg8::Gemm g{(const bf16_t*)(ws + WS_PREP), rw1 + E_RW1 + E_RW2, D}; LatentOrder S; S.init_lat(D, Ff.G, Ff.bid); EpiPlain E{OUTb, D};
            pg8::gemm_phase<EpiPlain, LatentOrder, pg8::Gemm, GEMM_ALIGN, GEMM_SP2>(Ff.lds, g, S, E, Ff.wave); } }
        SEAM(pb + 19);
        if (EN_THIN && IN(pb + 20)) { const Frame Ff = fresh(F);
            if (Ff.bid < 32) { pg8::Gemm g{(const bf16_t*)(ws + WS_PREP), rw1 + E_RW1 + E_RW2, D}; CtxOrder8 S{Ff.bid}; EpiPlain E{OUTb, D};
                pg8::gemm_phase<EpiPlain, CtxOrder8, pg8::Gemm, GEMM_ALIGN, GEMM_SP2>(Ff.lds, g, S, E, Ff.wave);
                { XcdBarrier bg = bar; asm volatile("" : "+s"(bg.bar)); ctx_mixer_thin(fresh(F), KA, bg.bar, 10 + lp, lr, 1, 1.0f, lr, 2); } }
            else thin_phase<1, 1, 32, 0>(Ff, KA, lr, 1, 1.0f, lr, 2); }
        SEAM(pb + 20);
        if (lp == 1) FFN_HALF(pb + 21, lr * 2 + 1, 1, lr, 2, 0.5f, 0, 0); else FFN_HALF(pb + 21, lr * 2 + 1, 0, lr, 2, 0.5f, lr + 1, 0);
    }
    if (DBG_STOP >= 0) { xcd_barrier(bar, fresh(F).wave == 0 && lane_opaque() == 0); copyout_phase(fresh(F), KA); }
#undef IN
#undef SEAM
#undef FFN_HALF
#undef BAR_NOW
#undef rw1
#undef ws
#undef KA
#undef Yb
#undef ACTb
#undef OUTb
}

extern "C" void kernel_launch(void* const* d_in, const int* in_sizes, int n_in, void* d_out, int out_size, void* d_ws, size_t ws_size, hipStream_t stream) {
    static int grid = 0;
    if (grid == 0) {
        if (n_in != 30 || in_sizes[0] != NB * SEQ * D || out_size != NB * SEQ * D || ws_size < WS_END) {
            fprintf(stderr, "kernel_launch: shape mismatch: n_in %d in0 %d out %d ws %zu (need >= %zu)\n", n_in, n_in > 0 ? in_sizes[0] : -1, out_size, ws_size, (size_t)WS_END); grid = -1; return; }
        int dev = 0, cus = 0, per_cu = 0;
        if (hipGetDevice(&dev) != hipSuccess || hipDeviceGetAttribute(&cus, hipDeviceAttributeMultiprocessorCount, dev) != hipSuccess) { fprintf(stderr, "kernel_launch: device query failed\n"); grid = -1; return; }
        if (hipFuncSetAttribute((const void*)fwd_kernel, hipFuncAttributeMaxDynamicSharedMemorySize, LDS_BYTES) != hipSuccess) { fprintf(stderr, "kernel_launch: hipFuncSetAttribute failed\n"); grid = -1; return; }
        if (hipOccupancyMaxActiveBlocksPerMultiprocessor(&per_cu, (const void*)fwd_kernel, NTHR, LDS_BYTES) != hipSuccess || per_cu < 1) { fprintf(stderr, "kernel_launch: occupancy query says %d blocks per CU\n", per_cu); }
        (void)hipGetLastError();
        grid = cus;
        if (grid > 256) grid = 256;
    }
    if (grid < 0) return;
    if (hipMemsetAsync((char*)d_ws + WS_CTL, 0, CTL_ZERO_BYTES, stream) != hipSuccess) { fprintf(stderr, "kernel_launch: memset failed\n"); return; }
    Args a{};
    for (int i = 0; i < 30; ++i) a.in[i] = (const float*)d_in[i];
    a.out = (float*)d_out; a.ws = (unsigned char*)d_ws;
    a.ph_lo = 0; a.ph_hi = NPHASE; a.li = 0; a.dbg = 0;
    hipLaunchKernelGGL(fwd_kernel, dim3(grid), dim3(NTHR), LDS_BYTES, stream, a);
    const hipError_t le = hipPeekAtLastError();
    if (le != hipSuccess) fprintf(stderr, "kernel_launch: launch failed: %s\n", hipGetErrorName(le));
}
```

```cpp
#include <hip/hip_runtime.h>
#include <cstdio>
#include <cstdint>
#include <cmath>
__device__ __forceinline__ int lane_opaque() { int l; asm volatile("v_mbcnt_lo_u32_b32 %0, -1, 0\n\tv_mbcnt_hi_u32_b32 %0, -1, %0" : "=v"(l)); return l; }
namespace pg8 {
#define PG8_LAS __attribute__((address_space(3)))
typedef unsigned short bf16_t;
typedef short bf16x8 __attribute__((ext_vector_type(8)));
typedef float f32x4 __attribute__((ext_vector_type(4)));
typedef unsigned u32x4 __attribute__((ext_vector_type(4)));
constexpr int BM = 256, BK = 64, HALF = 128, HTB = HALF * BK * 2  , STAGE_BYTES = 8 * HTB, NXCD = 8, WGM = 8;

__host__ __device__ __forceinline__ int lds_byte(int r, int c) { const int st = (r >> 4) * 2 + (c >> 5), rr = r & 15, cc = c & 31, ob = rr * 64 + cc * 2; return st * 1024 + (ob ^ (((ob >> 9) & 1) << 5)); }
__host__ __device__ __forceinline__ void stage_rc(int b, int& R, int& C) { const int st = b / 1024, sb = b % 1024, swz = sb ^ (((sb >> 9) & 1) << 5); R = (st >> 1) * 16 + swz / 64; C = (st & 1) * 32 + (swz % 64) / 2; }
__host__ __device__ __forceinline__ int perm32(int rho) { const int n = rho >> 4, i = rho & 15; return 8 * (i >> 2) + 4 * n + (i & 3); }

struct Unit { int pm, pn; };
struct Gemm { const bf16_t* A; const bf16_t* Bt; int K;
    __device__ __forceinline__ const char* a_tile(const Unit& u) const { return (const char*)A + (size_t)u.pm * (size_t)(BM * 2) * K; }
    __device__ __forceinline__ const char* b_tile(const Unit& u) const { return (const char*)Bt + (size_t)u.pn * (size_t)(BM * 2) * K; }
    __device__ __forceinline__ int klen() const { return K; } };

struct StaticOrder {
    int nM, nN, nwg, G, c;
    __host__ __device__ void init(int M, int N, int G_, int c_) { nM = M / BM; nN = N / BM; nwg = nM * nN; G = G_; c = c_; }
    __host__ __device__ bool next(int i, Unit& u) const {
        const long L = (long)i * G + c; if (L >= nwg) return false;
        int wgid = (int)L; { const int q = nwg / NXCD, r = nwg % NXCD, xcd = wgid % NXCD, off = wgid / NXCD; wgid = (xcd < r ? xcd * (q + 1) : r * (q + 1) + (xcd - r) * q) + off; }
        const int nig = WGM * nN, gid = wgid / nig, fm = gid * WGM, gsz = (nM - fm) < WGM ? (nM - fm) : WGM;
        u.pm = fm + ((wgid % nig) % gsz); u.pn = (wgid % nig) / gsz; return true;
    }
    __device__ __forceinline__ void a_ready(const Unit&) const {}
    __device__ __forceinline__ void done(const Unit&) const {}
};

typedef __bf16 bf16x2_cv __attribute__((ext_vector_type(2)));
typedef float f32x2_cv __attribute__((ext_vector_type(2)));
__device__ __forceinline__ unsigned cvt_pk_bf16(float lo, float hi) { const f32x2_cv v = {lo, hi}; const bf16x2_cv b = __builtin_convertvector(v, bf16x2_cv); return __builtin_bit_cast(unsigned, b); }

template <class Epi, class Sched, class GT, bool ALIGN_EPI = false, bool SP2 = false>
__device__ __forceinline__ void gemm_phase(PG8_LAS unsigned char* lds, const GT g, const Sched& S, const Epi& E, const int wid  ) {
    const int lane = lane_opaque(), tid = wid * 64 + lane, wr = wid >> 2, wc = wid & 3, fr = lane & 15, fq = lane >> 4;
    const int K = g.K, nt = g.klen() / BK;
    unsigned voffA[2], voffB[2];
#pragma unroll
    for (int i = 0; i < 2; ++i) { int R, C; stage_rc(tid * 16 + i * 8192, R, C); const int Rb = Epi::PERM ? ((R & ~31) + perm32(R & 31)) : R;
        voffA[i] = (unsigned)(R * K + C) * 2u; voffB[i] = (unsigned)(Rb * K + C) * 2u; }
    asm volatile("" : "+v"(voffA[0]), "+v"(voffA[1]), "+v"(voffB[0]), "+v"(voffB[1]));
    const size_t kstep = (size_t)(BK * 2);
    const size_t hstep = (size_t)HALF * K * 2;
    const unsigned ldsw = (unsigned)wid * 1024u;
    const int aoff = lds_byte(wr * 64 + fr, fq * 8), boff = lds_byte(wc * 32 + fr, fq * 8);
#define PG8_SA(b, h) (((b) * 2 + (h)) * HTB)
#define PG8_SB(b, h) ((4 + (b) * 2 + (h)) * HTB)
#define PG8_STAGE(bufoff, gbase, voff) do { _Pragma("unroll") for (int _i = 0; _i < 2; ++_i) \
        __builtin_amdgcn_global_load_lds((const unsigned*)((const char*)(gbase) + (voff)[_i]), (PG8_LAS unsigned*)(lds + (bufoff) + ldsw + _i * 8192), 16, 0, 0); } while (0)
#define PG8_LDA(dst, b, h) do { _Pragma("unroll") for (int m = 0; m < 4; ++m) _Pragma("unroll") for (int k = 0; k < 2; ++k) dst[m][k] = *(const PG8_LAS bf16x8*)(lds + PG8_SA(b, h) + aoff + m * 2048 + k * 1024); } while (0)
#define PG8_LDB(dst, b, h) do { _Pragma("unroll") for (int n = 0; n < 2; ++n) _Pragma("unroll") for (int k = 0; k < 2; ++k) dst[n][k] = *(const PG8_LAS bf16x8*)(lds + PG8_SB(b, h) + boff + n * 2048 + k * 1024); } while (0)
#define PG8_MMA(ai, bj, At, Bt) do { __builtin_amdgcn_s_setprio(1); _Pragma("unroll") for (int m = 0; m < 4; ++m) _Pragma("unroll") for (int n = 0; n < 2; ++n) _Pragma("unroll") for (int k = 0; k < 2; ++k) \
        acc[ai][bj][m][n] = __builtin_amdgcn_mfma_f32_16x16x32_bf16(Bt[n][k], At[m][k], acc[ai][bj][m][n], 0, 0, 0); __builtin_amdgcn_s_setprio(0); } while (0)
#define PG8_WAIT_V(n) asm volatile("s_waitcnt vmcnt(" #n ")" ::: "memory")
#define PG8_WAIT_L(n) asm volatile("s_waitcnt lgkmcnt(" #n ")" ::: "memory")
#define PG8_BAR __builtin_amdgcn_s_barrier()
#define PG8_SCHED __builtin_amdgcn_sched_barrier(0)
    Unit cur, nxt; int ui = 0;
    if (!S.next(0, cur)) return;
    f32x4 acc[2][2][4][2];
#pragma unroll
    for (int a = 0; a < 2; ++a)
#pragma unroll
        for (int b = 0; b < 2; ++b)
#pragma unroll
            for (int m = 0; m < 4; ++m)
#pragma unroll
                for (int n = 0; n < 2; ++n) acc[a][b][m][n] = (f32x4){0.f, 0.f, 0.f, 0.f};
    bf16x8 At[4][2], B0[2][2], B1[2][2];
    const char* cA = g.a_tile(cur); const char* cB = g.b_tile(cur);
    S.a_ready(cur);
    if constexpr (SP2) {
        PG8_STAGE(PG8_SB(0, 0), cB, voffB); PG8_STAGE(PG8_SB(0, 1), cB + hstep, voffB); PG8_STAGE(PG8_SA(0, 0), cA, voffA); PG8_STAGE(PG8_SA(0, 1), cA + hstep, voffA);
        if (wr == 1) PG8_BAR;
        PG8_WAIT_V(2); PG8_BAR;
        PG8_STAGE(PG8_SB(1, 0), cB + kstep, voffB); PG8_STAGE(PG8_SA(1, 0), cA + kstep, voffA); PG8_STAGE(PG8_SB(1, 1), cB + hstep + kstep, voffB);
        PG8_WAIT_V(6); PG8_BAR;
    } else {
        PG8_STAGE(PG8_SB(0, 0), cB, voffB); PG8_STAGE(PG8_SA(0, 0), cA, voffA); PG8_STAGE(PG8_SB(0, 1), cB + hstep, voffB); PG8_STAGE(PG8_SA(0, 1), cA + hstep, voffA);
        if (wr == 1) PG8_BAR;
        PG8_WAIT_V(4); PG8_BAR;
        PG8_STAGE(PG8_SB(1, 0), cB + kstep, voffB); PG8_STAGE(PG8_SA(1, 0), cA + kstep, voffA); PG8_STAGE(PG8_SB(1, 1), cB + hstep + kstep, voffB);
        PG8_WAIT_V(6); PG8_BAR;
    }
    for (;;) {
        const bool has_next = S.next(ui + 1, nxt);
        const char* nA = has_next ? g.a_tile(nxt) : cA; const char* nB = has_next ? g.b_tile(nxt) : cB;
        for (int t = 0; t < nt; t += 2) {
            const bool last = (t == nt - 2);
            const char* a1 = cA + (size_t)(t + 1) * kstep;
            const char* a2 = last ? nA : cA + (size_t)(t + 2) * kstep; const char* b2 = last ? nB : cB + (size_t)(t + 2) * kstep;
            const char* a3 = a2 + kstep; const char* b3 = b2 + kstep;
            if (last && has_next) S.a_ready(nxt);
            if constexpr (SP2) {
            PG8_LDB(B0, 0, 0); PG8_LDB(B1, 0, 1); PG8_SCHED; PG8_LDA(At, 0, 0); PG8_STAGE(PG8_SA(1, 1), a1 + hstep, voffA);
            PG8_WAIT_V(8); PG8_WAIT_L(0); PG8_BAR; PG8_MMA(0, 0, At, B0); PG8_MMA(0, 1, At, B1); PG8_BAR; PG8_SCHED;
            PG8_LDA(At, 0, 1); PG8_STAGE(PG8_SB(0, 0), b2, voffB); PG8_STAGE(PG8_SB(0, 1), b2 + hstep, voffB); PG8_STAGE(PG8_SA(0, 0), a2, voffA);
            PG8_WAIT_V(8); PG8_WAIT_L(0); PG8_BAR; PG8_MMA(1, 0, At, B0); PG8_MMA(1, 1, At, B1); PG8_BAR; PG8_SCHED;
            PG8_LDB(B0, 1, 0); PG8_LDB(B1, 1, 1); PG8_SCHED; PG8_LDA(At, 1, 0); PG8_STAGE(PG8_SA(0, 1), a2 + hstep, voffA);
            PG8_WAIT_V(8); PG8_WAIT_L(0); PG8_BAR; PG8_MMA(0, 0, At, B0); PG8_MMA(0, 1, At, B1); PG8_BAR; PG8_SCHED;
            PG8_LDA(At, 1, 1); PG8_STAGE(PG8_SB(1, 0), b3, voffB); PG8_STAGE(PG8_SB(1, 1), b3 + hstep, voffB); PG8_STAGE(PG8_SA(1, 0), a3, voffA);
            PG8_WAIT_V(8); PG8_WAIT_L(0); PG8_BAR; PG8_MMA(1, 0, At, B0); PG8_MMA(1, 1, At, B1); PG8_BAR; PG8_SCHED;
            } else {
            PG8_LDB(B0, 0, 0); PG8_SCHED; PG8_LDA(At, 0, 0); PG8_STAGE(PG8_SA(1, 1), a1 + hstep, voffA);
            PG8_WAIT_L(8); PG8_BAR; PG8_WAIT_L(0); PG8_MMA(0, 0, At, B0); PG8_BAR; PG8_SCHED;
            PG8_LDB(B1, 0, 1); PG8_STAGE(PG8_SB(0, 0), b2, voffB);
            PG8_BAR; PG8_WAIT_L(0); PG8_MMA(0, 1, At, B1); PG8_BAR;
            PG8_LDA(At, 0, 1); PG8_STAGE(PG8_SA(0, 0), a2, voffA);
            PG8_BAR; PG8_WAIT_L(0); PG8_MMA(1, 0, At, B0); PG8_BAR; PG8_SCHED;
            PG8_STAGE(PG8_SB(0, 1), b2 + hstep, voffB);
            PG8_WAIT_V(6); PG8_BAR; PG8_MMA(1, 1, At, B1); PG8_BAR;
            PG8_LDB(B0, 1, 0); PG8_SCHED; PG8_LDA(At, 1, 0); PG8_STAGE(PG8_SA(0, 1), a2 + hstep, voffA);
            PG8_WAIT_L(8); PG8_BAR; PG8_WAIT_L(0); PG8_MMA(0, 0, At, B0); PG8_BAR; PG8_SCHED;
            PG8_LDB(B1, 1, 1); PG8_STAGE(PG8_SB(1, 0), b3, voffB);
            PG8_BAR; PG8_WAIT_L(0); PG8_MMA(0, 1, At, B1); PG8_BAR;
            PG8_LDA(At, 1, 1); PG8_STAGE(PG8_SA(1, 0), a3, voffA);
            PG8_BAR; PG8_WAIT_L(0); PG8_MMA(1, 0, At, B0); PG8_BAR; PG8_SCHED;
            PG8_STAGE(PG8_SB(1, 1), b3 + hstep, voffB);
            PG8_WAIT_V(6); PG8_BAR; PG8_MMA(1, 1, At, B1); PG8_BAR;
            }
        }
        if constexpr (ALIGN_EPI) { if (wr == 0) PG8_BAR; }
        if constexpr (!Epi::AFTER_DRAIN) { E(acc, cur, wr, wc, fr, fq); S.done(cur); }
        if (!has_next) break;
#pragma unroll
        for (int a = 0; a < 2; ++a)
#pragma unroll
            for (int b = 0; b < 2; ++b)
#pragma unroll
                for (int m = 0; m < 4; ++m)
#pragma unroll
                    for (int n = 0; n < 2; ++n) acc[a][b][m][n] = (f32x4){0.f, 0.f, 0.f, 0.f};
        cur = nxt; cA = nA; cB = nB; ++ui;
        if constexpr (ALIGN_EPI) { if (wr == 1) PG8_BAR; }
    }
    PG8_WAIT_V(0);
    if constexpr (!ALIGN_EPI) { if (wr == 0) PG8_BAR; }
    PG8_BAR;
    if constexpr (Epi::AFTER_DRAIN) { E.fused(acc, cur, wr, wc, fr, fq, lds, wid, lane); S.done(cur); }
#undef PG8_SA
#undef PG8_SB
#undef PG8_STAGE
#undef PG8_LDA
#undef PG8_LDB
#undef PG8_MMA
#undef PG8_WAIT_V
#undef PG8_WAIT_L
#undef PG8_BAR
#undef PG8_SCHED
}
}

#define LAS __attribute__((address_space(3)))
#define XB_TMO      128
#define XB_XCNT(j)  (256  + 64 * (j))
#define XB_XSUB(j)  (1280 + 64 * (j))
#define XB_XGEN(j)  (2304 + 64 * (j))
#define XB_TOP      3328
#define XB_TOPGEN   3392
#define XCD_BAR_WORDS 3456
#define XB_SPIN_CAP (1u << 20)

__device__ __forceinline__ unsigned xb_ld(unsigned* p)              { return __hip_atomic_load(p, __ATOMIC_RELAXED, __HIP_MEMORY_SCOPE_AGENT); }
__device__ __forceinline__ unsigned xb_add(unsigned* p, unsigned v) { return __hip_atomic_fetch_add(p, v, __ATOMIC_RELAXED, __HIP_MEMORY_SCOPE_AGENT); }
__device__ __forceinline__ unsigned xb_xcc_id() { return (unsigned)__builtin_amdgcn_s_getreg((3 << 11) | 20) & 0xFu; }
#define XB_SPIN(cond, bar) do { unsigned _sp = 0; while (cond) { __builtin_amdgcn_s_sleep(1); \
    if ((++_sp & 255u) == 0u) { if (xb_ld(&(bar)[XB_TMO])) break; if (_sp > XB_SPIN_CAP) { atomicAdd(&(bar)[XB_TMO], 1u); break; } } } } while (0)

struct XcdBarrier {
    unsigned* bar; unsigned x;
    volatile LAS unsigned* st;
};

__device__ __forceinline__ XcdBarrier xcd_barrier_post(unsigned* bar, volatile LAS unsigned* st) {
    XcdBarrier b; b.bar = bar; b.x = xb_xcc_id(); b.st = st;
    if (threadIdx.x == 0) (void)xb_add(&bar[XB_XCNT(b.x)], 1u);
    return b;
}
__device__ __forceinline__ void xcd_barrier_complete(unsigned* bar, unsigned x, unsigned& nloc, unsigned& nx) {
    const unsigned G = gridDim.x * gridDim.y * gridDim.z;
    unsigned sum, cnt, mine, sp = 0u;
    for (;;) {
        sum = 0u; cnt = 0u; mine = 0u;
#pragma unroll
        for (unsigned j = 0; j < 16; ++j) { const unsigned c = xb_ld(&bar[XB_XCNT(j)]); sum += c; cnt += (c > 0u) ? 1u : 0u; mine = (j == x) ? c : mine; }
        if (sum == G) break;
        __builtin_amdgcn_s_sleep(1);
        if ((++sp & 255u) == 0u) { if (xb_ld(&bar[XB_TMO])) break; if (sp > XB_SPIN_CAP) { atomicAdd(&bar[XB_TMO], 1u); break; } }
    }
    nloc = mine > 0u ? mine : 1u; nx = cnt > 0u ? cnt : 1u;
}

__device__ __forceinline__ void xcd_barrier(const XcdBarrier& b, const bool tid0  ) {
    asm volatile("s_waitcnt vmcnt(0)" ::: "memory");
    __syncthreads();
    if (tid0) {
        unsigned* bar = b.bar;
        __builtin_amdgcn_s_waitcnt(0);
        unsigned nloc = b.st[0], nx = b.st[1];
        if (nloc == 0u) { xcd_barrier_complete(bar, b.x, nloc, nx); b.st[0] = nloc; b.st[1] = nx; }
        const unsigned old = xb_add(&bar[XB_XSUB(b.x)], 1u);
        const unsigned gen = old / nloc;
        if (old + 1u == (gen + 1u) * nloc) {
            __builtin_amdgcn_fence(__ATOMIC_RELEASE, "agent");
            asm volatile("s_waitcnt vmcnt(0)" ::: "memory");
            const unsigned og = xb_add(&bar[XB_TOP], 1u);
            const unsigned tg = og / nx;
            if (og + 1u == (tg + 1u) * nx) xb_add(&bar[XB_TOPGEN], 1u);
            else XB_SPIN(xb_ld(&bar[XB_TOPGEN]) == tg, bar);
            __builtin_amdgcn_fence(__ATOMIC_ACQUIRE, "agent");
            xb_add(&bar[XB_XGEN(b.x)], 1u);
            asm volatile("s_waitcnt vmcnt(0)" ::: "memory");
        } else {
            XB_SPIN(xb_ld(&bar[XB_XGEN(b.x)]) == gen, bar);
            __builtin_amdgcn_fence(__ATOMIC_ACQUIRE, "agent");
            asm volatile("s_waitcnt vmcnt(0)" ::: "memory");
        }
    }
    __syncthreads();
}

namespace attn {
using bf16 = unsigned short;
constexpr int   D = 128, NW = 8, QBLK = 32, KVBLK = 64;
constexpr float SCALE = 0.088388347648318440f;
constexpr float THR = 8.f;
constexpr int SDEPTH = 2;
constexpr int LDQ = 2048, LDK = 512, LDO = 2048;
constexpr size_t SHM_V = KVBLK * D * 2, SHM_K = KVBLK * D * 2, SHM_ATTN = 2 * SHM_V + 2 * SHM_K + NW * 64 * 4;
using bf16x8 = __attribute__((ext_vector_type(8))) short;
using s16x4  = __attribute__((ext_vector_type(4))) short;
using f32x16 = __attribute__((ext_vector_type(16))) float;
using f32x8  = __attribute__((ext_vector_type(8))) float;
using u32x4  = __attribute__((ext_vector_type(4))) unsigned;
#define KSWZ(row, colB) ((row) * 256 + ((colB) ^ (((row) & 7) << 4)))
#define SBAR() __builtin_amdgcn_sched_barrier(0)
__device__ __forceinline__ int crow(int r, int hi) { return (r & 3) + 8 * (r >> 2) + 4 * hi; }
__device__ __forceinline__ unsigned cvtpk(float lo, float hi) {
  return pg8::cvt_pk_bf16(lo, hi);
}
template <typename TIn> struct Stage;
__device__ __forceinline__ unsigned f2bf_(float f) { unsigned u = __builtin_bit_cast(unsigned, f); return (u + 0x7fffu + ((u >> 16) & 1u)) >> 16; }
template <> struct Stage<bf16>  { using T = bf16x8;
  __device__ static __forceinline__ T ld8(const bf16* p) { return *reinterpret_cast<const bf16x8*>(p); }
  __device__ static __forceinline__ bf16x8 tobf(T x) { return x; } };
template <> struct Stage<float> { using T = f32x8;
  __device__ static __forceinline__ T ld8(const float* p) { return *reinterpret_cast<const f32x8*>(p); }
  __device__ static __forceinline__ bf16x8 tobf(T x) {
    u32x4 w = {cvtpk(x[0], x[1]), cvtpk(x[2], x[3]), cvtpk(x[4], x[5]), cvtpk(x[6], x[7])}; return *reinterpret_cast<bf16x8*>(&w); } };

__device__ __forceinline__ void partialSM(f32x16& p0, f32x16& p1, float& m_reg, float& mn, float& alpha) {
  constexpr float C = SCALE * 1.4426950408889634f;
  float pmax = p0[0]; for (int r = 1; r < 16; ++r) pmax = fmaxf(pmax, p0[r]); for (int r = 0; r < 16; ++r) pmax = fmaxf(pmax, p1[r]);
  { auto rr = __builtin_amdgcn_permlane32_swap(__float_as_uint(pmax), __float_as_uint(pmax), false, false);
    pmax = fmaxf(__uint_as_float(rr[0]), __uint_as_float(rr[1])); }
  if (__builtin_expect(__all(pmax - m_reg <= THR / SCALE), 1)) { mn = m_reg; alpha = 1.f; }
  else { mn = fmaxf(m_reg, pmax); alpha = __builtin_amdgcn_exp2f((m_reg - mn) * C); m_reg = mn; }
  float mnC = -mn * C;
  for (int r = 0; r < 16; ++r) p0[r] = fmaf(p0[r], C, mnC); for (int r = 0; r < 16; ++r) p1[r] = fmaf(p1[r], C, mnC);
  for (int r = 0; r < 16; ++r) p0[r] = __builtin_amdgcn_exp2f(p0[r]);
}
__device__ __forceinline__ void partialSM_fix(f32x16& p0, f32x16& p1, const float mnC) {
  (void)p1; (void)mnC;
  for (int r = 0; r < 16; ++r) p0[r] = __builtin_amdgcn_exp2f(p0[r]);
}
__device__ __forceinline__ void finishSM(f32x16& p0, f32x16& p1, float alpha, float& l_reg, bf16x8& pa0, bf16x8& pa1, bf16x8& pa2, bf16x8& pa3) {
  for (int r = 0; r < 16; ++r) p1[r] = __builtin_amdgcn_exp2f(p1[r]);
  float ps = 0; for (int r = 0; r < 16; ++r) ps += p0[r]; for (int r = 0; r < 16; ++r) ps += p1[r];
  { auto rr = __builtin_amdgcn_permlane32_swap(__float_as_uint(ps), __float_as_uint(ps), false, false);
    ps = __uint_as_float(rr[0]) + __uint_as_float(rr[1]); }
  l_reg = l_reg * alpha + ps;
#define PK4(P, BASE, OUT) do { unsigned a0 = cvtpk(P[BASE + 0], P[BASE + 1]), a1 = cvtpk(P[BASE + 2], P[BASE + 3]);   \
    unsigned b0 = cvtpk(P[BASE + 4], P[BASE + 5]), b1 = cvtpk(P[BASE + 6], P[BASE + 7]);                              \
    auto r0 = __builtin_amdgcn_permlane32_swap(a0, b0, false, false); auto r1 = __builtin_amdgcn_permlane32_swap(a1, b1, false, false); \
    u32x4 w = {r0[0], r1[0], r0[1], r1[1]}; OUT = *reinterpret_cast<bf16x8*>(&w); } while (0)
  PK4(p0, 0, pa0); PK4(p0, 8, pa1); PK4(p1, 0, pa2); PK4(p1, 8, pa3);
#undef PK4
}
__device__ __forceinline__ void qkt(f32x16& p0, f32x16& p1, const bf16* Ks, const bf16x8* qr, int r32, int hi) {
  p0 = f32x16{}; p1 = f32x16{};
  for (int d0 = 0; d0 < 8; ++d0) { int cb = (d0 * 16 + hi * 8) * 2;
    bf16x8 b0 = *reinterpret_cast<const bf16x8*>((const char*)Ks + KSWZ(r32, cb));
    bf16x8 b1 = *reinterpret_cast<const bf16x8*>((const char*)Ks + KSWZ(32 + r32, cb));
    p0 = __builtin_amdgcn_mfma_f32_32x32x16_bf16(b0, qr[d0], p0, 0, 0, 0);
    p1 = __builtin_amdgcn_mfma_f32_32x32x16_bf16(b1, qr[d0], p1, 0, 0, 0); }
}
__device__ __forceinline__ int v_st(int k, int c) { const int kk = (k & ~0xC) | ((k & 4) << 1) | ((k & 8) >> 1); return ((kk >> 3) * 4 + (c >> 5)) * 512 + ((kk & 7) * 32 + (c & 31)) * 2; }
__device__ __forceinline__ int v_rd_base(int lane) { return ((lane & 3) << 3) | (((lane >> 2) & 3) << 6) | (((lane >> 4) & 1) << 5) | (((lane >> 5) & 1) << 8); }
constexpr int v_rd_off(int d0, int ks, int half) { return d0 * 512 + ks * 4096 + half * 2048; }
template <int OFF> __device__ __forceinline__ s16x4 tr_read(int vb) {
  s16x4 r; asm volatile("ds_read_b64_tr_b16 %0, %1 offset:%2" : "=&v"(r) : "v"(vb), "i"(OFF) : "memory"); return r;
}
template <int D0> __device__ __forceinline__ void pv_one(f32x16& od, int vb, bf16x8 pa0, bf16x8 pa1, bf16x8 pa2, bf16x8 pa3) {
  const s16x4 l0 = tr_read<v_rd_off(D0, 0, 0)>(vb), h0 = tr_read<v_rd_off(D0, 0, 1)>(vb), l1 = tr_read<v_rd_off(D0, 1, 0)>(vb), h1 = tr_read<v_rd_off(D0, 1, 1)>(vb);
  const s16x4 l2 = tr_read<v_rd_off(D0, 2, 0)>(vb), h2 = tr_read<v_rd_off(D0, 2, 1)>(vb), l3 = tr_read<v_rd_off(D0, 3, 0)>(vb), h3 = tr_read<v_rd_off(D0, 3, 1)>(vb);
  asm volatile("s_waitcnt lgkmcnt(0)" ::: "memory"); SBAR();
#define PK(L, H) (bf16x8){L[0], L[1], L[2], L[3], H[0], H[1], H[2], H[3]}
  od = __builtin_amdgcn_mfma_f32_32x32x16_bf16(pa0, PK(l0, h0), od, 0, 0, 0);
  od = __builtin_amdgcn_mfma_f32_32x32x16_bf16(pa1, PK(l1, h1), od, 0, 0, 0);
  od = __builtin_amdgcn_mfma_f32_32x32x16_bf16(pa2, PK(l2, h2), od, 0, 0, 0);
  od = __builtin_amdgcn_mfma_f32_32x32x16_bf16(pa3, PK(l3, h3), od, 0, 0, 0);
#undef PK
}
__device__ __forceinline__ void pv_d0(f32x16* o, int vb, bf16x8 pa0, bf16x8 pa1, bf16x8 pa2, bf16x8 pa3) {
  pv_one<0>(o[0], vb, pa0, pa1, pa2, pa3); pv_one<1>(o[1], vb, pa0, pa1, pa2, pa3); pv_one<2>(o[2], vb, pa0, pa1, pa2, pa3); pv_one<3>(o[3], vb, pa0, pa1, pa2, pa3);
}

template <typename TQ, bool FIXM = false>
__device__ __forceinline__ void attn_dense_body(const TQ* __restrict__ Qb, const bf16* __restrict__ Kh, const bf16* __restrict__ Vh,
                                                bf16* __restrict__ Ob, int seq, char* lds, const int wid, const float mfix = 0.f) {
  using St = Stage<bf16>; using SQ = Stage<TQ>;
  const int lane = lane_opaque(), tid = wid * 64 + lane, r32 = lane & 31, hi = lane >> 5;
  bf16* V_lds = (bf16*)lds; bf16* K_lds = (bf16*)(lds + 2 * SHM_V);
  float* ws = (float*)(lds + 2 * SHM_V + 2 * SHM_K) + wid * 64; float* li_l = ws; float* al_l = ws + 32;
  float m_reg = -1e30f, l_reg = 0; f32x16 o[4] = {}; bf16x8 qr[8]; const float mnCf = -mfix * (SCALE * 1.4426950408889634f); (void)mnCf; (void)m_reg;
  const TQ* Qw = Qb + (long)(wid * QBLK + r32) * LDQ + hi * 8;
#pragma unroll
  for (int d0 = 0; d0 < 8; ++d0) qr[d0] = SQ::tobf(SQ::ld8(Qw + d0 * 16));
  const int sr = tid >> 4, sc = (tid & 15) * 8, vst0 = v_st(sr, sc), vst1 = v_st(32 + sr, sc);
  const int vb0 = (int)(uintptr_t)V_lds + v_rd_base(lane);
  struct { typename St::T vs0, vs1, ks0, ks1; } sr_[SDEPTH];
#define SLOAD(i, k0) do { sr_[i].vs0 = St::ld8(&Vh[(long)((k0) + sr) * LDK + sc]); sr_[i].vs1 = St::ld8(&Vh[(long)((k0) + 32 + sr) * LDK + sc]); \
    sr_[i].ks0 = St::ld8(&Kh[(long)((k0) + sr) * LDK + sc]); sr_[i].ks1 = St::ld8(&Kh[(long)((k0) + 32 + sr) * LDK + sc]); } while (0)
#define SWRITE(b, i) do { *(bf16x8*)((char*)V_lds + (b) * SHM_V + vst0) = St::tobf(sr_[i].vs0);          \
    *(bf16x8*)((char*)V_lds + (b) * SHM_V + vst1) = St::tobf(sr_[i].vs1); int kc = sc * 2;               \
    *(bf16x8*)((char*)K_lds + (b) * SHM_K + KSWZ(sr, kc)) = St::tobf(sr_[i].ks0);                       \
    *(bf16x8*)((char*)K_lds + (b) * SHM_K + KSWZ(32 + sr, kc)) = St::tobf(sr_[i].ks1); } while (0)
#define SWAIT() do { if constexpr (SDEPTH == 2) asm volatile("s_waitcnt vmcnt(4)" ::: "memory"); else asm volatile("s_waitcnt vmcnt(0)" ::: "memory"); } while (0)
#define RESC(a) do { if (__any((a) < 1.f)) { if (hi == 0) al_l[r32] = (a); asm volatile("s_waitcnt lgkmcnt(0)" ::: "memory"); \
    for (int d = 0; d < 4; ++d) for (int r = 0; r < 16; ++r) o[d][r] *= al_l[crow(r, hi)]; } } while (0)
  f32x16 pA0, pA1, pB0, pB1; float mnA, mnB, alA, alB; bf16x8 pa0, pa1, pa2, pa3; const int NT = seq / KVBLK;
  constexpr int SE = 0, SO = SDEPTH - 1;
  SLOAD(SE, 0); asm volatile("s_waitcnt vmcnt(0)" ::: "memory"); SWRITE(0, SE); __syncthreads();
  qkt(pA0, pA1, K_lds, qr, r32, hi); do { if constexpr (FIXM) { partialSM_fix(pA0, pA1, mnCf); alA = 1.f; } else partialSM(pA0, pA1, m_reg, mnA, alA); } while (0);
  SLOAD(SO, KVBLK); if constexpr (SDEPTH == 2) { if (2 < NT) SLOAD(SE, 2 * KVBLK); }
  SWAIT(); SWRITE(1, SO); __syncthreads();
  for (int j = 1; j + 1 < NT; j += 2) {
    SBAR(); qkt(pB0, pB1, (bf16*)((char*)K_lds + SHM_K), qr, r32, hi);
    finishSM(pA0, pA1, FIXM ? 1.f : alA, l_reg, pa0, pa1, pa2, pa3); SBAR();
    SLOAD(SO, (j + SDEPTH) * KVBLK); SBAR();
    pv_d0(o, vb0, pa0, pa1, pa2, pa3); do { if constexpr (FIXM) { partialSM_fix(pB0, pB1, mnCf); alB = 1.f; } else partialSM(pB0, pB1, m_reg, mnB, alB); } while (0);
    __syncthreads(); SWAIT(); SWRITE(0, SE);
    do { if constexpr (!FIXM) RESC(alB); } while (0); __syncthreads();
    SBAR(); qkt(pA0, pA1, K_lds, qr, r32, hi);
    finishSM(pB0, pB1, FIXM ? 1.f : alB, l_reg, pa0, pa1, pa2, pa3); SBAR();
    if (SDEPTH == 1 || j + 3 < NT) SLOAD(SE, (j + 1 + SDEPTH) * KVBLK); SBAR();
    pv_d0(o, vb0 + (int)SHM_V, pa0, pa1, pa2, pa3); do { if constexpr (FIXM) { partialSM_fix(pA0, pA1, mnCf); alA = 1.f; } else partialSM(pA0, pA1, m_reg, mnA, alA); } while (0);
    __syncthreads(); SWAIT(); SWRITE(1, SO);
    do { if constexpr (!FIXM) RESC(alA); } while (0); __syncthreads();
  }
  SBAR(); qkt(pB0, pB1, (bf16*)((char*)K_lds + SHM_K), qr, r32, hi);
  finishSM(pA0, pA1, FIXM ? 1.f : alA, l_reg, pa0, pa1, pa2, pa3); SBAR();
  pv_d0(o, vb0, pa0, pa1, pa2, pa3); do { if constexpr (FIXM) { partialSM_fix(pB0, pB1, mnCf); alB = 1.f; } else partialSM(pB0, pB1, m_reg, mnB, alB); } while (0);
  __syncthreads(); do { if constexpr (!FIXM) RESC(alB); } while (0);
  finishSM(pB0, pB1, FIXM ? 1.f : alB, l_reg, pa0, pa1, pa2, pa3); SBAR();
  pv_d0(o, vb0 + (int)SHM_V, pa0, pa1, pa2, pa3);
  if (hi == 0) li_l[r32] = l_reg; asm volatile("s_waitcnt lgkmcnt(0)" ::: "memory");
  float rli[16];
#pragma unroll
  for (int r = 0; r < 16; ++r) rli[r] = __builtin_amdgcn_rcpf(li_l[crow(r, hi)]);
  bf16* Ow = Ob + (long)(wid * QBLK) * LDO;
  char* stg = (char*)K_lds + wid * 4096;
#pragma unroll
  for (int half = 0; half < 2; ++half) {
#pragma unroll
    for (int r = 0; r < 16; ++r) { const unsigned w = cvtpk(o[2 * half][r] * rli[r], o[2 * half + 1][r] * rli[r]); char* pr = stg + crow(r, hi) * 128 + r32 * 2;
      *reinterpret_cast<unsigned short*>(pr) = (unsigned short)w; *reinterpret_cast<unsigned short*>(pr + 64) = (unsigned short)(w >> 16); }
    asm volatile("s_waitcnt lgkmcnt(0)" ::: "memory");
#pragma unroll
    for (int k = 0; k < 4; ++k) { const int row = 8 * k + (lane >> 3), ch = lane & 7;
      const u32x4 v = *reinterpret_cast<const u32x4*>(stg + row * 128 + ch * 16);
      *reinterpret_cast<u32x4*>(Ow + (long)row * LDO + half * 64 + ch * 8) = v; }
    asm volatile("s_waitcnt lgkmcnt(0)" ::: "memory");
  }
#undef SLOAD
#undef SWRITE
#undef SWAIT
#undef RESC
}
#undef KSWZ
#undef SBAR
}

#define GAS __attribute__((address_space(1)))
typedef unsigned short bf16_t;
typedef unsigned u32x4 __attribute__((ext_vector_type(4)));
typedef unsigned u32x2 __attribute__((ext_vector_type(2)));
typedef float f32x4 __attribute__((ext_vector_type(4)));
typedef float f32x2 __attribute__((ext_vector_type(2)));
typedef short bf16x8 __attribute__((ext_vector_type(8)));

constexpr int D = 2048, NB = 4, SEQ = 4096, CTXL = 256, TB = SEQ + CTXL, M = NB * TB, FF = 5632, DEPTH = 4;
constexpr int NWAVES = 8, NTHR = 512;
constexpr int NCTXWG = 64;
constexpr float NORM_EPS = 1e-6f;
static_assert(M == 17408 && M % 256 == 0 && TB % 256 == 0, "row layout");

constexpr size_t MiB = 1u << 20;
constexpr size_t WS_CTL = 0, CTL_ZERO_BYTES = 1 * MiB;
constexpr size_t WS_MOD = 1 * MiB;
constexpr size_t WS_ROPE = 4 * MiB;
constexpr size_t WS_WB = 8 * MiB;
constexpr size_t E_F1 = (size_t)2 * FF * D, E_F2 = (size_t)D * FF;
constexpr size_t WS_WA = WS_WB + 8 * (E_F1 + E_F2) * 2;
constexpr size_t E_QKV = (size_t)3072 * D, E_SQ = (size_t)D * D;
constexpr size_t WS_WR = WS_WA + 2 * (E_QKV + E_SQ) * 2;
constexpr size_t E_RW1 = (size_t)6912 * D, E_RW2 = (size_t)10240 * 256;
constexpr size_t WS_WEND = WS_WR + 2 * (E_RW1 + E_RW2 + E_SQ) * 2;
static_assert(WS_WEND == 656 * MiB, "weight map");
constexpr size_t SZ_R2 = (size_t)M * D * 2, SZ_R4 = (size_t)M * D * 4;
constexpr size_t WS_X = 656 * MiB;
constexpr size_t WS_Y = WS_X + SZ_R4;
constexpr size_t WS_ACT = WS_Y + SZ_R2;
constexpr size_t WS_OUT = 1048 * MiB;
constexpr size_t WS_MIX = WS_OUT + SZ_R2;
static_assert(WS_ACT + (size_t)M * FF * 2 <= WS_OUT, "act map");
constexpr size_t WS_Q = WS_MIX, WS_K = WS_Q + SZ_R2, WS_V = WS_K + SZ_R2 / 4, WS_O = WS_V + SZ_R2 / 4;
constexpr size_t WS_MIX6 = WS_MIX;
constexpr size_t WS_WDEC = WS_MIX;
constexpr size_t WS_AA = WS_MIX + 2 * SZ_R4;
constexpr size_t WS_RR = WS_MIX + 6 * SZ_R2;
constexpr size_t WS_KK_ = WS_RR + SZ_R2;
constexpr size_t WS_VV = WS_KK_ + SZ_R2;
constexpr size_t WS_KN = WS_VV + SZ_R2;
constexpr size_t WS_GG = WS_KN + SZ_R2;
constexpr size_t WS_GL = WS_GG + SZ_R2;
constexpr size_t WS_WL = WS_GL + 9 * MiB, WS_AL = WS_WL + 9 * MiB;
constexpr size_t WS_PART = WS_AL + 9 * MiB;
constexpr size_t WS_BON = WS_PART + 16 * MiB;
constexpr size_t WS_END = WS_BON + 5 * MiB;
constexpr size_t WS_YS = WS_ACT;
constexpr size_t WS_PREP = WS_Y;
static_assert(WS_AA + 2 * SZ_R2 == WS_RR, "rwkv overlay");
static_assert(WS_END <= 2100 * MiB, "ws map");
constexpr int CW_BAR = 4096;
constexpr int MAX_LAUNCH = 64;
constexpr int CW_GRP = CW_BAR + MAX_LAUNCH * XCD_BAR_WORDS;
constexpr int CW_FC = CW_GRP + 16 * 4 * 64 + 2 * 128 * 64;
static_assert((CW_FC + 8 * 64) * 4 <= (int)WS_MOD, "ctl map (context tile counters)");
constexpr int CW_PAIR = CW_GRP + 16 * 4 * 64;
static_assert((CW_PAIR + 2 * 128 * 64) * 4 <= (int)WS_MOD, "ctl map (pair counters)");
static_assert((CW_GRP + 16 * 4 * 64) * 4 <= (int)WS_MOD, "ctl map (group counters)");
static_assert((CW_BAR + MAX_LAUNCH * XCD_BAR_WORDS) * 4 <= (int)WS_MOD, "ctl map");

constexpr int RING_BYTES = 131072, LDSCTL_OFF = RING_BYTES, MISC_OFF = LDSCTL_OFF + 320, LDS_BYTES = 163840;

struct Args { const float* in[30]; float* out; unsigned char* ws; int ph_lo, ph_hi, li, dbg; };
typedef const __attribute__((address_space(4))) Args KArgs;
struct Frame { LAS unsigned char* lds; unsigned char* ldsg; int wave, G, bid; };

#define LDS_WAIT() asm volatile("s_waitcnt lgkmcnt(0)" ::: "memory")
__device__ __forceinline__ unsigned f2bf(float f) { unsigned u = __builtin_bit_cast(unsigned, f); return (u + 0x7fffu + ((u >> 16) & 1u)) >> 16; }
__device__ __forceinline__ unsigned pk2(float lo, float hi) { return pg8::cvt_pk_bf16(lo, hi); }
__device__ __forceinline__ float bflo(unsigned w) { return __builtin_bit_cast(float, w << 16); }
__device__ __forceinline__ float bfhi(unsigned w) { return __builtin_bit_cast(float, w & 0xffff0000u); }
__device__ __forceinline__ void unpack8(const u32x4 w, float (&v)[8]) { v[0] = bflo(w.x); v[1] = bfhi(w.x); v[2] = bflo(w.y); v[3] = bfhi(w.y); v[4] = bflo(w.z); v[5] = bfhi(w.z); v[6] = bflo(w.w); v[7] = bfhi(w.w); }
__device__ __forceinline__ u32x4 pack8(const float (&v)[8]) { u32x4 w; w.x = pk2(v[0], v[1]); w.y = pk2(v[2], v[3]); w.z = pk2(v[4], v[5]); w.w = pk2(v[6], v[7]); return w; }
typedef _Float16 h16x2 __attribute__((ext_vector_type(2)));
__device__ __forceinline__ void unpack8h(const u32x4 w, float (&v)[8]) {
    const unsigned wx = w.x, wy = w.y, wz = w.z, ww = w.w;
    const h16x2 a = __builtin_bit_cast(h16x2, wx), b = __builtin_bit_cast(h16x2, wy), c = __builtin_bit_cast(h16x2, wz), d = __builtin_bit_cast(h16x2, ww);
    v[0] = (float)a.x; v[1] = (float)a.y; v[2] = (float)b.x; v[3] = (float)b.y; v[4] = (float)c.x; v[5] = (float)c.y; v[6] = (float)d.x; v[7] = (float)d.y; }
__device__ __forceinline__ u32x4 pack8h(const float (&v)[8]) {
    h16x2 a, b, c, d; a.x = (_Float16)v[0]; a.y = (_Float16)v[1]; b.x = (_Float16)v[2]; b.y = (_Float16)v[3]; c.x = (_Float16)v[4]; c.y = (_Float16)v[5]; d.x = (_Float16)v[6]; d.y = (_Float16)v[7];
    u32x4 w; w.x = __builtin_bit_cast(unsigned, a); w.y = __builtin_bit_cast(unsigned, b); w.z = __builtin_bit_cast(unsigned, c); w.w = __builtin_bit_cast(unsigned, d); return w; }
__device__ __forceinline__ float wave_sum(float v) {
#pragma unroll
    for (int o = 1; o < 64; o <<= 1) v += __shfl_xor(v, o);
    return v;
}
template <int CTRL> __device__ __forceinline__ float dppf(float x) { return __builtin_bit_cast(float, __builtin_amdgcn_mov_dpp(__builtin_bit_cast(int, x), CTRL, 0xF, 0xF, true)); }
__device__ __forceinline__ float sum8(float v) { v += dppf<0xB1>(v); v += dppf<0x4E>(v); v += dppf<0x141>(v); return v; }
__device__ __forceinline__ float sum16(float v) { v = sum8(v); v += dppf<0x140>(v); return v; }
__device__ __forceinline__ float fsigmoid(float x) { return __builtin_amdgcn_rcpf(1.0f + __builtin_amdgcn_exp2f(-1.4426950408889634f * x)); }
__device__ __forceinline__ float ftanh(float x) { return 1.0f - 2.0f * __builtin_amdgcn_rcpf(1.0f + __builtin_amdgcn_exp2f(2.8853900817779268f * x)); }
__device__ __forceinline__ float fsilu(float x) { return x * fsigmoid(x); }

using pg8::Unit;
typedef float accf32x4 __attribute__((ext_vector_type(4)));
struct EpiPlain {
    static constexpr bool PERM = true, AFTER_DRAIN = false;
    bf16_t* O; int ldc;
    __device__ __forceinline__ void operator()(const accf32x4 (&acc)[2][2][4][2], const Unit& u, int wr, int wc, int fr, int fq) const {
        const int row0 = u.pm * 256 + wr * 64 + fr, col0 = u.pn * 256 + wc * 32 + 8 * fq;
#pragma unroll
        for (int ai = 0; ai < 2; ++ai)
#pragma unroll
            for (int m = 0; m < 4; ++m) { bf16_t* rowp = O + (size_t)(row0 + ai * 128 + m * 16) * ldc + col0;
#pragma unroll
                for (int bj = 0; bj < 2; ++bj) { const accf32x4 v0 = acc[ai][bj][m][0], v1 = acc[ai][bj][m][1];
                    u32x4 w; w.x = pk2(v0[0], v0[1]); w.y = pk2(v0[2], v0[3]); w.z = pk2(v1[0], v1[1]); w.w = pk2(v1[2], v1[3]);
                    *(u32x4*)(rowp + bj * 128) = w; } }
    }
};
struct EpiQKV {
    static constexpr bool PERM = true, AFTER_DRAIN = false;
    unsigned char* wsb;
    __device__ __forceinline__ void operator()(const accf32x4 (&acc)[2][2][4][2], const Unit& u, int wr, int wc, int fr, int fq) const {
        size_t ooff; int ldc, ct;
        if (u.pn < 8) { ooff = WS_Q; ldc = 2048; ct = u.pn; } else if (u.pn < 10) { ooff = WS_K; ldc = 512; ct = u.pn - 8; } else { ooff = WS_V; ldc = 512; ct = u.pn - 10; }
        bf16_t* O = (bf16_t*)(wsb + ooff);
        const int row0 = u.pm * 256 + wr * 64 + fr, col0 = ct * 256 + wc * 32 + 8 * fq;
#pragma unroll
        for (int ai = 0; ai < 2; ++ai)
#pragma unroll
            for (int m = 0; m < 4; ++m) { bf16_t* rowp = O + (size_t)(row0 + ai * 128 + m * 16) * ldc + col0;
#pragma unroll
                for (int bj = 0; bj < 2; ++bj) { const accf32x4 v0 = acc[ai][bj][m][0], v1 = acc[ai][bj][m][1];
                    u32x4 w; w.x = pk2(v0[0], v0[1]); w.y = pk2(v0[2], v0[3]); w.z = pk2(v1[0], v1[1]); w.w = pk2(v1[2], v1[3]);
                    *(u32x4*)(rowp + bj * 128) = w; } }
    }
};
struct EpiQKVN {
    static constexpr bool PERM = true, AFTER_DRAIN = false;
    unsigned char* wsb; const float* gq; const float* gk; LAS float* xch; float qscale;
    __device__ __forceinline__ void operator()(const accf32x4 (&acc)[2][2][4][2], const Unit& u, int wr, int wc, int fr, int fq) const {
        size_t ooff; int ldc, ct;
        if (u.pn < 8) { ooff = WS_Q; ldc = 2048; ct = u.pn; } else if (u.pn < 10) { ooff = WS_K; ldc = 512; ct = u.pn - 8; } else { ooff = WS_V; ldc = 512; ct = u.pn - 10; }
        bf16_t* O = (bf16_t*)(wsb + ooff);
        const int row0 = u.pm * 256 + wr * 64 + fr, col0 = ct * 256 + wc * 32 + 8 * fq;
        if (u.pn >= 10) {
#pragma unroll
            for (int ai = 0; ai < 2; ++ai)
#pragma unroll
                for (int m = 0; m < 4; ++m) { bf16_t* rowp = O + (size_t)(row0 + ai * 128 + m * 16) * ldc + col0;
#pragma unroll
                    for (int bj = 0; bj < 2; ++bj) { const accf32x4 v0 = acc[ai][bj][m][0], v1 = acc[ai][bj][m][1];
                        u32x4 w; w.x = pk2(v0[0], v0[1]); w.y = pk2(v0[2], v0[3]); w.z = pk2(v1[0], v1[1]); w.w = pk2(v1[2], v1[3]);
                        *(u32x4*)(rowp + bj * 128) = w; } }
            return;
        }
#pragma unroll
        for (int ai = 0; ai < 2; ++ai)
#pragma unroll
            for (int m = 0; m < 4; ++m)
#pragma unroll
                for (int bj = 0; bj < 2; ++bj) { const accf32x4 v0 = acc[ai][bj][m][0], v1 = acc[ai][bj][m][1];
                    float x = v0[0] * v0[0] + v0[1] * v0[1] + v0[2] * v0[2] + v0[3] * v0[3] + v1[0] * v1[0] + v1[1] * v1[1] + v1[2] * v1[2] + v1[3] * v1[3];
                    { const unsigned ub = __builtin_bit_cast(unsigned, x); auto rr = __builtin_amdgcn_permlane16_swap(ub, ub, false, false); const unsigned r0 = rr[0], r1 = rr[1];
                      x = __builtin_bit_cast(float, r0) + __builtin_bit_cast(float, r1); }
                    { const unsigned ub = __builtin_bit_cast(unsigned, x); auto rr = __builtin_amdgcn_permlane32_swap(ub, ub, false, false); const unsigned r0 = rr[0], r1 = rr[1];
                      x = __builtin_bit_cast(float, r0) + __builtin_bit_cast(float, r1); }
                    if (fq == 0) xch[((wr * 128 + ai * 64 + m * 16 + fr) * 2 + bj) * 4 + wc] = x; }
        asm volatile("s_waitcnt lgkmcnt(0)" ::: "memory");
        __builtin_amdgcn_s_barrier();
        asm volatile("" ::: "memory");
        const float* gp = (u.pn < 8 ? gq : gk) + wc * 32 + 8 * fq;
        const f32x4 g0 = *(const f32x4*)gp, g1 = *(const f32x4*)(gp + 4);
        const bool lat = (u.pm % 17) != 0;
        const float* COS = (const float*)(wsb + WS_ROPE); const float* SIN = COS + 4096 * 64;
#pragma unroll
        for (int ai = 0; ai < 2; ++ai)
#pragma unroll
            for (int m = 0; m < 4; ++m) { const int row = row0 + ai * 128 + m * 16; bf16_t* rowp = O + (size_t)row * ldc + col0;
                f32x4 cs = (f32x4){1.f, 1.f, 1.f, 1.f}, sn = (f32x4){0.f, 0.f, 0.f, 0.f};
                if (lat) { const int pos = row % TB - CTXL; cs = *(const f32x4*)(COS + (size_t)pos * 64 + wc * 16 + 4 * fq); sn = *(const f32x4*)(SIN + (size_t)pos * 64 + wc * 16 + 4 * fq); }
#pragma unroll
                for (int bj = 0; bj < 2; ++bj) {
                    const f32x4 pp = *(const LAS f32x4*)(xch + ((wr * 128 + ai * 64 + m * 16 + fr) * 2 + bj) * 4);
                    const float rs = rsqrtf((pp[0] + pp[1] + pp[2] + pp[3]) * (1.0f / 128.0f) + NORM_EPS) * (u.pn < 8 ? qscale : 1.0f);
                    const accf32x4 v0 = acc[ai][bj][m][0], v1 = acc[ai][bj][m][1];
                    const float a0 = v0[0] * rs * g0[0], a1 = v0[1] * rs * g0[1], a2 = v0[2] * rs * g0[2], a3 = v0[3] * rs * g0[3];
                    const float b0 = v1[0] * rs * g1[0], b1 = v1[1] * rs * g1[1], b2 = v1[2] * rs * g1[2], b3 = v1[3] * rs * g1[3];
                    u32x4 w;
                    w.x = pk2(a0 * cs[0] - a1 * sn[0], a0 * sn[0] + a1 * cs[0]); w.y = pk2(a2 * cs[1] - a3 * sn[1], a2 * sn[1] + a3 * cs[1]);
                    w.z = pk2(b0 * cs[2] - b1 * sn[2], b0 * sn[2] + b1 * cs[2]); w.w = pk2(b2 * cs[3] - b3 * sn[3], b2 * sn[3] + b3 * cs[3]);
                    *(u32x4*)(rowp + bj * 128) = w; } }
    }
};
struct EpiSwiGLU {
    static constexpr bool PERM = true, AFTER_DRAIN = false;
    bf16_t* O;
    __device__ __forceinline__ void operator()(const accf32x4 (&acc)[2][2][4][2], const Unit& u, int wr, int wc, int fr, int fq) const {
        const int row0 = u.pm * 256 + wr * 64 + fr, col0 = u.pn * 128 + wc * 32 + 8 * fq;
#pragma unroll
        for (int ai = 0; ai < 2; ++ai)
#pragma unroll
            for (int m = 0; m < 4; ++m) { bf16_t* rowp = O + (size_t)(row0 + ai * 128 + m * 16) * FF + col0;
                float r[8];
#pragma unroll
                for (int n = 0; n < 2; ++n)
#pragma unroll
                    for (int e = 0; e < 4; ++e) { const float g = acc[ai][0][m][n][e], up = acc[ai][1][m][n][e]; r[4 * n + e] = fsilu(g) * up; }
                *(u32x4*)rowp = pack8(r); }
    }
};
struct EpiRw1 {
    static constexpr bool PERM = true, AFTER_DRAIN = false;
    unsigned char* wsb; const float* k_k;
    __device__ __forceinline__ void operator()(const accf32x4 (&acc)[2][2][4][2], const Unit& u, int wr, int wc, int fr, int fq) const {
        const int row0 = u.pm * 256 + wr * 64 + fr, cit = 64 * wc + 8 * fq;
        const int pn = u.pn;
        if (pn >= 8 && pn < 16) {
            bf16_t* K = (bf16_t*)(wsb + WS_KK_); bf16_t* KN = (bf16_t*)(wsb + WS_KN);
            const int colb = (pn - 8) * 256 + cit;
            float kk0[8], kk1[8];
            { const f32x4 a0 = *(const f32x4*)(k_k + colb), a1 = *(const f32x4*)(k_k + colb + 4), b0 = *(const f32x4*)(k_k + colb + 32), b1 = *(const f32x4*)(k_k + colb + 36);
#pragma unroll
              for (int e = 0; e < 4; ++e) { kk0[e] = a0[e]; kk0[4 + e] = a1[e]; kk1[e] = b0[e]; kk1[4 + e] = b1[e]; } }
#pragma unroll
            for (int ai = 0; ai < 2; ++ai)
#pragma unroll
                for (int m = 0; m < 4; ++m) { const size_t ro = (size_t)(row0 + ai * 128 + m * 16) * D + colb;
                    float k0[8], k1[8], q0[8], q1[8]; float ss = 0.f;
#pragma unroll
                    for (int n = 0; n < 2; ++n)
#pragma unroll
                        for (int e = 0; e < 4; ++e) { k0[4 * n + e] = acc[ai][0][m][n][e]; k1[4 * n + e] = acc[ai][1][m][n][e]; }
#pragma unroll
                    for (int i = 0; i < 8; ++i) { q0[i] = k0[i] * kk0[i]; q1[i] = k1[i] * kk1[i]; ss += q0[i] * q0[i] + q1[i] * q1[i]; }
                    ss += __shfl_xor(ss, 16); ss += __shfl_xor(ss, 32);
                    const float rs = rsqrtf(ss + 1e-12f);
#pragma unroll
                    for (int i = 0; i < 8; ++i) { q0[i] *= rs; q1[i] *= rs; }
                    *(u32x4*)(K + ro) = pack8(k0); *(u32x4*)(K + ro + 32) = pack8(k1);
                    *(u32x4*)(KN + ro) = pack8(q0); *(u32x4*)(KN + ro + 32) = pack8(q1); }
        } else if (pn < 24) {
            bf16_t* O = (bf16_t*)(wsb + (pn < 8 ? WS_RR : WS_VV)); const int colb = (pn & 7) * 256 + cit;
#pragma unroll
            for (int ai = 0; ai < 2; ++ai)
#pragma unroll
                for (int m = 0; m < 4; ++m) { const size_t ro = (size_t)(row0 + ai * 128 + m * 16) * D + colb;
#pragma unroll
                    for (int bj = 0; bj < 2; ++bj) { const accf32x4 v0 = acc[ai][bj][m][0], v1 = acc[ai][bj][m][1];
                        u32x4 w; w.x = pk2(v0[0], v0[1]); w.y = pk2(v0[2], v0[3]); w.z = pk2(v1[0], v1[1]); w.w = pk2(v1[2], v1[3]);
                        *(u32x4*)(O + ro + 32 * bj) = w; } }
        } else {
            bf16_t* O = (bf16_t*)(wsb + WS_GL + (size_t)(pn - 24) * (9 * MiB));
#pragma unroll
            for (int ai = 0; ai < 2; ++ai)
#pragma unroll
                for (int m = 0; m < 4; ++m) { const size_t ro = (size_t)(row0 + ai * 128 + m * 16) * 256 + cit;
#pragma unroll
                    for (int bj = 0; bj < 2; ++bj) { float r[8];
#pragma unroll
                        for (int n = 0; n < 2; ++n)
#pragma unroll
                            for (int e = 0; e < 4; ++e) { const float x = acc[ai][bj][m][n][e]; r[4 * n + e] = pn == 24 ? fsigmoid(x) : (pn == 25 ? ftanh(x) : x); }
                        *(u32x4*)(O + ro + 32 * bj) = pack8(r); } }
        }
    }
};
struct EpiRw2 {
    static constexpr bool PERM = true, AFTER_DRAIN = false;
    unsigned char* wsb; const float *w0, *a0; size_t aa_off;
    __device__ __forceinline__ void operator()(const accf32x4 (&acc)[2][2][4][2], const Unit& u, int wr, int wc, int fr, int fq) const {
        const int row0 = u.pm * 256 + wr * 64 + fr, cit = 64 * wc + 8 * fq;
        const int pn = u.pn;
        if (pn < 8) {
            bf16_t* G = (bf16_t*)(wsb + WS_GG);
            const int colb = pn * 256 + cit;
#pragma unroll
            for (int ai = 0; ai < 2; ++ai)
#pragma unroll
                for (int m = 0; m < 4; ++m) { const size_t ro = (size_t)(row0 + ai * 128 + m * 16) * D + colb;
#pragma unroll
                    for (int bj = 0; bj < 2; ++bj) { const accf32x4 v0 = acc[ai][bj][m][0], v1 = acc[ai][bj][m][1];
                        u32x4 w; w.x = pk2(v0[0], v0[1]); w.y = pk2(v0[2], v0[3]); w.z = pk2(v1[0], v1[1]); w.w = pk2(v1[2], v1[3]);
                        *(u32x4*)(G + ro + 32 * bj) = w; } }
        } else if (pn < 24) {
            const int d = (pn - 8) >> 3, colb = ((pn - 8) & 7) * 256 + cit;
            bf16_t* Wd = (bf16_t*)(wsb + WS_WDEC) + (size_t)d * M * D;
#pragma unroll
            for (int bj = 0; bj < 2; ++bj) {
                const f32x4 b0 = *(const f32x4*)(w0 + d * D + colb + 32 * bj), b1 = *(const f32x4*)(w0 + d * D + colb + 32 * bj + 4);
#pragma unroll
                for (int ai = 0; ai < 2; ++ai)
#pragma unroll
                    for (int m = 0; m < 4; ++m) { const size_t ro = (size_t)(row0 + ai * 128 + m * 16) * D + colb + 32 * bj;
                        float lw[8];
#pragma unroll
                        for (int e = 0; e < 4; ++e) { lw[e] = -0.8750387749f * fsigmoid(acc[ai][bj][m][0][e] + b0[e]);
                                                      lw[4 + e] = -0.8750387749f * fsigmoid(acc[ai][bj][m][1][e] + b1[e]); }
                        *(u32x4*)(Wd + ro) = pack8(lw); } }
        } else {
            const int d = (pn - 24) >> 3, colb = ((pn - 24) & 7) * 256 + cit;
            bf16_t* AAd = (bf16_t*)(wsb + aa_off) + (size_t)d * M * D;
#pragma unroll
            for (int bj = 0; bj < 2; ++bj) {
                const int cb = colb + 32 * bj;
                const f32x4 b0 = *(const f32x4*)(a0 + d * D + cb), b1 = *(const f32x4*)(a0 + d * D + cb + 4);
#pragma unroll
                for (int ai = 0; ai < 2; ++ai)
#pragma unroll
                    for (int m = 0; m < 4; ++m) { const size_t ro = (size_t)(row0 + ai * 128 + m * 16) * D + cb;
                        float av[8];
#pragma unroll
                        for (int e = 0; e < 4; ++e) { av[e] = fsigmoid(acc[ai][bj][m][0][e] + b0[e]); av[4 + e] = fsigmoid(acc[ai][bj][m][1][e] + b1[e]); }
                        *(u32x4*)(AAd + ro) = pack8(av); } }
        }
    }
};
struct GemmRw1 { const bf16_t* MIX; const bf16_t* Bt;  int K;
    __device__ __forceinline__ const char* a_tile(const Unit& u) const { int idx = u.pn < 24 ? (u.pn >> 3) : (u.pn - 21);
#ifdef DBG_RW1_SAMEA
        idx = 0;
#endif
        return (const char*)MIX + (size_t)idx * SZ_R2 + (size_t)u.pm * (size_t)(256 * 2) * D; }
    __device__ __forceinline__ const char* b_tile(const Unit& u) const { return (const char*)Bt + (size_t)u.pn * (size_t)(256 * 2) * D; }
    __device__ __forceinline__ int klen() const { return K; } };
struct GemmRw2 { const unsigned char* wsb; const bf16_t* Bt; int K, KL;
    __device__ __forceinline__ int koff(const Unit& u) const { return KL < 256 ? (((u.pn - 8) >> 3) & 1) * 64 : 0; }
    __device__ __forceinline__ const char* a_tile(const Unit& u) const { const size_t ao = u.pn < 8 ? WS_GL : (u.pn < 24 ? WS_WL : WS_AL); return (const char*)wsb + ao + (size_t)u.pm * (size_t)(256 * 2) * 256 + (size_t)koff(u) * 2; }
    __device__ __forceinline__ const char* b_tile(const Unit& u) const { return (const char*)Bt + (size_t)u.pn * (size_t)(256 * 2) * 256 + (size_t)koff(u) * 2; }
    __device__ __forceinline__ int klen() const { return KL; } };
struct Rw2WAOrder : pg8::StaticOrder {
    __device__ bool next(int i, Unit& u) const { if (!pg8::StaticOrder::next(i, u)) return false; u.pn += 8; return true; }
};

__device__ __forceinline__ int hp_row(int c) { return 128 * ((c & 63) >> 5) + 32 * (c >> 6) + (c & 31); }
__device__ __forceinline__ int hp_col(int rho) { return 64 * ((rho & 127) >> 5) + 32 * (rho >> 7) + (rho & 31); }
__device__ __forceinline__ void cvt_item(const float* W, int K, int N, bf16_t* WT, int mode, int row_off, LAS float* scr, int item, int lane) {
    const int nblk = N / 32, kb = item / nblk, nb = item - kb * nblk, k0 = 64 * kb, n0 = 32 * nb;
#pragma unroll 8
    for (int i = 0; i < 32; ++i) { const int kk = 2 * i + (lane >> 5); scr[kk * 33 + (lane & 31)] = W[(size_t)(k0 + kk) * N + n0 + (lane & 31)]; }
    LDS_WAIT(); asm volatile("" ::: "memory");
    int dr;
    if (mode == 0) dr = n0;
    else if (mode == 1) { dr = n0 < FF ? 256 * (n0 / 128) + (n0 % 128) : 256 * ((n0 - FF) / 128) + 128 + ((n0 - FF) % 128); }
    else { dr = (n0 & ~255) + hp_row(n0 & 255); }
    dr += row_off;
    const int c = lane & 7;
#pragma unroll
    for (int j = 0; j < 4; ++j) { const int n = (lane >> 3) + 8 * j; const LAS float* s = scr + (8 * c) * 33 + n;
        u32x4 o; o.x = pk2(s[0 * 33], s[1 * 33]); o.y = pk2(s[2 * 33], s[3 * 33]); o.z = pk2(s[4 * 33], s[5 * 33]); o.w = pk2(s[6 * 33], s[7 * 33]);
        *(u32x4*)(WT + (size_t)(dr + n) * K + k0 + 8 * c) = o; }
    LDS_WAIT(); asm volatile("" ::: "memory");
}
constexpr int I_F1 = (D / 64) * (2 * FF / 32), I_F2 = (FF / 64) * (D / 32), I_QKV = (D / 64) * (3072 / 32), I_SQ = (D / 64) * (D / 32), I_G1 = (D / 64) * (256 / 32), I_G2 = (256 / 64) * (D / 32);
constexpr int CVT_FFN = 4 * (I_F1 + I_F2), CVT_ATT = I_QKV + I_SQ, CVT_RW = 4 * I_SQ + I_G1 + I_G2, CVT_HALF = CVT_FFN + CVT_ATT + CVT_RW;
__device__ __forceinline__ void cvt_big_item(KArgs* a, int r, int late, LAS float* scr, int lane_) {
    bf16_t* WB = (bf16_t*)(a->ws + WS_WB); bf16_t* WA = (bf16_t*)(a->ws + WS_WA); bf16_t* WR = (bf16_t*)(a->ws + WS_WR);
    if (r < CVT_FFN) { const int lq = r / (I_F1 + I_F2), lh = 4 * late + lq; r -= lq * (I_F1 + I_F2);
        bf16_t* base = WB + (size_t)lh * (E_F1 + E_F2);
        if (r < I_F1) cvt_item(a->in[8] + (size_t)lh * D * 2 * FF, D, 2 * FF, base, 1, 0, scr, r, lane_);
        else cvt_item(a->in[9] + (size_t)lh * FF * D, FF, D, base + E_F1, 0, 0, scr, r - I_F1, lane_);
        return; }
    r -= CVT_FFN;
    const int j = late;
    if (r < CVT_ATT) {
        bf16_t* base = WA + (size_t)j * (E_QKV + E_SQ);
        if (r < I_QKV) cvt_item(a->in[10] + (size_t)j * D * 3072, D, 3072, base, 0, 0, scr, r, lane_);
        else cvt_item(a->in[11] + (size_t)j * D * D, D, D, base + E_QKV, 0, 0, scr, r - I_QKV, lane_);
        return; }
    r -= CVT_ATT;
    { bf16_t* rw1 = WR + (size_t)j * (E_RW1 + E_RW2 + E_SQ); bf16_t* rw2 = rw1 + E_RW1; bf16_t* ro = rw2 + E_RW2;
      if (r < 3 * I_SQ) { const int q = r / I_SQ; cvt_item(a->in[15] + ((size_t)j * 3 + q) * D * D, D, D, rw1, 2, q * 2048, scr, r - q * I_SQ, lane_); return; }
      r -= 3 * I_SQ;
      if (r < I_SQ) { cvt_item(a->in[16] + (size_t)j * D * D, D, D, ro, 0, 0, scr, r, lane_); return; }
      r -= I_SQ;
      if (r < I_G1) { cvt_item(a->in[17] + (size_t)j * D * 256, D, 256, rw1, 2, 6144, scr, r, lane_); return; }
      r -= I_G1;
      cvt_item(a->in[18] + (size_t)j * 256 * D, 256, D, rw2, 2, 0, scr, r, lane_); }
}
struct CvtJob { const float* W; bf16_t* WT; int K, N, mode, row_off, item; };
constexpr int CVT_N0 = 3 * (I_F1 + I_F2) + CVT_ATT + (3 * I_SQ + I_G1 + I_G2), CVT_N1 = 5 * (I_F1 + I_F2) + CVT_ATT + CVT_RW + I_SQ;
__device__ __forceinline__ CvtJob cvt_decode(KArgs* a, int r, int g) {
    bf16_t* WB = (bf16_t*)(a->ws + WS_WB); bf16_t* WA = (bf16_t*)(a->ws + WS_WA); bf16_t* WR = (bf16_t*)(a->ws + WS_WR);
    CvtJob j; j.row_off = 0; j.mode = 0;
    const int nffn = (g ? 5 : 3) * (I_F1 + I_F2);
    if (r < nffn) { const int lq = r / (I_F1 + I_F2), lh = (g ? 3 : 0) + lq; r -= lq * (I_F1 + I_F2);
        bf16_t* base = WB + (size_t)lh * (E_F1 + E_F2);
        if (r < I_F1) { j.W = a->in[8] + (size_t)lh * D * 2 * FF; j.K = D; j.N = 2 * FF; j.WT = base; j.mode = 1; j.item = r; }
        else { j.W = a->in[9] + (size_t)lh * FF * D; j.K = FF; j.N = D; j.WT = base + E_F1; j.item = r - I_F1; }
        return j; }
    r -= nffn;
    int l = g;
    if (r < CVT_ATT) {
        bf16_t* base = WA + (size_t)l * (E_QKV + E_SQ);
        if (r < I_QKV) { j.W = a->in[10] + (size_t)l * D * 3072; j.K = D; j.N = 3072; j.WT = base; j.item = r; }
        else { j.W = a->in[11] + (size_t)l * D * D; j.K = D; j.N = D; j.WT = base + E_QKV; j.item = r - I_QKV; }
        return j; }
    r -= CVT_ATT;
    if (r < 3 * I_SQ) { bf16_t* rw1 = WR + (size_t)l * (E_RW1 + E_RW2 + E_SQ);
        const int q = r / I_SQ; j.W = a->in[15] + ((size_t)l * 3 + q) * D * D; j.K = D; j.N = D; j.WT = rw1; j.mode = 2; j.row_off = q * 2048; j.item = r - q * I_SQ; return j; }
    r -= 3 * I_SQ;
    if (r < I_G1) { bf16_t* rw1 = WR + (size_t)l * (E_RW1 + E_RW2 + E_SQ); j.W = a->in[17] + (size_t)l * D * 256; j.K = D; j.N = 256; j.WT = rw1; j.mode = 2; j.row_off = 6144; j.item = r; return j; }
    r -= I_G1;
    if (r < I_G2) { bf16_t* rw2 = WR + (size_t)l * (E_RW1 + E_RW2 + E_SQ) + E_RW1; j.W = a->in[18] + (size_t)l * 256 * D; j.K = 256; j.N = D; j.WT = rw2; j.mode = 2; j.item = r; return j; }
    r -= I_G2;
    l = r < I_SQ ? 1 : 0; r -= (1 - l) * I_SQ;
    { bf16_t* ro = WR + (size_t)l * (E_RW1 + E_RW2 + E_SQ) + E_RW1 + E_RW2; j.W = a->in[16] + (size_t)l * D * D; j.K = D; j.N = D; j.WT = ro; j.item = r; }
    return j;
}
__device__ __forceinline__ void cvt_job_load(const CvtJob& j, int lane, float (&v)[32]) {
    const int nblk = j.N / 32, kb = j.item / nblk, nb = j.item - kb * nblk, k0 = 64 * kb, n0 = 32 * nb;
    const float* p = j.W + (size_t)(k0 + (lane >> 5)) * j.N + n0 + (lane & 31);
#pragma unroll
    for (int i = 0; i < 32; ++i) v[i] = p[(size_t)(2 * i) * j.N];
}
__device__ __forceinline__ void cvt_job_store(const CvtJob& j, LAS float* scr, int lane, const float (&v)[32]) {
    const int nblk = j.N / 32, kb = j.item / nblk, nb = j.item - kb * nblk, k0 = 64 * kb, n0 = 32 * nb;
#pragma unroll
    for (int i = 0; i < 32; ++i) scr[(2 * i + (lane >> 5)) * 33 + (lane & 31)] = v[i];
    LDS_WAIT(); asm volatile("" ::: "memory");
    int dr;
    if (j.mode == 0) dr = n0;
    else if (j.mode == 1) { dr = n0 < FF ? 256 * (n0 / 128) + (n0 % 128) : 256 * ((n0 - FF) / 128) + 128 + ((n0 - FF) % 128); }
    else { dr = (n0 & ~255) + hp_row(n0 & 255); }
    dr += j.row_off;
    const int c = lane & 7;
#pragma unroll
    for (int q = 0; q < 4; ++q) { const int n = (lane >> 3) + 8 * q; const LAS float* sp = scr + (8 * c) * 33 + n;
        u32x4 o; o.x = pk2(sp[0 * 33], sp[1 * 33]); o.y = pk2(sp[2 * 33], sp[3 * 33]); o.z = pk2(sp[4 * 33], sp[5 * 33]); o.w = pk2(sp[6 * 33], sp[7 * 33]);
        *(u32x4*)(j.WT + (size_t)(dr + n) * j.K + k0 + 8 * c) = o; }
    LDS_WAIT(); asm volatile("" ::: "memory");
}
__device__ __forceinline__ void p0a_phase(const Frame F, KArgs* a) {
    const int lane_ = lane_opaque(), tid_ = F.wave * 64 + lane_; (void)tid_; (void)lane_;
    LAS float* scr = (LAS float*)(F.lds + F.wave * 16384);
    const int gw = F.bid * NWAVES + F.wave, NGW = F.G * NWAVES;
    bf16_t* WR = (bf16_t*)(a->ws + WS_WR);
    for (int it = gw; it < CVT_N0; it += NGW) { const CvtJob j = cvt_decode(a, it, 0); float v[32]; cvt_job_load(j, lane_, v); cvt_job_store(j, scr, lane_, v); }
    {
        constexpr int P_A = 256 * 2048 / 2, P_C = 4096 * 256 / 2, P_J = 2 * P_A + 2 * P_C;
        for (int p = F.bid * NTHR + tid_; p < 2 * P_J; p += F.G * NTHR) {
            const int j = p / P_J; int r = p - j * P_J;
            bf16_t* rw1 = WR + (size_t)j * (E_RW1 + E_RW2 + E_SQ); bf16_t* rw2 = rw1 + E_RW1;
            if (r < 2 * P_A) { const int which = r / P_A; r -= which * P_A;
                const int rho = r / 1024, k = (r - rho * 1024) * 2, c = hp_col(rho);
                const float* src = (which == 0 ? a->in[20] : a->in[23]);
                float v0 = 0.f, v1 = 0.f;
                if (c < 192) { const int d = c / 96, jj = c - d * 96; const float* s = src + (((size_t)j * 2 + d) * D + k) * 96 + jj; v0 = s[0]; v1 = s[96]; }
                *(unsigned*)(rw1 + (size_t)(6400 + 256 * which + rho) * D + k) = pk2(v0, v1);
            } else { r -= 2 * P_A; const int which = r / P_C; r -= which * P_C;
                const int nrow = r / 128, k = (r - nrow * 128) * 2;
                const int d = nrow >> 11, np = nrow & 2047, c = (np & ~255) + hp_col(np & 255);
                const float* src = (which == 0 ? a->in[21] : a->in[24]);
                float v0 = 0.f, v1 = 0.f;
                if (k < 192 && (k / 96) == d) { const int kk = k - d * 96; const float* s = src + (((size_t)j * 2 + d) * 96 + kk) * D + c; v0 = s[0]; v1 = s[D]; }
                *(unsigned*)(rw2 + (size_t)(2048 + 4096 * which + nrow) * 256 + k) = pk2(v0, v1);
            }
        }
    }
#ifdef DBG_FILL_WS
    {
        u32x4* p = (u32x4*)(a->ws + WS_X); const size_t n16 = (WS_END - WS_X) / 16;
        for (size_t i = (size_t)F.bid * NTHR + tid_; i < n16; i += (size_t)F.G * NTHR) p[i] = (u32x4){0xAAAAAAAAu, 0xAAAAAAAAu, 0xAAAAAAAAu, 0xAAAAAAAAu};
    }
#endif
    {
        float* COS = (float*)(a->ws + WS_ROPE); float* SIN = COS + 4096 * 64;
        for (int p = F.bid * NTHR + tid_; p < 4096 * 64; p += F.G * NTHR) {
            const int t = p >> 6, f = p & 63; const int pos = f < 32 ? (t >> 6) : (t & 63); const int fi = f & 31;
            const float inv = exp2f(-(float)fi * (13.287712379549449f / 32.0f));
            const float ang = (float)pos * inv;
            COS[p] = cosf(ang); SIN[p] = sinf(ang);
        }
    }
    {
        LAS float* sv = (LAS float*)F.lds;
        LAS float* part = (LAS float*)(F.lds + 65536);
        float* MOD = (float*)(a->ws + WS_MOD);
        __syncthreads();
        for (int idx = tid_; idx < 5 * D; idx += NTHR) { const int cc = idx >> 11, kk = idx & 2047; const float x = cc < 4 ? a->in[1][cc * D + kk] : a->in[3][kk]; sv[kk * 8 + cc] = fsilu(x); }
        __syncthreads();
        for (int u = F.bid; u < 4 * 72; u += F.G) {
            const int l = u / 72, nb = u - l * 72;
            const int n = nb * 256 + lane_ * 4, k0 = F.wave * 256;
            const float* wp = a->in[4] + ((size_t)l * D + k0) * 18432 + n;
            f32x4 acc[5];
#pragma unroll
            for (int c = 0; c < 5; ++c) acc[c] = (f32x4){0.f, 0.f, 0.f, 0.f};
#pragma unroll 8
            for (int kk = 0; kk < 256; ++kk) { const f32x4 w4 = *(const f32x4*)(wp + (size_t)kk * 18432);
                const f32x4 s4 = *(const LAS f32x4*)(sv + (k0 + kk) * 8); const float s5 = sv[(k0 + kk) * 8 + 4];
                acc[0] += w4 * s4[0]; acc[1] += w4 * s4[1]; acc[2] += w4 * s4[2]; acc[3] += w4 * s4[3]; acc[4] += w4 * s5; }
#pragma unroll
            for (int c = 0; c < 5; ++c) *(LAS f32x4*)(part + (F.wave * 5 + c) * 256 + lane_ * 4) = acc[c];
            __syncthreads();
            for (int o = tid_; o < 5 * 256; o += NTHR) { const int c = o >> 8, col = o & 255; float s = a->in[5][(size_t)l * 18432 + nb * 256 + col];
#pragma unroll
                for (int w = 0; w < 8; ++w) s += part[(w * 5 + c) * 256 + col];
                MOD[((size_t)l * 5 + c) * 18432 + nb * 256 + col] = s; }
            __syncthreads();
        }
    }
}

template <int MODE> struct ThinCtx { float PA[4][8], PB[4][8], PC[4][8]; int cur_c; };
template <int MODE, bool CTXP>
__device__ __forceinline__ void thin_row(ThinCtx<MODE>& T, KArgs* a, const int lane, const int m, int l, int s, float wgt, int nl, int ns) {
    const float* MOD = (const float*)(a->ws + WS_MOD);
    bf16_t* X = (bf16_t*)(a->ws + WS_X)  ; bf16_t* Y = (bf16_t*)(a->ws + WS_Y); const bf16_t* OUT = (const bf16_t*)(a->ws + WS_OUT);
    const int b = m / TB, j = m - b * TB, c = j < CTXL ? 4 : b;
    if (MODE == 2 && c == 4) return;
    if (c != T.cur_c) {
        T.cur_c = c;
#pragma unroll
        for (int q = 0; q < 4; ++q) { const int e0 = 512 * q + 8 * lane;
            if (MODE != 0) { const float* gp = MOD + (((size_t)l * 5 + c) * 9 + s * 3 + 2) * D + e0; const float* np = a->in[7] + ((size_t)l * 3 + s) * D + e0;
#pragma unroll
                for (int i = 0; i < 8; ++i) T.PA[q][i] = wgt * gp[i] * np[i]; }
            if (MODE != 2) { const float* sc = MOD + (((size_t)nl * 5 + c) * 9 + ns * 3 + 1) * D + e0; const float* sh = MOD + (((size_t)nl * 5 + c) * 9 + ns * 3 + 0) * D + e0; const float* np = a->in[6] + ((size_t)nl * 3 + ns) * D + e0;
#pragma unroll
                for (int i = 0; i < 8; ++i) { T.PB[q][i] = np[i] * (1.0f + sc[i]); T.PC[q][i] = sh[i]; } } }
    }
    float x[4][8];
    if (MODE == 0) {
        const float* src = j < CTXL ? a->in[2] + ((size_t)b * CTXL + j) * D : a->in[0] + ((size_t)b * SEQ + (j - CTXL)) * D;
#pragma unroll
        for (int q = 0; q < 4; ++q) { const f32x4 v0 = *(const f32x4*)(src + 512 * q + 8 * lane), v1 = *(const f32x4*)(src + 512 * q + 8 * lane + 4);
#pragma unroll
            for (int e = 0; e < 4; ++e) { x[q][e] = v0[e]; x[q][4 + e] = v1[e]; } }
    } else {
        float o[4][8]; float ss = 0.f;
#pragma unroll
        for (int q = 0; q < 4; ++q) {
            if (CTXP) { const float* P0 = (const float*)(a->ws + WS_PART) + (size_t)(b * CTXL + j) * D + 512 * q + 8 * lane; const float* P1 = P0 + (size_t)(NB * CTXL) * D;
                const f32x4 a0 = *(const f32x4*)P0, a1 = *(const f32x4*)(P0 + 4), b0 = *(const f32x4*)P1, b1 = *(const f32x4*)(P1 + 4);
#pragma unroll
                for (int e = 0; e < 4; ++e) { o[q][e] = a0[e] + b0[e]; o[q][4 + e] = a1[e] + b1[e]; } }
            else unpack8(*(const u32x4*)(OUT + (size_t)m * D + 512 * q + 8 * lane), o[q]);
#pragma unroll
            for (int i = 0; i < 8; ++i) ss += o[q][i] * o[q][i]; }
        ss = wave_sum(ss);
        const float r1 = rsqrtf(ss * (1.0f / D) + NORM_EPS);
#pragma unroll
        for (int q = 0; q < 4; ++q) { float xo[8]; unpack8h(*(const u32x4*)(X + (size_t)m * D + 512 * q + 8 * lane), xo);
#pragma unroll
            for (int e = 0; e < 8; ++e) x[q][e] = xo[e] + T.PA[q][e] * (o[q][e] * r1); }
    }
    if (MODE == 2) {
        float* dst = a->out + ((size_t)b * SEQ + (j - CTXL)) * D;
#pragma unroll
        for (int q = 0; q < 4; ++q) { *(f32x4*)(dst + 512 * q + 8 * lane) = (f32x4){x[q][0], x[q][1], x[q][2], x[q][3]}; *(f32x4*)(dst + 512 * q + 8 * lane + 4) = (f32x4){x[q][4], x[q][5], x[q][6], x[q][7]}; }
        return;
    }
    float ss2 = 0.f;
#pragma unroll
    for (int q = 0; q < 4; ++q) { *(u32x4*)(X + (size_t)m * D + 512 * q + 8 * lane) = pack8h(x[q]);
#pragma unroll
        for (int i = 0; i < 8; ++i) ss2 += x[q][i] * x[q][i]; }
    ss2 = wave_sum(ss2);
    const float r2 = rsqrtf(ss2 * (1.0f / D) + NORM_EPS);
#pragma unroll
    for (int q = 0; q < 4; ++q) { float y[8];
#pragma unroll
        for (int i = 0; i < 8; ++i) y[i] = (x[q][i] * r2) * T.PB[q][i] + T.PC[q][i];
        *(u32x4*)(Y + (size_t)m * D + 512 * q + 8 * lane) = pack8(y); }
}
template <int MODE, int ROWSET, int NX = NCTXWG, int WX = 0>
__device__ __forceinline__ void thin_phase(const Frame F, KArgs* a, int l, int s, float wgt, int nl, int ns) {
    const int lane_ = lane_opaque();
    ThinCtx<MODE> T; T.cur_c = -1;
    if (ROWSET == 0) {
        for (int ch = F.bid; ch < M / 68; ch += F.G) {
            const int r0 = ch * 68 + (F.wave < 4 ? 9 * F.wave : 36 + 8 * (F.wave - 4)), nr = F.wave < 4 ? 9 : 8;
            for (int r = 0; r < nr; ++r) thin_row<MODE, false>(T, a, lane_, r0 + r, l, s, wgt, nl, ns);
        }
    } else if (ROWSET == 1) {
        const long tot = (long)NX * NWAVES * WX + (long)(F.G - NX) * NWAVES * 8;
        const long st = F.bid < NX ? (long)(F.bid * NWAVES + F.wave) * WX : (long)NX * NWAVES * WX + (long)((F.bid - NX) * NWAVES + F.wave) * 8, en = st + (F.bid < NX ? WX : 8);
        const int l0 = (int)((st * (NB * SEQ)) / tot), l1 = (int)((en * (NB * SEQ)) / tot);
        for (int li = l0; li < l1; ++li) thin_row<MODE, false>(T, a, lane_, (li >> 12) * TB + CTXL + (li & (SEQ - 1)), l, s, wgt, nl, ns);
    } else {
        for (int c = F.bid * NWAVES + F.wave; c < NB * CTXL; c += F.G * NWAVES) thin_row<MODE, true>(T, a, lane_, (c >> 8) * TB + (c & (CTXL - 1)), l, s, wgt, nl, ns);
    }
}
__device__ __forceinline__ void ctx_group_thin(const Frame F, KArgs* a, unsigned* bar, int site, int l, int s, float wgt, int nl, int ns) {
    asm volatile("s_waitcnt vmcnt(0)" ::: "memory");
    __syncthreads();
    const int lane_ = lane_opaque();
    if (F.wave == 0 && lane_ == 0) {
        unsigned* c = (unsigned*)(a->ws + WS_CTL) + CW_GRP + (site * 4 + (F.bid >> 4)) * 64;
        __builtin_amdgcn_fence(__ATOMIC_RELEASE, "agent");
        asm volatile("s_waitcnt vmcnt(0)" ::: "memory");
        (void)xb_add(c, 1u);
        XB_SPIN(xb_ld(c) < 16u, bar);
        __builtin_amdgcn_fence(__ATOMIC_ACQUIRE, "agent");
        asm volatile("s_waitcnt vmcnt(0)" ::: "memory");
    }
    __syncthreads();
    ThinCtx<1> T; T.cur_c = -1;
    const int b = F.bid >> 4, r0 = (F.bid & 15) * 16 + F.wave * 2;
    thin_row<1, true>(T, a, lane_, b * TB + r0, l, s, wgt, nl, ns);
    thin_row<1, true>(T, a, lane_, b * TB + r0 + 1, l, s, wgt, nl, ns);
}
__device__ __forceinline__ void ctx_group_sync(const Frame F, KArgs* a, unsigned* bar, int site, int panel, unsigned n) {
    asm volatile("s_waitcnt vmcnt(0)" ::: "memory");
    __syncthreads();
    if (F.wave == 0 && lane_opaque() == 0) {
        unsigned* c = (unsigned*)(a->ws + WS_CTL) + CW_GRP + (site * 4 + panel) * 64;
        __builtin_amdgcn_fence(__ATOMIC_RELEASE, "agent");
        asm volatile("s_waitcnt vmcnt(0)" ::: "memory");
        (void)xb_add(c, 1u);
        XB_SPIN(xb_ld(c) < n, bar);
        __builtin_amdgcn_fence(__ATOMIC_ACQUIRE, "agent");
        asm volatile("s_waitcnt vmcnt(0)" ::: "memory");
    }
    __syncthreads();
}
struct CtxOrder8 {
    int c;
    __device__ bool next(int i, Unit& u) const { if (i != 0 || c >= 32) return false; u.pm = (c >> 3) * 17; u.pn = c & 7; return true; }
    __device__ __forceinline__ void a_ready(const Unit&) const {}
    __device__ __forceinline__ void done(const Unit&) const {}
};
__device__ __forceinline__ void ctx_mixer_thin(const Frame F, KArgs* a, unsigned* bar, int site, int l, int s, float wgt, int nl, int ns) {
    ctx_group_sync(F, a, bar, site, F.bid >> 3, 8u);
    const int lane_ = lane_opaque();
    ThinCtx<1> T; T.cur_c = -1;
    const int b = F.bid >> 3, r0 = (F.bid & 7) * 32 + F.wave * 4;
#pragma unroll 1
    for (int r = 0; r < 4; ++r) thin_row<1, false>(T, a, lane_, b * TB + r0 + r, l, s, wgt, nl, ns);
}
struct Ffn1Order {
    int G, c; unsigned* ctr;
    __device__ bool next(int i, Unit& u) const {
        const int L = i * G + c; if (L >= 68 * 44) return false;
        if (L < 176) { const int p = L / 44; u.pm = p * 17; u.pn = L - p * 44; return true; }
        constexpr int nM = 64, nN = 44, nwg = nM * nN;
        int wgid = L - 176; { const int q = nwg / pg8::NXCD, r = nwg % pg8::NXCD, xcd = wgid % pg8::NXCD, off = wgid / pg8::NXCD; wgid = (xcd < r ? xcd * (q + 1) : r * (q + 1) + (xcd - r) * q) + off; }
        const int nig = pg8::WGM * nN, gid = wgid / nig, fm = gid * pg8::WGM, gsz = (nM - fm) < pg8::WGM ? (nM - fm) : pg8::WGM;
        const int pl = fm + ((wgid % nig) % gsz); u.pm = pl + (pl >> 4) + 1; u.pn = (wgid % nig) / gsz; return true;
    }
    __device__ __forceinline__ void a_ready(const Unit&) const {}
    __device__ __forceinline__ void done(const Unit& u) const {
        if (u.pm % 17 == 0) {
            asm volatile("s_waitcnt vmcnt(0)" ::: "memory");
            __builtin_amdgcn_s_barrier();
            if (threadIdx.x == 0) { __builtin_amdgcn_fence(__ATOMIC_RELEASE, "agent"); asm volatile("s_waitcnt vmcnt(0)" ::: "memory"); (void)xb_add(ctr, 1u); }
        }
    }
};
struct LatentOrder : pg8::StaticOrder {
    __device__ void init_lat(int N, int G_, int c_) { init(64 * 256, N, G_, c_); }
    __device__ bool next(int i, Unit& u) const { if (!pg8::StaticOrder::next(i, u)) return false; u.pm = u.pm + (u.pm >> 4) + 1; return true; }
};
struct CtxOrder2 {
    int c;
    __device__ bool next(int i, Unit& u) const { if (i != 0 || c >= NCTXWG) return false; const int idx = c >> 1; u.pm = (idx >> 3) * 17; u.pn = (idx & 7) + 8 * (c & 1); return true; }
    __device__ __forceinline__ void a_ready(const Unit&) const {}
    __device__ __forceinline__ void done(const Unit&) const {}
};
struct GemmCtxSplit { const bf16_t* A; const bf16_t* Bt; int K;
    __device__ __forceinline__ const char* a_tile(const Unit& u) const { return (const char*)A + (size_t)u.pm * (size_t)(256 * 2) * K + (size_t)(u.pn >> 3) * (size_t)(K / 2) * 2; }
    __device__ __forceinline__ const char* b_tile(const Unit& u) const { return (const char*)Bt + (size_t)(u.pn & 7) * (size_t)(256 * 2) * K + (size_t)(u.pn >> 3) * (size_t)(K / 2) * 2; }
    __device__ __forceinline__ int klen() const { return K / 2; } };
struct EpiCtxPart {
    static constexpr bool PERM = true, AFTER_DRAIN = false;
    float* P;
    __device__ __forceinline__ void operator()(const accf32x4 (&acc)[2][2][4][2], const Unit& u, int wr, int wc, int fr, int fq) const {
        const int row0 = (u.pm / 17) * 256 + wr * 64 + fr, col0 = (u.pn & 7) * 256 + wc * 32 + 8 * fq;
        float* base = P + (size_t)(u.pn >> 3) * (NB * CTXL) * D;
#pragma unroll
        for (int ai = 0; ai < 2; ++ai)
#pragma unroll
            for (int m = 0; m < 4; ++m) { float* rowp = base + (size_t)(row0 + ai * 128 + m * 16) * D + col0;
#pragma unroll
                for (int bj = 0; bj < 2; ++bj) { *(f32x4*)(rowp + bj * 128) = acc[ai][bj][m][0]; *(f32x4*)(rowp + bj * 128 + 4) = acc[ai][bj][m][1]; } }
    }
};
#ifndef DBG_DUMP_OFF
#define DBG_DUMP_OFF WS_X
#define DBG_DUMP_F32 1
#endif
__device__ __forceinline__ void copyout_phase(const Frame F, KArgs* a) {
    const int lane_ = lane_opaque();
    for (int m = F.bid * NWAVES + F.wave; m < M; m += F.G * NWAVES) { const int b = m / TB, j = m - b * TB; if (j < CTXL) continue;
        float* dst = a->out + ((size_t)b * SEQ + (j - CTXL)) * D;
#if defined(DBG_DUMP_P256)
        { const size_t offs[] = {DBG_DUMP_P256}; constexpr int NL = sizeof(offs) / sizeof(offs[0]);
          for (int q = 0; q < 4; ++q) { float acc[8], v[8]; for (int e = 0; e < 8; ++e) acc[e] = 0.f;
              if (q == 0 && lane_ < 32) { for (int t = 0; t < NL; ++t) { unpack8(*(const u32x4*)((const bf16_t*)(a->ws + offs[t]) + (size_t)m * 256 + 8 * lane_), v); for (int e = 0; e < 8; ++e) acc[e] += (1.f + t) * v[e]; } }
              *(f32x4*)(dst + 512 * q + 8 * lane_) = (f32x4){acc[0], acc[1], acc[2], acc[3]}; *(f32x4*)(dst + 512 * q + 8 * lane_ + 4) = (f32x4){acc[4], acc[5], acc[6], acc[7]}; }
          continue; }
#endif
#ifndef DBG_DUMP_W
#define DBG_DUMP_W(t) (1.f + (t))
#endif
#if defined(DBG_DUMP_LIST)
        { const size_t offs[] = {DBG_DUMP_LIST}; constexpr int NL = sizeof(offs) / sizeof(offs[0]);
#pragma unroll
          for (int q = 0; q < 4; ++q) { const size_t ro = (size_t)m * D + 512 * q + 8 * lane_; float acc[8], v[8];
              for (int e = 0; e < 8; ++e) acc[e] = 0.f;
#pragma unroll
              for (int t = 0; t < NL; ++t) { unpack8(*(const u32x4*)((const bf16_t*)(a->ws + offs[t]) + ro), v); for (int e = 0; e < 8; ++e) acc[e] += DBG_DUMP_W(t) * v[e]; }
              *(f32x4*)(dst + 512 * q + 8 * lane_) = (f32x4){acc[0], acc[1], acc[2], acc[3]}; *(f32x4*)(dst + 512 * q + 8 * lane_ + 4) = (f32x4){acc[4], acc[5], acc[6], acc[7]}; }
          continue; }
#endif
        if (DBG_DUMP_F32) { const float* X = (const float*)(a->ws + (DBG_DUMP_OFF));
#pragma unroll
            for (int q = 0; q < 8; ++q) *(f32x4*)(dst + 256 * q + 4 * lane_) = *(const f32x4*)(X + (size_t)m * D + 256 * q + 4 * lane_); }
        else { const bf16_t* Bq = (const bf16_t*)(a->ws + (DBG_DUMP_OFF));
#pragma unroll
            for (int q = 0; q < 4; ++q) { float v[8]; unpack8(*(const u32x4*)(Bq + (size_t)m * D + 512 * q + 8 * lane_), v);
                *(f32x4*)(dst + 512 * q + 8 * lane_) = (f32x4){v[0], v[1], v[2], v[3]}; *(f32x4*)(dst + 512 * q + 8 * lane_ + 4) = (f32x4){v[4], v[5], v[6], v[7]}; } }
    }
}

__device__ __forceinline__ void mixes_phase(const Frame F, KArgs* a, int jr) {
    const int lane_ = lane_opaque(), tid_ = F.wave * 64 + lane_; (void)tid_; (void)lane_;
    const bf16_t* Y = (const bf16_t*)(a->ws + WS_Y); bf16_t* MIX = (bf16_t*)(a->ws + WS_MIX6);
    const int rg = F.wave >> 2, e0 = 512 * (F.wave & 3) + 8 * lane_;
    float mu[6][8];
    { const int muidx[6] = {0, 2, 3, 5, 1, 4};
#pragma unroll
      for (int q = 0; q < 6; ++q) { const float* mp = a->in[14] + ((size_t)jr * 6 + muidx[q]) * D + e0;
#pragma unroll
          for (int i = 0; i < 8; ++i) mu[q][i] = mp[i]; } }
    for (int ch = F.bid; ch < M / 68; ch += F.G) {
        const int r0 = ch * 68 + 34 * rg;
        float yp[8], yc[8], yn[8];
        if (r0 > 0) unpack8(*(const u32x4*)(Y + (size_t)(r0 - 1) * D + e0), yp); else {
#pragma unroll
            for (int i = 0; i < 8; ++i) yp[i] = 0.f; }
        unpack8(*(const u32x4*)(Y + (size_t)r0 * D + e0), yc);
        for (int r = 0; r < 34; ++r) { const int m = r0 + r, j = m % TB;
            if (m + 1 < M) unpack8(*(const u32x4*)(Y + (size_t)(m + 1) * D + e0), yn); else {
#pragma unroll
                for (int i = 0; i < 8; ++i) yn[i] = 0.f; }
            const float pv = (j != 0 && j != CTXL) ? 0.5f : 0.f, nv = (j != CTXL - 1 && j != TB - 1) ? 0.5f : 0.f;
            float xx[8];
#pragma unroll
            for (int i = 0; i < 8; ++i) xx[i] = (pv * yp[i] + nv * yn[i]) - yc[i];
#pragma unroll
            for (int q = 0; q < 6; ++q) { float o[8];
#pragma unroll
                for (int i = 0; i < 8; ++i) o[i] = yc[i] + xx[i] * mu[q][i];
                *(u32x4*)(MIX + (size_t)q * M * D + (size_t)m * D + e0) = pack8(o); }
#pragma unroll
            for (int i = 0; i < 8; ++i) { yp[i] = yc[i]; yc[i] = yn[i]; }
        }
    }
}

__device__ __forceinline__ void qknorm_phase(const Frame F, KArgs* a, int ja) {
    const int lane_ = lane_opaque(), tid_ = F.wave * 64 + lane_; (void)tid_; (void)lane_;
    bf16_t* Q = (bf16_t*)(a->ws + WS_Q); bf16_t* K = (bf16_t*)(a->ws + WS_K);
    const float* COS = (const float*)(a->ws + WS_ROPE); const float* SIN = COS + 4096 * 64;
    const int li = lane_ & 15, hs = lane_ >> 4;
    float gq[8], gk[8];
#pragma unroll
    for (int i = 0; i < 8; ++i) { gq[i] = a->in[12][ja * 128 + 8 * li + i]; gk[i] = a->in[13][ja * 128 + 8 * li + i]; }
    for (int m = F.bid * NWAVES + F.wave; m < M; m += F.G * NWAVES) {
        const int j = m % TB; const bool lat = j >= CTXL; const int pos = lat ? j - CTXL : 0;
        f32x4 cs = (f32x4){1.f, 1.f, 1.f, 1.f}, sn = (f32x4){0.f, 0.f, 0.f, 0.f};
        if (lat) { cs = *(const f32x4*)(COS + (size_t)pos * 64 + 4 * li); sn = *(const f32x4*)(SIN + (size_t)pos * 64 + 4 * li); }
#pragma unroll
        for (int p = 0; p < 5; ++p) {
            bf16_t* ptr = p < 4 ? Q + (size_t)m * D + (4 * p + hs) * 128 + 8 * li : K + (size_t)m * 512 + hs * 128 + 8 * li;
            float v[8]; unpack8(*(const u32x4*)ptr, v);
            float ss = 0.f;
#pragma unroll
            for (int i = 0; i < 8; ++i) ss += v[i] * v[i];
            ss = sum16(ss);
            const float rs = rsqrtf(ss * (1.0f / 128.0f) + NORM_EPS);
            float o[8];
#pragma unroll
            for (int i = 0; i < 4; ++i) { const float x1 = v[2 * i] * rs * (p < 4 ? gq[2 * i] : gk[2 * i]), x2 = v[2 * i + 1] * rs * (p < 4 ? gq[2 * i + 1] : gk[2 * i + 1]);
                o[2 * i] = x1 * cs[i] - x2 * sn[i]; o[2 * i + 1] = x1 * sn[i] + x2 * cs[i]; }
            *(u32x4*)ptr = pack8(o);
        }
    }
}

template <int R> __device__ __forceinline__ float ror16(float x) { return __builtin_bit_cast(float, __builtin_amdgcn_mov_dpp(__builtin_bit_cast(int, x), 0x120 + R, 0xF, 0xF, true)); }
__device__ __forceinline__ float sum_row16(float x) { x += ror16<8>(x); x += ror16<4>(x); x += ror16<2>(x); x += ror16<1>(x); return x; }
__device__ __forceinline__ float sum_rows(float x) {
    x += ror16<8>(x);
    { const unsigned u = __builtin_bit_cast(unsigned, x); auto rr = __builtin_amdgcn_permlane16_swap(u, u, false, false); const unsigned r0 = rr[0], r1 = rr[1];
      x = __builtin_bit_cast(float, r0) + __builtin_bit_cast(float, r1); }
    { const unsigned u = __builtin_bit_cast(unsigned, x); auto rr = __builtin_amdgcn_permlane32_swap(u, u, false, false); const unsigned r0 = rr[0], r1 = rr[1];
      x = __builtin_bit_cast(float, r0) + __builtin_bit_cast(float, r1); }
    return x;
}
template <bool HI> __device__ __forceinline__ f32x2 pk_mul_bc(f32x2 a, f32x2 b) { f32x2 d;
    if (HI) asm("v_pk_mul_f32 %0, %1, %2 op_sel:[0,1] op_sel_hi:[1,1]" : "=v"(d) : "v"(a), "v"(b)); else asm("v_pk_mul_f32 %0, %1, %2 op_sel_hi:[1,0]" : "=v"(d) : "v"(a), "v"(b)); return d; }
template <bool HI> __device__ __forceinline__ f32x2 pk_fma_bc(f32x2 a, f32x2 b, f32x2 c) { f32x2 d;
    if (HI) asm("v_pk_fma_f32 %0, %1, %2, %3 op_sel:[0,1,0] op_sel_hi:[1,1,1]" : "=v"(d) : "v"(a), "v"(b), "v"(c)); else asm("v_pk_fma_f32 %0, %1, %2, %3 op_sel_hi:[1,0,1]" : "=v"(d) : "v"(a), "v"(b), "v"(c)); return d; }
template <bool HI> __device__ __forceinline__ f32x2 pk_nfma_bc(f32x2 a, f32x2 b, f32x2 c) { f32x2 d;
    if (HI) asm("v_pk_fma_f32 %0, %1, %2, %3 op_sel:[0,1,0] op_sel_hi:[1,1,1] neg_lo:[1,0,0] neg_hi:[1,0,0]" : "=v"(d) : "v"(a), "v"(b), "v"(c));
    else asm("v_pk_fma_f32 %0, %1, %2, %3 op_sel_hi:[1,0,1] neg_lo:[1,0,0] neg_hi:[1,0,0]" : "=v"(d) : "v"(a), "v"(b), "v"(c)); return d; }
__device__ __forceinline__ void scan_phase(const Frame F, KArgs* a, int jr, const bool cvt_late, unsigned* bar) {
    const int lane_ = lane_opaque(), tid_ = F.wave * 64 + lane_; (void)tid_; (void)lane_;
    LAS float* L = (LAS float*)F.lds;
    constexpr int BUF = 32 * 384, YB0 = 2 * BUF, YBUF = 32 * 64;
    const int lane = lane_, li8 = (lane & 7) * 8, vrow = 16 * (F.wave & 3) + 2 * (lane >> 3);
    const bool comp = F.wave < 4;
    const bf16_t* KR = (const bf16_t*)(a->ws + WS_KK_); const bf16_t* AA = (const bf16_t*)(a->ws + WS_AA);
    const bf16_t* KN = (const bf16_t*)(a->ws + WS_KN); const bf16_t* RR = (const bf16_t*)(a->ws + WS_RR); const bf16_t* VV = (const bf16_t*)(a->ws + WS_VV);
    bf16_t* YS = (bf16_t*)(a->ws + WS_YS);
    for (int chain = F.bid; chain < 256; chain += F.G) {
        const int b = chain >> 6, h = (chain >> 1) & 31, dir = chain & 1;
        const size_t doff = (size_t)dir * M * D;
        const int hc = h * 64;
#define SCAN_M0(q) (b * TB + (dir == 0 ? 32 * (q) : ((q) < 8 ? 224 - 32 * (q) : 4576 - 32 * (q))))
        __syncthreads();
        if (!comp) {
            const int t = tid_ - 256, lrow = t >> 3, lpart = t & 7, trow = dir ? 31 - lrow : lrow;
            const bf16_t* pk_ = KR + hc + lpart * 8; const bf16_t* pn_ = KN + hc + lpart * 8; const bf16_t* pa_ = AA + doff + hc + lpart * 8;
            const bf16_t* pr_ = RR + hc + lpart * 8; const bf16_t* pv_ = VV + hc + lpart * 8; const bf16_t* pw_ = (const bf16_t*)(a->ws + WS_WDEC) + doff + hc + lpart * 8;
            float ka[8], rk[8];
#pragma unroll
            for (int i = 0; i < 8; ++i) { ka[i] = a->in[26][(size_t)jr * D + hc + lpart * 8 + i]; rk[i] = a->in[27][(size_t)jr * D + hc + lpart * 8 + i]; }
            float* BON = (float*)(a->ws + WS_BON) + (size_t)dir * M * 32 + h;
            const bf16_t* YSo = YS + (size_t)(1 - dir) * M * D + hc + lpart * 8; const float* BONo = (const float*)(a->ws + WS_BON) + (size_t)(1 - dir) * M * 32 + h;
            const bf16_t* GGp = (const bf16_t*)(a->ws + WS_GG) + hc + lpart * 8; bf16_t* PREPp = (bf16_t*)(a->ws + WS_PREP) + hc + lpart * 8;
            float lnw8[8], lnb8[8]; float sb_prev = 0.f;
#pragma unroll
            for (int i = 0; i < 8; ++i) { lnw8[i] = a->in[28][(size_t)jr * D + hc + lpart * 8 + i]; lnb8[i] = a->in[29][(size_t)jr * D + hc + lpart * 8 + i]; }
#define SCAN_PREP(m_, o_, v_, bs_) do { float sm_ = 0.f; _Pragma("unroll") for (int i_ = 0; i_ < 8; ++i_) sm_ += o_[i_]; const float mean_ = sum8(sm_) * (1.0f / 64.0f); float sq_ = 0.f; \
        _Pragma("unroll") for (int i_ = 0; i_ < 8; ++i_) { o_[i_] -= mean_; sq_ += o_[i_] * o_[i_]; } const float rs_ = rsqrtf(sum8(sq_) * (1.0f / 64.0f) + 64e-5f); \
        float g_[8], out_[8]; unpack8(*(const u32x4*)(GGp + (size_t)(m_) * D), g_); \
        _Pragma("unroll") for (int i_ = 0; i_ < 8; ++i_) out_[i_] = (o_[i_] * rs_ * lnw8[i_] + lnb8[i_] + (bs_) * v_[i_]) * g_[i_]; \
        *(u32x4*)(PREPp + (size_t)(m_) * D) = pack8(out_); } while (0)
            u32x4 gk, gn, ga, gr, gv, gw;
#define SCAN_LOAD(q) do { const size_t ro_ = ((size_t)SCAN_M0(q) + trow) * D; gk = *(const u32x4*)(pk_ + ro_); gn = *(const u32x4*)(pn_ + ro_); ga = *(const u32x4*)(pa_ + ro_); \
        gr = *(const u32x4*)(pr_ + ro_); gv = *(const u32x4*)(pv_ + ro_); gw = *(const u32x4*)(pw_ + ro_); } while (0)
#define SCAN_ST8(off_, t_) do { *(LAS f32x4*)(d_ + (off_)) = (f32x4){t_[0], t_[1], t_[2], t_[3]}; *(LAS f32x4*)(d_ + (off_) + 4) = (f32x4){t_[4], t_[5], t_[6], t_[7]}; } while (0)
#define SCAN_WRITE(bufi) do { LAS float* d_ = L + (bufi) * BUF + lrow * 384 + lpart * 8; \
        { float ta_[8], tb_[8], tc_[8]; unpack8(gk, ta_); unpack8(gn, tb_); unpack8(ga, tc_); float kd_[8], bb_[8]; \
          _Pragma("unroll") for (int i_ = 0; i_ < 8; ++i_) { kd_[i_] = ta_[i_] * (1.0f + (tc_[i_] - 1.0f) * ka[i_]); bb_[i_] = tb_[i_] * tc_[i_]; } \
          SCAN_ST8(64, kd_); SCAN_ST8(128, bb_); SCAN_ST8(192, tb_); } \
        { float ta_[8], tb_[8], tc_[8]; unpack8(gr, ta_); unpack8(gv, tb_); unpack8(gw, tc_); \
          _Pragma("unroll") for (int i_ = 0; i_ < 8; ++i_) tc_[i_] = __builtin_amdgcn_exp2f(tc_[i_]); SCAN_ST8(0, tc_); SCAN_ST8(256, ta_); SCAN_ST8(320, tb_); } } while (0)
            SCAN_LOAD(0); SCAN_WRITE(0);
            float cv[32]; CvtJob cv_job; bool cv_have = false;
            cv_job.W = nullptr; cv_job.WT = nullptr; cv_job.K = cv_job.N = 32; cv_job.mode = cv_job.row_off = cv_job.item = 0;
#pragma unroll
            for (int i = 0; i < 32; ++i) cv[i] = 0.f;
            __syncthreads();
            for (int q = 0; q < 136; ++q) {
                const int bi = q & 1;
                if (q + 1 < 136) SCAN_LOAD(q + 1);
                if (cvt_late && chain == F.bid) {
                    LAS float* scr = (LAS float*)(F.lds + (F.wave == 4 ? 116736 : 132096 + (F.wave - 5) * 8448));
                    if (cv_have) { cvt_job_store(cv_job, scr, lane_, cv); cv_have = false; }
                    const int gwl = F.bid * 4 + (F.wave - 4), ngwl = F.G * 4, nper = (CVT_N1 + ngwl - 1) / ngwl;
                    const int k = (q * nper) / 136;
                    if (k < ((q + 1) * nper) / 136) { const int it = gwl + k * ngwl; if (it < CVT_N1) { cv_job = cvt_decode(a, it, 1); cvt_job_load(cv_job, lane_, cv); cv_have = true; } } }
                if (q > 0) {
                    const LAS float* ys = L + YB0 + (bi ^ 1) * YBUF + lrow * 64 + lpart * 8; float t8[8];
                    const f32x4 y0 = *(const LAS f32x4*)ys, y1 = *(const LAS f32x4*)(ys + 4);
#pragma unroll
                    for (int e = 0; e < 4; ++e) { t8[e] = y0[e]; t8[4 + e] = y1[e]; }
                    const size_t mrow = (size_t)SCAN_M0(q - 1) + trow;
                    if (q - 1 < 72) *(u32x4*)(YS + doff + mrow * D + hc + lpart * 8) = pack8(t8);
                    else { float yp[8], vv[8]; unpack8(*(const u32x4*)(YSo + mrow * D), yp);
                        const LAS float* pv = L + (bi ^ 1) * BUF + lrow * 384 + 320 + lpart * 8; const f32x4 v0 = *(const LAS f32x4*)pv, v1 = *(const LAS f32x4*)(pv + 4);
#pragma unroll
                        for (int e = 0; e < 4; ++e) { vv[e] = v0[e]; vv[4 + e] = v1[e]; }
#pragma unroll
                        for (int e = 0; e < 8; ++e) t8[e] += yp[e];
                        const float bs = sb_prev + BONo[mrow * 32];
                        SCAN_PREP(mrow, t8, vv, bs); } }
                if (q == 72) {
                    asm volatile("s_waitcnt vmcnt(0)" ::: "memory");
                    LAS unsigned* lc = (LAS unsigned*)(F.lds + 157696);
                    if (lane_ == 0) (void)__hip_atomic_fetch_add(lc, 1u, __ATOMIC_RELAXED, __HIP_MEMORY_SCOPE_WORKGROUP);
                    if (F.wave == 4) { unsigned sp_ = 0; while (__hip_atomic_load(lc, __ATOMIC_RELAXED, __HIP_MEMORY_SCOPE_WORKGROUP) < 4u && ++sp_ < (1u << 22)) __builtin_amdgcn_s_sleep(1);
                        if (lane_ == 0) { unsigned* pc = (unsigned*)(a->ws + WS_CTL) + CW_PAIR + (jr * 128 + (chain >> 1)) * 64;
                            __builtin_amdgcn_fence(__ATOMIC_RELEASE, "agent"); asm volatile("s_waitcnt vmcnt(0)" ::: "memory");
                            (void)xb_add(pc, 1u); XB_SPIN(xb_ld(pc) < 2u, bar);
                            __builtin_amdgcn_fence(__ATOMIC_ACQUIRE, "agent"); asm volatile("s_waitcnt vmcnt(0)" ::: "memory");
                            __hip_atomic_store(lc, 0u, __ATOMIC_RELAXED, __HIP_MEMORY_SCOPE_WORKGROUP); } } }
                if (dir == 0 && q >= 73 && q < 81) {
                    const size_t mrow = (size_t)(b * TB + 32 * (q - 73) + lrow); float o8[8], y1[8], vv[8];
                    unpack8(*(const u32x4*)(YS + mrow * D + hc + lpart * 8), o8); unpack8(*(const u32x4*)(YSo + mrow * D), y1); unpack8(*(const u32x4*)(VV + mrow * D + hc + lpart * 8), vv);
#pragma unroll
                    for (int e = 0; e < 8; ++e) o8[e] += y1[e];
                    const float bs = BON[mrow * 32] + BONo[mrow * 32];
                    SCAN_PREP(mrow, o8, vv, bs); }
                {
                    const LAS float* pr = L + bi * BUF + lrow * 384 + lpart * 8; const f32x4 r0 = *(const LAS f32x4*)(pr + 256), r1 = *(const LAS f32x4*)(pr + 260), k0 = *(const LAS f32x4*)(pr + 64), k1 = *(const LAS f32x4*)(pr + 68);
                    float sb = 0.f;
#pragma unroll
                    for (int e = 0; e < 4; ++e) sb += r0[e] * k0[e] * rk[e] + r1[e] * k1[e] * rk[4 + e];
                    sb = sum8(sb);
                    if (lpart == 0 && q < 72) BON[((size_t)SCAN_M0(q) + trow) * 32] = sb;
                    sb_prev = sb; }
                if (q + 1 < 136) SCAN_WRITE(bi ^ 1);
                __syncthreads();
            }
            if (cv_have) { LAS float* scr = (LAS float*)(F.lds + (F.wave == 4 ? 116736 : 132096 + (F.wave - 5) * 8448)); cvt_job_store(cv_job, scr, lane_, cv); }
            {   const LAS float* ys = L + YB0 + 1 * YBUF + lrow * 64 + lpart * 8; float t8[8];
                const f32x4 y0 = *(const LAS f32x4*)ys, y1 = *(const LAS f32x4*)(ys + 4);
#pragma unroll
                for (int e = 0; e < 4; ++e) { t8[e] = y0[e]; t8[4 + e] = y1[e]; }
                const size_t mrow = (size_t)SCAN_M0(135) + trow; float yp[8], vv[8]; unpack8(*(const u32x4*)(YSo + mrow * D), yp);
                const LAS float* pv = L + 1 * BUF + lrow * 384 + 320 + lpart * 8; const f32x4 v0 = *(const LAS f32x4*)pv, v1 = *(const LAS f32x4*)(pv + 4);
#pragma unroll
                for (int e = 0; e < 4; ++e) { vv[e] = v0[e]; vv[4 + e] = v1[e]; }
#pragma unroll
                for (int e = 0; e < 8; ++e) t8[e] += yp[e];
                const float bs = sb_prev + BONo[mrow * 32];
                SCAN_PREP(mrow, t8, vv, bs); }
#undef SCAN_PREP
#undef SCAN_LOAD
#undef SCAN_WRITE
#undef SCAN_ST8
        } else {
            f32x2 S2[8];
#pragma unroll
            for (int i = 0; i < 8; ++i) S2[i] = (f32x2){0.f, 0.f};
            __syncthreads();
            for (int q = 0; q < 136; ++q) {
                const int bi = q & 1;
                const LAS float* base = L + bi * BUF; constexpr int stp = 384;
                const bool lead = (lane & 7) == 0; const int ystp = lead ? 64 : 0;
                LAS float* yaddr = lead ? L + YB0 + bi * YBUF + vrow : L + YB0 + 2 * YBUF + ((F.wave & 3) * 64 + lane) * 2;
#define SCAN_LD8(dst_, p_, off_) do { const f32x4 lo_ = *(const LAS f32x4*)((p_) + (off_) + li8), hi_ = *(const LAS f32x4*)((p_) + (off_) + li8 + 4); \
        dst_[0] = (f32x2){lo_[0], lo_[1]}; dst_[1] = (f32x2){lo_[2], lo_[3]}; dst_[2] = (f32x2){hi_[0], hi_[1]}; dst_[3] = (f32x2){hi_[2], hi_[3]}; } while (0)
#define PKM_LO(d, a, b) "v_pk_mul_f32 " d ", " a ", " b " op_sel_hi:[1,0]\n\t"
#define PKM_HI(d, a, b) "v_pk_mul_f32 " d ", " a ", " b " op_sel:[0,1] op_sel_hi:[1,1]\n\t"
#define PKF_LO(d, a, b, c) "v_pk_fma_f32 " d ", " a ", " b ", " c " op_sel_hi:[1,0,1]\n\t"
#define PKF_HI(d, a, b, c) "v_pk_fma_f32 " d ", " a ", " b ", " c " op_sel:[0,1,0] op_sel_hi:[1,1,1]\n\t"
#define PKN_LO(d, a, b, c) "v_pk_fma_f32 " d ", " a ", " b ", " c " op_sel_hi:[1,0,1] neg_lo:[1,0,0] neg_hi:[1,0,0]\n\t"
#define PKN_HI(d, a, b, c) "v_pk_fma_f32 " d ", " a ", " b ", " c " op_sel:[0,1,0] op_sel_hi:[1,1,1] neg_lo:[1,0,0] neg_hi:[1,0,0]\n\t"
#define DPPA(r, ctl) "v_add_f32_dpp " r ", " r ", " r " " ctl " row_mask:0xf bank_mask:0xf\n\t"
#define DPP_1 "quad_perm:[1,0,3,2]"
#define DPP_2 "quad_perm:[2,3,0,1]"
#define DPP_3 "row_half_mirror"
#define SA_SUM(pk_, t_, v_, d_) asm volatile( \
        PKM_LO("%2", "%10", "%11") PKM_HI("%3", "%10", "%11") DPPA("%0", DPP_1) DPPA("%1", DPP_1) PKM_LO("%4", "%10", "%12") DPPA("%0", DPP_2) DPPA("%1", DPP_2) PKM_HI("%5", "%10", "%12") \
        DPPA("%0", DPP_3) DPPA("%1", DPP_3) PKM_LO("%6", "%10", "%13") PKM_HI("%7", "%10", "%13") PKM_LO("%8", "%10", "%14") PKM_HI("%9", "%10", "%14") \
        : "+v"(pk_.x), "+v"(pk_.y), "=&v"(t_[0]), "=&v"(t_[1]), "=&v"(t_[2]), "=&v"(t_[3]), "=&v"(t_[4]), "=&v"(t_[5]), "=&v"(t_[6]), "=&v"(t_[7]) \
        : "v"(v_), "v"(d_[0]), "v"(d_[1]), "v"(d_[2]), "v"(d_[3]))
#define UPD(S_, t_, pk_, b_, w_) asm volatile( \
        PKN_LO("%8", "%16", "%17", "%8") PKN_HI("%9", "%16", "%17", "%9") PKN_LO("%10", "%16", "%18", "%10") PKN_HI("%11", "%16", "%18", "%11") \
        PKN_LO("%12", "%16", "%19", "%12") PKN_HI("%13", "%16", "%19", "%13") PKN_LO("%14", "%16", "%20", "%14") PKN_HI("%15", "%16", "%20", "%15") \
        PKF_LO("%0", "%0", "%21", "%8") PKF_HI("%1", "%1", "%21", "%9") PKF_LO("%2", "%2", "%22", "%10") PKF_HI("%3", "%3", "%22", "%11") \
        PKF_LO("%4", "%4", "%23", "%12") PKF_HI("%5", "%5", "%23", "%13") PKF_LO("%6", "%6", "%24", "%14") PKF_HI("%7", "%7", "%24", "%15") \
        : "+v"(S_[0]), "+v"(S_[1]), "+v"(S_[2]), "+v"(S_[3]), "+v"(S_[4]), "+v"(S_[5]), "+v"(S_[6]), "+v"(S_[7]), \
          "+v"(t_[0]), "+v"(t_[1]), "+v"(t_[2]), "+v"(t_[3]), "+v"(t_[4]), "+v"(t_[5]), "+v"(t_[6]), "+v"(t_[7]) \
        : "v"(pk_), "v"(b_[0]), "v"(b_[1]), "v"(b_[2]), "v"(b_[3]), "v"(w_[0]), "v"(w_[1]), "v"(w_[2]), "v"(w_[3]))
#define DOT8(o_, o1_, S_, x_) asm volatile( \
        PKM_LO("%0", "%2", "%10") PKM_HI("%1", "%3", "%10") PKF_LO("%0", "%4", "%11", "%0") PKF_HI("%1", "%5", "%11", "%1") PKF_LO("%0", "%6", "%12", "%0") PKF_HI("%1", "%7", "%12", "%1") \
        PKF_LO("%0", "%8", "%13", "%0") PKF_HI("%1", "%9", "%13", "%1") "v_pk_add_f32 %0, %0, %1\n\t" \
        : "=&v"(o_), "=&v"(o1_) : "v"(S_[0]), "v"(S_[1]), "v"(S_[2]), "v"(S_[3]), "v"(S_[4]), "v"(S_[5]), "v"(S_[6]), "v"(S_[7]), "v"(x_[0]), "v"(x_[1]), "v"(x_[2]), "v"(x_[3]))
#define YSUM(yk_, o_, o1_, S_, x_) asm volatile( \
        PKM_LO("%2", "%4", "%12") PKM_HI("%3", "%5", "%12") DPPA("%0", DPP_1) DPPA("%1", DPP_1) PKF_LO("%2", "%6", "%13", "%2") DPPA("%0", DPP_2) DPPA("%1", DPP_2) PKF_HI("%3", "%7", "%13", "%3") \
        DPPA("%0", DPP_3) DPPA("%1", DPP_3) PKF_LO("%2", "%8", "%14", "%2") PKF_HI("%3", "%9", "%14", "%3") PKF_LO("%2", "%10", "%15", "%2") PKF_HI("%3", "%11", "%15", "%3") "v_pk_add_f32 %2, %2, %3\n\t" \
        : "+v"(yk_.x), "+v"(yk_.y), "=&v"(o_), "=&v"(o1_) : "v"(S_[0]), "v"(S_[1]), "v"(S_[2]), "v"(S_[3]), "v"(S_[4]), "v"(S_[5]), "v"(S_[6]), "v"(S_[7]), "v"(x_[0]), "v"(x_[1]), "v"(x_[2]), "v"(x_[3]))
                f32x2 nw[4], nd[4], nb[4], nn[4], nr[4]; f32x2 nv2;
                SCAN_LD8(nw, base, 0); SCAN_LD8(nd, base, 64); SCAN_LD8(nb, base, 128); SCAN_LD8(nn, base, 192); SCAN_LD8(nr, base, 256); nv2 = *(const LAS f32x2*)(base + 320 + vrow);
                f32x2 pk, pk1; DOT8(pk, pk1, S2, nn);
#pragma unroll 8
                for (int s = 0; s < 32; ++s) {
                    f32x2 w8[4], d8[4], b8[4], r8[4]; const f32x2 v2 = nv2;
#pragma unroll
                    for (int c = 0; c < 4; ++c) { w8[c] = nw[c]; d8[c] = nd[c]; b8[c] = nb[c]; r8[c] = nr[c]; }
                    { const LAS float* p = base + (s + 1) * stp;
                      SCAN_LD8(nw, p, 0); SCAN_LD8(nd, p, 64); SCAN_LD8(nb, p, 128); SCAN_LD8(nn, p, 192); SCAN_LD8(nr, p, 256); nv2 = *(const LAS f32x2*)(p + 320 + vrow); }
                    f32x2 t8[8];
                    SA_SUM(pk, t8, v2, d8);
                    UPD(S2, t8, pk, b8, w8);
                    f32x2 yk, yk1; DOT8(yk, yk1, S2, r8);
                    f32x2 npk, npk1; YSUM(yk, npk, npk1, S2, nn);
                    *(LAS f32x2*)(yaddr + s * ystp) = yk;
                    pk = npk;
                }
#undef PKM_LO
#undef PKM_HI
#undef PKF_LO
#undef PKF_HI
#undef PKN_LO
#undef PKN_HI
#undef DPPA
#undef SA_SUM
#undef UPD
#undef DOT8
#undef YSUM
#undef SCAN_LD8
                __syncthreads();
            }
        }
        __syncthreads();
#undef SCAN_M0
    }
}

__device__ __forceinline__ void outprep_phase(const Frame F, KArgs* a, int jr) {
    const int lane_ = lane_opaque(), tid_ = F.wave * 64 + lane_; (void)tid_; (void)lane_;
    const bf16_t* YS = (const bf16_t*)(a->ws + WS_YS); const float* BON = (const float*)(a->ws + WS_BON);
    const bf16_t* VV = (const bf16_t*)(a->ws + WS_VV); const bf16_t* GG = (const bf16_t*)(a->ws + WS_GG);
    bf16_t* PREP = (bf16_t*)(a->ws + WS_PREP);
    const float* lw = a->in[28] + (size_t)jr * D; const float* lb = a->in[29] + (size_t)jr * D;
    for (int m = F.bid * NWAVES + F.wave; m < M; m += F.G * NWAVES) {
#pragma unroll
        for (int q = 0; q < 4; ++q) { const int e0 = 512 * q + 8 * lane_; const size_t ro = (size_t)m * D + e0;
            float y0[8], y1[8], o[8];
            unpack8(*(const u32x4*)(YS + ro), y0); unpack8(*(const u32x4*)(YS + (size_t)M * D + ro), y1);
            float sm = 0.f;
#pragma unroll
            for (int i = 0; i < 8; ++i) { o[i] = y0[i] + y1[i]; sm += o[i]; }
            const float mean = sum8(sm) * (1.0f / 64.0f);
            float sq = 0.f;
#pragma unroll
            for (int i = 0; i < 8; ++i) { o[i] -= mean; sq += o[i] * o[i]; }
            const float rs = rsqrtf(sum8(sq) * (1.0f / 64.0f) + 64e-5f);
            float v[8], g[8];
            unpack8(*(const u32x4*)(VV + ro), v); unpack8(*(const u32x4*)(GG + ro), g);
            const int hd = e0 >> 6;
            const float bs = BON[(size_t)m * 32 + hd] + BON[(size_t)M * 32 + (size_t)m * 32 + hd];
            float out[8];
#pragma unroll
            for (int i = 0; i < 8; ++i) out[i] = (o[i] * rs * lw[e0 + i] + lb[e0 + i] + bs * v[i]) * g[i];
            *(u32x4*)(PREP + ro) = pack8(out); }
    }
}

__device__ __forceinline__ float attn_score_bound(KArgs* a, int ja) {
    const int ln = lane_opaque(); float mq = fmaxf(fabsf(a->in[12][ja * 128 + ln]), fabsf(a->in[12][ja * 128 + 64 + ln])), mk = fmaxf(fabsf(a->in[13][ja * 128 + ln]), fabsf(a->in[13][ja * 128 + 64 + ln]));
#pragma unroll
    for (int o = 1; o < 64; o <<= 1) { mq = fmaxf(mq, __shfl_xor(mq, o)); mk = fmaxf(mk, __shfl_xor(mk, o)); }
    return __builtin_bit_cast(float, __builtin_amdgcn_readfirstlane(__builtin_bit_cast(int, 128.0f * 1.02f * mq * mk)));
}
__device__ __forceinline__ void attention_phase(const Frame F, KArgs* a, int ja) {
    const attn::bf16* Q = (const attn::bf16*)(a->ws + WS_Q); const attn::bf16* K = (const attn::bf16*)(a->ws + WS_K); const attn::bf16* V = (const attn::bf16*)(a->ws + WS_V);
    attn::bf16* O = (attn::bf16*)(a->ws + WS_O);
    const float mfix = attn_score_bound(a, ja);
    const bool fixm = mfix * attn::SCALE <= 30.0f;
    for (int u = F.bid; u < 1024 + 64; u += F.G) {
        size_t qoff, koff; int seq;
        if (u < 1024) { const int c = u & 255, i = u >> 8, grp = (c & 7) >> 1, member = (c & 1) * 32 + (c >> 3), bk = i * 4 + grp, b = bk >> 2, kvh = bk & 3, hq = kvh * 4 + (member >> 4), qb = member & 15;
            qoff = (size_t)(b * TB + CTXL + qb * 256) * 2048 + hq * 128; koff = (size_t)b * TB * 512 + kvh * 128; seq = TB; }
        else { const int cu = u - 1024, b = cu >> 4, hq = cu & 15, kvh = hq >> 2;
            qoff = (size_t)(b * TB) * 2048 + hq * 128; koff = (size_t)b * TB * 512 + kvh * 128; seq = CTXL; }
        if (fixm) attn::attn_dense_body<attn::bf16, true>(Q + qoff, K + koff, V + koff, O + qoff, seq, (char*)F.ldsg, F.wave, mfix);
        else attn::attn_dense_body<attn::bf16, false>(Q + qoff, K + koff, V + koff, O + qoff, seq, (char*)F.ldsg, F.wave);
        __syncthreads();
    }
}

#ifndef EN_P0
#define EN_P0 1
#endif
#ifndef EN_THIN
#define EN_THIN 1
#endif
#ifndef EN_QKN
#define EN_QKN 1
#endif
#ifndef EN_ATT
#define EN_ATT 1
#endif
#ifndef EN_MIX
#define EN_MIX 1
#endif
#ifndef EN_SCAN
#define EN_SCAN 1
#endif
#ifndef EN_OPREP
#define EN_OPREP 1
#endif
#ifndef EN_FFN
#define EN_FFN 1
#endif
#ifndef EN_GQKV
#define EN_GQKV 1
#endif
#ifndef EN_GWO
#define EN_GWO 1
#endif
#ifndef EN_RW1
#define EN_RW1 1
#endif
#ifndef EN_RW2
#define EN_RW2 1
#endif
__device__ __forceinline__ KArgs* opaque_k(KArgs* p) { asm volatile("" : "+s"(p)); return p; }
#ifndef DBG_STOP
#define DBG_STOP -1
#endif
__device__ __forceinline__ Frame fresh(const Frame& F) { Frame R = F; asm volatile("" : "+s"(R.bid), "+s"(R.G), "+s"(R.wave)); return R; }
#ifndef GEMM_ALIGN
#define GEMM_ALIGN true
#define GEMM_SP2 true
#endif
#ifndef RW2_ALIGN
#define RW2_ALIGN true
#define RW2_SP2 true
#endif
#ifndef RW1_ALIGN
#define RW1_ALIGN true
#define RW1_SP2 true
#endif
#ifndef REP_THIN
#define REP_THIN 1
#endif
#ifndef REP_OG
#define REP_OG 1
#endif
#ifndef REP_EW
#define REP_EW 1
#endif
#ifndef REP_FFN1
#define REP_FFN1 1
#endif
#ifndef REP_FFN2
#define REP_FFN2 1
#endif
#ifndef REP_P0
#define REP_P0 1
#endif
#ifndef REP_SCAN
#define REP_SCAN 1
#endif
#ifndef REP_ATT
#define REP_ATT 1
#endif
#ifndef REP_RW1
#define REP_RW1 1
#endif
constexpr int NPHASE = 50;
constexpr int STOP_PHASE = (DBG_STOP >= 0) ? DBG_STOP : NPHASE - 1;
__global__ void __launch_bounds__(NTHR, 2) fwd_kernel(Args args) {
    extern __shared__ __attribute__((aligned(16))) unsigned char lds[];
    Frame F;
    F.lds = (LAS unsigned char*)lds; F.ldsg = lds;
    F.wave = __builtin_amdgcn_readfirstlane((int)threadIdx.x >> 6);
    F.G = gridDim.x; F.bid = blockIdx.x;
    for (int u = threadIdx.x; u < (LDS_BYTES - LDSCTL_OFF) / 4; u += NTHR) ((LAS unsigned*)(F.lds + LDSCTL_OFF))[u] = 0u;
    __syncthreads();
    KArgs* const kap = (KArgs*)__builtin_amdgcn_kernarg_segment_ptr();
    XcdBarrier bar = xcd_barrier_post((unsigned*)(kap->ws + WS_CTL) + CW_BAR + kap->li * XCD_BAR_WORDS, (volatile LAS unsigned*)(F.lds + MISC_OFF) + 8);
#define KA (opaque_k(kap))
#define ws (KA->ws)
#define IN(k) ((k) <= STOP_PHASE)
#define SEAM(k) do { if (IN(k) && IN((k) + 1)) { XcdBarrier bb_ = bar; asm volatile("" : "+s"(bb_.x), "+s"(bb_.bar)); xcd_barrier(bb_, fresh(F).wave == 0 && lane_opaque() == 0); } } while (0)
#define Yb ((bf16_t*)(ws + WS_Y))
#define ACTb ((bf16_t*)(ws + WS_ACT))
#define OUTb ((bf16_t*)(ws + WS_OUT))
#define BAR_NOW() do { XcdBarrier bb_ = bar; asm volatile("" : "+s"(bb_.x), "+s"(bb_.bar)); xcd_barrier(bb_, fresh(F).wave == 0 && lane_opaque() == 0); } while (0)
#define FFN_HALF(pk, lh, FINAL, tl, ts, tw, tnl, tns) do { \
    for (int rep_ = 0; rep_ < REP_FFN1; ++rep_) { if (rep_) __syncthreads(); \
    if (EN_FFN && IN(pk)) { const Frame Ff_ = fresh(F); const bf16_t* w1_ = (const bf16_t*)(ws + WS_WB) + (size_t)(lh) * (E_F1 + E_F2); \
        pg8::Gemm g_{Yb, w1_, D}; EpiSwiGLU E_{ACTb}; \
        if (FINAL) { LatentOrder S_; S_.init_lat(2 * FF, Ff_.G, Ff_.bid); pg8::gemm_phase<EpiSwiGLU, LatentOrder, pg8::Gemm, GEMM_ALIGN, GEMM_SP2>(Ff_.lds, g_, S_, E_, Ff_.wave); } \
        else { Ffn1Order S_{Ff_.G, Ff_.bid, (unsigned*)(ws + WS_CTL) + CW_FC + (lh) * 64}; pg8::gemm_phase<EpiSwiGLU, Ffn1Order, pg8::Gemm, true, GEMM_SP2>(Ff_.lds, g_, S_, E_, Ff_.wave); \
            if (rep_ == REP_FFN1 - 1 && Ff_.G == 256 && Ff_.bid >= 176 && Ff_.bid < 176 + NCTXWG) {     \
                const Frame Fc_ = fresh(F); XcdBarrier bg_ = bar; asm volatile("" : "+s"(bg_.bar)); \
                asm volatile("s_waitcnt vmcnt(0)" ::: "memory"); __syncthreads(); \
                if (Fc_.wave == 0 && lane_opaque() == 0) { unsigned* pc_ = (unsigned*)(ws + WS_CTL) + CW_FC + (lh) * 64; XB_SPIN(xb_ld(pc_) < 176u, bg_.bar); __builtin_amdgcn_fence(__ATOMIC_ACQUIRE, "agent"); asm volatile("s_waitcnt vmcnt(0)" ::: "memory"); } \
                __syncthreads(); \
                const bf16_t* w2c_ = (const bf16_t*)(ws + WS_WB) + (size_t)(lh) * (E_F1 + E_F2) + E_F1; \
                GemmCtxSplit gc_{ACTb, w2c_, FF}; CtxOrder2 Sc_{Fc_.bid - 176}; EpiCtxPart Ec_{(float*)(ws + WS_PART)}; \
                pg8::gemm_phase<EpiCtxPart, CtxOrder2, GemmCtxSplit, GEMM_ALIGN, GEMM_SP2>(Fc_.lds, gc_, Sc_, Ec_, Fc_.wave); } } } } \
    SEAM(pk); \
    for (int rep_ = 0; rep_ < REP_FFN2; ++rep_) { if (rep_) __syncthreads(); \
    if (EN_FFN && IN((pk) + 1)) { const Frame Ff_ = fresh(F); const bf16_t* w2_ = (const bf16_t*)(ws + WS_WB) + (size_t)(lh) * (E_F1 + E_F2) + E_F1; \
        pg8::Gemm g_{ACTb, w2_, FF}; LatentOrder S_; S_.init_lat(D, Ff_.G, Ff_.bid); EpiPlain E_{OUTb, D}; \
        pg8::gemm_phase<EpiPlain, LatentOrder, pg8::Gemm, GEMM_ALIGN, GEMM_SP2>(Ff_.lds, g_, S_, E_, Ff_.wave); } } \
    SEAM((pk) + 1); \
    if (IN((pk) + 2)) { const Frame Ff_ = fresh(F); \
        if (FINAL) thin_phase<2, 1, 0>(Ff_, KA, tl, ts, tw, tnl, tns); \
        else { for (int rt_ = 1; rt_ < REP_THIN; ++rt_) thin_phase<1, 1, 0>(Ff_, KA, tl, ts, 0.f, tnl, tns); thin_phase<1, 1, 0>(Ff_, KA, tl, ts, tw, tnl, tns); thin_phase<1, 2>(fresh(F), KA, tl, ts, tw, tnl, tns); } \
        } \
    SEAM((pk) + 2); } while (0)

    for (int rep_ = 0; rep_ < REP_P0; ++rep_) { if (rep_) __syncthreads(); if (EN_P0 && IN(0)) p0a_phase(fresh(F), KA); }
    SEAM(0);
    if (EN_THIN && IN(1)) thin_phase<0, 0>(fresh(F), KA, 0, 0, 0.f, 0, 0);
    SEAM(1);
    for (int lp = 0; lp < 2; ++lp) {
        const int pb = 2 + 24 * lp, la = 2 * lp, lr = 2 * lp + 1;
        FFN_HALF(pb + 0, la * 2 + 0, 0, la, 0, 0.5f, la, 1);
        for (int rep_ = 0; rep_ < REP_OG; ++rep_) { if (rep_) __syncthreads();
        if (EN_GQKV && IN(pb + 3)) { const Frame Ff = fresh(F); const bf16_t* wq = (const bf16_t*)(ws + WS_WA) + (size_t)lp * (E_QKV + E_SQ);
            pg8::Gemm g{Yb, wq, D}; pg8::StaticOrder S; S.init(M, 3072, Ff.G, Ff.bid); EpiQKVN E{ws, KA->in[12] + lp * 128, KA->in[13] + lp * 128, (LAS float*)(Ff.lds + 132096), attn_score_bound(KA, lp) * attn::SCALE <= 30.0f ? attn::SCALE * 1.4426950408889634f : 1.0f};
            pg8::gemm_phase<EpiQKVN, pg8::StaticOrder, pg8::Gemm, true, GEMM_SP2>(Ff.lds, g, S, E, Ff.wave); } }
        SEAM(pb + 3);
        for (int rep_ = 0; rep_ < REP_ATT; ++rep_) { if (rep_) __syncthreads(); if (EN_ATT && IN(pb + 5)) attention_phase(fresh(F), KA, lp); }
        SEAM(pb + 5);
        for (int rep_ = 0; rep_ < REP_OG; ++rep_) { if (rep_) __syncthreads();
        if (EN_GWO && IN(pb + 6)) { const Frame Ff = fresh(F); const bf16_t* wo = (const bf16_t*)(ws + WS_WA) + (size_t)lp * (E_QKV + E_SQ) + E_QKV;
            pg8::Gemm g{(const bf16_t*)(ws + WS_O), wo, D}; LatentOrder S; S.init_lat(D, Ff.G, Ff.bid); EpiPlain E{OUTb, D};
            pg8::gemm_phase<EpiPlain, LatentOrder, pg8::Gemm, GEMM_ALIGN, GEMM_SP2>(Ff.lds, g, S, E, Ff.wave); } }
        SEAM(pb + 6);
        if (EN_THIN && IN(pb + 7)) { const Frame Ff = fresh(F);
            if (Ff.bid < 32) { const bf16_t* wo = (const bf16_t*)(ws + WS_WA) + (size_t)lp * (E_QKV + E_SQ) + E_QKV;
                pg8::Gemm g{(const bf16_t*)(ws + WS_O), wo, D}; CtxOrder8 S{Ff.bid}; EpiPlain E{OUTb, D};
                pg8::gemm_phase<EpiPlain, CtxOrder8, pg8::Gemm, GEMM_ALIGN, GEMM_SP2>(Ff.lds, g, S, E, Ff.wave);
                { XcdBarrier bg = bar; asm volatile("" : "+s"(bg.bar)); ctx_mixer_thin(fresh(F), KA, bg.bar, 8 + lp, la, 1, 1.0f, la, 2); } }
            else thin_phase<1, 1, 32, 0>(Ff, KA, la, 1, 1.0f, la, 2); }
        SEAM(pb + 7);
        FFN_HALF(pb + 8, la * 2 + 1, 0, la, 2, 0.5f, lr, 0);
        FFN_HALF(pb + 11, lr * 2 + 0, 0, lr, 0, 0.5f, lr, 1);
        for (int rep_ = 0; rep_ < REP_EW; ++rep_) { if (EN_MIX && IN(pb + 14)) mixes_phase(fresh(F), KA, lp); }
        SEAM(pb + 14);
#ifdef DBG_DOUBLE_BAR
        SEAM(pb + 14);
#endif
#define rw1 ((const bf16_t*)(ws + WS_WR) + (size_t)lp * (E_RW1 + E_RW2 + E_SQ))
        for (int rep_ = 0; rep_ < REP_OG; ++rep_) { if (rep_) __syncthreads();
        if (EN_RW1 && IN(pb + 15)) { const Frame Ff = fresh(F); GemmRw1 g{(const bf16_t*)(ws + WS_MIX6), rw1, D}; pg8::StaticOrder S; S.init(M, 6912, Ff.G, Ff.bid);
            EpiRw1 E{ws, KA->in[25] + (size_t)lp * D};
            pg8::gemm_phase<EpiRw1, pg8::StaticOrder, GemmRw1, RW1_ALIGN, RW1_SP2>(Ff.lds, g, S, E, Ff.wave); } }
        SEAM(pb + 15);
        for (int rep_ = 0; rep_ < REP_OG; ++rep_) { if (rep_) __syncthreads();
        if (EN_RW2 && IN(pb + 16)) {
            { const Frame Ff = fresh(F); int k2_ = 256; asm volatile("" : "+s"(k2_));
              GemmRw2 g{ws, rw1 + E_RW1, 256, k2_}; pg8::StaticOrder S; S.init(M, 2048, Ff.G, Ff.bid);
              EpiRw2 E{ws, KA->in[19] + (size_t)lp * 2 * D, KA->in[22] + (size_t)lp * 2 * D, WS_AA};
              pg8::gemm_phase<EpiRw2, pg8::StaticOrder, GemmRw2, RW2_ALIGN, RW2_SP2>(Ff.lds, g, S, E, Ff.wave); }
            __syncthreads();
            { const Frame Ff = fresh(F); int k3_ = 128; asm volatile("" : "+s"(k3_));
              GemmRw2 g{ws, rw1 + E_RW1, 256, k3_}; Rw2WAOrder S; S.init(M, 8192, Ff.G, Ff.G - 1 - Ff.bid);
              EpiRw2 E{ws, KA->in[19] + (size_t)lp * 2 * D, KA->in[22] + (size_t)lp * 2 * D, WS_AA};
              pg8::gemm_phase<EpiRw2, Rw2WAOrder, GemmRw2, RW2_ALIGN, RW2_SP2>(Ff.lds, g, S, E, Ff.wave); } } }
        #ifdef DBG_RW2_TWICE
        __syncthreads();
        if (EN_RW2 && IN(pb + 16)) { const Frame Ff = fresh(F); int k2_ = 256; asm volatile("" : "+s"(k2_));     GemmRw2 g{ws, rw1 + E_RW1, k2_}; pg8::StaticOrder S; S.init(M, 10240, Ff.G, Ff.bid);
            EpiRw2 E{ws,
                     KA->in[19] + (size_t)lp * 2 * D, KA->in[22] + (size_t)lp * 2 * D, WS_END};
            pg8::gemm_phase<EpiRw2, pg8::StaticOrder, GemmRw2, RW2_ALIGN, RW2_SP2>(Ff.lds, g, S, E, Ff.wave); }
#endif
        SEAM(pb + 16);
        for (int rep_ = 0; rep_ < REP_SCAN; ++rep_) { if (rep_) __syncthreads(); if (EN_SCAN && IN(pb + 17)) { XcdBarrier bg = bar; asm volatile("" : "+s"(bg.bar)); scan_phase(fresh(F), KA, lp, lp == 0 && rep_ == 0, bg.bar); } }
        SEAM(pb + 17);
        for (int rep_ = 0; rep_ < REP_OG; ++rep_) { if (rep_) __syncthreads();
        if (EN_GWO && IN(pb + 19)) { const Frame Ff = fresh(F); pg8::Gemm g{(const bf16_t*)(ws + WS_PREP), rw1 + E_RW1 + E_RW2, D}; LatentOrder S; S.init_lat(D, Ff.G, Ff.bid); EpiPlain E{OUTb, D};
            pg8::gemm_phase<EpiPlain, LatentOrder, pg8::Gemm, GEMM_ALIGN, GEMM_SP2>(Ff.lds, g, S, E, Ff.wave); } }
        SEAM(pb + 19);
        if (EN_THIN && IN(pb + 20)) { const Frame Ff = fresh(F);
            if (Ff.bid < 32) { pg8::Gemm g{(const bf16_t*)(ws + WS_PREP), rw1 + E_RW1 + E_RW2, D}; CtxOrder8 S{Ff.bid}; EpiPlain E{OUTb, D};
                pg8::gemm_phase<EpiPlain, CtxOrder8, pg8::Gemm, GEMM_ALIGN, GEMM_SP2>(Ff.lds, g, S, E, Ff.wave);
                { XcdBarrier bg = bar; asm volatile("" : "+s"(bg.bar)); ctx_mixer_thin(fresh(F), KA, bg.bar, 10 + lp, lr, 1, 1.0f, lr, 2); } }
            else thin_phase<1, 1, 32, 0>(Ff, KA, lr, 1, 1.0f, lr, 2); }
        SEAM(pb + 20);
        if (lp == 1) FFN_HALF(pb + 21, lr * 2 + 1, 1, lr, 2, 0.5f, 0, 0); else FFN_HALF(pb + 21, lr * 2 + 1, 0, lr, 2, 0.5f, lr + 1, 0);
    }
    if (DBG_STOP >= 0) { xcd_barrier(bar, fresh(F).wave == 0 && lane_opaque() == 0); copyout_phase(fresh(F), KA); }
#undef IN
#undef SEAM
#undef FFN_HALF
#undef BAR_NOW
#undef rw1
#undef ws
#undef KA
#undef Yb
#undef ACTb
#undef OUTb
}

extern "C" void kernel_launch(void* const* d_in, const int* in_sizes, int n_in, void* d_out, int out_size, void* d_ws, size_t ws_size, hipStream_t stream) {
    static int grid = 0;
    if (grid == 0) {
        if (n_in != 30 || in_sizes[0] != NB * SEQ * D || out_size != NB * SEQ * D || ws_size < WS_END) {
            fprintf(stderr, "kernel_launch: shape mismatch: n_in %d in0 %d out %d ws %zu (need >= %zu)\n", n_in, n_in > 0 ? in_sizes[0] : -1, out_size, ws_size, (size_t)WS_END); grid = -1; return; }
        int dev = 0, cus = 0, per_cu = 0;
        if (hipGetDevice(&dev) != hipSuccess || hipDeviceGetAttribute(&cus, hipDeviceAttributeMultiprocessorCount, dev) != hipSuccess) { fprintf(stderr, "kernel_launch: device query failed\n"); grid = -1; return; }
        if (hipFuncSetAttribute((const void*)fwd_kernel, hipFuncAttributeMaxDynamicSharedMemorySize, LDS_BYTES) != hipSuccess) { fprintf(stderr, "kernel_launch: hipFuncSetAttribute failed\n"); grid = -1; return; }
        if (hipOccupancyMaxActiveBlocksPerMultiprocessor(&per_cu, (const void*)fwd_kernel, NTHR, LDS_BYTES) != hipSuccess || per_cu < 1) { fprintf(stderr, "kernel_launch: occupancy query says %d blocks per CU\n", per_cu); }
        (void)hipGetLastError();
        grid = cus;
        if (grid > 256) grid = 256;
    }
    if (grid < 0) return;
    if (hipMemsetAsync((char*)d_ws + WS_CTL, 0, CTL_ZERO_BYTES, stream) != hipSuccess) { fprintf(stderr, "kernel_launch: memset failed\n"); return; }
    Args a{};
    for (int i = 0; i < 30; ++i) a.in[i] = (const float*)d_in[i];
    a.out = (float*)d_out; a.ws = (unsigned char*)d_ws;
    a.ph_lo = 0; a.ph_hi = NPHASE; a.li = 0; a.dbg = 0;
    hipLaunchKernelGGL(fwd_kernel, dim3(grid), dim3(NTHR), LDS_BYTES, stream, a);
    const hipError_t le = hipPeekAtLastError();
    if (le != hipSuccess) fprintf(stderr, "kernel_launch: launch failed: %s\n", hipGetErrorName(le));
}
```

```cpp
#include <hip/hip_runtime.h>
#include <cstdio>
#include <cstdint>
#include <cmath>
__device__ __forceinline__ int lane_opaque() { int l; asm volatile("v_mbcnt_lo_u32_b32 %0, -1, 0\n\tv_mbcnt_hi_u32_b32 %0, -1, %0" : "=v"(l)); return l; }
namespace pg8 {
#define PG8_LAS __attribute__((address_space(3)))
typedef unsigned short bf16_t;
typedef short bf16x8 __attribute__((ext_vector_type(8)));
typedef float f32x4 __attribute__((ext_vector_type(4)));
typedef unsigned u32x4 __attribute__((ext_vector_type(4)));
constexpr int BM = 256, BK = 64, HALF = 128, HTB = HALF * BK * 2  , STAGE_BYTES = 8 * HTB, NXCD = 8, WGM = 8;

__host__ __device__ __forceinline__ int lds_byte(int r, int c) { const int st = (r >> 4) * 2 + (c >> 5), rr = r & 15, cc = c & 31, ob = rr * 64 + cc * 2; return st * 1024 + (ob ^ (((ob >> 9) & 1) << 5)); }
__host__ __device__ __forceinline__ void stage_rc(int b, int& R, int& C) { const int st = b / 1024, sb = b % 1024, swz = sb ^ (((sb >> 9) & 1) << 5); R = (st >> 1) * 16 + swz / 64; C = (st & 1) * 32 + (swz % 64) / 2; }
__host__ __device__ __forceinline__ int perm32(int rho) { const int n = rho >> 4, i = rho & 15; return 8 * (i >> 2) + 4 * n + (i & 3); }

struct Unit { int pm, pn; };
struct Gemm { const bf16_t* A; const bf16_t* Bt; int K;
    __device__ __forceinline__ const char* a_tile(const Unit& u) const { return (const char*)A + (size_t)u.pm * (size_t)(BM * 2) * K; }
    __device__ __forceinline__ const char* b_tile(const Unit& u) const { return (const char*)Bt + (size_t)u.pn * (size_t)(BM * 2) * K; }
    __device__ __forceinline__ int klen() const { return K; } };

struct StaticOrder {
    int nM, nN, nwg, G, c;
    __host__ __device__ void init(int M, int N, int G_, int c_) { nM = M / BM; nN = N / BM; nwg = nM * nN; G = G_; c = c_; }
    __host__ __device__ bool next(int i, Unit& u) const {
        const long L = (long)i * G + c; if (L >= nwg) return false;
        int wgid = (int)L; { const int q = nwg / NXCD, r = nwg % NXCD, xcd = wgid % NXCD, off = wgid / NXCD; wgid = (xcd < r ? xcd * (q + 1) : r * (q + 1) + (xcd - r) * q) + off; }
        const int nig = WGM * nN, gid = wgid / nig, fm = gid * WGM, gsz = (nM - fm) < WGM ? (nM - fm) : WGM;
        u.pm = fm + ((wgid % nig) % gsz); u.pn = (wgid % nig) / gsz; return true;
    }
    __device__ __forceinline__ void a_ready(const Unit&) const {}
    __device__ __forceinline__ void done(const Unit&) const {}
};

typedef __bf16 bf16x2_cv __attribute__((ext_vector_type(2)));
typedef float f32x2_cv __attribute__((ext_vector_type(2)));
__device__ __forceinline__ unsigned cvt_pk_bf16(float lo, float hi) { const f32x2_cv v = {lo, hi}; const bf16x2_cv b = __builtin_convertvector(v, bf16x2_cv); return __builtin_bit_cast(unsigned, b); }

template <class Epi, class Sched, class GT, bool ALIGN_EPI = false, bool SP2 = false>
__device__ __forceinline__ void gemm_phase(PG8_LAS unsigned char* lds, const GT g, const Sched& S, const Epi& E, const int wid  ) {
    const int lane = lane_opaque(), tid = wid * 64 + lane, wr = wid >> 2, wc = wid & 3, fr = lane & 15, fq = lane >> 4;
    const int K = g.K, nt = g.klen() / BK;
    unsigned voffA[2], voffB[2];
#pragma unroll
    for (int i = 0; i < 2; ++i) { int R, C; stage_rc(tid * 16 + i * 8192, R, C); const int Rb = Epi::PERM ? ((R & ~31) + perm32(R & 31)) : R;
        voffA[i] = (unsigned)(R * K + C) * 2u; voffB[i] = (unsigned)(Rb * K + C) * 2u; }
    asm volatile("" : "+v"(voffA[0]), "+v"(voffA[1]), "+v"(voffB[0]), "+v"(voffB[1]));
    const size_t kstep = (size_t)(BK * 2);
    const size_t hstep = (size_t)HALF * K * 2;
    const unsigned ldsw = (unsigned)wid * 1024u;
    const int aoff = lds_byte(wr * 64 + fr, fq * 8), boff = lds_byte(wc * 32 + fr, fq * 8);
#define PG8_SA(b, h) (((b) * 2 + (h)) * HTB)
#define PG8_SB(b, h) ((4 + (b) * 2 + (h)) * HTB)
#define PG8_STAGE(bufoff, gbase, voff) do { _Pragma("unroll") for (int _i = 0; _i < 2; ++_i) \
        __builtin_amdgcn_global_load_lds((const unsigned*)((const char*)(gbase) + (voff)[_i]), (PG8_LAS unsigned*)(lds + (bufoff) + ldsw + _i * 8192), 16, 0, 0); } while (0)
#define PG8_LDA(dst, b, h) do { _Pragma("unroll") for (int m = 0; m < 4; ++m) _Pragma("unroll") for (int k = 0; k < 2; ++k) dst[m][k] = *(const PG8_LAS bf16x8*)(lds + PG8_SA(b, h) + aoff + m * 2048 + k * 1024); } while (0)
#define PG8_LDB(dst, b, h) do { _Pragma("unroll") for (int n = 0; n < 2; ++n) _Pragma("unroll") for (int k = 0; k < 2; ++k) dst[n][k] = *(const PG8_LAS bf16x8*)(lds + PG8_SB(b, h) + boff + n * 2048 + k * 1024); } while (0)
#define PG8_MMA(ai, bj, At, Bt) do { __builtin_amdgcn_s_setprio(1); _Pragma("unroll") for (int m = 0; m < 4; ++m) _Pragma("unroll") for (int n = 0; n < 2; ++n) _Pragma("unroll") for (int k = 0; k < 2; ++k) \
        acc[ai][bj][m][n] = __builtin_amdgcn_mfma_f32_16x16x32_bf16(Bt[n][k], At[m][k], acc[ai][bj][m][n], 0, 0, 0); __builtin_amdgcn_s_setprio(0); } while (0)
#define PG8_WAIT_V(n) asm volatile("s_waitcnt vmcnt(" #n ")" ::: "memory")
#define PG8_WAIT_L(n) asm volatile("s_waitcnt lgkmcnt(" #n ")" ::: "memory")
#define PG8_BAR __builtin_amdgcn_s_barrier()
#define PG8_SCHED __builtin_amdgcn_sched_barrier(0)
    Unit cur, nxt; int ui = 0;
    if (!S.next(0, cur)) return;
    f32x4 acc[2][2][4][2];
#pragma unroll
    for (int a = 0; a < 2; ++a)
#pragma unroll
        for (int b = 0; b < 2; ++b)
#pragma unroll
            for (int m = 0; m < 4; ++m)
#pragma unroll
                for (int n = 0; n < 2; ++n) acc[a][b][m][n] = (f32x4){0.f, 0.f, 0.f, 0.f};
    bf16x8 At[4][2], B0[2][2], B1[2][2];
    const char* cA = g.a_tile(cur); const char* cB = g.b_tile(cur);
    S.a_ready(cur);
    if constexpr (SP2) {
        PG8_STAGE(PG8_SB(0, 0), cB, voffB); PG8_STAGE(PG8_SB(0, 1), cB + hstep, voffB); PG8_STAGE(PG8_SA(0, 0), cA, voffA); PG8_STAGE(PG8_SA(0, 1), cA + hstep, voffA);
        if (wr == 1) PG8_BAR;
        PG8_WAIT_V(2); PG8_BAR;
        PG8_STAGE(PG8_SB(1, 0), cB + kstep, voffB); PG8_STAGE(PG8_SA(1, 0), cA + kstep, voffA); PG8_STAGE(PG8_SB(1, 1), cB + hstep + kstep, voffB);
        PG8_WAIT_V(6); PG8_BAR;
    } else {
        PG8_STAGE(PG8_SB(0, 0), cB, voffB); PG8_STAGE(PG8_SA(0, 0), cA, voffA); PG8_STAGE(PG8_SB(0, 1), cB + hstep, voffB); PG8_STAGE(PG8_SA(0, 1), cA + hstep, voffA);
        if (wr == 1) PG8_BAR;
        PG8_WAIT_V(4); PG8_BAR;
        PG8_STAGE(PG8_SB(1, 0), cB + kstep, voffB); PG8_STAGE(PG8_SA(1, 0), cA + kstep, voffA); PG8_STAGE(PG8_SB(1, 1), cB + hstep + kstep, voffB);
        PG8_WAIT_V(6); PG8_BAR;
    }
    for (;;) {
        const bool has_next = S.next(ui + 1, nxt);
        const char* nA = has_next ? g.a_tile(nxt) : cA; const char* nB = has_next ? g.b_tile(nxt) : cB;
        for (int t = 0; t < nt; t += 2) {
            const bool last = (t == nt - 2);
            const char* a1 = cA + (size_t)(t + 1) * kstep;
            const char* a2 = last ? nA : cA + (size_t)(t + 2) * kstep; const char* b2 = last ? nB : cB + (size_t)(t + 2) * kstep;
            const char* a3 = a2 + kstep; const char* b3 = b2 + kstep;
            if (last && has_next) S.a_ready(nxt);
            if constexpr (SP2) {
            PG8_LDB(B0, 0, 0); PG8_LDB(B1, 0, 1); PG8_SCHED; PG8_LDA(At, 0, 0); PG8_STAGE(PG8_SA(1, 1), a1 + hstep, voffA);
            PG8_WAIT_V(8); PG8_WAIT_L(0); PG8_BAR; PG8_MMA(0, 0, At, B0); PG8_MMA(0, 1, At, B1); PG8_BAR; PG8_SCHED;
            PG8_LDA(At, 0, 1); PG8_STAGE(PG8_SB(0, 0), b2, voffB); PG8_STAGE(PG8_SB(0, 1), b2 + hstep, voffB); PG8_STAGE(PG8_SA(0, 0), a2, voffA);
            PG8_WAIT_V(8); PG8_WAIT_L(0); PG8_BAR; PG8_MMA(1, 0, At, B0); PG8_MMA(1, 1, At, B1); PG8_BAR; PG8_SCHED;
            PG8_LDB(B0, 1, 0); PG8_LDB(B1, 1, 1); PG8_SCHED; PG8_LDA(At, 1, 0); PG8_STAGE(PG8_SA(0, 1), a2 + hstep, voffA);
            PG8_WAIT_V(8); PG8_WAIT_L(0); PG8_BAR; PG8_MMA(0, 0, At, B0); PG8_MMA(0, 1, At, B1); PG8_BAR; PG8_SCHED;
            PG8_LDA(At, 1, 1); PG8_STAGE(PG8_SB(1, 0), b3, voffB); PG8_STAGE(PG8_SB(1, 1), b3 + hstep, voffB); PG8_STAGE(PG8_SA(1, 0), a3, voffA);
            PG8_WAIT_V(8); PG8_WAIT_L(0); PG8_BAR; PG8_MMA(1, 0, At, B0); PG8_MMA(1, 1, At, B1); PG8_BAR; PG8_SCHED;
            } else {
            PG8_LDB(B0, 0, 0); PG8_SCHED; PG8_LDA(At, 0, 0); PG8_STAGE(PG8_SA(1, 1), a1 + hstep, voffA);
            PG8_WAIT_L(8); PG8_BAR; PG8_WAIT_L(0); PG8_MMA(0, 0, At, B0); PG8_BAR; PG8_SCHED;
            PG8_LDB(B1, 0, 1); PG8_STAGE(PG8_SB(0, 0), b2, voffB);
            PG8_BAR; PG8_WAIT_L(0); PG8_MMA(0, 1, At, B1); PG8_BAR;
            PG8_LDA(At, 0, 1); PG8_STAGE(PG8_SA(0, 0), a2, voffA);
            PG8_BAR; PG8_WAIT_L(0); PG8_MMA(1, 0, At, B0); PG8_BAR; PG8_SCHED;
            PG8_STAGE(PG8_SB(0, 1), b2 + hstep, voffB);
            PG8_WAIT_V(6); PG8_BAR; PG8_MMA(1, 1, At, B1); PG8_BAR;
            PG8_LDB(B0, 1, 0); PG8_SCHED; PG8_LDA(At, 1, 0); PG8_STAGE(PG8_SA(0, 1), a2 + hstep, voffA);
            PG8_WAIT_L(8); PG8_BAR; PG8_WAIT_L(0); PG8_MMA(0, 0, At, B0); PG8_BAR; PG8_SCHED;
            PG8_LDB(B1, 1, 1); PG8_STAGE(PG8_SB(1, 0), b3, voffB);
            PG8_BAR; PG8_WAIT_L(0); PG8_MMA(0, 1, At, B1); PG8_BAR;
            PG8_LDA(At, 1, 1); PG8_STAGE(PG8_SA(1, 0), a3, voffA);
            PG8_BAR; PG8_WAIT_L(0); PG8_MMA(1, 0, At, B0); PG8_BAR; PG8_SCHED;
            PG8_STAGE(PG8_SB(1, 1), b3 + hstep, voffB);
            PG8_WAIT_V(6); PG8_BAR; PG8_MMA(1, 1, At, B1); PG8_BAR;
            }
        }
        if constexpr (ALIGN_EPI) { if (wr == 0) PG8_BAR; }
        if constexpr (!Epi::AFTER_DRAIN) { E(acc, cur, wr, wc, fr, fq); S.done(cur); }
        if (!has_next) break;
#pragma unroll
        for (int a = 0; a < 2; ++a)
#pragma unroll
            for (int b = 0; b < 2; ++b)
#pragma unroll
                for (int m = 0; m < 4; ++m)
#pragma unroll
                    for (int n = 0; n < 2; ++n) acc[a][b][m][n] = (f32x4){0.f, 0.f, 0.f, 0.f};
        cur = nxt; cA = nA; cB = nB; ++ui;
        if constexpr (ALIGN_EPI) { if (wr == 1) PG8_BAR; }
    }
    PG8_WAIT_V(0);
    if constexpr (!ALIGN_EPI) { if (wr == 0) PG8_BAR; }
    PG8_BAR;
    if constexpr (Epi::AFTER_DRAIN) { E.fused(acc, cur, wr, wc, fr, fq, lds, wid, lane); S.done(cur); }
#undef PG8_SA
#undef PG8_SB
#undef PG8_STAGE
#undef PG8_LDA
#undef PG8_LDB
#undef PG8_MMA
#undef PG8_WAIT_V
#undef PG8_WAIT_L
#undef PG8_BAR
#undef PG8_SCHED
}
}

#define LAS __attribute__((address_space(3)))
#define XB_TMO      128
#define XB_XCNT(j)  (256  + 64 * (j))
#define XB_XSUB(j)  (1280 + 64 * (j))
#define XB_XGEN(j)  (2304 + 64 * (j))
#define XB_TOP      3328
#define XB_TOPGEN   3392
#define XCD_BAR_WORDS 3456
#define XB_SPIN_CAP (1u << 20)

__device__ __forceinline__ unsigned xb_ld(unsigned* p)              { return __hip_atomic_load(p, __ATOMIC_RELAXED, __HIP_MEMORY_SCOPE_AGENT); }
__device__ __forceinline__ unsigned xb_add(unsigned* p, unsigned v) { return __hip_atomic_fetch_add(p, v, __ATOMIC_RELAXED, __HIP_MEMORY_SCOPE_AGENT); }
__device__ __forceinline__ unsigned xb_xcc_id() { return (unsigned)__builtin_amdgcn_s_getreg((3 << 11) | 20) & 0xFu; }
#define XB_SPIN(cond, bar) do { unsigned _sp = 0; while (cond) { __builtin_amdgcn_s_sleep(1); \
    if ((++_sp & 255u) == 0u) { if (xb_ld(&(bar)[XB_TMO])) break; if (_sp > XB_SPIN_CAP) { atomicAdd(&(bar)[XB_TMO], 1u); break; } } } } while (0)

struct XcdBarrier {
    unsigned* bar; unsigned x;
    volatile LAS unsigned* st;
};

__device__ __forceinline__ XcdBarrier xcd_barrier_post(unsigned* bar, volatile LAS unsigned* st) {
    XcdBarrier b; b.bar = bar; b.x = xb_xcc_id(); b.st = st;
    if (threadIdx.x == 0) (void)xb_add(&bar[XB_XCNT(b.x)], 1u);
    return b;
}
__device__ __forceinline__ void xcd_barrier_complete(unsigned* bar, unsigned x, unsigned& nloc, unsigned& nx) {
    const unsigned G = gridDim.x * gridDim.y * gridDim.z;
    unsigned sum, cnt, mine, sp = 0u;
    for (;;) {
        sum = 0u; cnt = 0u; mine = 0u;
#pragma unroll
        for (unsigned j = 0; j < 16; ++j) { const unsigned c = xb_ld(&bar[XB_XCNT(j)]); sum += c; cnt += (c > 0u) ? 1u : 0u; mine = (j == x) ? c : mine; }
        if (sum == G) break;
        __builtin_amdgcn_s_sleep(1);
        if ((++sp & 255u) == 0u) { if (xb_ld(&bar[XB_TMO])) break; if (sp > XB_SPIN_CAP) { atomicAdd(&bar[XB_TMO], 1u); break; } }
    }
    nloc = mine > 0u ? mine : 1u; nx = cnt > 0u ? cnt : 1u;
}

__device__ __forceinline__ void xcd_barrier(const XcdBarrier& b, const bool tid0  ) {
    asm volatile("s_waitcnt vmcnt(0)" ::: "memory");
    __syncthreads();
    if (tid0) {
        unsigned* bar = b.bar;
        __builtin_amdgcn_s_waitcnt(0);
        unsigned nloc = b.st[0], nx = b.st[1];
        if (nloc == 0u) { xcd_barrier_complete(bar, b.x, nloc, nx); b.st[0] = nloc; b.st[1] = nx; }
        const unsigned old = xb_add(&bar[XB_XSUB(b.x)], 1u);
        const unsigned gen = old / nloc;
        if (old + 1u == (gen + 1u) * nloc) {
            __builtin_amdgcn_fence(__ATOMIC_RELEASE, "agent");
            asm volatile("s_waitcnt vmcnt(0)" ::: "memory");
            const unsigned og = xb_add(&bar[XB_TOP], 1u);
            const unsigned tg = og / nx;
            if (og + 1u == (tg + 1u) * nx) xb_add(&bar[XB_TOPGEN], 1u);
            else XB_SPIN(xb_ld(&bar[XB_TOPGEN]) == tg, bar);
            __builtin_amdgcn_fence(__ATOMIC_ACQUIRE, "agent");
            xb_add(&bar[XB_XGEN(b.x)], 1u);
            asm volatile("s_waitcnt vmcnt(0)" ::: "memory");
        } else {
            XB_SPIN(xb_ld(&bar[XB_XGEN(b.x)]) == gen, bar);
            __builtin_amdgcn_fence(__ATOMIC_ACQUIRE, "agent");
            asm volatile("s_waitcnt vmcnt(0)" ::: "memory");
        }
    }
    __syncthreads();
}

namespace attn {
using bf16 = unsigned short;
constexpr int   D = 128, NW = 8, QBLK = 32, KVBLK = 64;
constexpr float SCALE = 0.088388347648318440f;
constexpr float THR = 8.f;
constexpr int SDEPTH = 2;
constexpr int LDQ = 2048, LDK = 512, LDO = 2048;
constexpr size_t SHM_V = KVBLK * D * 2, SHM_K = KVBLK * D * 2, SHM_ATTN = 2 * SHM_V + 2 * SHM_K + NW * 64 * 4;
using bf16x8 = __attribute__((ext_vector_type(8))) short;
using s16x4  = __attribute__((ext_vector_type(4))) short;
using f32x16 = __attribute__((ext_vector_type(16))) float;
using f32x8  = __attribute__((ext_vector_type(8))) float;
using u32x4  = __attribute__((ext_vector_type(4))) unsigned;
#define KSWZ(row, colB) ((row) * 256 + ((colB) ^ (((row) & 7) << 4)))
#define SBAR() __builtin_amdgcn_sched_barrier(0)
__device__ __forceinline__ int crow(int r, int hi) { return (r & 3) + 8 * (r >> 2) + 4 * hi; }
__device__ __forceinline__ unsigned cvtpk(float lo, float hi) {
  return pg8::cvt_pk_bf16(lo, hi);
}
template <typename TIn> struct Stage;
__device__ __forceinline__ unsigned f2bf_(float f) { unsigned u = __builtin_bit_cast(unsigned, f); return (u + 0x7fffu + ((u >> 16) & 1u)) >> 16; }
template <> struct Stage<bf16>  { using T = bf16x8;
  __device__ static __forceinline__ T ld8(const bf16* p) { return *reinterpret_cast<const bf16x8*>(p); }
  __device__ static __forceinline__ bf16x8 tobf(T x) { return x; } };
template <> struct Stage<float> { using T = f32x8;
  __device__ static __forceinline__ T ld8(const float* p) { return *reinterpret_cast<const f32x8*>(p); }
  __device__ static __forceinline__ bf16x8 tobf(T x) {
    u32x4 w = {cvtpk(x[0], x[1]), cvtpk(x[2], x[3]), cvtpk(x[4], x[5]), cvtpk(x[6], x[7])}; return *reinterpret_cast<bf16x8*>(&w); } };

__device__ __forceinline__ void partialSM(f32x16& p0, f32x16& p1, float& m_reg, float& mn, float& alpha) {
  constexpr float C = SCALE * 1.4426950408889634f;
  float pmax = p0[0]; for (int r = 1; r < 16; ++r) pmax = fmaxf(pmax, p0[r]); for (int r = 0; r < 16; ++r) pmax = fmaxf(pmax, p1[r]);
  { auto rr = __builtin_amdgcn_permlane32_swap(__float_as_uint(pmax), __float_as_uint(pmax), false, false);
    pmax = fmaxf(__uint_as_float(rr[0]), __uint_as_float(rr[1])); }
  if (__builtin_expect(__all(pmax - m_reg <= THR / SCALE), 1)) { mn = m_reg; alpha = 1.f; }
  else { mn = fmaxf(m_reg, pmax); alpha = __builtin_amdgcn_exp2f((m_reg - mn) * C); m_reg = mn; }
  float mnC = -mn * C;
  for (int r = 0; r < 16; ++r) p0[r] = fmaf(p0[r], C, mnC); for (int r = 0; r < 16; ++r) p1[r] = fmaf(p1[r], C, mnC);
  for (int r = 0; r < 16; ++r) p0[r] = __builtin_amdgcn_exp2f(p0[r]);
}
__device__ __forceinline__ void partialSM_fix(f32x16& p0, f32x16& p1, const float mnC) {
  (void)p1; (void)mnC;
  for (int r = 0; r < 16; ++r) p0[r] = __builtin_amdgcn_exp2f(p0[r]);
}
__device__ __forceinline__ void finishSM(f32x16& p0, f32x16& p1, float alpha, float& l_reg, bf16x8& pa0, bf16x8& pa1, bf16x8& pa2, bf16x8& pa3) {
  for (int r = 0; r < 16; ++r) p1[r] = __builtin_amdgcn_exp2f(p1[r]);
  float ps = 0; for (int r = 0; r < 16; ++r) ps += p0[r]; for (int r = 0; r < 16; ++r) ps += p1[r];
  { auto rr = __builtin_amdgcn_permlane32_swap(__float_as_uint(ps), __float_as_uint(ps), false, false);
    ps = __uint_as_float(rr[0]) + __uint_as_float(rr[1]); }
  l_reg = l_reg * alpha + ps;
#define PK4(P, BASE, OUT) do { unsigned a0 = cvtpk(P[BASE + 0], P[BASE + 1]), a1 = cvtpk(P[BASE + 2], P[BASE + 3]);   \
    unsigned b0 = cvtpk(P[BASE + 4], P[BASE + 5]), b1 = cvtpk(P[BASE + 6], P[BASE + 7]);                              \
    auto r0 = __builtin_amdgcn_permlane32_swap(a0, b0, false, false); auto r1 = __builtin_amdgcn_permlane32_swap(a1, b1, false, false); \
    u32x4 w = {r0[0], r1[0], r0[1], r1[1]}; OUT = *reinterpret_cast<bf16x8*>(&w); } while (0)
  PK4(p0, 0, pa0); PK4(p0, 8, pa1); PK4(p1, 0, pa2); PK4(p1, 8, pa3);
#undef PK4
}
__device__ __forceinline__ void qkt(f32x16& p0, f32x16& p1, const bf16* Ks, const bf16x8* qr, int r32, int hi) {
  p0 = f32x16{}; p1 = f32x16{};
  for (int d0 = 0; d0 < 8; ++d0) { int cb = (d0 * 16 + hi * 8) * 2;
    bf16x8 b0 = *reinterpret_cast<const bf16x8*>((const char*)Ks + KSWZ(r32, cb));
    bf16x8 b1 = *reinterpret_cast<const bf16x8*>((const char*)Ks + KSWZ(32 + r32, cb));
    p0 = __builtin_amdgcn_mfma_f32_32x32x16_bf16(b0, qr[d0], p0, 0, 0, 0);
    p1 = __builtin_amdgcn_mfma_f32_32x32x16_bf16(b1, qr[d0], p1, 0, 0, 0); }
}
__device__ __forceinline__ int v_st(int k, int c) { const int kk = (k & ~0xC) | ((k & 4) << 1) | ((k & 8) >> 1); return ((kk >> 3) * 4 + (c >> 5)) * 512 + ((kk & 7) * 32 + (c & 31)) * 2; }
__device__ __forceinline__ int v_rd_base(int lane) { return ((lane & 3) << 3) | (((lane >> 2) & 3) << 6) | (((lane >> 4) & 1) << 5) | (((lane >> 5) & 1) << 8); }
constexpr int v_rd_off(int d0, int ks, int half) { return d0 * 512 + ks * 4096 + half * 2048; }
template <int OFF> __device__ __forceinline__ s16x4 tr_read(int vb) {
  s16x4 r; asm volatile("ds_read_b64_tr_b16 %0, %1 offset:%2" : "=&v"(r) : "v"(vb), "i"(OFF) : "memory"); return r;
}
template <int D0> __device__ __forceinline__ void pv_one(f32x16& od, int vb, bf16x8 pa0, bf16x8 pa1, bf16x8 pa2, bf16x8 pa3) {
  const s16x4 l0 = tr_read<v_rd_off(D0, 0, 0)>(vb), h0 = tr_read<v_rd_off(D0, 0, 1)>(vb), l1 = tr_read<v_rd_off(D0, 1, 0)>(vb), h1 = tr_read<v_rd_off(D0, 1, 1)>(vb);
  const s16x4 l2 = tr_read<v_rd_off(D0, 2, 0)>(vb), h2 = tr_read<v_rd_off(D0, 2, 1)>(vb), l3 = tr_read<v_rd_off(D0, 3, 0)>(vb), h3 = tr_read<v_rd_off(D0, 3, 1)>(vb);
  asm volatile("s_waitcnt lgkmcnt(0)" ::: "memory"); SBAR();
#define PK(L, H) (bf16x8){L[0], L[1], L[2], L[3], H[0], H[1], H[2], H[3]}
  od = __builtin_amdgcn_mfma_f32_32x32x16_bf16(pa0, PK(l0, h0), od, 0, 0, 0);
  od = __builtin_amdgcn_mfma_f32_32x32x16_bf16(pa1, PK(l1, h1), od, 0, 0, 0);
  od = __builtin_amdgcn_mfma_f32_32x32x16_bf16(pa2, PK(l2, h2), od, 0, 0, 0);
  od = __builtin_amdgcn_mfma_f32_32x32x16_bf16(pa3, PK(l3, h3), od, 0, 0, 0);
#undef PK
}
__device__ __forceinline__ void pv_d0(f32x16* o, int vb, bf16x8 pa0, bf16x8 pa1, bf16x8 pa2, bf16x8 pa3) {
  pv_one<0>(o[0], vb, pa0, pa1, pa2, pa3); pv_one<1>(o[1], vb, pa0, pa1, pa2, pa3); pv_one<2>(o[2], vb, pa0, pa1, pa2, pa3); pv_one<3>(o[3], vb, pa0, pa1, pa2, pa3);
}

template <typename TQ, bool FIXM = false>
__device__ __forceinline__ void attn_dense_body(const TQ* __restrict__ Qb, const bf16* __restrict__ Kh, const bf16* __restrict__ Vh,
                                                bf16* __restrict__ Ob, int seq, char* lds, const int wid, const float mfix = 0.f) {
  using St = Stage<bf16>; using SQ = Stage<TQ>;
  const int lane = lane_opaque(), tid = wid * 64 + lane, r32 = lane & 31, hi = lane >> 5;
  bf16* V_lds = (bf16*)lds; bf16* K_lds = (bf16*)(lds + 2 * SHM_V);
  float* ws = (float*)(lds + 2 * SHM_V + 2 * SHM_K) + wid * 64; float* li_l = ws; float* al_l = ws + 32;
  float m_reg = -1e30f, l_reg = 0; f32x16 o[4] = {}; bf16x8 qr[8]; const float mnCf = -mfix * (SCALE * 1.4426950408889634f); (void)mnCf; (void)m_reg;
  const TQ* Qw = Qb + (long)(wid * QBLK + r32) * LDQ + hi * 8;
#pragma unroll
  for (int d0 = 0; d0 < 8; ++d0) qr[d0] = SQ::tobf(SQ::ld8(Qw + d0 * 16));
  const int sr = tid >> 4, sc = (tid & 15) * 8, vst0 = v_st(sr, sc), vst1 = v_st(32 + sr, sc);
  const int vb0 = (int)(uintptr_t)V_lds + v_rd_base(lane);
  struct { typename St::T vs0, vs1, ks0, ks1; } sr_[SDEPTH];
#define SLOAD(i, k0) do { sr_[i].vs0 = St::ld8(&Vh[(long)((k0) + sr) * LDK + sc]); sr_[i].vs1 = St::ld8(&Vh[(long)((k0) + 32 + sr) * LDK + sc]); \
    sr_[i].ks0 = St::ld8(&Kh[(long)((k0) + sr) * LDK + sc]); sr_[i].ks1 = St::ld8(&Kh[(long)((k0) + 32 + sr) * LDK + sc]); } while (0)
#define SWRITE(b, i) do { *(bf16x8*)((char*)V_lds + (b) * SHM_V + vst0) = St::tobf(sr_[i].vs0);          \
    *(bf16x8*)((char*)V_lds + (b) * SHM_V + vst1) = St::tobf(sr_[i].vs1); int kc = sc * 2;               \
    *(bf16x8*)((char*)K_lds + (b) * SHM_K + KSWZ(sr, kc)) = St::tobf(sr_[i].ks0);                       \
    *(bf16x8*)((char*)K_lds + (b) * SHM_K + KSWZ(32 + sr, kc)) = St::tobf(sr_[i].ks1); } while (0)
#define SWAIT() do { if constexpr (SDEPTH == 2) asm volatile("s_waitcnt vmcnt(4)" ::: "memory"); else asm volatile("s_waitcnt vmcnt(0)" ::: "memory"); } while (0)
#define RESC(a) do { if (__any((a) < 1.f)) { if (hi == 0) al_l[r32] = (a); asm volatile("s_waitcnt lgkmcnt(0)" ::: "memory"); \
    for (int d = 0; d < 4; ++d) for (int r = 0; r < 16; ++r) o[d][r] *= al_l[crow(r, hi)]; } } while (0)
  f32x16 pA0, pA1, pB0, pB1; float mnA, mnB, alA, alB; bf16x8 pa0, pa1, pa2, pa3; const int NT = seq / KVBLK;
  constexpr int SE = 0, SO = SDEPTH - 1;
  SLOAD(SE, 0); asm volatile("s_waitcnt vmcnt(0)" ::: "memory"); SWRITE(0, SE); __syncthreads();
  qkt(pA0, pA1, K_lds, qr, r32, hi); do { if constexpr (FIXM) { partialSM_fix(pA0, pA1, mnCf); alA = 1.f; } else partialSM(pA0, pA1, m_reg, mnA, alA); } while (0);
  SLOAD(SO, KVBLK); if constexpr (SDEPTH == 2) { if (2 < NT) SLOAD(SE, 2 * KVBLK); }
  SWAIT(); SWRITE(1, SO); __syncthreads();
  for (int j = 1; j + 1 < NT; j += 2) {
    SBAR(); qkt(pB0, pB1, (bf16*)((char*)K_lds + SHM_K), qr, r32, hi);
    finishSM(pA0, pA1, FIXM ? 1.f : alA, l_reg, pa0, pa1, pa2, pa3); SBAR();
    SLOAD(SO, (j + SDEPTH) * KVBLK); SBAR();
    pv_d0(o, vb0, pa0, pa1, pa2, pa3); do { if constexpr (FIXM) { partialSM_fix(pB0, pB1, mnCf); alB = 1.f; } else partialSM(pB0, pB1, m_reg, mnB, alB); } while (0);
    __syncthreads(); SWAIT(); SWRITE(0, SE);
    do { if constexpr (!FIXM) RESC(alB); } while (0); __syncthreads();
    SBAR(); qkt(pA0, pA1, K_lds, qr, r32, hi);
    finishSM(pB0, pB1, FIXM ? 1.f : alB, l_reg, pa0, pa1, pa2, pa3); SBAR();
    if (SDEPTH == 1 || j + 3 < NT) SLOAD(SE, (j + 1 + SDEPTH) * KVBLK); SBAR();
    pv_d0(o, vb0 + (int)SHM_V, pa0, pa1, pa2, pa3); do { if constexpr (FIXM) { partialSM_fix(pA0, pA1, mnCf); alA = 1.f; } else partialSM(pA0, pA1, m_reg, mnA, alA); } while (0);
    __syncthreads(); SWAIT(); SWRITE(1, SO);
    do { if constexpr (!FIXM) RESC(alA); } while (0); __syncthreads();
  }
  SBAR(); qkt(pB0, pB1, (bf16*)((char*)K_lds + SHM_K), qr, r32, hi);
  finishSM(pA0, pA1, FIXM ? 1.f : alA, l_reg, pa0, pa1, pa2, pa3); SBAR();
  pv_d0(o, vb0, pa0, pa1, pa2, pa3); do { if constexpr (FIXM) { partialSM_fix(pB0, pB1, mnCf); alB = 1.f; } else partialSM(pB0, pB1, m_reg, mnB, alB); } while (0);
  __syncthreads(); do { if constexpr (!FIXM) RESC(alB); } while (0);
  finishSM(pB0, pB1, FIXM ? 1.f : alB, l_reg, pa0, pa1, pa2, pa3); SBAR();
  pv_d0(o, vb0 + (int)SHM_V, pa0, pa1, pa2, pa3);
  if (hi == 0) li_l[r32] = l_reg; asm volatile("s_waitcnt lgkmcnt(0)" ::: "memory");
  float rli[16];
#pragma unroll
  for (int r = 0; r < 16; ++r) rli[r] = __builtin_amdgcn_rcpf(li_l[crow(r, hi)]);
  bf16* Ow = Ob + (long)(wid * QBLK) * LDO;
  char* stg = (char*)K_lds + wid * 4096;
#pragma unroll
  for (int half = 0; half < 2; ++half) {
#pragma unroll
    for (int r = 0; r < 16; ++r) { const unsigned w = cvtpk(o[2 * half][r] * rli[r], o[2 * half + 1][r] * rli[r]); char* pr = stg + crow(r, hi) * 128 + r32 * 2;
      *reinterpret_cast<unsigned short*>(pr) = (unsigned short)w; *reinterpret_cast<unsigned short*>(pr + 64) = (unsigned short)(w >> 16); }
    asm volatile("s_waitcnt lgkmcnt(0)" ::: "memory");
#pragma unroll
    for (int k = 0; k < 4; ++k) { const int row = 8 * k + (lane >> 3), ch = lane & 7;
      const u32x4 v = *reinterpret_cast<const u32x4*>(stg + row * 128 + ch * 16);
      *reinterpret_cast<u32x4*>(Ow + (long)row * LDO + half * 64 + ch * 8) = v; }
    asm volatile("s_waitcnt lgkmcnt(0)" ::: "memory");
  }
#undef SLOAD
#undef SWRITE
#undef SWAIT
#undef RESC
}
#undef KSWZ
#undef SBAR
}

#define GAS __attribute__((address_space(1)))
typedef unsigned short bf16_t;
typedef unsigned u32x4 __attribute__((ext_vector_type(4)));
typedef unsigned u32x2 __attribute__((ext_vector_type(2)));
typedef float f32x4 __attribute__((ext_vector_type(4)));
typedef float f32x2 __attribute__((ext_vector_type(2)));
typedef short bf16x8 __attribute__((ext_vector_type(8)));

constexpr int D = 2048, NB = 4, SEQ = 4096, CTXL = 256, TB = SEQ + CTXL, M = NB * TB, FF = 5632, DEPTH = 4;
constexpr int NWAVES = 8, NTHR = 512;
constexpr int NCTXWG = 64;
constexpr float NORM_EPS = 1e-6f;
static_assert(M == 17408 && M % 256 == 0 && TB % 256 == 0, "row layout");

constexpr size_t MiB = 1u << 20;
constexpr size_t WS_CTL = 0, CTL_ZERO_BYTES = 1 * MiB;
constexpr size_t WS_MOD = 1 * MiB;
constexpr size_t WS_ROPE = 4 * MiB;
constexpr size_t WS_WB = 8 * MiB;
constexpr size_t E_F1 = (size_t)2 * FF * D, E_F2 = (size_t)D * FF;
constexpr size_t WS_WA = WS_WB + 8 * (E_F1 + E_F2) * 2;
constexpr size_t E_QKV = (size_t)3072 * D, E_SQ = (size_t)D * D;
constexpr size_t WS_WR = WS_WA + 2 * (E_QKV + E_SQ) * 2;
constexpr size_t E_RW1 = (size_t)6912 * D, E_RW2 = (size_t)10240 * 256;
constexpr size_t WS_WEND = WS_WR + 2 * (E_RW1 + E_RW2 + E_SQ) * 2;
static_assert(WS_WEND == 656 * MiB, "weight map");
constexpr size_t SZ_R2 = (size_t)M * D * 2, SZ_R4 = (size_t)M * D * 4;
constexpr size_t WS_X = 656 * MiB;
constexpr size_t WS_Y = WS_X + SZ_R4;
constexpr size_t WS_ACT = WS_Y + SZ_R2;
constexpr size_t WS_OUT = 1048 * MiB;
constexpr size_t WS_MIX = WS_OUT + SZ_R2;
static_assert(WS_ACT + (size_t)M * FF * 2 <= WS_OUT, "act map");
constexpr size_t WS_Q = WS_MIX, WS_K = WS_Q + SZ_R2, WS_V = WS_K + SZ_R2 / 4, WS_O = WS_V + SZ_R2 / 4;
constexpr size_t WS_MIX6 = WS_MIX;
constexpr size_t WS_WDEC = WS_MIX;
constexpr size_t WS_AA = WS_MIX + 2 * SZ_R4;
constexpr size_t WS_RR = WS_MIX + 6 * SZ_R2;
constexpr size_t WS_KK_ = WS_RR + SZ_R2;
constexpr size_t WS_VV = WS_KK_ + SZ_R2;
constexpr size_t WS_KN = WS_VV + SZ_R2;
constexpr size_t WS_GG = WS_KN + SZ_R2;
constexpr size_t WS_GL = WS_GG + SZ_R2;
constexpr size_t WS_WL = WS_GL + 9 * MiB, WS_AL = WS_WL + 9 * MiB;
constexpr size_t WS_PART = WS_AL + 9 * MiB;
constexpr size_t WS_BON = WS_PART + 16 * MiB;
constexpr size_t WS_END = WS_BON + 5 * MiB;
constexpr size_t WS_YS = WS_ACT;
constexpr size_t WS_PREP = WS_Y;
static_assert(WS_AA + 2 * SZ_R2 == WS_RR, "rwkv overlay");
static_assert(WS_END <= 2100 * MiB, "ws map");
constexpr int CW_BAR = 4096;
constexpr int MAX_LAUNCH = 64;
constexpr int CW_GRP = CW_BAR + MAX_LAUNCH * XCD_BAR_WORDS;
constexpr int CW_FC = CW_GRP + 16 * 4 * 64 + 2 * 128 * 64;
static_assert((CW_FC + 8 * 64) * 4 <= (int)WS_MOD, "ctl map (context tile counters)");
constexpr int CW_PAIR = CW_GRP + 16 * 4 * 64;
static_assert((CW_PAIR + 2 * 128 * 64) * 4 <= (int)WS_MOD, "ctl map (pair counters)");
static_assert((CW_GRP + 16 * 4 * 64) * 4 <= (int)WS_MOD, "ctl map (group counters)");
static_assert((CW_BAR + MAX_LAUNCH * XCD_BAR_WORDS) * 4 <= (int)WS_MOD, "ctl map");

constexpr int RING_BYTES = 131072, LDSCTL_OFF = RING_BYTES, MISC_OFF = LDSCTL_OFF + 320, LDS_BYTES = 163840;

struct Args { const float* in[30]; float* out; unsigned char* ws; int ph_lo, ph_hi, li, dbg; };
typedef const __attribute__((address_space(4))) Args KArgs;
struct Frame { LAS unsigned char* lds; unsigned char* ldsg; int wave, G, bid; };

#define LDS_WAIT() asm volatile("s_waitcnt lgkmcnt(0)" ::: "memory")
__device__ __forceinline__ unsigned f2bf(float f) { unsigned u = __builtin_bit_cast(unsigned, f); return (u + 0x7fffu + ((u >> 16) & 1u)) >> 16; }
__device__ __forceinline__ unsigned pk2(float lo, float hi) { return pg8::cvt_pk_bf16(lo, hi); }
__device__ __forceinline__ float bflo(unsigned w) { return __builtin_bit_cast(float, w << 16); }
__device__ __forceinline__ float bfhi(unsigned w) { return __builtin_bit_cast(float, w & 0xffff0000u); }
__device__ __forceinline__ void unpack8(const u32x4 w, float (&v)[8]) { v[0] = bflo(w.x); v[1] = bfhi(w.x); v[2] = bflo(w.y); v[3] = bfhi(w.y); v[4] = bflo(w.z); v[5] = bfhi(w.z); v[6] = bflo(w.w); v[7] = bfhi(w.w); }
__device__ __forceinline__ u32x4 pack8(const float (&v)[8]) { u32x4 w; w.x = pk2(v[0], v[1]); w.y = pk2(v[2], v[3]); w.z = pk2(v[4], v[5]); w.w = pk2(v[6], v[7]); return w; }
typedef _Float16 h16x2 __attribute__((ext_vector_type(2)));
__device__ __forceinline__ void unpack8h(const u32x4 w, float (&v)[8]) {
    const unsigned wx = w.x, wy = w.y, wz = w.z, ww = w.w;
    const h16x2 a = __builtin_bit_cast(h16x2, wx), b = __builtin_bit_cast(h16x2, wy), c = __builtin_bit_cast(h16x2, wz), d = __builtin_bit_cast(h16x2, ww);
    v[0] = (float)a.x; v[1] = (float)a.y; v[2] = (float)b.x; v[3] = (float)b.y; v[4] = (float)c.x; v[5] = (float)c.y; v[6] = (float)d.x; v[7] = (float)d.y; }
__device__ __forceinline__ u32x4 pack8h(const float (&v)[8]) {
    h16x2 a, b, c, d; a.x = (_Float16)v[0]; a.y = (_Float16)v[1]; b.x = (_Float16)v[2]; b.y = (_Float16)v[3]; c.x = (_Float16)v[4]; c.y = (_Float16)v[5]; d.x = (_Float16)v[6]; d.y = (_Float16)v[7];
    u32x4 w; w.x = __builtin_bit_cast(unsigned, a); w.y = __builtin_bit_cast(unsigned, b); w.z = __builtin_bit_cast(unsigned, c); w.w = __builtin_bit_cast(unsigned, d); return w; }
__device__ __forceinline__ float wave_sum(float v) {
#pragma unroll
    for (int o = 1; o < 64; o <<= 1) v += __shfl_xor(v, o);
    return v;
}
template <int CTRL> __device__ __forceinline__ float dppf(float x) { return __builtin_bit_cast(float, __builtin_amdgcn_mov_dpp(__builtin_bit_cast(int, x), CTRL, 0xF, 0xF, true)); }
__device__ __forceinline__ float sum8(float v) { v += dppf<0xB1>(v); v += dppf<0x4E>(v); v += dppf<0x141>(v); return v; }
__device__ __forceinline__ float sum16(float v) { v = sum8(v); v += dppf<0x140>(v); return v; }
__device__ __forceinline__ float fsigmoid(float x) { return __builtin_amdgcn_rcpf(1.0f + __builtin_amdgcn_exp2f(-1.4426950408889634f * x)); }
__device__ __forceinline__ float ftanh(float x) { return 1.0f - 2.0f * __builtin_amdgcn_rcpf(1.0f + __builtin_amdgcn_exp2f(2.8853900817779268f * x)); }
__device__ __forceinline__ float fsilu(float x) { return x * fsigmoid(x); }

using pg8::Unit;
typedef float accf32x4 __attribute__((ext_vector_type(4)));
struct EpiPlain {
    static constexpr bool PERM = true, AFTER_DRAIN = false;
    bf16_t* O; int ldc;
    __device__ __forceinline__ void operator()(const accf32x4 (&acc)[2][2][4][2], const Unit& u, int wr, int wc, int fr, int fq) const {
        const int row0 = u.pm * 256 + wr * 64 + fr, col0 = u.pn * 256 + wc * 32 + 8 * fq;
#pragma unroll
        for (int ai = 0; ai < 2; ++ai)
#pragma unroll
            for (int m = 0; m < 4; ++m) { bf16_t* rowp = O + (size_t)(row0 + ai * 128 + m * 16) * ldc + col0;
#pragma unroll
                for (int bj = 0; bj < 2; ++bj) { const accf32x4 v0 = acc[ai][bj][m][0], v1 = acc[ai][bj][m][1];
                    u32x4 w; w.x = pk2(v0[0], v0[1]); w.y = pk2(v0[2], v0[3]); w.z = pk2(v1[0], v1[1]); w.w = pk2(v1[2], v1[3]);
                    *(u32x4*)(rowp + bj * 128) = w; } }
    }
};
struct EpiQKV {
    static constexpr bool PERM = true, AFTER_DRAIN = false;
    unsigned char* wsb;
    __device__ __forceinline__ void operator()(const accf32x4 (&acc)[2][2][4][2], const Unit& u, int wr, int wc, int fr, int fq) const {
        size_t ooff; int ldc, ct;
        if (u.pn < 8) { ooff = WS_Q; ldc = 2048; ct = u.pn; } else if (u.pn < 10) { ooff = WS_K; ldc = 512; ct = u.pn - 8; } else { ooff = WS_V; ldc = 512; ct = u.pn - 10; }
        bf16_t* O = (bf16_t*)(wsb + ooff);
        const int row0 = u.pm * 256 + wr * 64 + fr, col0 = ct * 256 + wc * 32 + 8 * fq;
#pragma unroll
        for (int ai = 0; ai < 2; ++ai)
#pragma unroll
            for (int m = 0; m < 4; ++m) { bf16_t* rowp = O + (size_t)(row0 + ai * 128 + m * 16) * ldc + col0;
#pragma unroll
                for (int bj = 0; bj < 2; ++bj) { const accf32x4 v0 = acc[ai][bj][m][0], v1 = acc[ai][bj][m][1];
                    u32x4 w; w.x = pk2(v0[0], v0[1]); w.y = pk2(v0[2], v0[3]); w.z = pk2(v1[0], v1[1]); w.w = pk2(v1[2], v1[3]);
                    *(u32x4*)(rowp + bj * 128) = w; } }
    }
};
struct EpiQKVN {
    static constexpr bool PERM = true, AFTER_DRAIN = false;
    unsigned char* wsb; const float* gq; const float* gk; LAS float* xch; float qscale;
    __device__ __forceinline__ void operator()(const accf32x4 (&acc)[2][2][4][2], const Unit& u, int wr, int wc, int fr, int fq) const {
        size_t ooff; int ldc, ct;
        if (u.pn < 8) { ooff = WS_Q; ldc = 2048; ct = u.pn; } else if (u.pn < 10) { ooff = WS_K; ldc = 512; ct = u.pn - 8; } else { ooff = WS_V; ldc = 512; ct = u.pn - 10; }
        bf16_t* O = (bf16_t*)(wsb + ooff);
        const int row0 = u.pm * 256 + wr * 64 + fr, col0 = ct * 256 + wc * 32 + 8 * fq;
        if (u.pn >= 10) {
#pragma unroll
            for (int ai = 0; ai < 2; ++ai)
#pragma unroll
                for (int m = 0; m < 4; ++m) { bf16_t* rowp = O + (size_t)(row0 + ai * 128 + m * 16) * ldc + col0;
#pragma unroll
                    for (int bj = 0; bj < 2; ++bj) { const accf32x4 v0 = acc[ai][bj][m][0], v1 = acc[ai][bj][m][1];
                        u32x4 w; w.x = pk2(v0[0], v0[1]); w.y = pk2(v0[2], v0[3]); w.z = pk2(v1[0], v1[1]); w.w = pk2(v1[2], v1[3]);
                        *(u32x4*)(rowp + bj * 128) = w; } }
            return;
        }
#pragma unroll
        for (int ai = 0; ai < 2; ++ai)
#pragma unroll
            for (int m = 0; m < 4; ++m)
#pragma unroll
                for (int bj = 0; bj < 2; ++bj) { const accf32x4 v0 = acc[ai][bj][m][0], v1 = acc[ai][bj][m][1];
                    float x = v0[0] * v0[0] + v0[1] * v0[1] + v0[2] * v0[2] + v0[3] * v0[3] + v1[0] * v1[0] + v1[1] * v1[1] + v1[2] * v1[2] + v1[3] * v1[3];
                    { const unsigned ub = __builtin_bit_cast(unsigned, x); auto rr = __builtin_amdgcn_permlane16_swap(ub, ub, false, false); const unsigned r0 = rr[0], r1 = rr[1];
                      x = __builtin_bit_cast(float, r0) + __builtin_bit_cast(float, r1); }
                    { const unsigned ub = __builtin_bit_cast(unsigned, x); auto rr = __builtin_amdgcn_permlane32_swap(ub, ub, false, false); const unsigned r0 = rr[0], r1 = rr[1];
                      x = __builtin_bit_cast(float, r0) + __builtin_bit_cast(float, r1); }
                    if (fq == 0) xch[((wr * 128 + ai * 64 + m * 16 + fr) * 2 + bj) * 4 + wc] = x; }
        asm volatile("s_waitcnt lgkmcnt(0)" ::: "memory");
        __builtin_amdgcn_s_barrier();
        asm volatile("" ::: "memory");
        const float* gp = (u.pn < 8 ? gq : gk) + wc * 32 + 8 * fq;
        const f32x4 g0 = *(const f32x4*)gp, g1 = *(const f32x4*)(gp + 4);
        const bool lat = (u.pm % 17) != 0;
        const float* COS = (const float*)(wsb + WS_ROPE); const float* SIN = COS + 4096 * 64;
#pragma unroll
        for (int ai = 0; ai < 2; ++ai)
#pragma unroll
            for (int m = 0; m < 4; ++m) { const int row = row0 + ai * 128 + m * 16; bf16_t* rowp = O + (size_t)row * ldc + col0;
                f32x4 cs = (f32x4){1.f, 1.f, 1.f, 1.f}, sn = (f32x4){0.f, 0.f, 0.f, 0.f};
                if (lat) { const int pos = row % TB - CTXL; cs = *(const f32x4*)(COS + (size_t)pos * 64 + wc * 16 + 4 * fq); sn = *(const f32x4*)(SIN + (size_t)pos * 64 + wc * 16 + 4 * fq); }
#pragma unroll
                for (int bj = 0; bj < 2; ++bj) {
                    const f32x4 pp = *(const LAS f32x4*)(xch + ((wr * 128 + ai * 64 + m * 16 + fr) * 2 + bj) * 4);
                    const float rs = rsqrtf((pp[0] + pp[1] + pp[2] + pp[3]) * (1.0f / 128.0f) + NORM_EPS) * (u.pn < 8 ? qscale : 1.0f);
                    const accf32x4 v0 = acc[ai][bj][m][0], v1 = acc[ai][bj][m][1];
                    const float a0 = v0[0] * rs * g0[0], a1 = v0[1] * rs * g0[1], a2 = v0[2] * rs * g0[2], a3 = v0[3] * rs * g0[3];
                    const float b0 = v1[0] * rs * g1[0], b1 = v1[1] * rs * g1[1], b2 = v1[2] * rs * g1[2], b3 = v1[3] * rs * g1[3];
                    u32x4 w;
                    w.x = pk2(a0 * cs[0] - a1 * sn[0], a0 * sn[0] + a1 * cs[0]); w.y = pk2(a2 * cs[1] - a3 * sn[1], a2 * sn[1] + a3 * cs[1]);
                    w.z = pk2(b0 * cs[2] - b1 * sn[2], b0 * sn[2] + b1 * cs[2]); w.w = pk2(b2 * cs[3] - b3 * sn[3], b2 * sn[3] + b3 * cs[3]);
                    *(u32x4*)(rowp + bj * 128) = w; } }
    }
};
struct EpiSwiGLU {
    static constexpr bool PERM = true, AFTER_DRAIN = false;
    bf16_t* O;
    __device__ __forceinline__ void operator()(const accf32x4 (&acc)[2][2][4][2], const Unit& u, int wr, int wc, int fr, int fq) const {
        const int row0 = u.pm * 256 + wr * 64 + fr, col0 = u.pn * 128 + wc * 32 + 8 * fq;
#pragma unroll
        for (int ai = 0; ai < 2; ++ai)
#pragma unroll
            for (int m = 0; m < 4; ++m) { bf16_t* rowp = O + (size_t)(row0 + ai * 128 + m * 16) * FF + col0;
                float r[8];
#pragma unroll
                for (int n = 0; n < 2; ++n)
#pragma unroll
                    for (int e = 0; e < 4; ++e) { const float g = acc[ai][0][m][n][e], up = acc[ai][1][m][n][e]; r[4 * n + e] = fsilu(g) * up; }
                *(u32x4*)rowp = pack8(r); }
    }
};
struct EpiRw1 {
    static constexpr bool PERM = true, AFTER_DRAIN = false;
    unsigned char* wsb; const float* k_k;
    __device__ __forceinline__ void operator()(const accf32x4 (&acc)[2][2][4][2], const Unit& u, int wr, int wc, int fr, int fq) const {
        const int row0 = u.pm * 256 + wr * 64 + fr, cit = 64 * wc + 8 * fq;
        const int pn = u.pn;
        if (pn >= 8 && pn < 16) {
            bf16_t* K = (bf16_t*)(wsb + WS_KK_); bf16_t* KN = (bf16_t*)(wsb + WS_KN);
            const int colb = (pn - 8) * 256 + cit;
            float kk0[8], kk1[8];
            { const f32x4 a0 = *(const f32x4*)(k_k + colb), a1 = *(const f32x4*)(k_k + colb + 4), b0 = *(const f32x4*)(k_k + colb + 32), b1 = *(const f32x4*)(k_k + colb + 36);
#pragma unroll
              for (int e = 0; e < 4; ++e) { kk0[e] = a0[e]; kk0[4 + e] = a1[e]; kk1[e] = b0[e]; kk1[4 + e] = b1[e]; } }
#pragma unroll
            for (int ai = 0; ai < 2; ++ai)
#pragma unroll
                for (int m = 0; m < 4; ++m) { const size_t ro = (size_t)(row0 + ai * 128 + m * 16) * D + colb;
                    float k0[8], k1[8], q0[8], q1[8]; float ss = 0.f;
#pragma unroll
                    for (int n = 0; n < 2; ++n)
#pragma unroll
                        for (int e = 0; e < 4; ++e) { k0[4 * n + e] = acc[ai][0][m][n][e]; k1[4 * n + e] = acc[ai][1][m][n][e]; }
#pragma unroll
                    for (int i = 0; i < 8; ++i) { q0[i] = k0[i] * kk0[i]; q1[i] = k1[i] * kk1[i]; ss += q0[i] * q0[i] + q1[i] * q1[i]; }
                    ss += __shfl_xor(ss, 16); ss += __shfl_xor(ss, 32);
                    const float rs = rsqrtf(ss + 1e-12f);
#pragma unroll
                    for (int i = 0; i < 8; ++i) { q0[i] *= rs; q1[i] *= rs; }
                    *(u32x4*)(K + ro) = pack8(k0); *(u32x4*)(K + ro + 32) = pack8(k1);
                    *(u32x4*)(KN + ro) = pack8(q0); *(u32x4*)(KN + ro + 32) = pack8(q1); }
        } else if (pn < 24) {
            bf16_t* O = (bf16_t*)(wsb + (pn < 8 ? WS_RR : WS_VV)); const int colb = (pn & 7) * 256 + cit;
#pragma unroll
            for (int ai = 0; ai < 2; ++ai)
#pragma unroll
                for (int m = 0; m < 4; ++m) { const size_t ro = (size_t)(row0 + ai * 128 + m * 16) * D + colb;
#pragma unroll
                    for (int bj = 0; bj < 2; ++bj) { const accf32x4 v0 = acc[ai][bj][m][0], v1 = acc[ai][bj][m][1];
                        u32x4 w; w.x = pk2(v0[0], v0[1]); w.y = pk2(v0[2], v0[3]); w.z = pk2(v1[0], v1[1]); w.w = pk2(v1[2], v1[3]);
                        *(u32x4*)(O + ro + 32 * bj) = w; } }
        } else {
            bf16_t* O = (bf16_t*)(wsb + WS_GL + (size_t)(pn - 24) * (9 * MiB));
#pragma unroll
            for (int ai = 0; ai < 2; ++ai)
#pragma unroll
                for (int m = 0; m < 4; ++m) { const size_t ro = (size_t)(row0 + ai * 128 + m * 16) * 256 + cit;
#pragma unroll
                    for (int bj = 0; bj < 2; ++bj) { float r[8];
#pragma unroll
                        for (int n = 0; n < 2; ++n)
#pragma unroll
                            for (int e = 0; e < 4; ++e) { const float x = acc[ai][bj][m][n][e]; r[4 * n + e] = pn == 24 ? fsigmoid(x) : (pn == 25 ? ftanh(x) : x); }
                        *(u32x4*)(O + ro + 32 * bj) = pack8(r); } }
        }
    }
};
struct EpiRw2 {
    static constexpr bool PERM = true, AFTER_DRAIN = false;
    unsigned char* wsb; const float *w0, *a0; size_t aa_off;
    __device__ __forceinline__ void operator()(const accf32x4 (&acc)[2][2][4][2], const Unit& u, int wr, int wc, int fr, int fq) const {
        const int row0 = u.pm * 256 + wr * 64 + fr, cit = 64 * wc + 8 * fq;
        const int pn = u.pn;
        if (pn < 8) {
            bf16_t* G = (bf16_t*)(wsb + WS_GG);
            const int colb = pn * 256 + cit;
#pragma unroll
            for (int ai = 0; ai < 2; ++ai)
#pragma unroll
                for (int m = 0; m < 4; ++m) { const size_t ro = (size_t)(row0 + ai * 128 + m * 16) * D + colb;
#pragma unroll
                    for (int bj = 0; bj < 2; ++bj) { const accf32x4 v0 = acc[ai][bj][m][0], v1 = acc[ai][bj][m][1];
                        u32x4 w; w.x = pk2(v0[0], v0[1]); w.y = pk2(v0[2], v0[3]); w.z = pk2(v1[0], v1[1]); w.w = pk2(v1[2], v1[3]);
                        *(u32x4*)(G + ro + 32 * bj) = w; } }
        } else if (pn < 24) {
            const int d = (pn - 8) >> 3, colb = ((pn - 8) & 7) * 256 + cit;
            bf16_t* Wd = (bf16_t*)(wsb + WS_WDEC) + (size_t)d * M * D;
#pragma unroll
            for (int bj = 0; bj < 2; ++bj) {
                const f32x4 b0 = *(const f32x4*)(w0 + d * D + colb + 32 * bj), b1 = *(const f32x4*)(w0 + d * D + colb + 32 * bj + 4);
#pragma unroll
                for (int ai = 0; ai < 2; ++ai)
#pragma unroll
                    for (int m = 0; m < 4; ++m) { const size_t ro = (size_t)(row0 + ai * 128 + m * 16) * D + colb + 32 * bj;
                        float lw[8];
#pragma unroll
                        for (int e = 0; e < 4; ++e) { lw[e] = -0.8750387749f * fsigmoid(acc[ai][bj][m][0][e] + b0[e]);
                                                      lw[4 + e] = -0.8750387749f * fsigmoid(acc[ai][bj][m][1][e] + b1[e]); }
                        *(u32x4*)(Wd + ro) = pack8(lw); } }
        } else {
            const int d = (pn - 24) >> 3, colb = ((pn - 24) & 7) * 256 + cit;
            bf16_t* AAd = (bf16_t*)(wsb + aa_off) + (size_t)d * M * D;
#pragma unroll
            for (int bj = 0; bj < 2; ++bj) {
                const int cb = colb + 32 * bj;
                const f32x4 b0 = *(const f32x4*)(a0 + d * D + cb), b1 = *(const f32x4*)(a0 + d * D + cb + 4);
#pragma unroll
                for (int ai = 0; ai < 2; ++ai)
#pragma unroll
                    for (int m = 0; m < 4; ++m) { const size_t ro = (size_t)(row0 + ai * 128 + m * 16) * D + cb;
                        float av[8];
#pragma unroll
                        for (int e = 0; e < 4; ++e) { av[e] = fsigmoid(acc[ai][bj][m][0][e] + b0[e]); av[4 + e] = fsigmoid(acc[ai][bj][m][1][e] + b1[e]); }
                        *(u32x4*)(AAd + ro) = pack8(av); } }
        }
    }
};
struct GemmRw1 { const bf16_t* MIX; const bf16_t* Bt;  int K;
    __device__ __forceinline__ const char* a_tile(const Unit& u) const { int idx = u.pn < 24 ? (u.pn >> 3) : (u.pn - 21);
#ifdef DBG_RW1_SAMEA
        idx = 0;
#endif
        return (const char*)MIX + (size_t)idx * SZ_R2 + (size_t)u.pm * (size_t)(256 * 2) * D; }
    __device__ __forceinline__ const char* b_tile(const Unit& u) const { return (const char*)Bt + (size_t)u.pn * (size_t)(256 * 2) * D; }
    __device__ __forceinline__ int klen() const { return K; } };
struct GemmRw2 { const unsigned char* wsb; const bf16_t* Bt; int K, KL;
    __device__ __forceinline__ int koff(const Unit& u) const { return KL < 256 ? (((u.pn - 8) >> 3) & 1) * 64 : 0; }
    __device__ __forceinline__ const char* a_tile(const Unit& u) const { const size_t ao = u.pn < 8 ? WS_GL : (u.pn < 24 ? WS_WL : WS_AL); return (const char*)wsb + ao + (size_t)u.pm * (size_t)(256 * 2) * 256 + (size_t)koff(u) * 2; }
    __device__ __forceinline__ const char* b_tile(const Unit& u) const { return (const char*)Bt + (size_t)u.pn * (size_t)(256 * 2) * 256 + (size_t)koff(u) * 2; }
    __device__ __forceinline__ int klen() const { return KL; } };
struct Rw2WAOrder : pg8::StaticOrder {
    __device__ bool next(int i, Unit& u) const { if (!pg8::StaticOrder::next(i, u)) return false; u.pn += 8; return true; }
};

__device__ __forceinline__ int hp_row(int c) { return 128 * ((c & 63) >> 5) + 32 * (c >> 6) + (c & 31); }
__device__ __forceinline__ int hp_col(int rho) { return 64 * ((rho & 127) >> 5) + 32 * (rho >> 7) + (rho & 31); }
__device__ __forceinline__ void cvt_item(const float* W, int K, int N, bf16_t* WT, int mode, int row_off, LAS float* scr, int item, int lane) {
    const int nblk = N / 32, kb = item / nblk, nb = item - kb * nblk, k0 = 64 * kb, n0 = 32 * nb;
#pragma unroll 8
    for (int i = 0; i < 32; ++i) { const int kk = 2 * i + (lane >> 5); scr[kk * 33 + (lane & 31)] = W[(size_t)(k0 + kk) * N + n0 + (lane & 31)]; }
    LDS_WAIT(); asm volatile("" ::: "memory");
    int dr;
    if (mode == 0) dr = n0;
    else if (mode == 1) { dr = n0 < FF ? 256 * (n0 / 128) + (n0 % 128) : 256 * ((n0 - FF) / 128) + 128 + ((n0 - FF) % 128); }
    else { dr = (n0 & ~255) + hp_row(n0 & 255); }
    dr += row_off;
    const int c = lane & 7;
#pragma unroll
    for (int j = 0; j < 4; ++j) { const int n = (lane >> 3) + 8 * j; const LAS float* s = scr + (8 * c) * 33 + n;
        u32x4 o; o.x = pk2(s[0 * 33], s[1 * 33]); o.y = pk2(s[2 * 33], s[3 * 33]); o.z = pk2(s[4 * 33], s[5 * 33]); o.w = pk2(s[6 * 33], s[7 * 33]);
        *(u32x4*)(WT + (size_t)(dr + n) * K + k0 + 8 * c) = o; }
    LDS_WAIT(); asm volatile("" ::: "memory");
}
constexpr int I_F1 = (D / 64) * (2 * FF / 32), I_F2 = (FF / 64) * (D / 32), I_QKV = (D / 64) * (3072 / 32), I_SQ = (D / 64) * (D / 32), I_G1 = (D / 64) * (256 / 32), I_G2 = (256 / 64) * (D / 32);
constexpr int CVT_FFN = 4 * (I_F1 + I_F2), CVT_ATT = I_QKV + I_SQ, CVT_RW = 4 * I_SQ + I_G1 + I_G2, CVT_HALF = CVT_FFN + CVT_ATT + CVT_RW;
__device__ __forceinline__ void cvt_big_item(KArgs* a, int r, int late, LAS float* scr, int lane_) {
    bf16_t* WB = (bf16_t*)(a->ws + WS_WB); bf16_t* WA = (bf16_t*)(a->ws + WS_WA); bf16_t* WR = (bf16_t*)(a->ws + WS_WR);
    if (r < CVT_FFN) { const int lq = r / (I_F1 + I_F2), lh = 4 * late + lq; r -= lq * (I_F1 + I_F2);
        bf16_t* base = WB + (size_t)lh * (E_F1 + E_F2);
        if (r < I_F1) cvt_item(a->in[8] + (size_t)lh * D * 2 * FF, D, 2 * FF, base, 1, 0, scr, r, lane_);
        else cvt_item(a->in[9] + (size_t)lh * FF * D, FF, D, base + E_F1, 0, 0, scr, r - I_F1, lane_);
        return; }
    r -= CVT_FFN;
    const int j = late;
    if (r < CVT_ATT) {
        bf16_t* base = WA + (size_t)j * (E_QKV + E_SQ);
        if (r < I_QKV) cvt_item(a->in[10] + (size_t)j * D * 3072, D, 3072, base, 0, 0, scr, r, lane_);
        else cvt_item(a->in[11] + (size_t)j * D * D, D, D, base + E_QKV, 0, 0, scr, r - I_QKV, lane_);
        return; }
    r -= CVT_ATT;
    { bf16_t* rw1 = WR + (size_t)j * (E_RW1 + E_RW2 + E_SQ); bf16_t* rw2 = rw1 + E_RW1; bf16_t* ro = rw2 + E_RW2;
      if (r < 3 * I_SQ) { const int q = r / I_SQ; cvt_item(a->in[15] + ((size_t)j * 3 + q) * D * D, D, D, rw1, 2, q * 2048, scr, r - q * I_SQ, lane_); return; }
      r -= 3 * I_SQ;
      if (r < I_SQ) { cvt_item(a->in[16] + (size_t)j * D * D, D, D, ro, 0, 0, scr, r, lane_); return; }
      r -= I_SQ;
      if (r < I_G1) { cvt_item(a->in[17] + (size_t)j * D * 256, D, 256, rw1, 2, 6144, scr, r, lane_); return; }
      r -= I_G1;
      cvt_item(a->in[18] + (size_t)j * 256 * D, 256, D, rw2, 2, 0, scr, r, lane_); }
}
struct CvtJob { const float* W; bf16_t* WT; int K, N, mode, row_off, item; };
constexpr int CVT_N0 = 3 * (I_F1 + I_F2) + CVT_ATT + (3 * I_SQ + I_G1 + I_G2), CVT_N1 = 5 * (I_F1 + I_F2) + CVT_ATT + CVT_RW + I_SQ;
__device__ __forceinline__ CvtJob cvt_decode(KArgs* a, int r, int g) {
    bf16_t* WB = (bf16_t*)(a->ws + WS_WB); bf16_t* WA = (bf16_t*)(a->ws + WS_WA); bf16_t* WR = (bf16_t*)(a->ws + WS_WR);
    CvtJob j; j.row_off = 0; j.mode = 0;
    const int nffn = (g ? 5 : 3) * (I_F1 + I_F2);
    if (r < nffn) { const int lq = r / (I_F1 + I_F2), lh = (g ? 3 : 0) + lq; r -= lq * (I_F1 + I_F2);
        bf16_t* base = WB + (size_t)lh * (E_F1 + E_F2);
        if (r < I_F1) { j.W = a->in[8] + (size_t)lh * D * 2 * FF; j.K = D; j.N = 2 * FF; j.WT = base; j.mode = 1; j.item = r; }
        else { j.W = a->in[9] + (size_t)lh * FF * D; j.K = FF; j.N = D; j.WT = base + E_F1; j.item = r - I_F1; }
        return j; }
    r -= nffn;
    int l = g;
    if (r < CVT_ATT) {
        bf16_t* base = WA + (size_t)l * (E_QKV + E_SQ);
        if (r < I_QKV) { j.W = a->in[10] + (size_t)l * D * 3072; j.K = D; j.N = 3072; j.WT = base; j.item = r; }
        else { j.W = a->in[11] + (size_t)l * D * D; j.K = D; j.N = D; j.WT = base + E_QKV; j.item = r - I_QKV; }
        return j; }
    r -= CVT_ATT;
    if (r < 3 * I_SQ) { bf16_t* rw1 = WR + (size_t)l * (E_RW1 + E_RW2 + E_SQ);
        const int q = r / I_SQ; j.W = a->in[15] + ((size_t)l * 3 + q) * D * D; j.K = D; j.N = D; j.WT = rw1; j.mode = 2; j.row_off = q * 2048; j.item = r - q * I_SQ; return j; }
    r -= 3 * I_SQ;
    if (r < I_G1) { bf16_t* rw1 = WR + (size_t)l * (E_RW1 + E_RW2 + E_SQ); j.W = a->in[17] + (size_t)l * D * 256; j.K = D; j.N = 256; j.WT = rw1; j.mode = 2; j.row_off = 6144; j.item = r; return j; }
    r -= I_G1;
    if (r < I_G2) { bf16_t* rw2 = WR + (size_t)l * (E_RW1 + E_RW2 + E_SQ) + E_RW1; j.W = a->in[18] + (size_t)l * 256 * D; j.K = 256; j.N = D; j.WT = rw2; j.mode = 2; j.item = r; return j; }
    r -= I_G2;
    l = r < I_SQ ? 1 : 0; r -= (1 - l) * I_SQ;
    { bf16_t* ro = WR + (size_t)l * (E_RW1 + E_RW2 + E_SQ) + E_RW1 + E_RW2; j.W = a->in[16] + (size_t)l * D * D; j.K = D; j.N = D; j.WT = ro; j.item = r; }
    return j;
}
__device__ __forceinline__ void cvt_job_load(const CvtJob& j, int lane, float (&v)[32]) {
    const int nblk = j.N / 32, kb = j.item / nblk, nb = j.item - kb * nblk, k0 = 64 * kb, n0 = 32 * nb;
    const float* p = j.W + (size_t)(k0 + (lane >> 5)) * j.N + n0 + (lane & 31);
#pragma unroll
    for (int i = 0; i < 32; ++i) v[i] = p[(size_t)(2 * i) * j.N];
}
__device__ __forceinline__ void cvt_job_store(const CvtJob& j, LAS float* scr, int lane, const float (&v)[32]) {
    const int nblk = j.N / 32, kb = j.item / nblk, nb = j.item - kb * nblk, k0 = 64 * kb, n0 = 32 * nb;
#pragma unroll
    for (int i = 0; i < 32; ++i) scr[(2 * i + (lane >> 5)) * 33 + (lane & 31)] = v[i];
    LDS_WAIT(); asm volatile("" ::: "memory");
    int dr;
    if (j.mode == 0) dr = n0;
    else if (j.mode == 1) { dr = n0 < FF ? 256 * (n0 / 128) + (n0 % 128) : 256 * ((n0 - FF) / 128) + 128 + ((n0 - FF) % 128); }
    else { dr = (n0 & ~255) + hp_row(n0 & 255); }
    dr += j.row_off;
    const int c = lane & 7;
#pragma unroll
    for (int q = 0; q < 4; ++q) { const int n = (lane >> 3) + 8 * q; const LAS float* sp = scr + (8 * c) * 33 + n;
        u32x4 o; o.x = pk2(sp[0 * 33], sp[1 * 33]); o.y = pk2(sp[2 * 33], sp[3 * 33]); o.z = pk2(sp[4 * 33], sp[5 * 33]); o.w = pk2(sp[6 * 33], sp[7 * 33]);
        *(u32x4*)(j.WT + (size_t)(dr + n) * j.K + k0 + 8 * c) = o; }
    LDS_WAIT(); asm volatile("" ::: "memory");
}
__device__ __forceinline__ void p0a_phase(const Frame F, KArgs* a) {
    const int lane_ = lane_opaque(), tid_ = F.wave * 64 + lane_; (void)tid_; (void)lane_;
    LAS float* scr = (LAS float*)(F.lds + F.wave * 16384);
    const int gw = F.bid * NWAVES + F.wave, NGW = F.G * NWAVES;
    bf16_t* WR = (bf16_t*)(a->ws + WS_WR);
    for (int it = gw; it < CVT_N0; it += NGW) { const CvtJob j = cvt_decode(a, it, 0); float v[32]; cvt_job_load(j, lane_, v); cvt_job_store(j, scr, lane_, v); }
    {
        constexpr int P_A = 256 * 2048 / 2, P_C = 4096 * 256 / 2, P_J = 2 * P_A + 2 * P_C;
        for (int p = F.bid * NTHR + tid_; p < 2 * P_J; p += F.G * NTHR) {
            const int j = p / P_J; int r = p - j * P_J;
            bf16_t* rw1 = WR + (size_t)j * (E_RW1 + E_RW2 + E_SQ); bf16_t* rw2 = rw1 + E_RW1;
            if (r < 2 * P_A) { const int which = r / P_A; r -= which * P_A;
                const int rho = r / 1024, k = (r - rho * 1024) * 2, c = hp_col(rho);
                const float* src = (which == 0 ? a->in[20] : a->in[23]);
                float v0 = 0.f, v1 = 0.f;
                if (c < 192) { const int d = c / 96, jj = c - d * 96; const float* s = src + (((size_t)j * 2 + d) * D + k) * 96 + jj; v0 = s[0]; v1 = s[96]; }
                *(unsigned*)(rw1 + (size_t)(6400 + 256 * which + rho) * D + k) = pk2(v0, v1);
            } else { r -= 2 * P_A; const int which = r / P_C; r -= which * P_C;
                const int nrow = r / 128, k = (r - nrow * 128) * 2;
                const int d = nrow >> 11, np = nrow & 2047, c = (np & ~255) + hp_col(np & 255);
                const float* src = (which == 0 ? a->in[21] : a->in[24]);
                float v0 = 0.f, v1 = 0.f;
                if (k < 192 && (k / 96) == d) { const int kk = k - d * 96; const float* s = src + (((size_t)j * 2 + d) * 96 + kk) * D + c; v0 = s[0]; v1 = s[D]; }
                *(unsigned*)(rw2 + (size_t)(2048 + 4096 * which + nrow) * 256 + k) = pk2(v0, v1);
            }
        }
    }
#ifdef DBG_FILL_WS
    {
        u32x4* p = (u32x4*)(a->ws + WS_X); const size_t n16 = (WS_END - WS_X) / 16;
        for (size_t i = (size_t)F.bid * NTHR + tid_; i < n16; i += (size_t)F.G * NTHR) p[i] = (u32x4){0xAAAAAAAAu, 0xAAAAAAAAu, 0xAAAAAAAAu, 0xAAAAAAAAu};
    }
#endif
    {
        float* COS = (float*)(a->ws + WS_ROPE); float* SIN = COS + 4096 * 64;
        for (int p = F.bid * NTHR + tid_; p < 4096 * 64; p += F.G * NTHR) {
            const int t = p >> 6, f = p & 63; const int pos = f < 32 ? (t >> 6) : (t & 63); const int fi = f & 31;
            const float inv = exp2f(-(float)fi * (13.287712379549449f / 32.0f));
            const float ang = (float)pos * inv;
            COS[p] = cosf(ang); SIN[p] = sinf(ang);
        }
    }
    {
        LAS float* sv = (LAS float*)F.lds;
        LAS float* part = (LAS float*)(F.lds + 65536);
        float* MOD = (float*)(a->ws + WS_MOD);
        __syncthreads();
        for (int idx = tid_; idx < 5 * D; idx += NTHR) { const int cc = idx >> 11, kk = idx & 2047; const float x = cc < 4 ? a->in[1][cc * D + kk] : a->in[3][kk]; sv[kk * 8 + cc] = fsilu(x); }
        __syncthreads();
        for (int u = F.bid; u < 4 * 72; u += F.G) {
            const int l = u / 72, nb = u - l * 72;
            const int n = nb * 256 + lane_ * 4, k0 = F.wave * 256;
            const float* wp = a->in[4] + ((size_t)l * D + k0) * 18432 + n;
            f32x4 acc[5];
#pragma unroll
            for (int c = 0; c < 5; ++c) acc[c] = (f32x4){0.f, 0.f, 0.f, 0.f};
#pragma unroll 8
            for (int kk = 0; kk < 256; ++kk) { const f32x4 w4 = *(const f32x4*)(wp + (size_t)kk * 18432);
                const f32x4 s4 = *(const LAS f32x4*)(sv + (k0 + kk) * 8); const float s5 = sv[(k0 + kk) * 8 + 4];
                acc[0] += w4 * s4[0]; acc[1] += w4 * s4[1]; acc[2] += w4 * s4[2]; acc[3] += w4 * s4[3]; acc[4] += w4 * s5; }
#pragma unroll
            for (int c = 0; c < 5; ++c) *(LAS f32x4*)(part + (F.wave * 5 + c) * 256 + lane_ * 4) = acc[c];
            __syncthreads();
            for (int o = tid_; o < 5 * 256; o += NTHR) { const int c = o >> 8, col = o & 255; float s = a->in[5][(size_t)l * 18432 + nb * 256 + col];
#pragma unroll
                for (int w = 0; w < 8; ++w) s += part[(w * 5 + c) * 256 + col];
                MOD[((size_t)l * 5 + c) * 18432 + nb * 256 + col] = s; }
            __syncthreads();
        }
    }
}

template <int MODE> struct ThinCtx { float PA[4][8], PB[4][8], PC[4][8]; int cur_c; };
template <int MODE, bool CTXP>
__device__ __forceinline__ void thin_row(ThinCtx<MODE>& T, KArgs* a, const int lane, const int m, int l, int s, float wgt, int nl, int ns) {
    const float* MOD = (const float*)(a->ws + WS_MOD);
    bf16_t* X = (bf16_t*)(a->ws + WS_X)  ; bf16_t* Y = (bf16_t*)(a->ws + WS_Y); const bf16_t* OUT = (const bf16_t*)(a->ws + WS_OUT);
    const int b = m / TB, j = m - b * TB, c = j < CTXL ? 4 : b;
    if (MODE == 2 && c == 4) return;
    if (c != T.cur_c) {
        T.cur_c = c;
#pragma unroll
        for (int q = 0; q < 4; ++q) { const int e0 = 512 * q + 8 * lane;
            if (MODE != 0) { const float* gp = MOD + (((size_t)l * 5 + c) * 9 + s * 3 + 2) * D + e0; const float* np = a->in[7] + ((size_t)l * 3 + s) * D + e0;
#pragma unroll
                for (int i = 0; i < 8; ++i) T.PA[q][i] = wgt * gp[i] * np[i]; }
            if (MODE != 2) { const float* sc = MOD + (((size_t)nl * 5 + c) * 9 + ns * 3 + 1) * D + e0; const float* sh = MOD + (((size_t)nl * 5 + c) * 9 + ns * 3 + 0) * D + e0; const float* np = a->in[6] + ((size_t)nl * 3 + ns) * D + e0;
#pragma unroll
                for (int i = 0; i < 8; ++i) { T.PB[q][i] = np[i] * (1.0f + sc[i]); T.PC[q][i] = sh[i]; } } }
    }
    float x[4][8];
    if (MODE == 0) {
        const float* src = j < CTXL ? a->in[2] + ((size_t)b * CTXL + j) * D : a->in[0] + ((size_t)b * SEQ + (j - CTXL)) * D;
#pragma unroll
        for (int q = 0; q < 4; ++q) { const f32x4 v0 = *(const f32x4*)(src + 512 * q + 8 * lane), v1 = *(const f32x4*)(src + 512 * q + 8 * lane + 4);
#pragma unroll
            for (int e = 0; e < 4; ++e) { x[q][e] = v0[e]; x[q][4 + e] = v1[e]; } }
    } else {
        float o[4][8]; float ss = 0.f;
#pragma unroll
        for (int q = 0; q < 4; ++q) {
            if (CTXP) { const float* P0 = (const float*)(a->ws + WS_PART) + (size_t)(b * CTXL + j) * D + 512 * q + 8 * lane; const float* P1 = P0 + (size_t)(NB * CTXL) * D;
                const f32x4 a0 = *(const f32x4*)P0, a1 = *(const f32x4*)(P0 + 4), b0 = *(const f32x4*)P1, b1 = *(const f32x4*)(P1 + 4);
#pragma unroll
                for (int e = 0; e < 4; ++e) { o[q][e] = a0[e] + b0[e]; o[q][4 + e] = a1[e] + b1[e]; } }
            else unpack8(*(const u32x4*)(OUT + (size_t)m * D + 512 * q + 8 * lane), o[q]);
#pragma unroll
            for (int i = 0; i < 8; ++i) ss += o[q][i] * o[q][i]; }
        ss = wave_sum(ss);
        const float r1 = rsqrtf(ss * (1.0f / D) + NORM_EPS);
#pragma unroll
        for (int q = 0; q < 4; ++q) { float xo[8]; unpack8h(*(const u32x4*)(X + (size_t)m * D + 512 * q + 8 * lane), xo);
#pragma unroll
            for (int e = 0; e < 8; ++e) x[q][e] = xo[e] + T.PA[q][e] * (o[q][e] * r1); }
    }
    if (MODE == 2) {
        float* dst = a->out + ((size_t)b * SEQ + (j - CTXL)) * D;
#pragma unroll
        for (int q = 0; q < 4; ++q) { *(f32x4*)(dst + 512 * q + 8 * lane) = (f32x4){x[q][0], x[q][1], x[q][2], x[q][3]}; *(f32x4*)(dst + 512 * q + 8 * lane + 4) = (f32x4){x[q][4], x[q][5], x[q][6], x[q][7]}; }
        return;
    }
    float ss2 = 0.f;
#pragma unroll
    for (int q = 0; q < 4; ++q) { *(u32x4*)(X + (size_t)m * D + 512 * q + 8 * lane) = pack8h(x[q]);
#pragma unroll
        for (int i = 0; i < 8; ++i) ss2 += x[q][i] * x[q][i]; }
    ss2 = wave_sum(ss2);
    const float r2 = rsqrtf(ss2 * (1.0f / D) + NORM_EPS);
#pragma unroll
    for (int q = 0; q < 4; ++q) { float y[8];
#pragma unroll
        for (int i = 0; i < 8; ++i) y[i] = (x[q][i] * r2) * T.PB[q][i] + T.PC[q][i];
        *(u32x4*)(Y + (size_t)m * D + 512 * q + 8 * lane) = pack8(y); }
}
template <int MODE, int ROWSET, int NX = NCTXWG, int WX = 0>
__device__ __forceinline__ void thin_phase(const Frame F, KArgs* a, int l, int s, float wgt, int nl, int ns) {
    const int lane_ = lane_opaque();
    ThinCtx<MODE> T; T.cur_c = -1;
    if (ROWSET == 0) {
        for (int ch = F.bid; ch < M / 68; ch += F.G) {
            const int r0 = ch * 68 + (F.wave < 4 ? 9 * F.wave : 36 + 8 * (F.wave - 4)), nr = F.wave < 4 ? 9 : 8;
            for (int r = 0; r < nr; ++r) thin_row<MODE, false>(T, a, lane_, r0 + r, l, s, wgt, nl, ns);
        }
    } else if (ROWSET == 1) {
        const long tot = (long)NX * NWAVES * WX + (long)(F.G - NX) * NWAVES * 8;
        const long st = F.bid < NX ? (long)(F.bid * NWAVES + F.wave) * WX : (long)NX * NWAVES * WX + (long)((F.bid - NX) * NWAVES + F.wave) * 8, en = st + (F.bid < NX ? WX : 8);
        const int l0 = (int)((st * (NB * SEQ)) / tot), l1 = (int)((en * (NB * SEQ)) / tot);
        for (int li = l0; li < l1; ++li) thin_row<MODE, false>(T, a, lane_, (li >> 12) * TB + CTXL + (li & (SEQ - 1)), l, s, wgt, nl, ns);
    } else {
        for (int c = F.bid * NWAVES + F.wave; c < NB * CTXL; c += F.G * NWAVES) thin_row<MODE, true>(T, a, lane_, (c >> 8) * TB + (c & (CTXL - 1)), l, s, wgt, nl, ns);
    }
}
__device__ __forceinline__ void ctx_group_thin(const Frame F, KArgs* a, unsigned* bar, int site, int l, int s, float wgt, int nl, int ns) {
    asm volatile("s_waitcnt vmcnt(0)" ::: "memory");
    __syncthreads();
    const int lane_ = lane_opaque();
    if (F.wave == 0 && lane_ == 0) {
        unsigned* c = (unsigned*)(a->ws + WS_CTL) + CW_GRP + (site * 4 + (F.bid >> 4)) * 64;
        __builtin_amdgcn_fence(__ATOMIC_RELEASE, "agent");
        asm volatile("s_waitcnt vmcnt(0)" ::: "memory");
        (void)xb_add(c, 1u);
        XB_SPIN(xb_ld(c) < 16u, bar);
        __builtin_amdgcn_fence(__ATOMIC_ACQUIRE, "agent");
        asm volatile("s_waitcnt vmcnt(0)" ::: "memory");
    }
    __syncthreads();
    ThinCtx<1> T; T.cur_c = -1;
    const int b = F.bid >> 4, r0 = (F.bid & 15) * 16 + F.wave * 2;
    thin_row<1, true>(T, a, lane_, b * TB + r0, l, s, wgt, nl, ns);
    thin_row<1, true>(T, a, lane_, b * TB + r0 + 1, l, s, wgt, nl, ns);
}
__device__ __forceinline__ void ctx_group_sync(const Frame F, KArgs* a, unsigned* bar, int site, int panel, unsigned n) {
    asm volatile("s_waitcnt vmcnt(0)" ::: "memory");
    __syncthreads();
    if (F.wave == 0 && lane_opaque() == 0) {
        unsigned* c = (unsigned*)(a->ws + WS_CTL) + CW_GRP + (site * 4 + panel) * 64;
        __builtin_amdgcn_fence(__ATOMIC_RELEASE, "agent");
        asm volatile("s_waitcnt vmcnt(0)" ::: "memory");
        (void)xb_add(c, 1u);
        XB_SPIN(xb_ld(c) < n, bar);
        __builtin_amdgcn_fence(__ATOMIC_ACQUIRE, "agent");
        asm volatile("s_waitcnt vmcnt(0)" ::: "memory");
    }
    __syncthreads();
}
struct CtxOrder8 {
    int c;
    __device__ bool next(int i, Unit& u) const { if (i != 0 || c >= 32) return false; u.pm = (c >> 3) * 17; u.pn = c & 7; return true; }
    __device__ __forceinline__ void a_ready(const Unit&) const {}
    __device__ __forceinline__ void done(const Unit&) const {}
};
__device__ __forceinline__ void ctx_mixer_thin(const Frame F, KArgs* a, unsigned* bar, int site, int l, int s, float wgt, int nl, int ns) {
    ctx_group_sync(F, a, bar, site, F.bid >> 3, 8u);
    const int lane_ = lane_opaque();
    ThinCtx<1> T; T.cur_c = -1;
    const int b = F.bid >> 3, r0 = (F.bid & 7) * 32 + F.wave * 4;
#pragma unroll 1
    for (int r = 0; r < 4; ++r) thin_row<1, false>(T, a, lane_, b * TB + r0 + r, l, s, wgt, nl, ns);
}
struct Ffn1Order {
    int G, c; unsigned* ctr;
    __device__ bool next(int i, Unit& u) const {
        const int L = i * G + c; if (L >= 68 * 44) return false;
        if (L < 176) { const int p = L / 44; u.pm = p * 17; u.pn = L - p * 44; return true; }
        constexpr int nM = 64, nN = 44, nwg = nM * nN;
        int wgid = L - 176; { const int q = nwg / pg8::NXCD, r = nwg % pg8::NXCD, xcd = wgid % pg8::NXCD, off = wgid / pg8::NXCD; wgid = (xcd < r ? xcd * (q + 1) : r * (q + 1) + (xcd - r) * q) + off; }
        const int nig = pg8::WGM * nN, gid = wgid / nig, fm = gid * pg8::WGM, gsz = (nM - fm) < pg8::WGM ? (nM - fm) : pg8::WGM;
        const int pl = fm + ((wgid % nig) % gsz); u.pm = pl + (pl >> 4) + 1; u.pn = (wgid % nig) / gsz; return true;
    }
    __device__ __forceinline__ void a_ready(const Unit&) const {}
    __device__ __forceinline__ void done(const Unit& u) const {
        if (u.pm % 17 == 0) {
            asm volatile("s_waitcnt vmcnt(0)" ::: "memory");
            __builtin_amdgcn_s_barrier();
            if (threadIdx.x == 0) { __builtin_amdgcn_fence(__ATOMIC_RELEASE, "agent"); asm volatile("s_waitcnt vmcnt(0)" ::: "memory"); (void)xb_add(ctr, 1u); }
        }
    }
};
struct LatentOrder : pg8::StaticOrder {
    __device__ void init_lat(int N, int G_, int c_) { init(64 * 256, N, G_, c_); }
    __device__ bool next(int i, Unit& u) const { if (!pg8::StaticOrder::next(i, u)) return false; u.pm = u.pm + (u.pm >> 4) + 1; return true; }
};
struct CtxOrder2 {
    int c;
    __device__ bool next(int i, Unit& u) const { if (i != 0 || c >= NCTXWG) return false; const int idx = c >> 1; u.pm = (idx >> 3) * 17; u.pn = (idx & 7) + 8 * (c & 1); return true; }
    __device__ __forceinline__ void a_ready(const Unit&) const {}
    __device__ __forceinline__ void done(const Unit&) const {}
};
struct GemmCtxSplit { const bf16_t* A; const bf16_t* Bt; int K;
    __device__ __forceinline__ const char* a_tile(const Unit& u) const { return (const char*)A + (size_t)u.pm * (size_t)(256 * 2) * K + (size_t)(u.pn >> 3) * (size_t)(K / 2) * 2; }
    __device__ __forceinline__ const char* b_tile(const Unit& u) const { return (const char*)Bt + (size_t)(u.pn & 7) * (size_t)(256 * 2) * K + (size_t)(u.pn >> 3) * (size_t)(K / 2) * 2; }
    __device__ __forceinline__ int klen() const { return K / 2; } };
struct EpiCtxPart {
    static constexpr bool PERM = true, AFTER_DRAIN = false;
    float* P;
    __device__ __forceinline__ void operator()(const accf32x4 (&acc)[2][2][4][2], const Unit& u, int wr, int wc, int fr, int fq) const {
        const int row0 = (u.pm / 17) * 256 + wr * 64 + fr, col0 = (u.pn & 7) * 256 + wc * 32 + 8 * fq;
        float* base = P + (size_t)(u.pn >> 3) * (NB * CTXL) * D;
#pragma unroll
        for (int ai = 0; ai < 2; ++ai)
#pragma unroll
            for (int m = 0; m < 4; ++m) { float* rowp = base + (size_t)(row0 + ai * 128 + m * 16) * D + col0;
#pragma unroll
                for (int bj = 0; bj < 2; ++bj) { *(f32x4*)(rowp + bj * 128) = acc[ai][bj][m][0]; *(f32x4*)(rowp + bj * 128 + 4) = acc[ai][bj][m][1]; } }
    }
};
#ifndef DBG_DUMP_OFF
#define DBG_DUMP_OFF WS_X
#define DBG_DUMP_F32 1
#endif
__device__ __forceinline__ void copyout_phase(const Frame F, KArgs* a) {
    const int lane_ = lane_opaque();
    for (int m = F.bid * NWAVES + F.wave; m < M; m += F.G * NWAVES) { const int b = m / TB, j = m - b * TB; if (j < CTXL) continue;
        float* dst = a->out + ((size_t)b * SEQ + (j - CTXL)) * D;
#if defined(DBG_DUMP_P256)
        { const size_t offs[] = {DBG_DUMP_P256}; constexpr int NL = sizeof(offs) / sizeof(offs[0]);
          for (int q = 0; q < 4; ++q) { float acc[8], v[8]; for (int e = 0; e < 8; ++e) acc[e] = 0.f;
              if (q == 0 && lane_ < 32) { for (int t = 0; t < NL; ++t) { unpack8(*(const u32x4*)((const bf16_t*)(a->ws + offs[t]) + (size_t)m * 256 + 8 * lane_), v); for (int e = 0; e < 8; ++e) acc[e] += (1.f + t) * v[e]; } }
              *(f32x4*)(dst + 512 * q + 8 * lane_) = (f32x4){acc[0], acc[1], acc[2], acc[3]}; *(f32x4*)(dst + 512 * q + 8 * lane_ + 4) = (f32x4){acc[4], acc[5], acc[6], acc[7]}; }
          continue; }
#endif
#ifndef DBG_DUMP_W
#define DBG_DUMP_W(t) (1.f + (t))
#endif
#if defined(DBG_DUMP_LIST)
        { const size_t offs[] = {DBG_DUMP_LIST}; constexpr int NL = sizeof(offs) / sizeof(offs[0]);
#pragma unroll
          for (int q = 0; q < 4; ++q) { const size_t ro = (size_t)m * D + 512 * q + 8 * lane_; float acc[8], v[8];
              for (int e = 0; e < 8; ++e) acc[e] = 0.f;
#pragma unroll
              for (int t = 0; t < NL; ++t) { unpack8(*(const u32x4*)((const bf16_t*)(a->ws + offs[t]) + ro), v); for (int e = 0; e < 8; ++e) acc[e] += DBG_DUMP_W(t) * v[e]; }
              *(f32x4*)(dst + 512 * q + 8 * lane_) = (f32x4){acc[0], acc[1], acc[2], acc[3]}; *(f32x4*)(dst + 512 * q + 8 * lane_ + 4) = (f32x4){acc[4], acc[5], acc[6], acc[7]}; }
          continue; }
#endif
        if (DBG_DUMP_F32) { const float* X = (const float*)(a->ws + (DBG_DUMP_OFF));
#pragma unroll
            for (int q = 0; q < 8; ++q) *(f32x4*)(dst + 256 * q + 4 * lane_) = *(const f32x4*)(X + (size_t)m * D + 256 * q + 4 * lane_); }
        else { const bf16_t* Bq = (const bf16_t*)(a->ws + (DBG_DUMP_OFF));
#pragma unroll
            for (int q = 0; q < 4; ++q) { float v[8]; unpack8(*(const u32x4*)(Bq + (size_t)m * D + 512 * q + 8 * lane_), v);
                *(f32x4*)(dst + 512 * q + 8 * lane_) = (f32x4){v[0], v[1], v[2], v[3]}; *(f32x4*)(dst + 512 * q + 8 * lane_ + 4) = (f32x4){v[4], v[5], v[6], v[7]}; } }
    }
}

__device__ __forceinline__ void mixes_phase(const Frame F, KArgs* a, int jr) {
    const int lane_ = lane_opaque(), tid_ = F.wave * 64 + lane_; (void)tid_; (void)lane_;
    const bf16_t* Y = (const bf16_t*)(a->ws + WS_Y); bf16_t* MIX = (bf16_t*)(a->ws + WS_MIX6);
    const int rg = F.wave >> 2, e0 = 512 * (F.wave & 3) + 8 * lane_;
    float mu[6][8];
    { const int muidx[6] = {0, 2, 3, 5, 1, 4};
#pragma unroll
      for (int q = 0; q < 6; ++q) { const float* mp = a->in[14] + ((size_t)jr * 6 + muidx[q]) * D + e0;
#pragma unroll
          for (int i = 0; i < 8; ++i) mu[q][i] = mp[i]; } }
    for (int ch = F.bid; ch < M / 68; ch += F.G) {
        const int r0 = ch * 68 + 34 * rg;
        float yp[8], yc[8], yn[8];
        if (r0 > 0) unpack8(*(const u32x4*)(Y + (size_t)(r0 - 1) * D + e0), yp); else {
#pragma unroll
            for (int i = 0; i < 8; ++i) yp[i] = 0.f; }
        unpack8(*(const u32x4*)(Y + (size_t)r0 * D + e0), yc);
        for (int r = 0; r < 34; ++r) { const int m = r0 + r, j = m % TB;
            if (m + 1 < M) unpack8(*(const u32x4*)(Y + (size_t)(m + 1) * D + e0), yn); else {
#pragma unroll
                for (int i = 0; i < 8; ++i) yn[i] = 0.f; }
            const float pv = (j != 0 && j != CTXL) ? 0.5f : 0.f, nv = (j != CTXL - 1 && j != TB - 1) ? 0.5f : 0.f;
            float xx[8];
#pragma unroll
            for (int i = 0; i < 8; ++i) xx[i] = (pv * yp[i] + nv * yn[i]) - yc[i];
#pragma unroll
            for (int q = 0; q < 6; ++q) { float o[8];
#pragma unroll
                for (int i = 0; i < 8; ++i) o[i] = yc[i] + xx[i] * mu[q][i];
                *(u32x4*)(MIX + (size_t)q * M * D + (size_t)m * D + e0) = pack8(o); }
#pragma unroll
            for (int i = 0; i < 8; ++i) { yp[i] = yc[i]; yc[i] = yn[i]; }
        }
    }
}

__device__ __forceinline__ void qknorm_phase(const Frame F, KArgs* a, int ja) {
    const int lane_ = lane_opaque(), tid_ = F.wave * 64 + lane_; (void)tid_; (void)lane_;
    bf16_t* Q = (bf16_t*)(a->ws + WS_Q); bf16_t* K = (bf16_t*)(a->ws + WS_K);
    const float* COS = (const float*)(a->ws + WS_ROPE); const float* SIN = COS + 4096 * 64;
    const int li = lane_ & 15, hs = lane_ >> 4;
    float gq[8], gk[8];
#pragma unroll
    for (int i = 0; i < 8; ++i) { gq[i] = a->in[12][ja * 128 + 8 * li + i]; gk[i] = a->in[13][ja * 128 + 8 * li + i]; }
    for (int m = F.bid * NWAVES + F.wave; m < M; m += F.G * NWAVES) {
        const int j = m % TB; const bool lat = j >= CTXL; const int pos = lat ? j - CTXL : 0;
        f32x4 cs = (f32x4){1.f, 1.f, 1.f, 1.f}, sn = (f32x4){0.f, 0.f, 0.f, 0.f};
        if (lat) { cs = *(const f32x4*)(COS + (size_t)pos * 64 + 4 * li); sn = *(const f32x4*)(SIN + (size_t)pos * 64 + 4 * li); }
#pragma unroll
        for (int p = 0; p < 5; ++p) {
            bf16_t* ptr = p < 4 ? Q + (size_t)m * D + (4 * p + hs) * 128 + 8 * li : K + (size_t)m * 512 + hs * 128 + 8 * li;
            float v[8]; unpack8(*(const u32x4*)ptr, v);
            float ss = 0.f;
#pragma unroll
            for (int i = 0; i < 8; ++i) ss += v[i] * v[i];
            ss = sum16(ss);
            const float rs = rsqrtf(ss * (1.0f / 128.0f) + NORM_EPS);
            float o[8];
#pragma unroll
            for (int i = 0; i < 4; ++i) { const float x1 = v[2 * i] * rs * (p < 4 ? gq[2 * i] : gk[2 * i]), x2 = v[2 * i + 1] * rs * (p < 4 ? gq[2 * i + 1] : gk[2 * i + 1]);
                o[2 * i] = x1 * cs[i] - x2 * sn[i]; o[2 * i + 1] = x1 * sn[i] + x2 * cs[i]; }
            *(u32x4*)ptr = pack8(o);
        }
    }
}

template <int R> __device__ __forceinline__ float ror16(float x) { return __builtin_bit_cast(float, __builtin_amdgcn_mov_dpp(__builtin_bit_cast(int, x), 0x120 + R, 0xF, 0xF, true)); }
__device__ __forceinline__ float sum_row16(float x) { x += ror16<8>(x); x += ror16<4>(x); x += ror16<2>(x); x += ror16<1>(x); return x; }
__device__ __forceinline__ float sum_rows(float x) {
    x += ror16<8>(x);
    { const unsigned u = __builtin_bit_cast(unsigned, x); auto rr = __builtin_amdgcn_permlane16_swap(u, u, false, false); const unsigned r0 = rr[0], r1 = rr[1];
      x = __builtin_bit_cast(float, r0) + __builtin_bit_cast(float, r1); }
    { const unsigned u = __builtin_bit_cast(unsigned, x); auto rr = __builtin_amdgcn_permlane32_swap(u, u, false, false); const unsigned r0 = rr[0], r1 = rr[1];
      x = __builtin_bit_cast(float, r0) + __builtin_bit_cast(float, r1); }
    return x;
}
template <bool HI> __device__ __forceinline__ f32x2 pk_mul_bc(f32x2 a, f32x2 b) { f32x2 d;
    if (HI) asm("v_pk_mul_f32 %0, %1, %2 op_sel:[0,1] op_sel_hi:[1,1]" : "=v"(d) : "v"(a), "v"(b)); else asm("v_pk_mul_f32 %0, %1, %2 op_sel_hi:[1,0]" : "=v"(d) : "v"(a), "v"(b)); return d; }
template <bool HI> __device__ __forceinline__ f32x2 pk_fma_bc(f32x2 a, f32x2 b, f32x2 c) { f32x2 d;
    if (HI) asm("v_pk_fma_f32 %0, %1, %2, %3 op_sel:[0,1,0] op_sel_hi:[1,1,1]" : "=v"(d) : "v"(a), "v"(b), "v"(c)); else asm("v_pk_fma_f32 %0, %1, %2, %3 op_sel_hi:[1,0,1]" : "=v"(d) : "v"(a), "v"(b), "v"(c)); return d; }
template <bool HI> __device__ __forceinline__ f32x2 pk_nfma_bc(f32x2 a, f32x2 b, f32x2 c) { f32x2 d;
    if (HI) asm("v_pk_fma_f32 %0, %1, %2, %3 op_sel:[0,1,0] op_sel_hi:[1,1,1] neg_lo:[1,0,0] neg_hi:[1,0,0]" : "=v"(d) : "v"(a), "v"(b), "v"(c));
    else asm("v_pk_fma_f32 %0, %1, %2, %3 op_sel_hi:[1,0,1] neg_lo:[1,0,0] neg_hi:[1,0,0]" : "=v"(d) : "v"(a), "v"(b), "v"(c)); return d; }
__device__ __forceinline__ void scan_phase(const Frame F, KArgs* a, int jr, const bool cvt_late, unsigned* bar) {
    const int lane_ = lane_opaque(), tid_ = F.wave * 64 + lane_; (void)tid_; (void)lane_;
    LAS float* L = (LAS float*)F.lds;
    constexpr int BUF = 32 * 384, YB0 = 2 * BUF, YBUF = 32 * 64;
    const int lane = lane_, li8 = (lane & 7) * 8, vrow = 16 * (F.wave & 3) + 2 * (lane >> 3);
    const bool comp = F.wave < 4;
    const bf16_t* KR = (const bf16_t*)(a->ws + WS_KK_); const bf16_t* AA = (const bf16_t*)(a->ws + WS_AA);
    const bf16_t* KN = (const bf16_t*)(a->ws + WS_KN); const bf16_t* RR = (const bf16_t*)(a->ws + WS_RR); const bf16_t* VV = (const bf16_t*)(a->ws + WS_VV);
    bf16_t* YS = (bf16_t*)(a->ws + WS_YS);
    for (int chain = F.bid; chain < 256; chain += F.G) {
        const int b = chain >> 6, h = (chain >> 1) & 31, dir = chain & 1;
        const size_t doff = (size_t)dir * M * D;
        const int hc = h * 64;
#define SCAN_M0(q) (b * TB + (dir == 0 ? 32 * (q) : ((q) < 8 ? 224 - 32 * (q) : 4576 - 32 * (q))))
        __syncthreads();
        if (!comp) {
            const int t = tid_ - 256, lrow = t >> 3, lpart = t & 7, trow = dir ? 31 - lrow : lrow;
            const bf16_t* pk_ = KR + hc + lpart * 8; const bf16_t* pn_ = KN + hc + lpart * 8; const bf16_t* pa_ = AA + doff + hc + lpart * 8;
            const bf16_t* pr_ = RR + hc + lpart * 8; const bf16_t* pv_ = VV + hc + lpart * 8; const bf16_t* pw_ = (const bf16_t*)(a->ws + WS_WDEC) + doff + hc + lpart * 8;
            float ka[8], rk[8];
#pragma unroll
            for (int i = 0; i < 8; ++i) { ka[i] = a->in[26][(size_t)jr * D + hc + lpart * 8 + i]; rk[i] = a->in[27][(size_t)jr * D + hc + lpart * 8 + i]; }
            float* BON = (float*)(a->ws + WS_BON) + (size_t)dir * M * 32 + h;
            const bf16_t* YSo = YS + (size_t)(1 - dir) * M * D + hc + lpart * 8; const float* BONo = (const float*)(a->ws + WS_BON) + (size_t)(1 - dir) * M * 32 + h;
            const bf16_t* GGp = (const bf16_t*)(a->ws + WS_GG) + hc + lpart * 8; bf16_t* PREPp = (bf16_t*)(a->ws + WS_PREP) + hc + lpart * 8;
            float lnw8[8], lnb8[8]; float sb_prev = 0.f;
#pragma unroll
            for (int i = 0; i < 8; ++i) { lnw8[i] = a->in[28][(size_t)jr * D + hc + lpart * 8 + i]; lnb8[i] = a->in[29][(size_t)jr * D + hc + lpart * 8 + i]; }
#define SCAN_PREP(m_, o_, v_, bs_) do { float sm_ = 0.f; _Pragma("unroll") for (int i_ = 0; i_ < 8; ++i_) sm_ += o_[i_]; const float mean_ = sum8(sm_) * (1.0f / 64.0f); float sq_ = 0.f; \
        _Pragma("unroll") for (int i_ = 0; i_ < 8; ++i_) { o_[i_] -= mean_; sq_ += o_[i_] * o_[i_]; } const float rs_ = rsqrtf(sum8(sq_) * (1.0f / 64.0f) + 64e-5f); \
        float g_[8], out_[8]; unpack8(*(const u32x4*)(GGp + (size_t)(m_) * D), g_); \
        _Pragma("unroll") for (int i_ = 0; i_ < 8; ++i_) out_[i_] = (o_[i_] * rs_ * lnw8[i_] + lnb8[i_] + (bs_) * v_[i_]) * g_[i_]; \
        *(u32x4*)(PREPp + (size_t)(m_) * D) = pack8(out_); } while (0)
            u32x4 gk, gn, ga, gr, gv, gw;
#define SCAN_LOAD(q) do { const size_t ro_ = ((size_t)SCAN_M0(q) + trow) * D; gk = *(const u32x4*)(pk_ + ro_); gn = *(const u32x4*)(pn_ + ro_); ga = *(const u32x4*)(pa_ + ro_); \
        gr = *(const u32x4*)(pr_ + ro_); gv = *(const u32x4*)(pv_ + ro_); gw = *(const u32x4*)(pw_ + ro_); } while (0)
#define SCAN_ST8(off_, t_) do { *(LAS f32x4*)(d_ + (off_)) = (f32x4){t_[0], t_[1], t_[2], t_[3]}; *(LAS f32x4*)(d_ + (off_) + 4) = (f32x4){t_[4], t_[5], t_[6], t_[7]}; } while (0)
#define SCAN_WRITE(bufi) do { LAS float* d_ = L + (bufi) * BUF + lrow * 384 + lpart * 8; \
        { float ta_[8], tb_[8], tc_[8]; unpack8(gk, ta_); unpack8(gn, tb_); unpack8(ga, tc_); float kd_[8], bb_[8]; \
          _Pragma("unroll") for (int i_ = 0; i_ < 8; ++i_) { kd_[i_] = ta_[i_] * (1.0f + (tc_[i_] - 1.0f) * ka[i_]); bb_[i_] = tb_[i_] * tc_[i_]; } \
          SCAN_ST8(64, kd_); SCAN_ST8(128, bb_); SCAN_ST8(192, tb_); } \
        { float ta_[8], tb_[8], tc_[8]; unpack8(gr, ta_); unpack8(gv, tb_); unpack8(gw, tc_); \
          _Pragma("unroll") for (int i_ = 0; i_ < 8; ++i_) tc_[i_] = __builtin_amdgcn_exp2f(tc_[i_]); SCAN_ST8(0, tc_); SCAN_ST8(256, ta_); SCAN_ST8(320, tb_); } } while (0)
            SCAN_LOAD(0); SCAN_WRITE(0);
            float cv[32]; CvtJob cv_job; bool cv_have = false;
            cv_job.W = nullptr; cv_job.WT = nullptr; cv_job.K = cv_job.N = 32; cv_job.mode = cv_job.row_off = cv_job.item = 0;
#pragma unroll
            for (int i = 0; i < 32; ++i) cv[i] = 0.f;
            __syncthreads();
            for (int q = 0; q < 136; ++q) {
                const int bi = q & 1;
                if (q + 1 < 136) SCAN_LOAD(q + 1);
                if (cvt_late && chain == F.bid) {
                    LAS float* scr = (LAS float*)(F.lds + (F.wave == 4 ? 116736 : 132096 + (F.wave - 5) * 8448));
                    if (cv_have) { cvt_job_store(cv_job, scr, lane_, cv); cv_have = false; }
                    const int gwl = F.bid * 4 + (F.wave - 4), ngwl = F.G * 4, nper = (CVT_N1 + ngwl - 1) / ngwl;
                    const int k = (q * nper) / 136;
                    if (k < ((q + 1) * nper) / 136) { const int it = gwl + k * ngwl; if (it < CVT_N1) { cv_job = cvt_decode(a, it, 1); cvt_job_load(cv_job, lane_, cv); cv_have = true; } } }
                if (q > 0) {
                    const LAS float* ys = L + YB0 + (bi ^ 1) * YBUF + lrow * 64 + lpart * 8; float t8[8];
                    const f32x4 y0 = *(const LAS f32x4*)ys, y1 = *(const LAS f32x4*)(ys + 4);
#pragma unroll
                    for (int e = 0; e < 4; ++e) { t8[e] = y0[e]; t8[4 + e] = y1[e]; }
                    const size_t mrow = (size_t)SCAN_M0(q - 1) + trow;
                    if (q - 1 < 72) *(u32x4*)(YS + doff + mrow * D + hc + lpart * 8) = pack8(t8);
                    else { float yp[8], vv[8]; unpack8(*(const u32x4*)(YSo + mrow * D), yp);
                        const LAS float* pv = L + (bi ^ 1) * BUF + lrow * 384 + 320 + lpart * 8; const f32x4 v0 = *(const LAS f32x4*)pv, v1 = *(const LAS f32x4*)(pv + 4);
#pragma unroll
                        for (int e = 0; e < 4; ++e) { vv[e] = v0[e]; vv[4 + e] = v1[e]; }
#pragma unroll
                        for (int e = 0; e < 8; ++e) t8[e] += yp[e];
                        const float bs = sb_prev + BONo[mrow * 32];
                        SCAN_PREP(mrow, t8, vv, bs); } }
                if (q == 72) {
                    asm volatile("s_waitcnt vmcnt(0)" ::: "memory");
                    LAS unsigned* lc = (LAS unsigned*)(F.lds + 157696);
                    if (lane_ == 0) (void)__hip_atomic_fetch_add(lc, 1u, __ATOMIC_RELAXED, __HIP_MEMORY_SCOPE_WORKGROUP);
                    if (F.wave == 4) { unsigned sp_ = 0; while (__hip_atomic_load(lc, __ATOMIC_RELAXED, __HIP_MEMORY_SCOPE_WORKGROUP) < 4u && ++sp_ < (1u << 22)) __builtin_amdgcn_s_sleep(1);
                        if (lane_ == 0) { unsigned* pc = (unsigned*)(a->ws + WS_CTL) + CW_PAIR + (jr * 128 + (chain >> 1)) * 64;
                            __builtin_amdgcn_fence(__ATOMIC_RELEASE, "agent"); asm volatile("s_waitcnt vmcnt(0)" ::: "memory");
                            (void)xb_add(pc, 1u); XB_SPIN(xb_ld(pc) < 2u, bar);
                            __builtin_amdgcn_fence(__ATOMIC_ACQUIRE, "agent"); asm volatile("s_waitcnt vmcnt(0)" ::: "memory");
                            __hip_atomic_store(lc, 0u, __ATOMIC_RELAXED, __HIP_MEMORY_SCOPE_WORKGROUP); } } }
                if (dir == 0 && q >= 73 && q < 81) {
                    const size_t mrow = (size_t)(b * TB + 32 * (q - 73) + lrow); float o8[8], y1[8], vv[8];
                    unpack8(*(const u32x4*)(YS + mrow * D + hc + lpart * 8), o8); unpack8(*(const u32x4*)(YSo + mrow * D), y1); unpack8(*(const u32x4*)(VV + mrow * D + hc + lpart * 8), vv);
#pragma unroll
                    for (int e = 0; e < 8; ++e) o8[e] += y1[e];
                    const float bs = BON[mrow * 32] + BONo[mrow * 32];
                    SCAN_PREP(mrow, o8, vv, bs); }
                {
                    const LAS float* pr = L + bi * BUF + lrow * 384 + lpart * 8; const f32x4 r0 = *(const LAS f32x4*)(pr + 256), r1 = *(const LAS f32x4*)(pr + 260), k0 = *(const LAS f32x4*)(pr + 64), k1 = *(const LAS f32x4*)(pr + 68);
                    float sb = 0.f;
#pragma unroll
                    for (int e = 0; e < 4; ++e) sb += r0[e] * k0[e] * rk[e] + r1[e] * k1[e] * rk[4 + e];
                    sb = sum8(sb);
                    if (lpart == 0 && q < 72) BON[((size_t)SCAN_M0(q) + trow) * 32] = sb;
                    sb_prev = sb; }
                if (q + 1 < 136) SCAN_WRITE(bi ^ 1);
                __syncthreads();
            }
            if (cv_have) { LAS float* scr = (LAS float*)(F.lds + (F.wave == 4 ? 116736 : 132096 + (F.wave - 5) * 8448)); cvt_job_store(cv_job, scr, lane_, cv); }
            {   const LAS float* ys = L + YB0 + 1 * YBUF + lrow * 64 + lpart * 8; float t8[8];
                const f32x4 y0 = *(const LAS f32x4*)ys, y1 = *(const LAS f32x4*)(ys + 4);
#pragma unroll
                for (int e = 0; e < 4; ++e) { t8[e] = y0[e]; t8[4 + e] = y1[e]; }
                const size_t mrow = (size_t)SCAN_M0(135) + trow; float yp[8], vv[8]; unpack8(*(const u32x4*)(YSo + mrow * D), yp);
                const LAS float* pv = L + 1 * BUF + lrow * 384 + 320 + lpart * 8; const f32x4 v0 = *(const LAS f32x4*)pv, v1 = *(const LAS f32x4*)(pv + 4);
#pragma unroll
                for (int e = 0; e < 4; ++e) { vv[e] = v0[e]; vv[4 + e] = v1[e]; }
#pragma unroll
                for (int e = 0; e < 8; ++e) t8[e] += yp[e];
                const float bs = sb_prev + BONo[mrow * 32];
                SCAN_PREP(mrow, t8, vv, bs); }
#undef SCAN_PREP
#undef SCAN_LOAD
#undef SCAN_WRITE
#undef SCAN_ST8
        } else {
            f32x2 S2[8];
#pragma unroll
            for (int i = 0; i < 8; ++i) S2[i] = (f32x2){0.f, 0.f};
            __syncthreads();
            for (int q = 0; q < 136; ++q) {
                const int bi = q & 1;
                const LAS float* base = L + bi * BUF; constexpr int stp = 384;
                const bool lead = (lane & 7) == 0; const int ystp = lead ? 64 : 0;
                LAS float* yaddr = lead ? L + YB0 + bi * YBUF + vrow : L + YB0 + 2 * YBUF + ((F.wave & 3) * 64 + lane) * 2;
#define SCAN_LD8(dst_, p_, off_) do { const f32x4 lo_ = *(const LAS f32x4*)((p_) + (off_) + li8), hi_ = *(const LAS f32x4*)((p_) + (off_) + li8 + 4); \
        dst_[0] = (f32x2){lo_[0], lo_[1]}; dst_[1] = (f32x2){lo_[2], lo_[3]}; dst_[2] = (f32x2){hi_[0], hi_[1]}; dst_[3] = (f32x2){hi_[2], hi_[3]}; } while (0)
#define PKM_LO(d, a, b) "v_pk_mul_f32 " d ", " a ", " b " op_sel_hi:[1,0]\n\t"
#define PKM_HI(d, a, b) "v_pk_mul_f32 " d ", " a ", " b " op_sel:[0,1] op_sel_hi:[1,1]\n\t"
#define PKF_LO(d, a, b, c) "v_pk_fma_f32 " d ", " a ", " b ", " c " op_sel_hi:[1,0,1]\n\t"
#define PKF_HI(d, a, b, c) "v_pk_fma_f32 " d ", " a ", " b ", " c " op_sel:[0,1,0] op_sel_hi:[1,1,1]\n\t"
#define PKN_LO(d, a, b, c) "v_pk_fma_f32 " d ", " a ", " b ", " c " op_sel_hi:[1,0,1] neg_lo:[1,0,0] neg_hi:[1,0,0]\n\t"
#define PKN_HI(d, a, b, c) "v_pk_fma_f32 " d ", " a ", " b ", " c " op_sel:[0,1,0] op_sel_hi:[1,1,1] neg_lo:[1,0,0] neg_hi:[1,0,0]\n\t"
#define DPPA(r, ctl) "v_add_f32_dpp " r ", " r ", " r " " ctl " row_mask:0xf bank_mask:0xf\n\t"
#define DPP_1 "quad_perm:[1,0,3,2]"
#define DPP_2 "quad_perm:[2,3,0,1]"
#define DPP_3 "row_half_mirror"
#define SA_SUM(pk_, t_, v_, d_) asm volatile( \
        PKM_LO("%2", "%10", "%11") PKM_HI("%3", "%10", "%11") DPPA("%0", DPP_1) DPPA("%1", DPP_1) PKM_LO("%4", "%10", "%12") DPPA("%0", DPP_2) DPPA("%1", DPP_2) PKM_HI("%5", "%10", "%12") \
        DPPA("%0", DPP_3) DPPA("%1", DPP_3) PKM_LO("%6", "%10", "%13") PKM_HI("%7", "%10", "%13") PKM_LO("%8", "%10", "%14") PKM_HI("%9", "%10", "%14") \
        : "+v"(pk_.x), "+v"(pk_.y), "=&v"(t_[0]), "=&v"(t_[1]), "=&v"(t_[2]), "=&v"(t_[3]), "=&v"(t_[4]), "=&v"(t_[5]), "=&v"(t_[6]), "=&v"(t_[7]) \
        : "v"(v_), "v"(d_[0]), "v"(d_[1]), "v"(d_[2]), "v"(d_[3]))
#define UPD(S_, t_, pk_, b_, w_) asm volatile( \
        PKN_LO("%8", "%16", "%17", "%8") PKN_HI("%9", "%16", "%17", "%9") PKN_LO("%10", "%16", "%18", "%10") PKN_HI("%11", "%16", "%18", "%11") \
        PKN_LO("%12", "%16", "%19", "%12") PKN_HI("%13", "%16", "%19", "%13") PKN_LO("%14", "%16", "%20", "%14") PKN_HI("%15", "%16", "%20", "%15") \
        PKF_LO("%0", "%0", "%21", "%8") PKF_HI("%1", "%1", "%21", "%9") PKF_LO("%2", "%2", "%22", "%10") PKF_HI("%3", "%3", "%22", "%11") \
        PKF_LO("%4", "%4", "%23", "%12") PKF_HI("%5", "%5", "%23", "%13") PKF_LO("%6", "%6", "%24", "%14") PKF_HI("%7", "%7", "%24", "%15") \
        : "+v"(S_[0]), "+v"(S_[1]), "+v"(S_[2]), "+v"(S_[3]), "+v"(S_[4]), "+v"(S_[5]), "+v"(S_[6]), "+v"(S_[7]), \
          "+v"(t_[0]), "+v"(t_[1]), "+v"(t_[2]), "+v"(t_[3]), "+v"(t_[4]), "+v"(t_[5]), "+v"(t_[6]), "+v"(t_[7]) \
        : "v"(pk_), "v"(b_[0]), "v"(b_[1]), "v"(b_[2]), "v"(b_[3]), "v"(w_[0]), "v"(w_[1]), "v"(w_[2]), "v"(w_[3]))
#define DOT8(o_, o1_, S_, x_) asm volatile( \
        PKM_LO("%0", "%2", "%10") PKM_HI("%1", "%3", "%10") PKF_LO("%0", "%4", "%11", "%0") PKF_HI("%1", "%5", "%11", "%1") PKF_LO("%0", "%6", "%12", "%0") PKF_HI("%1", "%7", "%12", "%1") \
        PKF_LO("%0", "%8", "%13", "%0") PKF_HI("%1", "%9", "%13", "%1") "v_pk_add_f32 %0, %0, %1\n\t" \
        : "=&v"(o_), "=&v"(o1_) : "v"(S_[0]), "v"(S_[1]), "v"(S_[2]), "v"(S_[3]), "v"(S_[4]), "v"(S_[5]), "v"(S_[6]), "v"(S_[7]), "v"(x_[0]), "v"(x_[1]), "v"(x_[2]), "v"(x_[3]))
#define YSUM(yk_, o_, o1_, S_, x_) asm volatile( \
        PKM_LO("%2", "%4", "%12") PKM_HI("%3", "%5", "%12") DPPA("%0", DPP_1) DPPA("%1", DPP_1) PKF_LO("%2", "%6", "%13", "%2") DPPA("%0", DPP_2) DPPA("%1", DPP_2) PKF_HI("%3", "%7", "%13", "%3") \
        DPPA("%0", DPP_3) DPPA("%1", DPP_3) PKF_LO("%2", "%8", "%14", "%2") PKF_HI("%3", "%9", "%14", "%3") PKF_LO("%2", "%10", "%15", "%2") PKF_HI("%3", "%11", "%15", "%3") "v_pk_add_f32 %2, %2, %3\n\t" \
        : "+v"(yk_.x), "+v"(yk_.y), "=&v"(o_), "=&v"(o1_) : "v"(S_[0]), "v"(S_[1]), "v"(S_[2]), "v"(S_[3]), "v"(S_[4]), "v"(S_[5]), "v"(S_[6]), "v"(S_[7]), "v"(x_[0]), "v"(x_[1]), "v"(x_[2]), "v"(x_[3]))
                f32x2 nw[4], nd[4], nb[4], nn[4], nr[4]; f32x2 nv2;
                SCAN_LD8(nw, base, 0); SCAN_LD8(nd, base, 64); SCAN_LD8(nb, base, 128); SCAN_LD8(nn, base, 192); SCAN_LD8(nr, base, 256); nv2 = *(const LAS f32x2*)(base + 320 + vrow);
                f32x2 pk, pk1; DOT8(pk, pk1, S2, nn);
#pragma unroll 8
                for (int s = 0; s < 32; ++s) {
                    f32x2 w8[4], d8[4], b8[4], r8[4]; const f32x2 v2 = nv2;
#pragma unroll
                    for (int c = 0; c < 4; ++c) { w8[c] = nw[c]; d8[c] = nd[c]; b8[c] = nb[c]; r8[c] = nr[c]; }
                    { const LAS float* p = base + (s + 1) * stp;
                      SCAN_LD8(nw, p, 0); SCAN_LD8(nd, p, 64); SCAN_LD8(nb, p, 128); SCAN_LD8(nn, p, 192); SCAN_LD8(nr, p, 256); nv2 = *(const LAS f32x2*)(p + 320 + vrow); }
                    f32x2 t8[8];
                    SA_SUM(pk, t8, v2, d8);
                    UPD(S2, t8, pk, b8, w8);
                    f32x2 yk, yk1; DOT8(yk, yk1, S2, r8);
                    f32x2 npk, npk1; YSUM(yk, npk, npk1, S2, nn);
                    *(LAS f32x2*)(yaddr + s * ystp) = yk;
                    pk = npk;
                }
#undef PKM_LO
#undef PKM_HI
#undef PKF_LO
#undef PKF_HI
#undef PKN_LO
#undef PKN_HI
#undef DPPA
#undef SA_SUM
#undef UPD
#undef DOT8
#undef YSUM
#undef SCAN_LD8
                __syncthreads();
            }
        }
        __syncthreads();
#undef SCAN_M0
    }
}

__device__ __forceinline__ void outprep_phase(const Frame F, KArgs* a, int jr) {
    const int lane_ = lane_opaque(), tid_ = F.wave * 64 + lane_; (void)tid_; (void)lane_;
    const bf16_t* YS = (const bf16_t*)(a->ws + WS_YS); const float* BON = (const float*)(a->ws + WS_BON);
    const bf16_t* VV = (const bf16_t*)(a->ws + WS_VV); const bf16_t* GG = (const bf16_t*)(a->ws + WS_GG);
    bf16_t* PREP = (bf16_t*)(a->ws + WS_PREP);
    const float* lw = a->in[28] + (size_t)jr * D; const float* lb = a->in[29] + (size_t)jr * D;
    for (int m = F.bid * NWAVES + F.wave; m < M; m += F.G * NWAVES) {
#pragma unroll
        for (int q = 0; q < 4; ++q) { const int e0 = 512 * q + 8 * lane_; const size_t ro = (size_t)m * D + e0;
            float y0[8], y1[8], o[8];
            unpack8(*(const u32x4*)(YS + ro), y0); unpack8(*(const u32x4*)(YS + (size_t)M * D + ro), y1);
            float sm = 0.f;
#pragma unroll
            for (int i = 0; i < 8; ++i) { o[i] = y0[i] + y1[i]; sm += o[i]; }
            const float mean = sum8(sm) * (1.0f / 64.0f);
            float sq = 0.f;
#pragma unroll
            for (int i = 0; i < 8; ++i) { o[i] -= mean; sq += o[i] * o[i]; }
            const float rs = rsqrtf(sum8(sq) * (1.0f / 64.0f) + 64e-5f);
            float v[8], g[8];
            unpack8(*(const u32x4*)(VV + ro), v); unpack8(*(const u32x4*)(GG + ro), g);
            const int hd = e0 >> 6;
            const float bs = BON[(size_t)m * 32 + hd] + BON[(size_t)M * 32 + (size_t)m * 32 + hd];
            float out[8];
#pragma unroll
            for (int i = 0; i < 8; ++i) out[i] = (o[i] * rs * lw[e0 + i] + lb[e0 + i] + bs * v[i]) * g[i];
            *(u32x4*)(PREP + ro) = pack8(out); }
    }
}

__device__ __forceinline__ float attn_score_bound(KArgs* a, int ja) {
    const int ln = lane_opaque(); float mq = fmaxf(fabsf(a->in[12][ja * 128 + ln]), fabsf(a->in[12][ja * 128 + 64 + ln])), mk = fmaxf(fabsf(a->in[13][ja * 128 + ln]), fabsf(a->in[13][ja * 128 + 64 + ln]));
#pragma unroll
    for (int o = 1; o < 64; o <<= 1) { mq = fmaxf(mq, __shfl_xor(mq, o)); mk = fmaxf(mk, __shfl_xor(mk, o)); }
    return __builtin_bit_cast(float, __builtin_amdgcn_readfirstlane(__builtin_bit_cast(int, 128.0f * 1.02f * mq * mk)));
}
__device__ __forceinline__ void attention_phase(const Frame F, KArgs* a, int ja) {
    const attn::bf16* Q = (const attn::bf16*)(a->ws + WS_Q); const attn::bf16* K = (const attn::bf16*)(a->ws + WS_K); const attn::bf16* V = (const attn::bf16*)(a->ws + WS_V);
    attn::bf16* O = (attn::bf16*)(a->ws + WS_O);
    const float mfix = attn_score_bound(a, ja);
    const bool fixm = mfix * attn::SCALE <= 30.0f;
    for (int u = F.bid; u < 1024 + 64; u += F.G) {
        size_t qoff, koff; int seq;
        if (u < 1024) { const int c = u & 255, i = u >> 8, grp = (c & 7) >> 1, member = (c & 1) * 32 + (c >> 3), bk = i * 4 + grp, b = bk >> 2, kvh = bk & 3, hq = kvh * 4 + (member >> 4), qb = member & 15;
            qoff = (size_t)(b * TB + CTXL + qb * 256) * 2048 + hq * 128; koff = (size_t)b * TB * 512 + kvh * 128; seq = TB; }
        else { const int cu = u - 1024, b = cu >> 4, hq = cu & 15, kvh = hq >> 2;
            qoff = (size_t)(b * TB) * 2048 + hq * 128; koff = (size_t)b * TB * 512 + kvh * 128; seq = CTXL; }
        if (fixm) attn::attn_dense_body<attn::bf16, true>(Q + qoff, K + koff, V + koff, O + qoff, seq, (char*)F.ldsg, F.wave, mfix);
        else attn::attn_dense_body<attn::bf16, false>(Q + qoff, K + koff, V + koff, O + qoff, seq, (char*)F.ldsg, F.wave);
        __syncthreads();
    }
}

#ifndef EN_P0
#define EN_P0 1
#endif
#ifndef EN_THIN
#define EN_THIN 1
#endif
#ifndef EN_QKN
#define EN_QKN 1
#endif
#ifndef EN_ATT
#define EN_ATT 1
#endif
#ifndef EN_MIX
#define EN_MIX 1
#endif
#ifndef EN_SCAN
#define EN_SCAN 1
#endif
#ifndef EN_OPREP
#define EN_OPREP 1
#endif
#ifndef EN_FFN
#define EN_FFN 1
#endif
#ifndef EN_GQKV
#define EN_GQKV 1
#endif
#ifndef EN_GWO
#define EN_GWO 1
#endif
#ifndef EN_RW1
#define EN_RW1 1
#endif
#ifndef EN_RW2
#define EN_RW2 1
#endif
__device__ __forceinline__ KArgs* opaque_k(KArgs* p) { asm volatile("" : "+s"(p)); return p; }
#ifndef DBG_STOP
#define DBG_STOP -1
#endif
__device__ __forceinline__ Frame fresh(const Frame& F) { Frame R = F; asm volatile("" : "+s"(R.bid), "+s"(R.G), "+s"(R.wave)); return R; }
#ifndef GEMM_ALIGN
#define GEMM_ALIGN true
#define GEMM_SP2 true
#endif
#ifndef RW2_ALIGN
#define RW2_ALIGN true
#define RW2_SP2 true
#endif
#ifndef RW1_ALIGN
#define RW1_ALIGN true
#define RW1_SP2 true
#endif
#ifndef REP_THIN
#define REP_THIN 1
#endif
#ifndef REP_OG
#define REP_OG 1
#endif
#ifndef REP_EW
#define REP_EW 1
#endif
#ifndef REP_FFN1
#define REP_FFN1 1
#endif
#ifndef REP_FFN2
#define REP_FFN2 1
#endif
#ifndef REP_P0
#define REP_P0 1
#endif
#ifndef REP_SCAN
#define REP_SCAN 1
#endif
#ifndef REP_ATT
#define REP_ATT 1
#endif
#ifndef REP_RW1
#define REP_RW1 1
#endif
constexpr int NPHASE = 50;
constexpr int STOP_PHASE = (DBG_STOP >= 0) ? DBG_STOP : NPHASE - 1;
__global__ void __launch_bounds__(NTHR, 2) fwd_kernel(Args args) {
    extern __shared__ __attribute__((aligned(16))) unsigned char lds[];
    Frame F;
    F.lds = (LAS unsigned char*)lds; F.ldsg = lds;
    F.wave = __builtin_amdgcn_readfirstlane((int)threadIdx.x >> 6);
    F.G = gridDim.x; F.bid = blockIdx.x;
    for (int u = threadIdx.x; u < (LDS_BYTES - LDSCTL_OFF) / 4; u += NTHR) ((LAS unsigned*)(F.lds + LDSCTL_OFF))[u] = 0u;
    __syncthreads();
    KArgs* const kap = (KArgs*)__builtin_amdgcn_kernarg_segment_ptr();
    XcdBarrier bar = xcd_barrier_post((unsigned*)(kap->ws + WS_CTL) + CW_BAR + kap->li * XCD_BAR_WORDS, (volatile LAS unsigned*)(F.lds + MISC_OFF) + 8);
#define KA (opaque_k(kap))
#define ws (KA->ws)
#define IN(k) ((k) <= STOP_PHASE)
#define SEAM(k) do { if (IN(k) && IN((k) + 1)) { XcdBarrier bb_ = bar; asm volatile("" : "+s"(bb_.x), "+s"(bb_.bar)); xcd_barrier(bb_, fresh(F).wave == 0 && lane_opaque() == 0); } } while (0)
#define Yb ((bf16_t*)(ws + WS_Y))
#define ACTb ((bf16_t*)(ws + WS_ACT))
#define OUTb ((bf16_t*)(ws + WS_OUT))
#define BAR_NOW() do { XcdBarrier bb_ = bar; asm volatile("" : "+s"(bb_.x), "+s"(bb_.bar)); xcd_barrier(bb_, fresh(F).wave == 0 && lane_opaque() == 0); } while (0)
#define FFN_HALF(pk, lh, FINAL, tl, ts, tw, tnl, tns) do { \
    for (int rep_ = 0; rep_ < REP_FFN1; ++rep_) { if (rep_) __syncthreads(); \
    if (EN_FFN && IN(pk)) { const Frame Ff_ = fresh(F); const bf16_t* w1_ = (const bf16_t*)(ws + WS_WB) + (size_t)(lh) * (E_F1 + E_F2); \
        pg8::Gemm g_{Yb, w1_, D}; EpiSwiGLU E_{ACTb}; \
        if (FINAL) { LatentOrder S_; S_.init_lat(2 * FF, Ff_.G, Ff_.bid); pg8::gemm_phase<EpiSwiGLU, LatentOrder, pg8::Gemm, GEMM_ALIGN, GEMM_SP2>(Ff_.lds, g_, S_, E_, Ff_.wave); } \
        else { Ffn1Order S_{Ff_.G, Ff_.bid, (unsigned*)(ws + WS_CTL) + CW_FC + (lh) * 64}; pg8::gemm_phase<EpiSwiGLU, Ffn1Order, pg8::Gemm, true, GEMM_SP2>(Ff_.lds, g_, S_, E_, Ff_.wave); \
            if (rep_ == REP_FFN1 - 1 && Ff_.G == 256 && Ff_.bid >= 176 && Ff_.bid < 176 + NCTXWG) {     \
                const Frame Fc_ = fresh(F); XcdBarrier bg_ = bar; asm volatile("" : "+s"(bg_.bar)); \
                asm volatile("s_waitcnt vmcnt(0)" ::: "memory"); __syncthreads(); \
                if (Fc_.wave == 0 && lane_opaque() == 0) { unsigned* pc_ = (unsigned*)(ws + WS_CTL) + CW_FC + (lh) * 64; XB_SPIN(xb_ld(pc_) < 176u, bg_.bar); __builtin_amdgcn_fence(__ATOMIC_ACQUIRE, "agent"); asm volatile("s_waitcnt vmcnt(0)" ::: "memory"); } \
                __syncthreads(); \
                const bf16_t* w2c_ = (const bf16_t*)(ws + WS_WB) + (size_t)(lh) * (E_F1 + E_F2) + E_F1; \
                GemmCtxSplit gc_{ACTb, w2c_, FF}; CtxOrder2 Sc_{Fc_.bid - 176}; EpiCtxPart Ec_{(float*)(ws + WS_PART)}; \
                pg8::gemm_phase<EpiCtxPart, CtxOrder2, GemmCtxSplit, GEMM_ALIGN, GEMM_SP2>(Fc_.lds, gc_, Sc_, Ec_, Fc_.wave); } } } } \
    SEAM(pk); \
    for (int rep_ = 0; rep_ < REP_FFN2; ++rep_) { if (rep_) __syncthreads(); \
    if (EN_FFN && IN((pk) + 1)) { const Frame Ff_ = fresh(F); const bf16_t* w2_ = (const bf16_t*)(ws + WS_WB) + (size_t)(lh) * (E_F1 + E_F2) + E_F1; \
        pg8::Gemm g_{ACTb, w2_, FF}; LatentOrder S_; S_.init_lat(D, Ff_.G, Ff_.bid); EpiPlain E_{OUTb, D}; \
        pg8::gemm_phase<EpiPlain, LatentOrder, pg8::Gemm, GEMM_ALIGN, GEMM_SP2>(Ff_.lds, g_, S_, E_, Ff_.wave); } } \
    SEAM((pk) + 1); \
    if (IN((pk) + 2)) { const Frame Ff_ = fresh(F); \
        if (FINAL) thin_phase<2, 1, 0>(Ff_, KA, tl, ts, tw, tnl, tns); \
        else { for (int rt_ = 1; rt_ < REP_THIN; ++rt_) thin_phase<1, 1, 0>(Ff_, KA, tl, ts, 0.f, tnl, tns); thin_phase<1, 1, 0>(Ff_, KA, tl, ts, tw, tnl, tns); thin_phase<1, 2>(fresh(F), KA, tl, ts, tw, tnl, tns); } \
        } \
    SEAM((pk) + 2); } while (0)

    for (int rep_ = 0; rep_ < REP_P0; ++rep_) { if (rep_) __syncthreads(); if (EN_P0 && IN(0)) p0a_phase(fresh(F), KA); }
    SEAM(0);
    if (EN_THIN && IN(1)) thin_phase<0, 0>(fresh(F), KA, 0, 0, 0.f, 0, 0);
    SEAM(1);
    for (int lp = 0; lp < 2; ++lp) {
        const int pb = 2 + 24 * lp, la = 2 * lp, lr = 2 * lp + 1;
        FFN_HALF(pb + 0, la * 2 + 0, 0, la, 0, 0.5f, la, 1);
        for (int rep_ = 0; rep_ < REP_OG; ++rep_) { if (rep_) __syncthreads();
        if (EN_GQKV && IN(pb + 3)) { const Frame Ff = fresh(F); const bf16_t* wq = (const bf16_t*)(ws + WS_WA) + (size_t)lp * (E_QKV + E_SQ);
            pg8::Gemm g{Yb, wq, D}; pg8::StaticOrder S; S.init(M, 3072, Ff.G, Ff.bid); EpiQKVN E{ws, KA->in[12] + lp * 128, KA->in[13] + lp * 128, (LAS float*)(Ff.lds + 132096), attn_score_bound(KA, lp) * attn::SCALE <= 30.0f ? attn::SCALE * 1.4426950408889634f : 1.0f};
            pg8::gemm_phase<EpiQKVN, pg8::StaticOrder, pg8::Gemm, true, GEMM_SP2>(Ff.lds, g, S, E, Ff.wave); } }
        SEAM(pb + 3);
        for (int rep_ = 0; rep_ < REP_ATT; ++rep_) { if (rep_) __syncthreads(); if (EN_ATT && IN(pb + 5)) attention_phase(fresh(F), KA, lp); }
        SEAM(pb + 5);
        for (int rep_ = 0; rep_ < REP_OG; ++rep_) { if (rep_) __syncthreads();
        if (EN_GWO && IN(pb + 6)) { const Frame Ff = fresh(F); const bf16_t* wo = (const bf16_t*)(ws + WS_WA) + (size_t)lp * (E_QKV + E_SQ) + E_QKV;
            pg8::Gemm g{(const bf16_t*)(ws + WS_O), wo, D}; LatentOrder S; S.init_lat(D, Ff.G, Ff.bid); EpiPlain E{OUTb, D};
            pg8::gemm_phase<EpiPlain, LatentOrder, pg8::Gemm, GEMM_ALIGN, GEMM_SP2>(Ff.lds, g, S, E, Ff.wave); } }
        SEAM(pb + 6);
        if (EN_THIN && IN(pb + 7)) { const Frame Ff = fresh(F);
            if (Ff.bid < 32) { const bf16_t* wo = (const bf16_t*)(ws + WS_WA) + (size_t)lp * (E_QKV + E_SQ) + E_QKV;
                pg8::Gemm g{(const bf16_t*)(ws + WS_O), wo, D}; CtxOrder8 S{Ff.bid}; EpiPlain E{OUTb, D};
                pg8::gemm_phase<EpiPlain, CtxOrder8, pg8::Gemm, GEMM_ALIGN, GEMM_SP2>(Ff.lds, g, S, E, Ff.wave);
                { XcdBarrier bg = bar; asm volatile("" : "+s"(bg.bar)); ctx_mixer_thin(fresh(F), KA, bg.bar, 8 + lp, la, 1, 1.0f, la, 2); } }
            else thin_phase<1, 1, 32, 0>(Ff, KA, la, 1, 1.0f, la, 2); }
        SEAM(pb + 7);
        FFN_HALF(pb + 8, la * 2 + 1, 0, la, 2, 0.5f, lr, 0);
        FFN_HALF(pb + 11, lr * 2 + 0, 0, lr, 0, 0.5f, lr, 1);
        for (int rep_ = 0; rep_ < REP_EW; ++rep_) { if (EN_MIX && IN(pb + 14)) mixes_phase(fresh(F), KA, lp); }
        SEAM(pb + 14);
#ifdef DBG_DOUBLE_BAR
        SEAM(pb + 14);
#endif
#define rw1 ((const bf16_t*)(ws + WS_WR) + (size_t)lp * (E_RW1 + E_RW2 + E_SQ))
        for (int rep_ = 0; rep_ < REP_OG; ++rep_) { if (rep_) __syncthreads();
        if (EN_RW1 && IN(pb + 15)) { const Frame Ff = fresh(F); GemmRw1 g{(const bf16_t*)(ws + WS_MIX6), rw1, D}; pg8::StaticOrder S; S.init(M, 6912, Ff.G, Ff.bid);
            EpiRw1 E{ws, KA->in[25] + (size_t)lp * D};
            pg8::gemm_phase<EpiRw1, pg8::StaticOrder, GemmRw1, RW1_ALIGN, RW1_SP2>(Ff.lds, g, S, E, Ff.wave); } }
        SEAM(pb + 15);
        for (int rep_ = 0; rep_ < REP_OG; ++rep_) { if (rep_) __syncthreads();
        if (EN_RW2 && IN(pb + 16)) {
            { const Frame Ff = fresh(F); int k2_ = 256; asm volatile("" : "+s"(k2_));
              GemmRw2 g{ws, rw1 + E_RW1, 256, k2_}; pg8::StaticOrder S; S.init(M, 2048, Ff.G, Ff.bid);
              EpiRw2 E{ws, KA->in[19] + (size_t)lp * 2 * D, KA->in[22] + (size_t)lp * 2 * D, WS_AA};
              pg8::gemm_phase<EpiRw2, pg8::StaticOrder, GemmRw2, RW2_ALIGN, RW2_SP2>(Ff.lds, g, S, E, Ff.wave); }
            __syncthreads();
            { const Frame Ff = fresh(F); int k3_ = 128; asm volatile("" : "+s"(k3_));
              GemmRw2 g{ws, rw1 + E_RW1, 256, k3_}; Rw2WAOrder S; S.init(M, 8192, Ff.G, Ff.G - 1 - Ff.bid);
              EpiRw2 E{ws, KA->in[19] + (size_t)lp * 2 * D, KA->in[22] + (size_t)lp * 2 * D, WS_AA};
              pg8::gemm_phase<EpiRw2, Rw2WAOrder, GemmRw2, RW2_ALIGN, RW2_SP2>(Ff.lds, g, S, E, Ff.wave); } } }
        #ifdef DBG_RW2_TWICE
        __syncthreads();
        if (EN_RW2 && IN(pb + 16)) { const Frame Ff = fresh(F); int k2_ = 256; asm volatile("" : "+s"(k2_));     GemmRw2 g{ws, rw1 + E_RW1, k2_}; pg8::StaticOrder S; S.init(M, 10240, Ff.G, Ff.bid);
            EpiRw2 E{ws,
                     KA->in[19] + (size_t)lp * 2 * D, KA->in[22] + (size_t)lp * 2 * D, WS_END};
            pg8::gemm_phase<EpiRw2, pg8::StaticOrder, GemmRw2, RW2_ALIGN, RW2_SP2>(Ff.lds, g, S, E, Ff.wave); }
#endif
        SEAM(pb + 16);
        for (int rep_ = 0; rep_ < REP_SCAN; ++rep_) { if (rep_) __syncthreads(); if (EN_SCAN && IN(pb + 17)) { XcdBarrier bg = bar; asm volatile("" : "+s"(bg.bar)); scan_phase(fresh(F), KA, lp, lp == 0 && rep_ == 0, bg.bar); } }
        SEAM(pb + 17);
        for (int rep_ = 0; rep_ < REP_OG; ++rep_) { if (rep_) __syncthreads();
        if (EN_GWO && IN(pb + 19)) { const Frame Ff = fresh(F); pg8::Gemm g{(const bf16_t*)(ws + WS_PREP), rw1 + E_RW1 + E_RW2, D}; LatentOrder S; S.init_lat(D, Ff.G, Ff.bid); EpiPlain E{OUTb, D};
            pg8::gemm_phase<EpiPlain, LatentOrder, pg8::Gemm, GEMM_ALIGN, GEMM_SP2>(Ff.lds, g, S, E, Ff.wave); } }
        SEAM(pb + 19);
        if (EN_THIN && IN(pb + 20)) { const Frame Ff = fresh(F);
            if (lp == 1) thin_phase<1, 1, 0>(Ff, KA, lr, 1, 1.0f, lr, 2);
            else if (Ff.bid < 32) { pg8::Gemm g{(const bf16_t*)(ws + WS_PREP), rw1 + E_RW1 + E_RW2, D}; CtxOrder8 S{Ff.bid}; EpiPlain E{OUTb, D};
                pg8::gemm_phase<EpiPlain, CtxOrder8, pg8::Gemm, GEMM_ALIGN, GEMM_SP2>(Ff.lds, g, S, E, Ff.wave);
                { XcdBarrier bg = bar; asm volatile("" : "+s"(bg.bar)); ctx_mixer_thin(fresh(F), KA, bg.bar, 10 + lp, lr, 1, 1.0f, lr, 2); } }
            else thin_phase<1, 1, 32, 0>(Ff, KA, lr, 1, 1.0f, lr, 2); }
        SEAM(pb + 20);
        if (lp == 1) FFN_HALF(pb + 21, lr * 2 + 1, 1, lr, 2, 0.5f, 0, 0); else FFN_HALF(pb + 21, lr * 2 + 1, 0, lr, 2, 0.5f, lr + 1, 0);
    }
    if (DBG_STOP >= 0) { xcd_barrier(bar, fresh(F).wave == 0 && lane_opaque() == 0); copyout_phase(fresh(F), KA); }
#undef IN
#undef SEAM
#undef FFN_HALF
#undef BAR_NOW
#undef rw1
#undef ws
#undef KA
#undef Yb
#undef ACTb
#undef OUTb
}

extern "C" void kernel_launch(void* const* d_in, const int* in_sizes, int n_in, void* d_out, int out_size, void* d_ws, size_t ws_size, hipStream_t stream) {
    static int grid = 0;
    if (grid == 0) {
        if (n_in != 30 || in_sizes[0] != NB * SEQ * D || out_size != NB * SEQ * D || ws_size < WS_END) {
            fprintf(stderr, "kernel_launch: shape mismatch: n_in %d in0 %d out %d ws %zu (need >= %zu)\n", n_in, n_in > 0 ? in_sizes[0] : -1, out_size, ws_size, (size_t)WS_END); grid = -1; return; }
        int dev = 0, cus = 0, per_cu = 0;
        if (hipGetDevice(&dev) != hipSuccess || hipDeviceGetAttribute(&cus, hipDeviceAttributeMultiprocessorCount, dev) != hipSuccess) { fprintf(stderr, "kernel_launch: device query failed\n"); grid = -1; return; }
        if (hipFuncSetAttribute((const void*)fwd_kernel, hipFuncAttributeMaxDynamicSharedMemorySize, LDS_BYTES) != hipSuccess) { fprintf(stderr, "kernel_launch: hipFuncSetAttribute failed\n"); grid = -1; return; }
        if (hipOccupancyMaxActiveBlocksPerMultiprocessor(&per_cu, (const void*)fwd_kernel, NTHR, LDS_BYTES) != hipSuccess || per_cu < 1) { fprintf(stderr, "kernel_launch: occupancy query says %d blocks per CU\n", per_cu); }
        (void)hipGetLastError();
        grid = cus;
        if (grid > 256) grid = 256;
    }
    if (grid < 0) return;
    if (hipMemsetAsync((char*)d_ws + WS_CTL, 0, CTL_ZERO_BYTES, stream) != hipSuccess) { fprintf(stderr, "kernel_launch: memset failed\n"); return; }
    Args a{};
    for (int i = 0; i < 30; ++i) a.in[i] = (const float*)d_in[i];
    a.out = (float*)d_out; a.ws = (unsigned char*)d_ws;
    a.ph_lo = 0; a.ph_hi = NPHASE; a.li = 0; a.dbg = 0;
    hipLaunchKernelGGL(fwd_kernel, dim3(grid), dim3(NTHR), LDS_BYTES, stream, a);
    const hipError_t le = hipPeekAtLastError();
    if (le != hipSuccess) fprintf(stderr, "kernel_launch: launch failed: %s\n", hipGetErrorName(le));
}
```

```cpp
#include <hip/hip_runtime.h>
#include <cstdio>
#include <cstdint>
#include <cmath>
__device__ __forceinline__ int lane_opaque() { int l; asm volatile("v_mbcnt_lo_u32_b32 %0, -1, 0\n\tv_mbcnt_hi_u32_b32 %0, -1, %0" : "=v"(l)); return l; }
namespace pg8 {
#define PG8_LAS __attribute__((address_space(3)))
typedef unsigned short bf16_t;
typedef short bf16x8 __attribute__((ext_vector_type(8)));
typedef float f32x4 __attribute__((ext_vector_type(4)));
typedef unsigned u32x4 __attribute__((ext_vector_type(4)));
constexpr int BM = 256, BK = 64, HALF = 128, HTB = HALF * BK * 2  , STAGE_BYTES = 8 * HTB, NXCD = 8, WGM = 8;

__host__ __device__ __forceinline__ int lds_byte(int r, int c) { const int st = (r >> 4) * 2 + (c >> 5), rr = r & 15, cc = c & 31, ob = rr * 64 + cc * 2; return st * 1024 + (ob ^ (((ob >> 9) & 1) << 5)); }
__host__ __device__ __forceinline__ void stage_rc(int b, int& R, int& C) { const int st = b / 1024, sb = b % 1024, swz = sb ^ (((sb >> 9) & 1) << 5); R = (st >> 1) * 16 + swz / 64; C = (st & 1) * 32 + (swz % 64) / 2; }
__host__ __device__ __forceinline__ int perm32(int rho) { const int n = rho >> 4, i = rho & 15; return 8 * (i >> 2) + 4 * n + (i & 3); }

struct Unit { int pm, pn; };
struct Gemm { const bf16_t* A; const bf16_t* Bt; int K;
    __device__ __forceinline__ const char* a_tile(const Unit& u) const { return (const char*)A + (size_t)u.pm * (size_t)(BM * 2) * K; }
    __device__ __forceinline__ const char* b_tile(const Unit& u) const { return (const char*)Bt + (size_t)u.pn * (size_t)(BM * 2) * K; }
    __device__ __forceinline__ int klen() const { return K; } };

struct StaticOrder {
    int nM, nN, nwg, G, c;
    __host__ __device__ void init(int M, int N, int G_, int c_) { nM = M / BM; nN = N / BM; nwg = nM * nN; G = G_; c = c_; }
    __host__ __device__ bool next(int i, Unit& u) const {
        const long L = (long)i * G + c; if (L >= nwg) return false;
        int wgid = (int)L; { const int q = nwg / NXCD, r = nwg % NXCD, xcd = wgid % NXCD, off = wgid / NXCD; wgid = (xcd < r ? xcd * (q + 1) : r * (q + 1) + (xcd - r) * q) + off; }
        const int nig = WGM * nN, gid = wgid / nig, fm = gid * WGM, gsz = (nM - fm) < WGM ? (nM - fm) : WGM;
        u.pm = fm + ((wgid % nig) % gsz); u.pn = (wgid % nig) / gsz; return true;
    }
    __device__ __forceinline__ void a_ready(const Unit&) const {}
    __device__ __forceinline__ void done(const Unit&) const {}
};

typedef __bf16 bf16x2_cv __attribute__((ext_vector_type(2)));
typedef float f32x2_cv __attribute__((ext_vector_type(2)));
__device__ __forceinline__ unsigned cvt_pk_bf16(float lo, float hi) { const f32x2_cv v = {lo, hi}; const bf16x2_cv b = __builtin_convertvector(v, bf16x2_cv); return __builtin_bit_cast(unsigned, b); }

template <class Epi, class Sched, class GT, bool ALIGN_EPI = false, bool SP2 = false>
__device__ __forceinline__ void gemm_phase(PG8_LAS unsigned char* lds, const GT g, const Sched& S, const Epi& E, const int wid  ) {
    const int lane = lane_opaque(), tid = wid * 64 + lane, wr = wid >> 2, wc = wid & 3, fr = lane & 15, fq = lane >> 4;
    const int K = g.K, nt = g.klen() / BK;
    unsigned voffA[2], voffB[2];
#pragma unroll
    for (int i = 0; i < 2; ++i) { int R, C; stage_rc(tid * 16 + i * 8192, R, C); const int Rb = Epi::PERM ? ((R & ~31) + perm32(R & 31)) : R;
        voffA[i] = (unsigned)(R * K + C) * 2u; voffB[i] = (unsigned)(Rb * K + C) * 2u; }
    asm volatile("" : "+v"(voffA[0]), "+v"(voffA[1]), "+v"(voffB[0]), "+v"(voffB[1]));
    const size_t kstep = (size_t)(BK * 2);
    const size_t hstep = (size_t)HALF * K * 2;
    const unsigned ldsw = (unsigned)wid * 1024u;
    const int aoff = lds_byte(wr * 64 + fr, fq * 8), boff = lds_byte(wc * 32 + fr, fq * 8);
#define PG8_SA(b, h) (((b) * 2 + (h)) * HTB)
#define PG8_SB(b, h) ((4 + (b) * 2 + (h)) * HTB)
#define PG8_STAGE(bufoff, gbase, voff) do { _Pragma("unroll") for (int _i = 0; _i < 2; ++_i) \
        __builtin_amdgcn_global_load_lds((const unsigned*)((const char*)(gbase) + (voff)[_i]), (PG8_LAS unsigned*)(lds + (bufoff) + ldsw + _i * 8192), 16, 0, 0); } while (0)
#define PG8_LDA(dst, b, h) do { _Pragma("unroll") for (int m = 0; m < 4; ++m) _Pragma("unroll") for (int k = 0; k < 2; ++k) dst[m][k] = *(const PG8_LAS bf16x8*)(lds + PG8_SA(b, h) + aoff + m * 2048 + k * 1024); } while (0)
#define PG8_LDB(dst, b, h) do { _Pragma("unroll") for (int n = 0; n < 2; ++n) _Pragma("unroll") for (int k = 0; k < 2; ++k) dst[n][k] = *(const PG8_LAS bf16x8*)(lds + PG8_SB(b, h) + boff + n * 2048 + k * 1024); } while (0)
#define PG8_MMA(ai, bj, At, Bt) do { __builtin_amdgcn_s_setprio(1); _Pragma("unroll") for (int m = 0; m < 4; ++m) _Pragma("unroll") for (int n = 0; n < 2; ++n) _Pragma("unroll") for (int k = 0; k < 2; ++k) \
        acc[ai][bj][m][n] = __builtin_amdgcn_mfma_f32_16x16x32_bf16(Bt[n][k], At[m][k], acc[ai][bj][m][n], 0, 0, 0); __builtin_amdgcn_s_setprio(0); } while (0)
#define PG8_WAIT_V(n) asm volatile("s_waitcnt vmcnt(" #n ")" ::: "memory")
#define PG8_WAIT_L(n) asm volatile("s_waitcnt lgkmcnt(" #n ")" ::: "memory")
#define PG8_BAR __builtin_amdgcn_s_barrier()
#define PG8_SCHED __builtin_amdgcn_sched_barrier(0)
    Unit cur, nxt; int ui = 0;
    if (!S.next(0, cur)) return;
    f32x4 acc[2][2][4][2];
#pragma unroll
    for (int a = 0; a < 2; ++a)
#pragma unroll
        for (int b = 0; b < 2; ++b)
#pragma unroll
            for (int m = 0; m < 4; ++m)
#pragma unroll
                for (int n = 0; n < 2; ++n) acc[a][b][m][n] = (f32x4){0.f, 0.f, 0.f, 0.f};
    bf16x8 At[4][2], B0[2][2], B1[2][2];
    const char* cA = g.a_tile(cur); const char* cB = g.b_tile(cur);
    S.a_ready(cur);
    if constexpr (SP2) {
        PG8_STAGE(PG8_SB(0, 0), cB, voffB); PG8_STAGE(PG8_SB(0, 1), cB + hstep, voffB); PG8_STAGE(PG8_SA(0, 0), cA, voffA); PG8_STAGE(PG8_SA(0, 1), cA + hstep, voffA);
        if (wr == 1) PG8_BAR;
        PG8_WAIT_V(2); PG8_BAR;
        PG8_STAGE(PG8_SB(1, 0), cB + kstep, voffB); PG8_STAGE(PG8_SA(1, 0), cA + kstep, voffA); PG8_STAGE(PG8_SB(1, 1), cB + hstep + kstep, voffB);
        PG8_WAIT_V(6); PG8_BAR;
    } else {
        PG8_STAGE(PG8_SB(0, 0), cB, voffB); PG8_STAGE(PG8_SA(0, 0), cA, voffA); PG8_STAGE(PG8_SB(0, 1), cB + hstep, voffB); PG8_STAGE(PG8_SA(0, 1), cA + hstep, voffA);
        if (wr == 1) PG8_BAR;
        PG8_WAIT_V(4); PG8_BAR;
        PG8_STAGE(PG8_SB(1, 0), cB + kstep, voffB); PG8_STAGE(PG8_SA(1, 0), cA + kstep, voffA); PG8_STAGE(PG8_SB(1, 1), cB + hstep + kstep, voffB);
        PG8_WAIT_V(6); PG8_BAR;
    }
    for (;;) {
        const bool has_next = S.next(ui + 1, nxt);
        const char* nA = has_next ? g.a_tile(nxt) : cA; const char* nB = has_next ? g.b_tile(nxt) : cB;
        for (int t = 0; t < nt; t += 2) {
            const bool last = (t == nt - 2);
            const char* a1 = cA + (size_t)(t + 1) * kstep;
            const char* a2 = last ? nA : cA + (size_t)(t + 2) * kstep; const char* b2 = last ? nB : cB + (size_t)(t + 2) * kstep;
            const char* a3 = a2 + kstep; const char* b3 = b2 + kstep;
            if (last && has_next) S.a_ready(nxt);
            if constexpr (SP2) {
            PG8_LDB(B0, 0, 0); PG8_LDB(B1, 0, 1); PG8_SCHED; PG8_LDA(At, 0, 0); PG8_STAGE(PG8_SA(1, 1), a1 + hstep, voffA);
            PG8_WAIT_V(8); PG8_WAIT_L(0); PG8_BAR; PG8_MMA(0, 0, At, B0); PG8_MMA(0, 1, At, B1); PG8_BAR; PG8_SCHED;
            PG8_LDA(At, 0, 1); PG8_STAGE(PG8_SB(0, 0), b2, voffB); PG8_STAGE(PG8_SB(0, 1), b2 + hstep, voffB); PG8_STAGE(PG8_SA(0, 0), a2, voffA);
            PG8_WAIT_V(8); PG8_WAIT_L(0); PG8_BAR; PG8_MMA(1, 0, At, B0); PG8_MMA(1, 1, At, B1); PG8_BAR; PG8_SCHED;
            PG8_LDB(B0, 1, 0); PG8_LDB(B1, 1, 1); PG8_SCHED; PG8_LDA(At, 1, 0); PG8_STAGE(PG8_SA(0, 1), a2 + hstep, voffA);
            PG8_WAIT_V(8); PG8_WAIT_L(0); PG8_BAR; PG8_MMA(0, 0, At, B0); PG8_MMA(0, 1, At, B1); PG8_BAR; PG8_SCHED;
            PG8_LDA(At, 1, 1); PG8_STAGE(PG8_SB(1, 0), b3, voffB); PG8_STAGE(PG8_SB(1, 1), b3 + hstep, voffB); PG8_STAGE(PG8_SA(1, 0), a3, voffA);
            PG8_WAIT_V(8); PG8_WAIT_L(0); PG8_BAR; PG8_MMA(1, 0, At, B0); PG8_MMA(1, 1, At, B1); PG8_BAR; PG8_SCHED;
            } else {
            PG8_LDB(B0, 0, 0); PG8_SCHED; PG8_LDA(At, 0, 0); PG8_STAGE(PG8_SA(1, 1), a1 + hstep, voffA);
            PG8_WAIT_L(8); PG8_BAR; PG8_WAIT_L(0); PG8_MMA(0, 0, At, B0); PG8_BAR; PG8_SCHED;
            PG8_LDB(B1, 0, 1); PG8_STAGE(PG8_SB(0, 0), b2, voffB);
            PG8_BAR; PG8_WAIT_L(0); PG8_MMA(0, 1, At, B1); PG8_BAR;
            PG8_LDA(At, 0, 1); PG8_STAGE(PG8_SA(0, 0), a2, voffA);
            PG8_BAR; PG8_WAIT_L(0); PG8_MMA(1, 0, At, B0); PG8_BAR; PG8_SCHED;
            PG8_STAGE(PG8_SB(0, 1), b2 + hstep, voffB);
            PG8_WAIT_V(6); PG8_BAR; PG8_MMA(1, 1, At, B1); PG8_BAR;
            PG8_LDB(B0, 1, 0); PG8_SCHED; PG8_LDA(At, 1, 0); PG8_STAGE(PG8_SA(0, 1), a2 + hstep, voffA);
            PG8_WAIT_L(8); PG8_BAR; PG8_WAIT_L(0); PG8_MMA(0, 0, At, B0); PG8_BAR; PG8_SCHED;
            PG8_LDB(B1, 1, 1); PG8_STAGE(PG8_SB(1, 0), b3, voffB);
            PG8_BAR; PG8_WAIT_L(0); PG8_MMA(0, 1, At, B1); PG8_BAR;
            PG8_LDA(At, 1, 1); PG8_STAGE(PG8_SA(1, 0), a3, voffA);
            PG8_BAR; PG8_WAIT_L(0); PG8_MMA(1, 0, At, B0); PG8_BAR; PG8_SCHED;
            PG8_STAGE(PG8_SB(1, 1), b3 + hstep, voffB);
            PG8_WAIT_V(6); PG8_BAR; PG8_MMA(1, 1, At, B1); PG8_BAR;
            }
        }
        if constexpr (ALIGN_EPI) { if (wr == 0) PG8_BAR; }
        if constexpr (!Epi::AFTER_DRAIN) { E(acc, cur, wr, wc, fr, fq); S.done(cur); }
        if (!has_next) break;
#pragma unroll
        for (int a = 0; a < 2; ++a)
#pragma unroll
            for (int b = 0; b < 2; ++b)
#pragma unroll
                for (int m = 0; m < 4; ++m)
#pragma unroll
                    for (int n = 0; n < 2; ++n) acc[a][b][m][n] = (f32x4){0.f, 0.f, 0.f, 0.f};
        cur = nxt; cA = nA; cB = nB; ++ui;
        if constexpr (ALIGN_EPI) { if (wr == 1) PG8_BAR; }
    }
    PG8_WAIT_V(0);
    if constexpr (!ALIGN_EPI) { if (wr == 0) PG8_BAR; }
    PG8_BAR;
    if constexpr (Epi::AFTER_DRAIN) { E.fused(acc, cur, wr, wc, fr, fq, lds, wid, lane); S.done(cur); }
#undef PG8_SA
#undef PG8_SB
#undef PG8_STAGE
#undef PG8_LDA
#undef PG8_LDB
#undef PG8_MMA
#undef PG8_WAIT_V
#undef PG8_WAIT_L
#undef PG8_BAR
#undef PG8_SCHED
}
}

#define LAS __attribute__((address_space(3)))
#define XB_TMO      128
#define XB_XCNT(j)  (256  + 64 * (j))
#define XB_XSUB(j)  (1280 + 64 * (j))
#define XB_XGEN(j)  (2304 + 64 * (j))
#define XB_TOP      3328
#define XB_TOPGEN   3392
#define XCD_BAR_WORDS 3456
#define XB_SPIN_CAP (1u << 20)

__device__ __forceinline__ unsigned xb_ld(unsigned* p)              { return __hip_atomic_load(p, __ATOMIC_RELAXED, __HIP_MEMORY_SCOPE_AGENT); }
__device__ __forceinline__ unsigned xb_add(unsigned* p, unsigned v) { return __hip_atomic_fetch_add(p, v, __ATOMIC_RELAXED, __HIP_MEMORY_SCOPE_AGENT); }
__device__ __forceinline__ unsigned xb_xcc_id() { return (unsigned)__builtin_amdgcn_s_getreg((3 << 11) | 20) & 0xFu; }
#define XB_SPIN(cond, bar) do { unsigned _sp = 0; while (cond) { __builtin_amdgcn_s_sleep(1); \
    if ((++_sp & 255u) == 0u) { if (xb_ld(&(bar)[XB_TMO])) break; if (_sp > XB_SPIN_CAP) { atomicAdd(&(bar)[XB_TMO], 1u); break; } } } } while (0)

struct XcdBarrier {
    unsigned* bar; unsigned x;
    volatile LAS unsigned* st;
};

__device__ __forceinline__ XcdBarrier xcd_barrier_post(unsigned* bar, volatile LAS unsigned* st) {
    XcdBarrier b; b.bar = bar; b.x = xb_xcc_id(); b.st = st;
    if (threadIdx.x == 0) (void)xb_add(&bar[XB_XCNT(b.x)], 1u);
    return b;
}
__device__ __forceinline__ void xcd_barrier_complete(unsigned* bar, unsigned x, unsigned& nloc, unsigned& nx) {
    const unsigned G = gridDim.x * gridDim.y * gridDim.z;
    unsigned sum, cnt, mine, sp = 0u;
    for (;;) {
        sum = 0u; cnt = 0u; mine = 0u;
#pragma unroll
        for (unsigned j = 0; j < 16; ++j) { const unsigned c = xb_ld(&bar[XB_XCNT(j)]); sum += c; cnt += (c > 0u) ? 1u : 0u; mine = (j == x) ? c : mine; }
        if (sum == G) break;
        __builtin_amdgcn_s_sleep(1);
        if ((++sp & 255u) == 0u) { if (xb_ld(&bar[XB_TMO])) break; if (sp > XB_SPIN_CAP) { atomicAdd(&bar[XB_TMO], 1u); break; } }
    }
    nloc = mine > 0u ? mine : 1u; nx = cnt > 0u ? cnt : 1u;
}

__device__ __forceinline__ void xcd_barrier(const XcdBarrier& b, const bool tid0  ) {
    asm volatile("s_waitcnt vmcnt(0)" ::: "memory");
    __syncthreads();
    if (tid0) {
        unsigned* bar = b.bar;
        __builtin_amdgcn_s_waitcnt(0);
        unsigned nloc = b.st[0], nx = b.st[1];
        if (nloc == 0u) { xcd_barrier_complete(bar, b.x, nloc, nx); b.st[0] = nloc; b.st[1] = nx; }
        const unsigned old = xb_add(&bar[XB_XSUB(b.x)], 1u);
        const unsigned gen = old / nloc;
        if (old + 1u == (gen + 1u) * nloc) {
            __builtin_amdgcn_fence(__ATOMIC_RELEASE, "agent");
            asm volatile("s_waitcnt vmcnt(0)" ::: "memory");
            const unsigned og = xb_add(&bar[XB_TOP], 1u);
            const unsigned tg = og / nx;
            if (og + 1u == (tg + 1u) * nx) xb_add(&bar[XB_TOPGEN], 1u);
            else XB_SPIN(xb_ld(&bar[XB_TOPGEN]) == tg, bar);
            __builtin_amdgcn_fence(__ATOMIC_ACQUIRE, "agent");
            xb_add(&bar[XB_XGEN(b.x)], 1u);
            asm volatile("s_waitcnt vmcnt(0)" ::: "memory");
        } else {
            XB_SPIN(xb_ld(&bar[XB_XGEN(b.x)]) == gen, bar);
            __builtin_amdgcn_fence(__ATOMIC_ACQUIRE, "agent");
            asm volatile("s_waitcnt vmcnt(0)" ::: "memory");
        }
    }
    __syncthreads();
}

namespace attn {
using bf16 = unsigned short;
constexpr int   D = 128, NW = 8, QBLK = 32, KVBLK = 64;
constexpr float SCALE = 0.088388347648318440f;
constexpr float THR = 8.f;
constexpr int SDEPTH = 2;
constexpr int LDQ = 2048, LDK = 512, LDO = 2048;
constexpr size_t SHM_V = KVBLK * D * 2, SHM_K = KVBLK * D * 2, SHM_ATTN = 2 * SHM_V + 2 * SHM_K + NW * 64 * 4;
using bf16x8 = __attribute__((ext_vector_type(8))) short;
using s16x4  = __attribute__((ext_vector_type(4))) short;
using f32x16 = __attribute__((ext_vector_type(16))) float;
using f32x8  = __attribute__((ext_vector_type(8))) float;
using u32x4  = __attribute__((ext_vector_type(4))) unsigned;
#define KSWZ(row, colB) ((row) * 256 + ((colB) ^ (((row) & 7) << 4)))
#define SBAR() __builtin_amdgcn_sched_barrier(0)
__device__ __forceinline__ int crow(int r, int hi) { return (r & 3) + 8 * (r >> 2) + 4 * hi; }
__device__ __forceinline__ unsigned cvtpk(float lo, float hi) {
  return pg8::cvt_pk_bf16(lo, hi);
}
template <typename TIn> struct Stage;
__device__ __forceinline__ unsigned f2bf_(float f) { unsigned u = __builtin_bit_cast(unsigned, f); return (u + 0x7fffu + ((u >> 16) & 1u)) >> 16; }
template <> struct Stage<bf16>  { using T = bf16x8;
  __device__ static __forceinline__ T ld8(const bf16* p) { return *reinterpret_cast<const bf16x8*>(p); }
  __device__ static __forceinline__ bf16x8 tobf(T x) { return x; } };
template <> struct Stage<float> { using T = f32x8;
  __device__ static __forceinline__ T ld8(const float* p) { return *reinterpret_cast<const f32x8*>(p); }
  __device__ static __forceinline__ bf16x8 tobf(T x) {
    u32x4 w = {cvtpk(x[0], x[1]), cvtpk(x[2], x[3]), cvtpk(x[4], x[5]), cvtpk(x[6], x[7])}; return *reinterpret_cast<bf16x8*>(&w); } };

__device__ __forceinline__ void partialSM(f32x16& p0, f32x16& p1, float& m_reg, float& mn, float& alpha) {
  constexpr float C = SCALE * 1.4426950408889634f;
  float pmax = p0[0]; for (int r = 1; r < 16; ++r) pmax = fmaxf(pmax, p0[r]); for (int r = 0; r < 16; ++r) pmax = fmaxf(pmax, p1[r]);
  { auto rr = __builtin_amdgcn_permlane32_swap(__float_as_uint(pmax), __float_as_uint(pmax), false, false);
    pmax = fmaxf(__uint_as_float(rr[0]), __uint_as_float(rr[1])); }
  if (__builtin_expect(__all(pmax - m_reg <= THR / SCALE), 1)) { mn = m_reg; alpha = 1.f; }
  else { mn = fmaxf(m_reg, pmax); alpha = __builtin_amdgcn_exp2f((m_reg - mn) * C); m_reg = mn; }
  float mnC = -mn * C;
  for (int r = 0; r < 16; ++r) p0[r] = fmaf(p0[r], C, mnC); for (int r = 0; r < 16; ++r) p1[r] = fmaf(p1[r], C, mnC);
  for (int r = 0; r < 16; ++r) p0[r] = __builtin_amdgcn_exp2f(p0[r]);
}
__device__ __forceinline__ void partialSM_fix(f32x16& p0, f32x16& p1, const float mnC) {
  (void)p1; (void)mnC;
  for (int r = 0; r < 16; ++r) p0[r] = __builtin_amdgcn_exp2f(p0[r]);
}
__device__ __forceinline__ void finishSM(f32x16& p0, f32x16& p1, float alpha, float& l_reg, bf16x8& pa0, bf16x8& pa1, bf16x8& pa2, bf16x8& pa3) {
  for (int r = 0; r < 16; ++r) p1[r] = __builtin_amdgcn_exp2f(p1[r]);
  float ps = 0; for (int r = 0; r < 16; ++r) ps += p0[r]; for (int r = 0; r < 16; ++r) ps += p1[r];
  { auto rr = __builtin_amdgcn_permlane32_swap(__float_as_uint(ps), __float_as_uint(ps), false, false);
    ps = __uint_as_float(rr[0]) + __uint_as_float(rr[1]); }
  l_reg = l_reg * alpha + ps;
#define PK4(P, BASE, OUT) do { unsigned a0 = cvtpk(P[BASE + 0], P[BASE + 1]), a1 = cvtpk(P[BASE + 2], P[BASE + 3]);   \
    unsigned b0 = cvtpk(P[BASE + 4], P[BASE + 5]), b1 = cvtpk(P[BASE + 6], P[BASE + 7]);                              \
    auto r0 = __builtin_amdgcn_permlane32_swap(a0, b0, false, false); auto r1 = __builtin_amdgcn_permlane32_swap(a1, b1, false, false); \
    u32x4 w = {r0[0], r1[0], r0[1], r1[1]}; OUT = *reinterpret_cast<bf16x8*>(&w); } while (0)
  PK4(p0, 0, pa0); PK4(p0, 8, pa1); PK4(p1, 0, pa2); PK4(p1, 8, pa3);
#undef PK4
}
__device__ __forceinline__ void qkt(f32x16& p0, f32x16& p1, const bf16* Ks, const bf16x8* qr, int r32, int hi) {
  p0 = f32x16{}; p1 = f32x16{};
  for (int d0 = 0; d0 < 8; ++d0) { int cb = (d0 * 16 + hi * 8) * 2;
    bf16x8 b0 = *reinterpret_cast<const bf16x8*>((const char*)Ks + KSWZ(r32, cb));
    bf16x8 b1 = *reinterpret_cast<const bf16x8*>((const char*)Ks + KSWZ(32 + r32, cb));
    p0 = __builtin_amdgcn_mfma_f32_32x32x16_bf16(b0, qr[d0], p0, 0, 0, 0);
    p1 = __builtin_amdgcn_mfma_f32_32x32x16_bf16(b1, qr[d0], p1, 0, 0, 0); }
}
__device__ __forceinline__ int v_st(int k, int c) { const int kk = (k & ~0xC) | ((k & 4) << 1) | ((k & 8) >> 1); return ((kk >> 3) * 4 + (c >> 5)) * 512 + ((kk & 7) * 32 + (c & 31)) * 2; }
__device__ __forceinline__ int v_rd_base(int lane) { return ((lane & 3) << 3) | (((lane >> 2) & 3) << 6) | (((lane >> 4) & 1) << 5) | (((lane >> 5) & 1) << 8); }
constexpr int v_rd_off(int d0, int ks, int half) { return d0 * 512 + ks * 4096 + half * 2048; }
template <int OFF> __device__ __forceinline__ s16x4 tr_read(int vb) {
  s16x4 r; asm volatile("ds_read_b64_tr_b16 %0, %1 offset:%2" : "=&v"(r) : "v"(vb), "i"(OFF) : "memory"); return r;
}
template <int D0> __device__ __forceinline__ void pv_one(f32x16& od, int vb, bf16x8 pa0, bf16x8 pa1, bf16x8 pa2, bf16x8 pa3) {
  const s16x4 l0 = tr_read<v_rd_off(D0, 0, 0)>(vb), h0 = tr_read<v_rd_off(D0, 0, 1)>(vb), l1 = tr_read<v_rd_off(D0, 1, 0)>(vb), h1 = tr_read<v_rd_off(D0, 1, 1)>(vb);
  const s16x4 l2 = tr_read<v_rd_off(D0, 2, 0)>(vb), h2 = tr_read<v_rd_off(D0, 2, 1)>(vb), l3 = tr_read<v_rd_off(D0, 3, 0)>(vb), h3 = tr_read<v_rd_off(D0, 3, 1)>(vb);
  asm volatile("s_waitcnt lgkmcnt(0)" ::: "memory"); SBAR();
#define PK(L, H) (bf16x8){L[0], L[1], L[2], L[3], H[0], H[1], H[2], H[3]}
  od = __builtin_amdgcn_mfma_f32_32x32x16_bf16(pa0, PK(l0, h0), od, 0, 0, 0);
  od = __builtin_amdgcn_mfma_f32_32x32x16_bf16(pa1, PK(l1, h1), od, 0, 0, 0);
  od = __builtin_amdgcn_mfma_f32_32x32x16_bf16(pa2, PK(l2, h2), od, 0, 0, 0);
  od = __builtin_amdgcn_mfma_f32_32x32x16_bf16(pa3, PK(l3, h3), od, 0, 0, 0);
#undef PK
}
__device__ __forceinline__ void pv_d0(f32x16* o, int vb, bf16x8 pa0, bf16x8 pa1, bf16x8 pa2, bf16x8 pa3) {
  pv_one<0>(o[0], vb, pa0, pa1, pa2, pa3); pv_one<1>(o[1], vb, pa0, pa1, pa2, pa3); pv_one<2>(o[2], vb, pa0, pa1, pa2, pa3); pv_one<3>(o[3], vb, pa0, pa1, pa2, pa3);
}

template <typename TQ, bool FIXM = false>
__device__ __forceinline__ void attn_dense_body(const TQ* __restrict__ Qb, const bf16* __restrict__ Kh, const bf16* __restrict__ Vh,
                                                bf16* __restrict__ Ob, int seq, char* lds, const int wid, const float mfix = 0.f) {
  using St = Stage<bf16>; using SQ = Stage<TQ>;
  const int lane = lane_opaque(), tid = wid * 64 + lane, r32 = lane & 31, hi = lane >> 5;
  bf16* V_lds = (bf16*)lds; bf16* K_lds = (bf16*)(lds + 2 * SHM_V);
  float* ws = (float*)(lds + 2 * SHM_V + 2 * SHM_K) + wid * 64; float* li_l = ws; float* al_l = ws + 32;
  float m_reg = -1e30f, l_reg = 0; f32x16 o[4] = {}; bf16x8 qr[8]; const float mnCf = -mfix * (SCALE * 1.4426950408889634f); (void)mnCf; (void)m_reg;
  const TQ* Qw = Qb + (long)(wid * QBLK + r32) * LDQ + hi * 8;
#pragma unroll
  for (int d0 = 0; d0 < 8; ++d0) qr[d0] = SQ::tobf(SQ::ld8(Qw + d0 * 16));
  const int sr = tid >> 4, sc = (tid & 15) * 8, vst0 = v_st(sr, sc), vst1 = v_st(32 + sr, sc);
  const int vb0 = (int)(uintptr_t)V_lds + v_rd_base(lane);
  struct { typename St::T vs0, vs1, ks0, ks1; } sr_[SDEPTH];
#define SLOAD(i, k0) do { sr_[i].vs0 = St::ld8(&Vh[(long)((k0) + sr) * LDK + sc]); sr_[i].vs1 = St::ld8(&Vh[(long)((k0) + 32 + sr) * LDK + sc]); \
    sr_[i].ks0 = St::ld8(&Kh[(long)((k0) + sr) * LDK + sc]); sr_[i].ks1 = St::ld8(&Kh[(long)((k0) + 32 + sr) * LDK + sc]); } while (0)
#define SWRITE(b, i) do { *(bf16x8*)((char*)V_lds + (b) * SHM_V + vst0) = St::tobf(sr_[i].vs0);          \
    *(bf16x8*)((char*)V_lds + (b) * SHM_V + vst1) = St::tobf(sr_[i].vs1); int kc = sc * 2;               \
    *(bf16x8*)((char*)K_lds + (b) * SHM_K + KSWZ(sr, kc)) = St::tobf(sr_[i].ks0);                       \
    *(bf16x8*)((char*)K_lds + (b) * SHM_K + KSWZ(32 + sr, kc)) = St::tobf(sr_[i].ks1); } while (0)
#define SWAIT() do { if constexpr (SDEPTH == 2) asm volatile("s_waitcnt vmcnt(4)" ::: "memory"); else asm volatile("s_waitcnt vmcnt(0)" ::: "memory"); } while (0)
#define RESC(a) do { if (__any((a) < 1.f)) { if (hi == 0) al_l[r32] = (a); asm volatile("s_waitcnt lgkmcnt(0)" ::: "memory"); \
    for (int d = 0; d < 4; ++d) for (int r = 0; r < 16; ++r) o[d][r] *= al_l[crow(r, hi)]; } } while (0)
  f32x16 pA0, pA1, pB0, pB1; float mnA, mnB, alA, alB; bf16x8 pa0, pa1, pa2, pa3; const int NT = seq / KVBLK;
  constexpr int SE = 0, SO = SDEPTH - 1;
  SLOAD(SE, 0); asm volatile("s_waitcnt vmcnt(0)" ::: "memory"); SWRITE(0, SE); __syncthreads();
  qkt(pA0, pA1, K_lds, qr, r32, hi); do { if constexpr (FIXM) { partialSM_fix(pA0, pA1, mnCf); alA = 1.f; } else partialSM(pA0, pA1, m_reg, mnA, alA); } while (0);
  SLOAD(SO, KVBLK); if constexpr (SDEPTH == 2) { if (2 < NT) SLOAD(SE, 2 * KVBLK); }
  SWAIT(); SWRITE(1, SO); __syncthreads();
  for (int j = 1; j + 1 < NT; j += 2) {
    SBAR(); qkt(pB0, pB1, (bf16*)((char*)K_lds + SHM_K), qr, r32, hi);
    finishSM(pA0, pA1, FIXM ? 1.f : alA, l_reg, pa0, pa1, pa2, pa3); SBAR();
    SLOAD(SO, (j + SDEPTH) * KVBLK); SBAR();
    pv_d0(o, vb0, pa0, pa1, pa2, pa3); do { if constexpr (FIXM) { partialSM_fix(pB0, pB1, mnCf); alB = 1.f; } else partialSM(pB0, pB1, m_reg, mnB, alB); } while (0);
    __syncthreads(); SWAIT(); SWRITE(0, SE);
    do { if constexpr (!FIXM) RESC(alB); } while (0); __syncthreads();
    SBAR(); qkt(pA0, pA1, K_lds, qr, r32, hi);
    finishSM(pB0, pB1, FIXM ? 1.f : alB, l_reg, pa0, pa1, pa2, pa3); SBAR();
    if (SDEPTH == 1 || j + 3 < NT) SLOAD(SE, (j + 1 + SDEPTH) * KVBLK); SBAR();
    pv_d0(o, vb0 + (int)SHM_V, pa0, pa1, pa2, pa3); do { if constexpr (FIXM) { partialSM_fix(pA0, pA1, mnCf); alA = 1.f; } else partialSM(pA0, pA1, m_reg, mnA, alA); } while (0);
    __syncthreads(); SWAIT(); SWRITE(1, SO);
    do { if constexpr (!FIXM) RESC(alA); } while (0); __syncthreads();
  }
  SBAR(); qkt(pB0, pB1, (bf16*)((char*)K_lds + SHM_K), qr, r32, hi);
  finishSM(pA0, pA1, FIXM ? 1.f : alA, l_reg, pa0, pa1, pa2, pa3); SBAR();
  pv_d0(o, vb0, pa0, pa1, pa2, pa3); do { if constexpr (FIXM) { partialSM_fix(pB0, pB1, mnCf); alB = 1.f; } else partialSM(pB0, pB1, m_reg, mnB, alB); } while (0);
  __syncthreads(); do { if constexpr (!FIXM) RESC(alB); } while (0);
  finishSM(pB0, pB1, FIXM ? 1.f : alB, l_reg, pa0, pa1, pa2, pa3); SBAR();
  pv_d0(o, vb0 + (int)SHM_V, pa0, pa1, pa2, pa3);
  if (hi == 0) li_l[r32] = l_reg; asm volatile("s_waitcnt lgkmcnt(0)" ::: "memory");
  float rli[16];
#pragma unroll
  for (int r = 0; r < 16; ++r) rli[r] = __builtin_amdgcn_rcpf(li_l[crow(r, hi)]);
  bf16* Ow = Ob + (long)(wid * QBLK) * LDO;
  char* stg = (char*)K_lds + wid * 4096;
#pragma unroll
  for (int half = 0; half < 2; ++half) {
#pragma unroll
    for (int r = 0; r < 16; ++r) { const unsigned w = cvtpk(o[2 * half][r] * rli[r], o[2 * half + 1][r] * rli[r]); char* pr = stg + crow(r, hi) * 128 + r32 * 2;
      *reinterpret_cast<unsigned short*>(pr) = (unsigned short)w; *reinterpret_cast<unsigned short*>(pr + 64) = (unsigned short)(w >> 16); }
    asm volatile("s_waitcnt lgkmcnt(0)" ::: "memory");
#pragma unroll
    for (int k = 0; k < 4; ++k) { const int row = 8 * k + (lane >> 3), ch = lane & 7;
      const u32x4 v = *reinterpret_cast<const u32x4*>(stg + row * 128 + ch * 16);
      *reinterpret_cast<u32x4*>(Ow + (long)row * LDO + half * 64 + ch * 8) = v; }
    asm volatile("s_waitcnt lgkmcnt(0)" ::: "memory");
  }
#undef SLOAD
#undef SWRITE
#undef SWAIT
#undef RESC
}
#undef KSWZ
#undef SBAR
}

#define GAS __attribute__((address_space(1)))
typedef unsigned short bf16_t;
typedef unsigned u32x4 __attribute__((ext_vector_type(4)));
typedef unsigned u32x2 __attribute__((ext_vector_type(2)));
typedef float f32x4 __attribute__((ext_vector_type(4)));
typedef float f32x2 __attribute__((ext_vector_type(2)));
typedef short bf16x8 __attribute__((ext_vector_type(8)));

constexpr int D = 2048, NB = 4, SEQ = 4096, CTXL = 256, TB = SEQ + CTXL, M = NB * TB, FF = 5632, DEPTH = 4;
constexpr int NWAVES = 8, NTHR = 512;
constexpr int NCTXWG = 64;
constexpr float NORM_EPS = 1e-6f;
static_assert(M == 17408 && M % 256 == 0 && TB % 256 == 0, "row layout");

constexpr size_t MiB = 1u << 20;
constexpr size_t WS_CTL = 0, CTL_ZERO_BYTES = 1 * MiB;
constexpr size_t WS_MOD = 1 * MiB;
constexpr size_t WS_ROPE = 4 * MiB;
constexpr size_t WS_WB = 8 * MiB;
constexpr size_t E_F1 = (size_t)2 * FF * D, E_F2 = (size_t)D * FF;
constexpr size_t WS_WA = WS_WB + 8 * (E_F1 + E_F2) * 2;
constexpr size_t E_QKV = (size_t)3072 * D, E_SQ = (size_t)D * D;
constexpr size_t WS_WR = WS_WA + 2 * (E_QKV + E_SQ) * 2;
constexpr size_t E_RW1 = (size_t)6912 * D, E_RW2 = (size_t)10240 * 256;
constexpr size_t WS_WEND = WS_WR + 2 * (E_RW1 + E_RW2 + E_SQ) * 2;
static_assert(WS_WEND == 656 * MiB, "weight map");
constexpr size_t SZ_R2 = (size_t)M * D * 2, SZ_R4 = (size_t)M * D * 4;
constexpr size_t WS_X = 656 * MiB;
constexpr size_t WS_Y = WS_X + SZ_R4;
constexpr size_t WS_ACT = WS_Y + SZ_R2;
constexpr size_t WS_OUT = 1048 * MiB;
constexpr size_t WS_MIX = WS_OUT + SZ_R2;
static_assert(WS_ACT + (size_t)M * FF * 2 <= WS_OUT, "act map");
constexpr size_t WS_Q = WS_MIX, WS_K = WS_Q + SZ_R2, WS_V = WS_K + SZ_R2 / 4, WS_O = WS_V + SZ_R2 / 4;
constexpr size_t WS_MIX6 = WS_MIX;
constexpr size_t WS_WDEC = WS_MIX;
constexpr size_t WS_AA = WS_MIX + 2 * SZ_R4;
constexpr size_t WS_RR = WS_MIX + 6 * SZ_R2;
constexpr size_t WS_KK_ = WS_RR + SZ_R2;
constexpr size_t WS_VV = WS_KK_ + SZ_R2;
constexpr size_t WS_KN = WS_VV + SZ_R2;
constexpr size_t WS_GG = WS_KN + SZ_R2;
constexpr size_t WS_GL = WS_GG + SZ_R2;
constexpr size_t WS_WL = WS_GL + 9 * MiB, WS_AL = WS_WL + 9 * MiB;
constexpr size_t WS_PART = WS_AL + 9 * MiB;
constexpr size_t WS_BON = WS_PART + 16 * MiB;
constexpr size_t WS_END = WS_BON + 5 * MiB;
constexpr size_t WS_YS = WS_ACT;
constexpr size_t WS_PREP = WS_Y;
static_assert(WS_AA + 2 * SZ_R2 == WS_RR, "rwkv overlay");
static_assert(WS_END <= 2100 * MiB, "ws map");
constexpr int CW_BAR = 4096;
constexpr int MAX_LAUNCH = 64;
constexpr int CW_GRP = CW_BAR + MAX_LAUNCH * XCD_BAR_WORDS;
constexpr int CW_FC = CW_GRP + 16 * 4 * 64 + 2 * 128 * 64;
static_assert((CW_FC + 8 * 64) * 4 <= (int)WS_MOD, "ctl map (context tile counters)");
constexpr int CW_PAIR = CW_GRP + 16 * 4 * 64;
static_assert((CW_PAIR + 2 * 128 * 64) * 4 <= (int)WS_MOD, "ctl map (pair counters)");
static_assert((CW_GRP + 16 * 4 * 64) * 4 <= (int)WS_MOD, "ctl map (group counters)");
static_assert((CW_BAR + MAX_LAUNCH * XCD_BAR_WORDS) * 4 <= (int)WS_MOD, "ctl map");

constexpr int RING_BYTES = 131072, LDSCTL_OFF = RING_BYTES, MISC_OFF = LDSCTL_OFF + 320, LDS_BYTES = 163840;

struct Args { const float* in[30]; float* out; unsigned char* ws; int ph_lo, ph_hi, li, dbg; };
typedef const __attribute__((address_space(4))) Args KArgs;
struct Frame { LAS unsigned char* lds; unsigned char* ldsg; int wave, G, bid; };

#define LDS_WAIT() asm volatile("s_waitcnt lgkmcnt(0)" ::: "memory")
__device__ __forceinline__ unsigned f2bf(float f) { unsigned u = __builtin_bit_cast(unsigned, f); return (u + 0x7fffu + ((u >> 16) & 1u)) >> 16; }
__device__ __forceinline__ unsigned pk2(float lo, float hi) { return pg8::cvt_pk_bf16(lo, hi); }
__device__ __forceinline__ float bflo(unsigned w) { return __builtin_bit_cast(float, w << 16); }
__device__ __forceinline__ float bfhi(unsigned w) { return __builtin_bit_cast(float, w & 0xffff0000u); }
__device__ __forceinline__ void unpack8(const u32x4 w, float (&v)[8]) { v[0] = bflo(w.x); v[1] = bfhi(w.x); v[2] = bflo(w.y); v[3] = bfhi(w.y); v[4] = bflo(w.z); v[5] = bfhi(w.z); v[6] = bflo(w.w); v[7] = bfhi(w.w); }
__device__ __forceinline__ u32x4 pack8(const float (&v)[8]) { u32x4 w; w.x = pk2(v[0], v[1]); w.y = pk2(v[2], v[3]); w.z = pk2(v[4], v[5]); w.w = pk2(v[6], v[7]); return w; }
typedef _Float16 h16x2 __attribute__((ext_vector_type(2)));
__device__ __forceinline__ void unpack8h(const u32x4 w, float (&v)[8]) {
    const unsigned wx = w.x, wy = w.y, wz = w.z, ww = w.w;
    const h16x2 a = __builtin_bit_cast(h16x2, wx), b = __builtin_bit_cast(h16x2, wy), c = __builtin_bit_cast(h16x2, wz), d = __builtin_bit_cast(h16x2, ww);
    v[0] = (float)a.x; v[1] = (float)a.y; v[2] = (float)b.x; v[3] = (float)b.y; v[4] = (float)c.x; v[5] = (float)c.y; v[6] = (float)d.x; v[7] = (float)d.y; }
__device__ __forceinline__ u32x4 pack8h(const float (&v)[8]) {
    h16x2 a, b, c, d; a.x = (_Float16)v[0]; a.y = (_Float16)v[1]; b.x = (_Float16)v[2]; b.y = (_Float16)v[3]; c.x = (_Float16)v[4]; c.y = (_Float16)v[5]; d.x = (_Float16)v[6]; d.y = (_Float16)v[7];
    u32x4 w; w.x = __builtin_bit_cast(unsigned, a); w.y = __builtin_bit_cast(unsigned, b); w.z = __builtin_bit_cast(unsigned, c); w.w = __builtin_bit_cast(unsigned, d); return w; }
__device__ __forceinline__ float wave_sum(float v) {
#pragma unroll
    for (int o = 1; o < 64; o <<= 1) v += __shfl_xor(v, o);
    return v;
}
template <int CTRL> __device__ __forceinline__ float dppf(float x) { return __builtin_bit_cast(float, __builtin_amdgcn_mov_dpp(__builtin_bit_cast(int, x), CTRL, 0xF, 0xF, true)); }
__device__ __forceinline__ float sum8(float v) { v += dppf<0xB1>(v); v += dppf<0x4E>(v); v += dppf<0x141>(v); return v; }
__device__ __forceinline__ float sum16(float v) { v = sum8(v); v += dppf<0x140>(v); return v; }
__device__ __forceinline__ float fsigmoid(float x) { return __builtin_amdgcn_rcpf(1.0f + __builtin_amdgcn_exp2f(-1.4426950408889634f * x)); }
__device__ __forceinline__ float ftanh(float x) { return 1.0f - 2.0f * __builtin_amdgcn_rcpf(1.0f + __builtin_amdgcn_exp2f(2.8853900817779268f * x)); }
__device__ __forceinline__ float fsilu(float x) { return x * fsigmoid(x); }

using pg8::Unit;
typedef float accf32x4 __attribute__((ext_vector_type(4)));
struct EpiPlain {
    static constexpr bool PERM = true, AFTER_DRAIN = false;
    bf16_t* O; int ldc;
    __device__ __forceinline__ void operator()(const accf32x4 (&acc)[2][2][4][2], const Unit& u, int wr, int wc, int fr, int fq) const {
        const int row0 = u.pm * 256 + wr * 64 + fr, col0 = u.pn * 256 + wc * 32 + 8 * fq;
#pragma unroll
        for (int ai = 0; ai < 2; ++ai)
#pragma unroll
            for (int m = 0; m < 4; ++m) { bf16_t* rowp = O + (size_t)(row0 + ai * 128 + m * 16) * ldc + col0;
#pragma unroll
                for (int bj = 0; bj < 2; ++bj) { const accf32x4 v0 = acc[ai][bj][m][0], v1 = acc[ai][bj][m][1];
                    u32x4 w; w.x = pk2(v0[0], v0[1]); w.y = pk2(v0[2], v0[3]); w.z = pk2(v1[0], v1[1]); w.w = pk2(v1[2], v1[3]);
                    *(u32x4*)(rowp + bj * 128) = w; } }
    }
};
struct EpiQKV {
    static constexpr bool PERM = true, AFTER_DRAIN = false;
    unsigned char* wsb;
    __device__ __forceinline__ void operator()(const accf32x4 (&acc)[2][2][4][2], const Unit& u, int wr, int wc, int fr, int fq) const {
        size_t ooff; int ldc, ct;
        if (u.pn < 8) { ooff = WS_Q; ldc = 2048; ct = u.pn; } else if (u.pn < 10) { ooff = WS_K; ldc = 512; ct = u.pn - 8; } else { ooff = WS_V; ldc = 512; ct = u.pn - 10; }
        bf16_t* O = (bf16_t*)(wsb + ooff);
        const int row0 = u.pm * 256 + wr * 64 + fr, col0 = ct * 256 + wc * 32 + 8 * fq;
#pragma unroll
        for (int ai = 0; ai < 2; ++ai)
#pragma unroll
            for (int m = 0; m < 4; ++m) { bf16_t* rowp = O + (size_t)(row0 + ai * 128 + m * 16) * ldc + col0;
#pragma unroll
                for (int bj = 0; bj < 2; ++bj) { const accf32x4 v0 = acc[ai][bj][m][0], v1 = acc[ai][bj][m][1];
                    u32x4 w; w.x = pk2(v0[0], v0[1]); w.y = pk2(v0[2], v0[3]); w.z = pk2(v1[0], v1[1]); w.w = pk2(v1[2], v1[3]);
                    *(u32x4*)(rowp + bj * 128) = w; } }
    }
};
struct EpiQKVN {
    static constexpr bool PERM = true, AFTER_DRAIN = false;
    unsigned char* wsb; const float* gq; const float* gk; LAS float* xch; float qscale;
    __device__ __forceinline__ void operator()(const accf32x4 (&acc)[2][2][4][2], const Unit& u, int wr, int wc, int fr, int fq) const {
        size_t ooff; int ldc, ct;
        if (u.pn < 8) { ooff = WS_Q; ldc = 2048; ct = u.pn; } else if (u.pn < 10) { ooff = WS_K; ldc = 512; ct = u.pn - 8; } else { ooff = WS_V; ldc = 512; ct = u.pn - 10; }
        bf16_t* O = (bf16_t*)(wsb + ooff);
        const int row0 = u.pm * 256 + wr * 64 + fr, col0 = ct * 256 + wc * 32 + 8 * fq;
        if (u.pn >= 10) {
#pragma unroll
            for (int ai = 0; ai < 2; ++ai)
#pragma unroll
                for (int m = 0; m < 4; ++m) { bf16_t* rowp = O + (size_t)(row0 + ai * 128 + m * 16) * ldc + col0;
#pragma unroll
                    for (int bj = 0; bj < 2; ++bj) { const accf32x4 v0 = acc[ai][bj][m][0], v1 = acc[ai][bj][m][1];
                        u32x4 w; w.x = pk2(v0[0], v0[1]); w.y = pk2(v0[2], v0[3]); w.z = pk2(v1[0], v1[1]); w.w = pk2(v1[2], v1[3]);
                        *(u32x4*)(rowp + bj * 128) = w; } }
            return;
        }
#pragma unroll
        for (int ai = 0; ai < 2; ++ai)
#pragma unroll
            for (int m = 0; m < 4; ++m)
#pragma unroll
                for (int bj = 0; bj < 2; ++bj) { const accf32x4 v0 = acc[ai][bj][m][0], v1 = acc[ai][bj][m][1];
                    float x = v0[0] * v0[0] + v0[1] * v0[1] + v0[2] * v0[2] + v0[3] * v0[3] + v1[0] * v1[0] + v1[1] * v1[1] + v1[2] * v1[2] + v1[3] * v1[3];
                    { const unsigned ub = __builtin_bit_cast(unsigned, x); auto rr = __builtin_amdgcn_permlane16_swap(ub, ub, false, false); const unsigned r0 = rr[0], r1 = rr[1];
                      x = __builtin_bit_cast(float, r0) + __builtin_bit_cast(float, r1); }
                    { const unsigned ub = __builtin_bit_cast(unsigned, x); auto rr = __builtin_amdgcn_permlane32_swap(ub, ub, false, false); const unsigned r0 = rr[0], r1 = rr[1];
                      x = __builtin_bit_cast(float, r0) + __builtin_bit_cast(float, r1); }
                    if (fq == 0) xch[((wr * 128 + ai * 64 + m * 16 + fr) * 2 + bj) * 4 + wc] = x; }
        asm volatile("s_waitcnt lgkmcnt(0)" ::: "memory");
        __builtin_amdgcn_s_barrier();
        asm volatile("" ::: "memory");
        const float* gp = (u.pn < 8 ? gq : gk) + wc * 32 + 8 * fq;
        const f32x4 g0 = *(const f32x4*)gp, g1 = *(const f32x4*)(gp + 4);
        const bool lat = (u.pm % 17) != 0;
        const float* COS = (const float*)(wsb + WS_ROPE); const float* SIN = COS + 4096 * 64;
#pragma unroll
        for (int ai = 0; ai < 2; ++ai)
#pragma unroll
            for (int m = 0; m < 4; ++m) { const int row = row0 + ai * 128 + m * 16; bf16_t* rowp = O + (size_t)row * ldc + col0;
                f32x4 cs = (f32x4){1.f, 1.f, 1.f, 1.f}, sn = (f32x4){0.f, 0.f, 0.f, 0.f};
                if (lat) { const int pos = row % TB - CTXL; cs = *(const f32x4*)(COS + (size_t)pos * 64 + wc * 16 + 4 * fq); sn = *(const f32x4*)(SIN + (size_t)pos * 64 + wc * 16 + 4 * fq); }
#pragma unroll
                for (int bj = 0; bj < 2; ++bj) {
                    const f32x4 pp = *(const LAS f32x4*)(xch + ((wr * 128 + ai * 64 + m * 16 + fr) * 2 + bj) * 4);
                    const float rs = rsqrtf((pp[0] + pp[1] + pp[2] + pp[3]) * (1.0f / 128.0f) + NORM_EPS) * (u.pn < 8 ? qscale : 1.0f);
                    const accf32x4 v0 = acc[ai][bj][m][0], v1 = acc[ai][bj][m][1];
                    const float a0 = v0[0] * rs * g0[0], a1 = v0[1] * rs * g0[1], a2 = v0[2] * rs * g0[2], a3 = v0[3] * rs * g0[3];
                    const float b0 = v1[0] * rs * g1[0], b1 = v1[1] * rs * g1[1], b2 = v1[2] * rs * g1[2], b3 = v1[3] * rs * g1[3];
                    u32x4 w;
                    w.x = pk2(a0 * cs[0] - a1 * sn[0], a0 * sn[0] + a1 * cs[0]); w.y = pk2(a2 * cs[1] - a3 * sn[1], a2 * sn[1] + a3 * cs[1]);
                    w.z = pk2(b0 * cs[2] - b1 * sn[2], b0 * sn[2] + b1 * cs[2]); w.w = pk2(b2 * cs[3] - b3 * sn[3], b2 * sn[3] + b3 * cs[3]);
                    *(u32x4*)(rowp + bj * 128) = w; } }
    }
};
struct EpiSwiGLU {
    static constexpr bool PERM = true, AFTER_DRAIN = false;
    bf16_t* O;
    __device__ __forceinline__ void operator()(const accf32x4 (&acc)[2][2][4][2], const Unit& u, int wr, int wc, int fr, int fq) const {
        const int row0 = u.pm * 256 + wr * 64 + fr, col0 = u.pn * 128 + wc * 32 + 8 * fq;
#pragma unroll
        for (int ai = 0; ai < 2; ++ai)
#pragma unroll
            for (int m = 0; m < 4; ++m) { bf16_t* rowp = O + (size_t)(row0 + ai * 128 + m * 16) * FF + col0;
                float r[8];
#pragma unroll
                for (int n = 0; n < 2; ++n)
#pragma unroll
                    for (int e = 0; e < 4; ++e) { const float g = acc[ai][0][m][n][e], up = acc[ai][1][m][n][e]; r[4 * n + e] = fsilu(g) * up; }
                *(u32x4*)rowp = pack8(r); }
    }
};
struct EpiRw1 {
    static constexpr bool PERM = true, AFTER_DRAIN = false;
    unsigned char* wsb; const float* k_k;
    __device__ __forceinline__ void operator()(const accf32x4 (&acc)[2][2][4][2], const Unit& u, int wr, int wc, int fr, int fq) const {
        const int row0 = u.pm * 256 + wr * 64 + fr, cit = 64 * wc + 8 * fq;
        const int pn = u.pn;
        if (pn >= 8 && pn < 16) {
            bf16_t* K = (bf16_t*)(wsb + WS_KK_); bf16_t* KN = (bf16_t*)(wsb + WS_KN);
            const int colb = (pn - 8) * 256 + cit;
            float kk0[8], kk1[8];
            { const f32x4 a0 = *(const f32x4*)(k_k + colb), a1 = *(const f32x4*)(k_k + colb + 4), b0 = *(const f32x4*)(k_k + colb + 32), b1 = *(const f32x4*)(k_k + colb + 36);
#pragma unroll
              for (int e = 0; e < 4; ++e) { kk0[e] = a0[e]; kk0[4 + e] = a1[e]; kk1[e] = b0[e]; kk1[4 + e] = b1[e]; } }
#pragma unroll
            for (int ai = 0; ai < 2; ++ai)
#pragma unroll
                for (int m = 0; m < 4; ++m) { const size_t ro = (size_t)(row0 + ai * 128 + m * 16) * D + colb;
                    float k0[8], k1[8], q0[8], q1[8]; float ss = 0.f;
#pragma unroll
                    for (int n = 0; n < 2; ++n)
#pragma unroll
                        for (int e = 0; e < 4; ++e) { k0[4 * n + e] = acc[ai][0][m][n][e]; k1[4 * n + e] = acc[ai][1][m][n][e]; }
#pragma unroll
                    for (int i = 0; i < 8; ++i) { q0[i] = k0[i] * kk0[i]; q1[i] = k1[i] * kk1[i]; ss += q0[i] * q0[i] + q1[i] * q1[i]; }
                    ss += __shfl_xor(ss, 16); ss += __shfl_xor(ss, 32);
                    const float rs = rsqrtf(ss + 1e-12f);
#pragma unroll
                    for (int i = 0; i < 8; ++i) { q0[i] *= rs; q1[i] *= rs; }
                    *(u32x4*)(K + ro) = pack8(k0); *(u32x4*)(K + ro + 32) = pack8(k1);
                    *(u32x4*)(KN + ro) = pack8(q0); *(u32x4*)(KN + ro + 32) = pack8(q1); }
        } else if (pn < 24) {
            bf16_t* O = (bf16_t*)(wsb + (pn < 8 ? WS_RR : WS_VV)); const int colb = (pn & 7) * 256 + cit;
#pragma unroll
            for (int ai = 0; ai < 2; ++ai)
#pragma unroll
                for (int m = 0; m < 4; ++m) { const size_t ro = (size_t)(row0 + ai * 128 + m * 16) * D + colb;
#pragma unroll
                    for (int bj = 0; bj < 2; ++bj) { const accf32x4 v0 = acc[ai][bj][m][0], v1 = acc[ai][bj][m][1];
                        u32x4 w; w.x = pk2(v0[0], v0[1]); w.y = pk2(v0[2], v0[3]); w.z = pk2(v1[0], v1[1]); w.w = pk2(v1[2], v1[3]);
                        *(u32x4*)(O + ro + 32 * bj) = w; } }
        } else {
            bf16_t* O = (bf16_t*)(wsb + WS_GL + (size_t)(pn - 24) * (9 * MiB));
#pragma unroll
            for (int ai = 0; ai < 2; ++ai)
#pragma unroll
                for (int m = 0; m < 4; ++m) { const size_t ro = (size_t)(row0 + ai * 128 + m * 16) * 256 + cit;
#pragma unroll
                    for (int bj = 0; bj < 2; ++bj) { float r[8];
#pragma unroll
                        for (int n = 0; n < 2; ++n)
#pragma unroll
                            for (int e = 0; e < 4; ++e) { const float x = acc[ai][bj][m][n][e]; r[4 * n + e] = pn == 24 ? fsigmoid(x) : (pn == 25 ? ftanh(x) : x); }
                        *(u32x4*)(O + ro + 32 * bj) = pack8(r); } }
        }
    }
};
struct EpiRw2 {
    static constexpr bool PERM = true, AFTER_DRAIN = false;
    unsigned char* wsb; const float *w0, *a0; size_t aa_off;
    __device__ __forceinline__ void operator()(const accf32x4 (&acc)[2][2][4][2], const Unit& u, int wr, int wc, int fr, int fq) const {
        const int row0 = u.pm * 256 + wr * 64 + fr, cit = 64 * wc + 8 * fq;
        const int pn = u.pn;
        if (pn < 8) {
            bf16_t* G = (bf16_t*)(wsb + WS_GG);
            const int colb = pn * 256 + cit;
#pragma unroll
            for (int ai = 0; ai < 2; ++ai)
#pragma unroll
                for (int m = 0; m < 4; ++m) { const size_t ro = (size_t)(row0 + ai * 128 + m * 16) * D + colb;
#pragma unroll
                    for (int bj = 0; bj < 2; ++bj) { const accf32x4 v0 = acc[ai][bj][m][0], v1 = acc[ai][bj][m][1];
                        u32x4 w; w.x = pk2(v0[0], v0[1]); w.y = pk2(v0[2], v0[3]); w.z = pk2(v1[0], v1[1]); w.w = pk2(v1[2], v1[3]);
                        *(u32x4*)(G + ro + 32 * bj) = w; } }
        } else if (pn < 24) {
            const int d = (pn - 8) >> 3, colb = ((pn - 8) & 7) * 256 + cit;
            bf16_t* Wd = (bf16_t*)(wsb + WS_WDEC) + (size_t)d * M * D;
#pragma unroll
            for (int bj = 0; bj < 2; ++bj) {
                const f32x4 b0 = *(const f32x4*)(w0 + d * D + colb + 32 * bj), b1 = *(const f32x4*)(w0 + d * D + colb + 32 * bj + 4);
#pragma unroll
                for (int ai = 0; ai < 2; ++ai)
#pragma unroll
                    for (int m = 0; m < 4; ++m) { const size_t ro = (size_t)(row0 + ai * 128 + m * 16) * D + colb + 32 * bj;
                        float lw[8];
#pragma unroll
                        for (int e = 0; e < 4; ++e) { lw[e] = -0.8750387749f * fsigmoid(acc[ai][bj][m][0][e] + b0[e]);
                                                      lw[4 + e] = -0.8750387749f * fsigmoid(acc[ai][bj][m][1][e] + b1[e]); }
                        *(u32x4*)(Wd + ro) = pack8(lw); } }
        } else {
            const int d = (pn - 24) >> 3, colb = ((pn - 24) & 7) * 256 + cit;
            bf16_t* AAd = (bf16_t*)(wsb + aa_off) + (size_t)d * M * D;
#pragma unroll
            for (int bj = 0; bj < 2; ++bj) {
                const int cb = colb + 32 * bj;
                const f32x4 b0 = *(const f32x4*)(a0 + d * D + cb), b1 = *(const f32x4*)(a0 + d * D + cb + 4);
#pragma unroll
                for (int ai = 0; ai < 2; ++ai)
#pragma unroll
                    for (int m = 0; m < 4; ++m) { const size_t ro = (size_t)(row0 + ai * 128 + m * 16) * D + cb;
                        float av[8];
#pragma unroll
                        for (int e = 0; e < 4; ++e) { av[e] = fsigmoid(acc[ai][bj][m][0][e] + b0[e]); av[4 + e] = fsigmoid(acc[ai][bj][m][1][e] + b1[e]); }
                        *(u32x4*)(AAd + ro) = pack8(av); } }
        }
    }
};
struct GemmRw1 { const bf16_t* MIX; const bf16_t* Bt;  int K;
    __device__ __forceinline__ const char* a_tile(const Unit& u) const { int idx = u.pn < 24 ? (u.pn >> 3) : (u.pn - 21);
#ifdef DBG_RW1_SAMEA
        idx = 0;
#endif
        return (const char*)MIX + (size_t)idx * SZ_R2 + (size_t)u.pm * (size_t)(256 * 2) * D; }
    __device__ __forceinline__ const char* b_tile(const Unit& u) const { return (const char*)Bt + (size_t)u.pn * (size_t)(256 * 2) * D; }
    __device__ __forceinline__ int klen() const { return K; } };
struct GemmRw2 { const unsigned char* wsb; const bf16_t* Bt; int K, KL;
    __device__ __forceinline__ int koff(const Unit& u) const { return KL < 256 ? (((u.pn - 8) >> 3) & 1) * 64 : 0; }
    __device__ __forceinline__ const char* a_tile(const Unit& u) const { const size_t ao = u.pn < 8 ? WS_GL : (u.pn < 24 ? WS_WL : WS_AL); return (const char*)wsb + ao + (size_t)u.pm * (size_t)(256 * 2) * 256 + (size_t)koff(u) * 2; }
    __device__ __forceinline__ const char* b_tile(const Unit& u) const { return (const char*)Bt + (size_t)u.pn * (size_t)(256 * 2) * 256 + (size_t)koff(u) * 2; }
    __device__ __forceinline__ int klen() const { return KL; } };
struct Rw2WAOrder : pg8::StaticOrder {
    __device__ bool next(int i, Unit& u) const { if (!pg8::StaticOrder::next(i, u)) return false; u.pn += 8; return true; }
};

__device__ __forceinline__ int hp_row(int c) { return 128 * ((c & 63) >> 5) + 32 * (c >> 6) + (c & 31); }
__device__ __forceinline__ int hp_col(int rho) { return 64 * ((rho & 127) >> 5) + 32 * (rho >> 7) + (rho & 31); }
__device__ __forceinline__ void cvt_item(const float* W, int K, int N, bf16_t* WT, int mode, int row_off, LAS float* scr, int item, int lane) {
    const int nblk = N / 32, kb = item / nblk, nb = item - kb * nblk, k0 = 64 * kb, n0 = 32 * nb;
#pragma unroll 8
    for (int i = 0; i < 32; ++i) { const int kk = 2 * i + (lane >> 5); scr[kk * 33 + (lane & 31)] = W[(size_t)(k0 + kk) * N + n0 + (lane & 31)]; }
    LDS_WAIT(); asm volatile("" ::: "memory");
    int dr;
    if (mode == 0) dr = n0;
    else if (mode == 1) { dr = n0 < FF ? 256 * (n0 / 128) + (n0 % 128) : 256 * ((n0 - FF) / 128) + 128 + ((n0 - FF) % 128); }
    else { dr = (n0 & ~255) + hp_row(n0 & 255); }
    dr += row_off;
    const int c = lane & 7;
#pragma unroll
    for (int j = 0; j < 4; ++j) { const int n = (lane >> 3) + 8 * j; const LAS float* s = scr + (8 * c) * 33 + n;
        u32x4 o; o.x = pk2(s[0 * 33], s[1 * 33]); o.y = pk2(s[2 * 33], s[3 * 33]); o.z = pk2(s[4 * 33], s[5 * 33]); o.w = pk2(s[6 * 33], s[7 * 33]);
        *(u32x4*)(WT + (size_t)(dr + n) * K + k0 + 8 * c) = o; }
    LDS_WAIT(); asm volatile("" ::: "memory");
}
constexpr int I_F1 = (D / 64) * (2 * FF / 32), I_F2 = (FF / 64) * (D / 32), I_QKV = (D / 64) * (3072 / 32), I_SQ = (D / 64) * (D / 32), I_G1 = (D / 64) * (256 / 32), I_G2 = (256 / 64) * (D / 32);
constexpr int CVT_FFN = 4 * (I_F1 + I_F2), CVT_ATT = I_QKV + I_SQ, CVT_RW = 4 * I_SQ + I_G1 + I_G2, CVT_HALF = CVT_FFN + CVT_ATT + CVT_RW;
__device__ __forceinline__ void cvt_big_item(KArgs* a, int r, int late, LAS float* scr, int lane_) {
    bf16_t* WB = (bf16_t*)(a->ws + WS_WB); bf16_t* WA = (bf16_t*)(a->ws + WS_WA); bf16_t* WR = (bf16_t*)(a->ws + WS_WR);
    if (r < CVT_FFN) { const int lq = r / (I_F1 + I_F2), lh = 4 * late + lq; r -= lq * (I_F1 + I_F2);
        bf16_t* base = WB + (size_t)lh * (E_F1 + E_F2);
        if (r < I_F1) cvt_item(a->in[8] + (size_t)lh * D * 2 * FF, D, 2 * FF, base, 1, 0, scr, r, lane_);
        else cvt_item(a->in[9] + (size_t)lh * FF * D, FF, D, base + E_F1, 0, 0, scr, r - I_F1, lane_);
        return; }
    r -= CVT_FFN;
    const int j = late;
    if (r < CVT_ATT) {
        bf16_t* base = WA + (size_t)j * (E_QKV + E_SQ);
        if (r < I_QKV) cvt_item(a->in[10] + (size_t)j * D * 3072, D, 3072, base, 0, 0, scr, r, lane_);
        else cvt_item(a->in[11] + (size_t)j * D * D, D, D, base + E_QKV, 0, 0, scr, r - I_QKV, lane_);
        return; }
    r -= CVT_ATT;
    { bf16_t* rw1 = WR + (size_t)j * (E_RW1 + E_RW2 + E_SQ); bf16_t* rw2 = rw1 + E_RW1; bf16_t* ro = rw2 + E_RW2;
      if (r < 3 * I_SQ) { const int q = r / I_SQ; cvt_item(a->in[15] + ((size_t)j * 3 + q) * D * D, D, D, rw1, 2, q * 2048, scr, r - q * I_SQ, lane_); return; }
      r -= 3 * I_SQ;
      if (r < I_SQ) { cvt_item(a->in[16] + (size_t)j * D * D, D, D, ro, 0, 0, scr, r, lane_); return; }
      r -= I_SQ;
      if (r < I_G1) { cvt_item(a->in[17] + (size_t)j * D * 256, D, 256, rw1, 2, 6144, scr, r, lane_); return; }
      r -= I_G1;
      cvt_item(a->in[18] + (size_t)j * 256 * D, 256, D, rw2, 2, 0, scr, r, lane_); }
}
struct CvtJob { const float* W; bf16_t* WT; int K, N, mode, row_off, item; };
constexpr int CVT_N0 = 3 * (I_F1 + I_F2) + CVT_ATT + (3 * I_SQ + I_G1 + I_G2), CVT_N1 = 5 * (I_F1 + I_F2) + CVT_ATT + CVT_RW + I_SQ;
__device__ __forceinline__ CvtJob cvt_decode(KArgs* a, int r, int g) {
    bf16_t* WB = (bf16_t*)(a->ws + WS_WB); bf16_t* WA = (bf16_t*)(a->ws + WS_WA); bf16_t* WR = (bf16_t*)(a->ws + WS_WR);
    CvtJob j; j.row_off = 0; j.mode = 0;
    const int nffn = (g ? 5 : 3) * (I_F1 + I_F2);
    if (r < nffn) { const int lq = r / (I_F1 + I_F2), lh = (g ? 3 : 0) + lq; r -= lq * (I_F1 + I_F2);
        bf16_t* base = WB + (size_t)lh * (E_F1 + E_F2);
        if (r < I_F1) { j.W = a->in[8] + (size_t)lh * D * 2 * FF; j.K = D; j.N = 2 * FF; j.WT = base; j.mode = 1; j.item = r; }
        else { j.W = a->in[9] + (size_t)lh * FF * D; j.K = FF; j.N = D; j.WT = base + E_F1; j.item = r - I_F1; }
        return j; }
    r -= nffn;
    int l = g;
    if (r < CVT_ATT) {
        bf16_t* base = WA + (size_t)l * (E_QKV + E_SQ);
        if (r < I_QKV) { j.W = a->in[10] + (size_t)l * D * 3072; j.K = D; j.N = 3072; j.WT = base; j.item = r; }
        else { j.W = a->in[11] + (size_t)l * D * D; j.K = D; j.N = D; j.WT = base + E_QKV; j.item = r - I_QKV; }
        return j; }
    r -= CVT_ATT;
    if (r < 3 * I_SQ) { bf16_t* rw1 = WR + (size_t)l * (E_RW1 + E_RW2 + E_SQ);
        const int q = r / I_SQ; j.W = a->in[15] + ((size_t)l * 3 + q) * D * D; j.K = D; j.N = D; j.WT = rw1; j.mode = 2; j.row_off = q * 2048; j.item = r - q * I_SQ; return j; }
    r -= 3 * I_SQ;
    if (r < I_G1) { bf16_t* rw1 = WR + (size_t)l * (E_RW1 + E_RW2 + E_SQ); j.W = a->in[17] + (size_t)l * D * 256; j.K = D; j.N = 256; j.WT = rw1; j.mode = 2; j.row_off = 6144; j.item = r; return j; }
    r -= I_G1;
    if (r < I_G2) { bf16_t* rw2 = WR + (size_t)l * (E_RW1 + E_RW2 + E_SQ) + E_RW1; j.W = a->in[18] + (size_t)l * 256 * D; j.K = 256; j.N = D; j.WT = rw2; j.mode = 2; j.item = r; return j; }
    r -= I_G2;
    l = r < I_SQ ? 1 : 0; r -= (1 - l) * I_SQ;
    { bf16_t* ro = WR + (size_t)l * (E_RW1 + E_RW2 + E_SQ) + E_RW1 + E_RW2; j.W = a->in[16] + (size_t)l * D * D; j.K = D; j.N = D; j.WT = ro; j.item = r; }
    return j;
}
__device__ __forceinline__ void cvt_job_load(const CvtJob& j, int lane, float (&v)[32]) {
    const int nblk = j.N / 32, kb = j.item / nblk, nb = j.item - kb * nblk, k0 = 64 * kb, n0 = 32 * nb;
    const float* p = j.W + (size_t)(k0 + (lane >> 5)) * j.N + n0 + (lane & 31);
#pragma unroll
    for (int i = 0; i < 32; ++i) v[i] = p[(size_t)(2 * i) * j.N];
}
__device__ __forceinline__ void cvt_job_store(const CvtJob& j, LAS float* scr, int lane, const float (&v)[32]) {
    const int nblk = j.N / 32, kb = j.item / nblk, nb = j.item - kb * nblk, k0 = 64 * kb, n0 = 32 * nb;
#pragma unroll
    for (int i = 0; i < 32; ++i) scr[(2 * i + (lane >> 5)) * 33 + (lane & 31)] = v[i];
    LDS_WAIT(); asm volatile("" ::: "memory");
    int dr;
    if (j.mode == 0) dr = n0;
    else if (j.mode == 1) { dr = n0 < FF ? 256 * (n0 / 128) + (n0 % 128) : 256 * ((n0 - FF) / 128) + 128 + ((n0 - FF) % 128); }
    else { dr = (n0 & ~255) + hp_row(n0 & 255); }
    dr += j.row_off;
    const int c = lane & 7;
#pragma unroll
    for (int q = 0; q < 4; ++q) { const int n = (lane >> 3) + 8 * q; const LAS float* sp = scr + (8 * c) * 33 + n;
        u32x4 o; o.x = pk2(sp[0 * 33], sp[1 * 33]); o.y = pk2(sp[2 * 33], sp[3 * 33]); o.z = pk2(sp[4 * 33], sp[5 * 33]); o.w = pk2(sp[6 * 33], sp[7 * 33]);
        *(u32x4*)(j.WT + (size_t)(dr + n) * j.K + k0 + 8 * c) = o; }
    LDS_WAIT(); asm volatile("" ::: "memory");
}
__device__ __forceinline__ void p0a_phase(const Frame F, KArgs* a) {
    const int lane_ = lane_opaque(), tid_ = F.wave * 64 + lane_; (void)tid_; (void)lane_;
    LAS float* scr = (LAS float*)(F.lds + F.wave * 16384);
    const int gw = F.bid * NWAVES + F.wave, NGW = F.G * NWAVES;
    bf16_t* WR = (bf16_t*)(a->ws + WS_WR);
    for (int it = gw; it < CVT_N0; it += NGW) { const CvtJob j = cvt_decode(a, it, 0); float v[32]; cvt_job_load(j, lane_, v); cvt_job_store(j, scr, lane_, v); }
    {
        constexpr int P_A = 256 * 2048 / 2, P_C = 4096 * 256 / 2, P_J = 2 * P_A + 2 * P_C;
        for (int p = F.bid * NTHR + tid_; p < 2 * P_J; p += F.G * NTHR) {
            const int j = p / P_J; int r = p - j * P_J;
            bf16_t* rw1 = WR + (size_t)j * (E_RW1 + E_RW2 + E_SQ); bf16_t* rw2 = rw1 + E_RW1;
            if (r < 2 * P_A) { const int which = r / P_A; r -= which * P_A;
                const int rho = r / 1024, k = (r - rho * 1024) * 2, c = hp_col(rho);
                const float* src = (which == 0 ? a->in[20] : a->in[23]);
                float v0 = 0.f, v1 = 0.f;
                if (c < 192) { const int d = c / 96, jj = c - d * 96; const float* s = src + (((size_t)j * 2 + d) * D + k) * 96 + jj; v0 = s[0]; v1 = s[96]; }
                *(unsigned*)(rw1 + (size_t)(6400 + 256 * which + rho) * D + k) = pk2(v0, v1);
            } else { r -= 2 * P_A; const int which = r / P_C; r -= which * P_C;
                const int nrow = r / 128, k = (r - nrow * 128) * 2;
                const int d = nrow >> 11, np = nrow & 2047, c = (np & ~255) + hp_col(np & 255);
                const float* src = (which == 0 ? a->in[21] : a->in[24]);
                float v0 = 0.f, v1 = 0.f;
                if (k < 192 && (k / 96) == d) { const int kk = k - d * 96; const float* s = src + (((size_t)j * 2 + d) * 96 + kk) * D + c; v0 = s[0]; v1 = s[D]; }
                *(unsigned*)(rw2 + (size_t)(2048 + 4096 * which + nrow) * 256 + k) = pk2(v0, v1);
            }
        }
    }
#ifdef DBG_FILL_WS
    {
        u32x4* p = (u32x4*)(a->ws + WS_X); const size_t n16 = (WS_END - WS_X) / 16;
        for (size_t i = (size_t)F.bid * NTHR + tid_; i < n16; i += (size_t)F.G * NTHR) p[i] = (u32x4){0xAAAAAAAAu, 0xAAAAAAAAu, 0xAAAAAAAAu, 0xAAAAAAAAu};
    }
#endif
    {
        float* COS = (float*)(a->ws + WS_ROPE); float* SIN = COS + 4096 * 64;
        for (int p = F.bid * NTHR + tid_; p < 4096 * 64; p += F.G * NTHR) {
            const int t = p >> 6, f = p & 63; const int pos = f < 32 ? (t >> 6) : (t & 63); const int fi = f & 31;
            const float inv = exp2f(-(float)fi * (13.287712379549449f / 32.0f));
            const float ang = (float)pos * inv;
            COS[p] = cosf(ang); SIN[p] = sinf(ang);
        }
    }
    {
        LAS float* sv = (LAS float*)F.lds;
        LAS float* part = (LAS float*)(F.lds + 65536);
        float* MOD = (float*)(a->ws + WS_MOD);
        __syncthreads();
        for (int idx = tid_; idx < 5 * D; idx += NTHR) { const int cc = idx >> 11, kk = idx & 2047; const float x = cc < 4 ? a->in[1][cc * D + kk] : a->in[3][kk]; sv[kk * 8 + cc] = fsilu(x); }
        __syncthreads();
        for (int u = F.bid; u < 4 * 72; u += F.G) {
            const int l = u / 72, nb = u - l * 72;
            const int n = nb * 256 + lane_ * 4, k0 = F.wave * 256;
            const float* wp = a->in[4] + ((size_t)l * D + k0) * 18432 + n;
            f32x4 acc[5];
#pragma unroll
            for (int c = 0; c < 5; ++c) acc[c] = (f32x4){0.f, 0.f, 0.f, 0.f};
#pragma unroll 8
            for (int kk = 0; kk < 256; ++kk) { const f32x4 w4 = *(const f32x4*)(wp + (size_t)kk * 18432);
                const f32x4 s4 = *(const LAS f32x4*)(sv + (k0 + kk) * 8); const float s5 = sv[(k0 + kk) * 8 + 4];
                acc[0] += w4 * s4[0]; acc[1] += w4 * s4[1]; acc[2] += w4 * s4[2]; acc[3] += w4 * s4[3]; acc[4] += w4 * s5; }
#pragma unroll
            for (int c = 0; c < 5; ++c) *(LAS f32x4*)(part + (F.wave * 5 + c) * 256 + lane_ * 4) = acc[c];
            __syncthreads();
            for (int o = tid_; o < 5 * 256; o += NTHR) { const int c = o >> 8, col = o & 255; float s = a->in[5][(size_t)l * 18432 + nb * 256 + col];
#pragma unroll
                for (int w = 0; w < 8; ++w) s += part[(w * 5 + c) * 256 + col];
                MOD[((size_t)l * 5 + c) * 18432 + nb * 256 + col] = s; }
            __syncthreads();
        }
    }
}

template <int MODE> struct ThinCtx { float PA[4][8], PB[4][8], PC[4][8]; int cur_c; };
template <int MODE, bool CTXP>
__device__ __forceinline__ void thin_row(ThinCtx<MODE>& T, KArgs* a, const int lane, const int m, int l, int s, float wgt, int nl, int ns) {
    const float* MOD = (const float*)(a->ws + WS_MOD);
    bf16_t* X = (bf16_t*)(a->ws + WS_X)  ; bf16_t* Y = (bf16_t*)(a->ws + WS_Y); const bf16_t* OUT = (const bf16_t*)(a->ws + WS_OUT);
    const int b = m / TB, j = m - b * TB, c = j < CTXL ? 4 : b;
    if (MODE == 2 && c == 4) return;
    if (c != T.cur_c) {
        T.cur_c = c;
#pragma unroll
        for (int q = 0; q < 4; ++q) { const int e0 = 512 * q + 8 * lane;
            if (MODE != 0) { const float* gp = MOD + (((size_t)l * 5 + c) * 9 + s * 3 + 2) * D + e0; const float* np = a->in[7] + ((size_t)l * 3 + s) * D + e0;
#pragma unroll
                for (int i = 0; i < 8; ++i) T.PA[q][i] = wgt * gp[i] * np[i]; }
            if (MODE != 2) { const float* sc = MOD + (((size_t)nl * 5 + c) * 9 + ns * 3 + 1) * D + e0; const float* sh = MOD + (((size_t)nl * 5 + c) * 9 + ns * 3 + 0) * D + e0; const float* np = a->in[6] + ((size_t)nl * 3 + ns) * D + e0;
#pragma unroll
                for (int i = 0; i < 8; ++i) { T.PB[q][i] = np[i] * (1.0f + sc[i]); T.PC[q][i] = sh[i]; } } }
    }
    float x[4][8];
    if (MODE == 0) {
        const float* src = j < CTXL ? a->in[2] + ((size_t)b * CTXL + j) * D : a->in[0] + ((size_t)b * SEQ + (j - CTXL)) * D;
#pragma unroll
        for (int q = 0; q < 4; ++q) { const f32x4 v0 = *(const f32x4*)(src + 512 * q + 8 * lane), v1 = *(const f32x4*)(src + 512 * q + 8 * lane + 4);
#pragma unroll
            for (int e = 0; e < 4; ++e) { x[q][e] = v0[e]; x[q][4 + e] = v1[e]; } }
    } else {
        float o[4][8]; float ss = 0.f;
#pragma unroll
        for (int q = 0; q < 4; ++q) {
            if (CTXP) { const float* P0 = (const float*)(a->ws + WS_PART) + (size_t)(b * CTXL + j) * D + 512 * q + 8 * lane; const float* P1 = P0 + (size_t)(NB * CTXL) * D;
                const f32x4 a0 = *(const f32x4*)P0, a1 = *(const f32x4*)(P0 + 4), b0 = *(const f32x4*)P1, b1 = *(const f32x4*)(P1 + 4);
#pragma unroll
                for (int e = 0; e < 4; ++e) { o[q][e] = a0[e] + b0[e]; o[q][4 + e] = a1[e] + b1[e]; } }
            else unpack8(*(const u32x4*)(OUT + (size_t)m * D + 512 * q + 8 * lane), o[q]);
#pragma unroll
            for (int i = 0; i < 8; ++i) ss += o[q][i] * o[q][i]; }
        ss = wave_sum(ss);
        const float r1 = rsqrtf(ss * (1.0f / D) + NORM_EPS);
#pragma unroll
        for (int q = 0; q < 4; ++q) { float xo[8]; unpack8h(*(const u32x4*)(X + (size_t)m * D + 512 * q + 8 * lane), xo);
#pragma unroll
            for (int e = 0; e < 8; ++e) x[q][e] = xo[e] + T.PA[q][e] * (o[q][e] * r1); }
    }
    if (MODE == 2) {
        float* dst = a->out + ((size_t)b * SEQ + (j - CTXL)) * D;
#pragma unroll
        for (int q = 0; q < 4; ++q) { *(f32x4*)(dst + 512 * q + 8 * lane) = (f32x4){x[q][0], x[q][1], x[q][2], x[q][3]}; *(f32x4*)(dst + 512 * q + 8 * lane + 4) = (f32x4){x[q][4], x[q][5], x[q][6], x[q][7]}; }
        return;
    }
    float ss2 = 0.f;
#pragma unroll
    for (int q = 0; q < 4; ++q) { *(u32x4*)(X + (size_t)m * D + 512 * q + 8 * lane) = pack8h(x[q]);
#pragma unroll
        for (int i = 0; i < 8; ++i) ss2 += x[q][i] * x[q][i]; }
    ss2 = wave_sum(ss2);
    const float r2 = rsqrtf(ss2 * (1.0f / D) + NORM_EPS);
#pragma unroll
    for (int q = 0; q < 4; ++q) { float y[8];
#pragma unroll
        for (int i = 0; i < 8; ++i) y[i] = (x[q][i] * r2) * T.PB[q][i] + T.PC[q][i];
        *(u32x4*)(Y + (size_t)m * D + 512 * q + 8 * lane) = pack8(y); }
}
template <int MODE, int ROWSET, int NX = NCTXWG, int WX = 0>
__device__ __forceinline__ void thin_phase(const Frame F, KArgs* a, int l, int s, float wgt, int nl, int ns) {
    const int lane_ = lane_opaque();
    ThinCtx<MODE> T; T.cur_c = -1;
    if (ROWSET == 0) {
        for (int ch = F.bid; ch < M / 68; ch += F.G) {
            const int r0 = ch * 68 + (F.wave < 4 ? 9 * F.wave : 36 + 8 * (F.wave - 4)), nr = F.wave < 4 ? 9 : 8;
            for (int r = 0; r < nr; ++r) thin_row<MODE, false>(T, a, lane_, r0 + r, l, s, wgt, nl, ns);
        }
    } else if (ROWSET == 1) {
        const long tot = (long)NX * NWAVES * WX + (long)(F.G - NX) * NWAVES * 8;
        const long st = F.bid < NX ? (long)(F.bid * NWAVES + F.wave) * WX : (long)NX * NWAVES * WX + (long)((F.bid - NX) * NWAVES + F.wave) * 8, en = st + (F.bid < NX ? WX : 8);
        const int l0 = (int)((st * (NB * SEQ)) / tot), l1 = (int)((en * (NB * SEQ)) / tot);
        for (int li = l0; li < l1; ++li) thin_row<MODE, false>(T, a, lane_, (li >> 12) * TB + CTXL + (li & (SEQ - 1)), l, s, wgt, nl, ns);
    } else {
        for (int c = F.wave * F.G + F.bid; c < NB * CTXL; c += F.G * NWAVES) thin_row<MODE, true>(T, a, lane_, (c >> 8) * TB + (c & (CTXL - 1)), l, s, wgt, nl, ns);
    }
}
__device__ __forceinline__ void ctx_group_thin(const Frame F, KArgs* a, unsigned* bar, int site, int l, int s, float wgt, int nl, int ns) {
    asm volatile("s_waitcnt vmcnt(0)" ::: "memory");
    __syncthreads();
    const int lane_ = lane_opaque();
    if (F.wave == 0 && lane_ == 0) {
        unsigned* c = (unsigned*)(a->ws + WS_CTL) + CW_GRP + (site * 4 + (F.bid >> 4)) * 64;
        __builtin_amdgcn_fence(__ATOMIC_RELEASE, "agent");
        asm volatile("s_waitcnt vmcnt(0)" ::: "memory");
        (void)xb_add(c, 1u);
        XB_SPIN(xb_ld(c) < 16u, bar);
        __builtin_amdgcn_fence(__ATOMIC_ACQUIRE, "agent");
        asm volatile("s_waitcnt vmcnt(0)" ::: "memory");
    }
    __syncthreads();
    ThinCtx<1> T; T.cur_c = -1;
    const int b = F.bid >> 4, r0 = (F.bid & 15) * 16 + F.wave * 2;
    thin_row<1, true>(T, a, lane_, b * TB + r0, l, s, wgt, nl, ns);
    thin_row<1, true>(T, a, lane_, b * TB + r0 + 1, l, s, wgt, nl, ns);
}
__device__ __forceinline__ void ctx_group_sync(const Frame F, KArgs* a, unsigned* bar, int site, int panel, unsigned n) {
    asm volatile("s_waitcnt vmcnt(0)" ::: "memory");
    __syncthreads();
    if (F.wave == 0 && lane_opaque() == 0) {
        unsigned* c = (unsigned*)(a->ws + WS_CTL) + CW_GRP + (site * 4 + panel) * 64;
        __builtin_amdgcn_fence(__ATOMIC_RELEASE, "agent");
        asm volatile("s_waitcnt vmcnt(0)" ::: "memory");
        (void)xb_add(c, 1u);
        XB_SPIN(xb_ld(c) < n, bar);
        __builtin_amdgcn_fence(__ATOMIC_ACQUIRE, "agent");
        asm volatile("s_waitcnt vmcnt(0)" ::: "memory");
    }
    __syncthreads();
}
struct CtxOrder8 {
    int c;
    __device__ bool next(int i, Unit& u) const { if (i != 0 || c >= 32) return false; u.pm = (c >> 3) * 17; u.pn = c & 7; return true; }
    __device__ __forceinline__ void a_ready(const Unit&) const {}
    __device__ __forceinline__ void done(const Unit&) const {}
};
__device__ __forceinline__ void ctx_mixer_thin(const Frame F, KArgs* a, unsigned* bar, int site, int l, int s, float wgt, int nl, int ns) {
    ctx_group_sync(F, a, bar, site, F.bid >> 3, 8u);
    const int lane_ = lane_opaque();
    ThinCtx<1> T; T.cur_c = -1;
    const int b = F.bid >> 3, r0 = (F.bid & 7) * 32 + F.wave * 4;
#pragma unroll 1
    for (int r = 0; r < 4; ++r) thin_row<1, false>(T, a, lane_, b * TB + r0 + r, l, s, wgt, nl, ns);
}
struct Ffn1Order {
    int G, c; unsigned* ctr;
    __device__ bool next(int i, Unit& u) const {
        const int L = i * G + c; if (L >= 68 * 44) return false;
        if (L < 176) { const int p = L / 44; u.pm = p * 17; u.pn = L - p * 44; return true; }
        constexpr int nM = 64, nN = 44, nwg = nM * nN;
        int wgid = L - 176; { const int q = nwg / pg8::NXCD, r = nwg % pg8::NXCD, xcd = wgid % pg8::NXCD, off = wgid / pg8::NXCD; wgid = (xcd < r ? xcd * (q + 1) : r * (q + 1) + (xcd - r) * q) + off; }
        const int nig = pg8::WGM * nN, gid = wgid / nig, fm = gid * pg8::WGM, gsz = (nM - fm) < pg8::WGM ? (nM - fm) : pg8::WGM;
        const int pl = fm + ((wgid % nig) % gsz); u.pm = pl + (pl >> 4) + 1; u.pn = (wgid % nig) / gsz; return true;
    }
    __device__ __forceinline__ void a_ready(const Unit&) const {}
    __device__ __forceinline__ void done(const Unit& u) const {
        if (u.pm % 17 == 0) {
            asm volatile("s_waitcnt vmcnt(0)" ::: "memory");
            __builtin_amdgcn_s_barrier();
            if (threadIdx.x == 0) { __builtin_amdgcn_fence(__ATOMIC_RELEASE, "agent"); asm volatile("s_waitcnt vmcnt(0)" ::: "memory"); (void)xb_add(ctr, 1u); }
        }
    }
};
struct LatentOrder : pg8::StaticOrder {
    __device__ void init_lat(int N, int G_, int c_) { init(64 * 256, N, G_, c_); }
    __device__ bool next(int i, Unit& u) const { if (!pg8::StaticOrder::next(i, u)) return false; u.pm = u.pm + (u.pm >> 4) + 1; return true; }
};
struct CtxOrder2 {
    int c;
    __device__ bool next(int i, Unit& u) const { if (i != 0 || c >= NCTXWG) return false; const int idx = c >> 1; u.pm = (idx >> 3) * 17; u.pn = (idx & 7) + 8 * (c & 1); return true; }
    __device__ __forceinline__ void a_ready(const Unit&) const {}
    __device__ __forceinline__ void done(const Unit&) const {}
};
struct GemmCtxSplit { const bf16_t* A; const bf16_t* Bt; int K;
    __device__ __forceinline__ const char* a_tile(const Unit& u) const { return (const char*)A + (size_t)u.pm * (size_t)(256 * 2) * K + (size_t)(u.pn >> 3) * (size_t)(K / 2) * 2; }
    __device__ __forceinline__ const char* b_tile(const Unit& u) const { return (const char*)Bt + (size_t)(u.pn & 7) * (size_t)(256 * 2) * K + (size_t)(u.pn >> 3) * (size_t)(K / 2) * 2; }
    __device__ __forceinline__ int klen() const { return K / 2; } };
struct EpiCtxPart {
    static constexpr bool PERM = true, AFTER_DRAIN = false;
    float* P;
    __device__ __forceinline__ void operator()(const accf32x4 (&acc)[2][2][4][2], const Unit& u, int wr, int wc, int fr, int fq) const {
        const int row0 = (u.pm / 17) * 256 + wr * 64 + fr, col0 = (u.pn & 7) * 256 + wc * 32 + 8 * fq;
        float* base = P + (size_t)(u.pn >> 3) * (NB * CTXL) * D;
#pragma unroll
        for (int ai = 0; ai < 2; ++ai)
#pragma unroll
            for (int m = 0; m < 4; ++m) { float* rowp = base + (size_t)(row0 + ai * 128 + m * 16) * D + col0;
#pragma unroll
                for (int bj = 0; bj < 2; ++bj) { *(f32x4*)(rowp + bj * 128) = acc[ai][bj][m][0]; *(f32x4*)(rowp + bj * 128 + 4) = acc[ai][bj][m][1]; } }
    }
};
#ifndef DBG_DUMP_OFF
#define DBG_DUMP_OFF WS_X
#define DBG_DUMP_F32 1
#endif
__device__ __forceinline__ void copyout_phase(const Frame F, KArgs* a) {
    const int lane_ = lane_opaque();
    for (int m = F.bid * NWAVES + F.wave; m < M; m += F.G * NWAVES) { const int b = m / TB, j = m - b * TB; if (j < CTXL) continue;
        float* dst = a->out + ((size_t)b * SEQ + (j - CTXL)) * D;
#if defined(DBG_DUMP_P256)
        { const size_t offs[] = {DBG_DUMP_P256}; constexpr int NL = sizeof(offs) / sizeof(offs[0]);
          for (int q = 0; q < 4; ++q) { float acc[8], v[8]; for (int e = 0; e < 8; ++e) acc[e] = 0.f;
              if (q == 0 && lane_ < 32) { for (int t = 0; t < NL; ++t) { unpack8(*(const u32x4*)((const bf16_t*)(a->ws + offs[t]) + (size_t)m * 256 + 8 * lane_), v); for (int e = 0; e < 8; ++e) acc[e] += (1.f + t) * v[e]; } }
              *(f32x4*)(dst + 512 * q + 8 * lane_) = (f32x4){acc[0], acc[1], acc[2], acc[3]}; *(f32x4*)(dst + 512 * q + 8 * lane_ + 4) = (f32x4){acc[4], acc[5], acc[6], acc[7]}; }
          continue; }
#endif
#ifndef DBG_DUMP_W
#define DBG_DUMP_W(t) (1.f + (t))
#endif
#if defined(DBG_DUMP_LIST)
        { const size_t offs[] = {DBG_DUMP_LIST}; constexpr int NL = sizeof(offs) / sizeof(offs[0]);
#pragma unroll
          for (int q = 0; q < 4; ++q) { const size_t ro = (size_t)m * D + 512 * q + 8 * lane_; float acc[8], v[8];
              for (int e = 0; e < 8; ++e) acc[e] = 0.f;
#pragma unroll
              for (int t = 0; t < NL; ++t) { unpack8(*(const u32x4*)((const bf16_t*)(a->ws + offs[t]) + ro), v); for (int e = 0; e < 8; ++e) acc[e] += DBG_DUMP_W(t) * v[e]; }
              *(f32x4*)(dst + 512 * q + 8 * lane_) = (f32x4){acc[0], acc[1], acc[2], acc[3]}; *(f32x4*)(dst + 512 * q + 8 * lane_ + 4) = (f32x4){acc[4], acc[5], acc[6], acc[7]}; }
          continue; }
#endif
        if (DBG_DUMP_F32) { const float* X = (const float*)(a->ws + (DBG_DUMP_OFF));
#pragma unroll
            for (int q = 0; q < 8; ++q) *(f32x4*)(dst + 256 * q + 4 * lane_) = *(const f32x4*)(X + (size_t)m * D + 256 * q + 4 * lane_); }
        else { const bf16_t* Bq = (const bf16_t*)(a->ws + (DBG_DUMP_OFF));
#pragma unroll
            for (int q = 0; q < 4; ++q) { float v[8]; unpack8(*(const u32x4*)(Bq + (size_t)m * D + 512 * q + 8 * lane_), v);
                *(f32x4*)(dst + 512 * q + 8 * lane_) = (f32x4){v[0], v[1], v[2], v[3]}; *(f32x4*)(dst + 512 * q + 8 * lane_ + 4) = (f32x4){v[4], v[5], v[6], v[7]}; } }
    }
}

__device__ __forceinline__ void mixes_phase(const Frame F, KArgs* a, int jr) {
    const int lane_ = lane_opaque(), tid_ = F.wave * 64 + lane_; (void)tid_; (void)lane_;
    const bf16_t* Y = (const bf16_t*)(a->ws + WS_Y); bf16_t* MIX = (bf16_t*)(a->ws + WS_MIX6);
    const int rg = F.wave >> 2, e0 = 512 * (F.wave & 3) + 8 * lane_;
    float mu[6][8];
    { const int muidx[6] = {0, 2, 3, 5, 1, 4};
#pragma unroll
      for (int q = 0; q < 6; ++q) { const float* mp = a->in[14] + ((size_t)jr * 6 + muidx[q]) * D + e0;
#pragma unroll
          for (int i = 0; i < 8; ++i) mu[q][i] = mp[i]; } }
    for (int ch = F.bid; ch < M / 68; ch += F.G) {
        const int r0 = ch * 68 + 34 * rg;
        float yp[8], yc[8], yn[8];
        if (r0 > 0) unpack8(*(const u32x4*)(Y + (size_t)(r0 - 1) * D + e0), yp); else {
#pragma unroll
            for (int i = 0; i < 8; ++i) yp[i] = 0.f; }
        unpack8(*(const u32x4*)(Y + (size_t)r0 * D + e0), yc);
        for (int r = 0; r < 34; ++r) { const int m = r0 + r, j = m % TB;
            if (m + 1 < M) unpack8(*(const u32x4*)(Y + (size_t)(m + 1) * D + e0), yn); else {
#pragma unroll
                for (int i = 0; i < 8; ++i) yn[i] = 0.f; }
            const float pv = (j != 0 && j != CTXL) ? 0.5f : 0.f, nv = (j != CTXL - 1 && j != TB - 1) ? 0.5f : 0.f;
            float xx[8];
#pragma unroll
            for (int i = 0; i < 8; ++i) xx[i] = (pv * yp[i] + nv * yn[i]) - yc[i];
#pragma unroll
            for (int q = 0; q < 6; ++q) { float o[8];
#pragma unroll
                for (int i = 0; i < 8; ++i) o[i] = yc[i] + xx[i] * mu[q][i];
                *(u32x4*)(MIX + (size_t)q * M * D + (size_t)m * D + e0) = pack8(o); }
#pragma unroll
            for (int i = 0; i < 8; ++i) { yp[i] = yc[i]; yc[i] = yn[i]; }
        }
    }
}

__device__ __forceinline__ void qknorm_phase(const Frame F, KArgs* a, int ja) {
    const int lane_ = lane_opaque(), tid_ = F.wave * 64 + lane_; (void)tid_; (void)lane_;
    bf16_t* Q = (bf16_t*)(a->ws + WS_Q); bf16_t* K = (bf16_t*)(a->ws + WS_K);
    const float* COS = (const float*)(a->ws + WS_ROPE); const float* SIN = COS + 4096 * 64;
    const int li = lane_ & 15, hs = lane_ >> 4;
    float gq[8], gk[8];
#pragma unroll
    for (int i = 0; i < 8; ++i) { gq[i] = a->in[12][ja * 128 + 8 * li + i]; gk[i] = a->in[13][ja * 128 + 8 * li + i]; }
    for (int m = F.bid * NWAVES + F.wave; m < M; m += F.G * NWAVES) {
        const int j = m % TB; const bool lat = j >= CTXL; const int pos = lat ? j - CTXL : 0;
        f32x4 cs = (f32x4){1.f, 1.f, 1.f, 1.f}, sn = (f32x4){0.f, 0.f, 0.f, 0.f};
        if (lat) { cs = *(const f32x4*)(COS + (size_t)pos * 64 + 4 * li); sn = *(const f32x4*)(SIN + (size_t)pos * 64 + 4 * li); }
#pragma unroll
        for (int p = 0; p < 5; ++p) {
            bf16_t* ptr = p < 4 ? Q + (size_t)m * D + (4 * p + hs) * 128 + 8 * li : K + (size_t)m * 512 + hs * 128 + 8 * li;
            float v[8]; unpack8(*(const u32x4*)ptr, v);
            float ss = 0.f;
#pragma unroll
            for (int i = 0; i < 8; ++i) ss += v[i] * v[i];
            ss = sum16(ss);
            const float rs = rsqrtf(ss * (1.0f / 128.0f) + NORM_EPS);
            float o[8];
#pragma unroll
            for (int i = 0; i < 4; ++i) { const float x1 = v[2 * i] * rs * (p < 4 ? gq[2 * i] : gk[2 * i]), x2 = v[2 * i + 1] * rs * (p < 4 ? gq[2 * i + 1] : gk[2 * i + 1]);
                o[2 * i] = x1 * cs[i] - x2 * sn[i]; o[2 * i + 1] = x1 * sn[i] + x2 * cs[i]; }
            *(u32x4*)ptr = pack8(o);
        }
    }
}

template <int R> __device__ __forceinline__ float ror16(float x) { return __builtin_bit_cast(float, __builtin_amdgcn_mov_dpp(__builtin_bit_cast(int, x), 0x120 + R, 0xF, 0xF, true)); }
__device__ __forceinline__ float sum_row16(float x) { x += ror16<8>(x); x += ror16<4>(x); x += ror16<2>(x); x += ror16<1>(x); return x; }
__device__ __forceinline__ float sum_rows(float x) {
    x += ror16<8>(x);
    { const unsigned u = __builtin_bit_cast(unsigned, x); auto rr = __builtin_amdgcn_permlane16_swap(u, u, false, false); const unsigned r0 = rr[0], r1 = rr[1];
      x = __builtin_bit_cast(float, r0) + __builtin_bit_cast(float, r1); }
    { const unsigned u = __builtin_bit_cast(unsigned, x); auto rr = __builtin_amdgcn_permlane32_swap(u, u, false, false); const unsigned r0 = rr[0], r1 = rr[1];
      x = __builtin_bit_cast(float, r0) + __builtin_bit_cast(float, r1); }
    return x;
}
template <bool HI> __device__ __forceinline__ f32x2 pk_mul_bc(f32x2 a, f32x2 b) { f32x2 d;
    if (HI) asm("v_pk_mul_f32 %0, %1, %2 op_sel:[0,1] op_sel_hi:[1,1]" : "=v"(d) : "v"(a), "v"(b)); else asm("v_pk_mul_f32 %0, %1, %2 op_sel_hi:[1,0]" : "=v"(d) : "v"(a), "v"(b)); return d; }
template <bool HI> __device__ __forceinline__ f32x2 pk_fma_bc(f32x2 a, f32x2 b, f32x2 c) { f32x2 d;
    if (HI) asm("v_pk_fma_f32 %0, %1, %2, %3 op_sel:[0,1,0] op_sel_hi:[1,1,1]" : "=v"(d) : "v"(a), "v"(b), "v"(c)); else asm("v_pk_fma_f32 %0, %1, %2, %3 op_sel_hi:[1,0,1]" : "=v"(d) : "v"(a), "v"(b), "v"(c)); return d; }
template <bool HI> __device__ __forceinline__ f32x2 pk_nfma_bc(f32x2 a, f32x2 b, f32x2 c) { f32x2 d;
    if (HI) asm("v_pk_fma_f32 %0, %1, %2, %3 op_sel:[0,1,0] op_sel_hi:[1,1,1] neg_lo:[1,0,0] neg_hi:[1,0,0]" : "=v"(d) : "v"(a), "v"(b), "v"(c));
    else asm("v_pk_fma_f32 %0, %1, %2, %3 op_sel_hi:[1,0,1] neg_lo:[1,0,0] neg_hi:[1,0,0]" : "=v"(d) : "v"(a), "v"(b), "v"(c)); return d; }
__device__ __forceinline__ void scan_phase(const Frame F, KArgs* a, int jr, const bool cvt_late, unsigned* bar) {
    const int lane_ = lane_opaque(), tid_ = F.wave * 64 + lane_; (void)tid_; (void)lane_;
    LAS float* L = (LAS float*)F.lds;
    constexpr int BUF = 32 * 384, YB0 = 2 * BUF, YBUF = 32 * 64;
    const int lane = lane_, li8 = (lane & 7) * 8, vrow = 16 * (F.wave & 3) + 2 * (lane >> 3);
    const bool comp = F.wave < 4;
    const bf16_t* KR = (const bf16_t*)(a->ws + WS_KK_); const bf16_t* AA = (const bf16_t*)(a->ws + WS_AA);
    const bf16_t* KN = (const bf16_t*)(a->ws + WS_KN); const bf16_t* RR = (const bf16_t*)(a->ws + WS_RR); const bf16_t* VV = (const bf16_t*)(a->ws + WS_VV);
    bf16_t* YS = (bf16_t*)(a->ws + WS_YS);
    for (int chain = F.bid; chain < 256; chain += F.G) {
        const int b = chain >> 6, h = (chain >> 1) & 31, dir = chain & 1;
        const size_t doff = (size_t)dir * M * D;
        const int hc = h * 64;
#define SCAN_M0(q) (b * TB + (dir == 0 ? 32 * (q) : ((q) < 8 ? 224 - 32 * (q) : 4576 - 32 * (q))))
        __syncthreads();
        if (!comp) {
            const int t = tid_ - 256, lrow = t >> 3, lpart = t & 7, trow = dir ? 31 - lrow : lrow;
            const bf16_t* pk_ = KR + hc + lpart * 8; const bf16_t* pn_ = KN + hc + lpart * 8; const bf16_t* pa_ = AA + doff + hc + lpart * 8;
            const bf16_t* pr_ = RR + hc + lpart * 8; const bf16_t* pv_ = VV + hc + lpart * 8; const bf16_t* pw_ = (const bf16_t*)(a->ws + WS_WDEC) + doff + hc + lpart * 8;
            float ka[8], rk[8];
#pragma unroll
            for (int i = 0; i < 8; ++i) { ka[i] = a->in[26][(size_t)jr * D + hc + lpart * 8 + i]; rk[i] = a->in[27][(size_t)jr * D + hc + lpart * 8 + i]; }
            float* BON = (float*)(a->ws + WS_BON) + (size_t)dir * M * 32 + h;
            const bf16_t* YSo = YS + (size_t)(1 - dir) * M * D + hc + lpart * 8; const float* BONo = (const float*)(a->ws + WS_BON) + (size_t)(1 - dir) * M * 32 + h;
            const bf16_t* GGp = (const bf16_t*)(a->ws + WS_GG) + hc + lpart * 8; bf16_t* PREPp = (bf16_t*)(a->ws + WS_PREP) + hc + lpart * 8;
            float lnw8[8], lnb8[8]; float sb_prev = 0.f;
#pragma unroll
            for (int i = 0; i < 8; ++i) { lnw8[i] = a->in[28][(size_t)jr * D + hc + lpart * 8 + i]; lnb8[i] = a->in[29][(size_t)jr * D + hc + lpart * 8 + i]; }
#define SCAN_PREP(m_, o_, v_, bs_) do { float sm_ = 0.f; _Pragma("unroll") for (int i_ = 0; i_ < 8; ++i_) sm_ += o_[i_]; const float mean_ = sum8(sm_) * (1.0f / 64.0f); float sq_ = 0.f; \
        _Pragma("unroll") for (int i_ = 0; i_ < 8; ++i_) { o_[i_] -= mean_; sq_ += o_[i_] * o_[i_]; } const float rs_ = rsqrtf(sum8(sq_) * (1.0f / 64.0f) + 64e-5f); \
        float g_[8], out_[8]; unpack8(*(const u32x4*)(GGp + (size_t)(m_) * D), g_); \
        _Pragma("unroll") for (int i_ = 0; i_ < 8; ++i_) out_[i_] = (o_[i_] * rs_ * lnw8[i_] + lnb8[i_] + (bs_) * v_[i_]) * g_[i_]; \
        *(u32x4*)(PREPp + (size_t)(m_) * D) = pack8(out_); } while (0)
            u32x4 gk, gn, ga, gr, gv, gw;
#define SCAN_LOAD(q) do { const size_t ro_ = ((size_t)SCAN_M0(q) + trow) * D; gk = *(const u32x4*)(pk_ + ro_); gn = *(const u32x4*)(pn_ + ro_); ga = *(const u32x4*)(pa_ + ro_); \
        gr = *(const u32x4*)(pr_ + ro_); gv = *(const u32x4*)(pv_ + ro_); gw = *(const u32x4*)(pw_ + ro_); } while (0)
#define SCAN_ST8(off_, t_) do { *(LAS f32x4*)(d_ + (off_)) = (f32x4){t_[0], t_[1], t_[2], t_[3]}; *(LAS f32x4*)(d_ + (off_) + 4) = (f32x4){t_[4], t_[5], t_[6], t_[7]}; } while (0)
#define SCAN_WRITE(bufi) do { LAS float* d_ = L + (bufi) * BUF + lrow * 384 + lpart * 8; \
        { float ta_[8], tb_[8], tc_[8]; unpack8(gk, ta_); unpack8(gn, tb_); unpack8(ga, tc_); float kd_[8], bb_[8]; \
          _Pragma("unroll") for (int i_ = 0; i_ < 8; ++i_) { kd_[i_] = ta_[i_] * (1.0f + (tc_[i_] - 1.0f) * ka[i_]); bb_[i_] = tb_[i_] * tc_[i_]; } \
          SCAN_ST8(64, kd_); SCAN_ST8(128, bb_); SCAN_ST8(192, tb_); } \
        { float ta_[8], tb_[8], tc_[8]; unpack8(gr, ta_); unpack8(gv, tb_); unpack8(gw, tc_); \
          _Pragma("unroll") for (int i_ = 0; i_ < 8; ++i_) tc_[i_] = __builtin_amdgcn_exp2f(tc_[i_]); SCAN_ST8(0, tc_); SCAN_ST8(256, ta_); SCAN_ST8(320, tb_); } } while (0)
            SCAN_LOAD(0); SCAN_WRITE(0);
            float cv[32]; CvtJob cv_job; bool cv_have = false;
            cv_job.W = nullptr; cv_job.WT = nullptr; cv_job.K = cv_job.N = 32; cv_job.mode = cv_job.row_off = cv_job.item = 0;
#pragma unroll
            for (int i = 0; i < 32; ++i) cv[i] = 0.f;
            __syncthreads();
            for (int q = 0; q < 136; ++q) {
                const int bi = q & 1;
                if (q + 1 < 136) SCAN_LOAD(q + 1);
                if (cvt_late && chain == F.bid) {
                    LAS float* scr = (LAS float*)(F.lds + (F.wave == 4 ? 116736 : 132096 + (F.wave - 5) * 8448));
                    if (cv_have) { cvt_job_store(cv_job, scr, lane_, cv); cv_have = false; }
                    const int gwl = F.bid * 4 + (F.wave - 4), ngwl = F.G * 4, nper = (CVT_N1 + ngwl - 1) / ngwl;
                    const int k = (q * nper) / 136;
                    if (k < ((q + 1) * nper) / 136) { const int it = gwl + k * ngwl; if (it < CVT_N1) { cv_job = cvt_decode(a, it, 1); cvt_job_load(cv_job, lane_, cv); cv_have = true; } } }
                if (q > 0) {
                    const LAS float* ys = L + YB0 + (bi ^ 1) * YBUF + lrow * 64 + lpart * 8; float t8[8];
                    const f32x4 y0 = *(const LAS f32x4*)ys, y1 = *(const LAS f32x4*)(ys + 4);
#pragma unroll
                    for (int e = 0; e < 4; ++e) { t8[e] = y0[e]; t8[4 + e] = y1[e]; }
                    const size_t mrow = (size_t)SCAN_M0(q - 1) + trow;
                    if (q - 1 < 72) *(u32x4*)(YS + doff + mrow * D + hc + lpart * 8) = pack8(t8);
                    else { float yp[8], vv[8]; unpack8(*(const u32x4*)(YSo + mrow * D), yp);
                        const LAS float* pv = L + (bi ^ 1) * BUF + lrow * 384 + 320 + lpart * 8; const f32x4 v0 = *(const LAS f32x4*)pv, v1 = *(const LAS f32x4*)(pv + 4);
#pragma unroll
                        for (int e = 0; e < 4; ++e) { vv[e] = v0[e]; vv[4 + e] = v1[e]; }
#pragma unroll
                        for (int e = 0; e < 8; ++e) t8[e] += yp[e];
                        const float bs = sb_prev + BONo[mrow * 32];
                        SCAN_PREP(mrow, t8, vv, bs); } }
                if (q == 72) {
                    asm volatile("s_waitcnt vmcnt(0)" ::: "memory");
                    LAS unsigned* lc = (LAS unsigned*)(F.lds + 157696);
                    if (lane_ == 0) (void)__hip_atomic_fetch_add(lc, 1u, __ATOMIC_RELAXED, __HIP_MEMORY_SCOPE_WORKGROUP);
                    if (F.wave == 4) { unsigned sp_ = 0; while (__hip_atomic_load(lc, __ATOMIC_RELAXED, __HIP_MEMORY_SCOPE_WORKGROUP) < 4u && ++sp_ < (1u << 22)) __builtin_amdgcn_s_sleep(1);
                        if (lane_ == 0) { unsigned* pc = (unsigned*)(a->ws + WS_CTL) + CW_PAIR + (jr * 128 + (chain >> 1)) * 64;
                            __builtin_amdgcn_fence(__ATOMIC_RELEASE, "agent"); asm volatile("s_waitcnt vmcnt(0)" ::: "memory");
                            (void)xb_add(pc, 1u); XB_SPIN(xb_ld(pc) < 2u, bar);
                            __builtin_amdgcn_fence(__ATOMIC_ACQUIRE, "agent"); asm volatile("s_waitcnt vmcnt(0)" ::: "memory");
                            __hip_atomic_store(lc, 0u, __ATOMIC_RELAXED, __HIP_MEMORY_SCOPE_WORKGROUP); } } }
                if (dir == 0 && q >= 73 && q < 81) {
                    const size_t mrow = (size_t)(b * TB + 32 * (q - 73) + lrow); float o8[8], y1[8], vv[8];
                    unpack8(*(const u32x4*)(YS + mrow * D + hc + lpart * 8), o8); unpack8(*(const u32x4*)(YSo + mrow * D), y1); unpack8(*(const u32x4*)(VV + mrow * D + hc + lpart * 8), vv);
#pragma unroll
                    for (int e = 0; e < 8; ++e) o8[e] += y1[e];
                    const float bs = BON[mrow * 32] + BONo[mrow * 32];
                    SCAN_PREP(mrow, o8, vv, bs); }
                {
                    const LAS float* pr = L + bi * BUF + lrow * 384 + lpart * 8; const f32x4 r0 = *(const LAS f32x4*)(pr + 256), r1 = *(const LAS f32x4*)(pr + 260), k0 = *(const LAS f32x4*)(pr + 64), k1 = *(const LAS f32x4*)(pr + 68);
                    float sb = 0.f;
#pragma unroll
                    for (int e = 0; e < 4; ++e) sb += r0[e] * k0[e] * rk[e] + r1[e] * k1[e] * rk[4 + e];
                    sb = sum8(sb);
                    if (lpart == 0 && q < 72) BON[((size_t)SCAN_M0(q) + trow) * 32] = sb;
                    sb_prev = sb; }
                if (q + 1 < 136) SCAN_WRITE(bi ^ 1);
                __syncthreads();
            }
            if (cv_have) { LAS float* scr = (LAS float*)(F.lds + (F.wave == 4 ? 116736 : 132096 + (F.wave - 5) * 8448)); cvt_job_store(cv_job, scr, lane_, cv); }
            {   const LAS float* ys = L + YB0 + 1 * YBUF + lrow * 64 + lpart * 8; float t8[8];
                const f32x4 y0 = *(const LAS f32x4*)ys, y1 = *(const LAS f32x4*)(ys + 4);
#pragma unroll
                for (int e = 0; e < 4; ++e) { t8[e] = y0[e]; t8[4 + e] = y1[e]; }
                const size_t mrow = (size_t)SCAN_M0(135) + trow; float yp[8], vv[8]; unpack8(*(const u32x4*)(YSo + mrow * D), yp);
                const LAS float* pv = L + 1 * BUF + lrow * 384 + 320 + lpart * 8; const f32x4 v0 = *(const LAS f32x4*)pv, v1 = *(const LAS f32x4*)(pv + 4);
#pragma unroll
                for (int e = 0; e < 4; ++e) { vv[e] = v0[e]; vv[4 + e] = v1[e]; }
#pragma unroll
                for (int e = 0; e < 8; ++e) t8[e] += yp[e];
                const float bs = sb_prev + BONo[mrow * 32];
                SCAN_PREP(mrow, t8, vv, bs); }
#undef SCAN_PREP
#undef SCAN_LOAD
#undef SCAN_WRITE
#undef SCAN_ST8
        } else {
            f32x2 S2[8];
#pragma unroll
            for (int i = 0; i < 8; ++i) S2[i] = (f32x2){0.f, 0.f};
            __syncthreads();
            for (int q = 0; q < 136; ++q) {
                const int bi = q & 1;
                const LAS float* base = L + bi * BUF; constexpr int stp = 384;
                const bool lead = (lane & 7) == 0; const int ystp = lead ? 64 : 0;
                LAS float* yaddr = lead ? L + YB0 + bi * YBUF + vrow : L + YB0 + 2 * YBUF + ((F.wave & 3) * 64 + lane) * 2;
#define SCAN_LD8(dst_, p_, off_) do { const f32x4 lo_ = *(const LAS f32x4*)((p_) + (off_) + li8), hi_ = *(const LAS f32x4*)((p_) + (off_) + li8 + 4); \
        dst_[0] = (f32x2){lo_[0], lo_[1]}; dst_[1] = (f32x2){lo_[2], lo_[3]}; dst_[2] = (f32x2){hi_[0], hi_[1]}; dst_[3] = (f32x2){hi_[2], hi_[3]}; } while (0)
#define PKM_LO(d, a, b) "v_pk_mul_f32 " d ", " a ", " b " op_sel_hi:[1,0]\n\t"
#define PKM_HI(d, a, b) "v_pk_mul_f32 " d ", " a ", " b " op_sel:[0,1] op_sel_hi:[1,1]\n\t"
#define PKF_LO(d, a, b, c) "v_pk_fma_f32 " d ", " a ", " b ", " c " op_sel_hi:[1,0,1]\n\t"
#define PKF_HI(d, a, b, c) "v_pk_fma_f32 " d ", " a ", " b ", " c " op_sel:[0,1,0] op_sel_hi:[1,1,1]\n\t"
#define PKN_LO(d, a, b, c) "v_pk_fma_f32 " d ", " a ", " b ", " c " op_sel_hi:[1,0,1] neg_lo:[1,0,0] neg_hi:[1,0,0]\n\t"
#define PKN_HI(d, a, b, c) "v_pk_fma_f32 " d ", " a ", " b ", " c " op_sel:[0,1,0] op_sel_hi:[1,1,1] neg_lo:[1,0,0] neg_hi:[1,0,0]\n\t"
#define DPPA(r, ctl) "v_add_f32_dpp " r ", " r ", " r " " ctl " row_mask:0xf bank_mask:0xf\n\t"
#define DPP_1 "quad_perm:[1,0,3,2]"
#define DPP_2 "quad_perm:[2,3,0,1]"
#define DPP_3 "row_half_mirror"
#define SA_SUM(pk_, t_, v_, d_) asm volatile( \
        PKM_LO("%2", "%10", "%11") PKM_HI("%3", "%10", "%11") DPPA("%0", DPP_1) DPPA("%1", DPP_1) PKM_LO("%4", "%10", "%12") DPPA("%0", DPP_2) DPPA("%1", DPP_2) PKM_HI("%5", "%10", "%12") \
        DPPA("%0", DPP_3) DPPA("%1", DPP_3) PKM_LO("%6", "%10", "%13") PKM_HI("%7", "%10", "%13") PKM_LO("%8", "%10", "%14") PKM_HI("%9", "%10", "%14") \
        : "+v"(pk_.x), "+v"(pk_.y), "=&v"(t_[0]), "=&v"(t_[1]), "=&v"(t_[2]), "=&v"(t_[3]), "=&v"(t_[4]), "=&v"(t_[5]), "=&v"(t_[6]), "=&v"(t_[7]) \
        : "v"(v_), "v"(d_[0]), "v"(d_[1]), "v"(d_[2]), "v"(d_[3]))
#define UPD(S_, t_, pk_, b_, w_) asm volatile( \
        PKN_LO("%8", "%16", "%17", "%8") PKN_HI("%9", "%16", "%17", "%9") PKN_LO("%10", "%16", "%18", "%10") PKN_HI("%11", "%16", "%18", "%11") \
        PKN_LO("%12", "%16", "%19", "%12") PKN_HI("%13", "%16", "%19", "%13") PKN_LO("%14", "%16", "%20", "%14") PKN_HI("%15", "%16", "%20", "%15") \
        PKF_LO("%0", "%0", "%21", "%8") PKF_HI("%1", "%1", "%21", "%9") PKF_LO("%2", "%2", "%22", "%10") PKF_HI("%3", "%3", "%22", "%11") \
        PKF_LO("%4", "%4", "%23", "%12") PKF_HI("%5", "%5", "%23", "%13") PKF_LO("%6", "%6", "%24", "%14") PKF_HI("%7", "%7", "%24", "%15") \
        : "+v"(S_[0]), "+v"(S_[1]), "+v"(S_[2]), "+v"(S_[3]), "+v"(S_[4]), "+v"(S_[5]), "+v"(S_[6]), "+v"(S_[7]), \
          "+v"(t_[0]), "+v"(t_[1]), "+v"(t_[2]), "+v"(t_[3]), "+v"(t_[4]), "+v"(t_[5]), "+v"(t_[6]), "+v"(t_[7]) \
        : "v"(pk_), "v"(b_[0]), "v"(b_[1]), "v"(b_[2]), "v"(b_[3]), "v"(w_[0]), "v"(w_[1]), "v"(w_[2]), "v"(w_[3]))
#define DOT8(o_, o1_, S_, x_) asm volatile( \
        PKM_LO("%0", "%2", "%10") PKM_HI("%1", "%3", "%10") PKF_LO("%0", "%4", "%11", "%0") PKF_HI("%1", "%5", "%11", "%1") PKF_LO("%0", "%6", "%12", "%0") PKF_HI("%1", "%7", "%12", "%1") \
        PKF_LO("%0", "%8", "%13", "%0") PKF_HI("%1", "%9", "%13", "%1") "v_pk_add_f32 %0, %0, %1\n\t" \
        : "=&v"(o_), "=&v"(o1_) : "v"(S_[0]), "v"(S_[1]), "v"(S_[2]), "v"(S_[3]), "v"(S_[4]), "v"(S_[5]), "v"(S_[6]), "v"(S_[7]), "v"(x_[0]), "v"(x_[1]), "v"(x_[2]), "v"(x_[3]))
#define YSUM(yk_, o_, o1_, S_, x_) asm volatile( \
        PKM_LO("%2", "%4", "%12") PKM_HI("%3", "%5", "%12") DPPA("%0", DPP_1) DPPA("%1", DPP_1) PKF_LO("%2", "%6", "%13", "%2") DPPA("%0", DPP_2) DPPA("%1", DPP_2) PKF_HI("%3", "%7", "%13", "%3") \
        DPPA("%0", DPP_3) DPPA("%1", DPP_3) PKF_LO("%2", "%8", "%14", "%2") PKF_HI("%3", "%9", "%14", "%3") PKF_LO("%2", "%10", "%15", "%2") PKF_HI("%3", "%11", "%15", "%3") "v_pk_add_f32 %2, %2, %3\n\t" \
        : "+v"(yk_.x), "+v"(yk_.y), "=&v"(o_), "=&v"(o1_) : "v"(S_[0]), "v"(S_[1]), "v"(S_[2]), "v"(S_[3]), "v"(S_[4]), "v"(S_[5]), "v"(S_[6]), "v"(S_[7]), "v"(x_[0]), "v"(x_[1]), "v"(x_[2]), "v"(x_[3]))
                f32x2 nw[4], nd[4], nb[4], nn[4], nr[4]; f32x2 nv2;
                SCAN_LD8(nw, base, 0); SCAN_LD8(nd, base, 64); SCAN_LD8(nb, base, 128); SCAN_LD8(nn, base, 192); SCAN_LD8(nr, base, 256); nv2 = *(const LAS f32x2*)(base + 320 + vrow);
                f32x2 pk, pk1; DOT8(pk, pk1, S2, nn);
#pragma unroll 8
                for (int s = 0; s < 32; ++s) {
                    f32x2 w8[4], d8[4], b8[4], r8[4]; const f32x2 v2 = nv2;
#pragma unroll
                    for (int c = 0; c < 4; ++c) { w8[c] = nw[c]; d8[c] = nd[c]; b8[c] = nb[c]; r8[c] = nr[c]; }
                    { const LAS float* p = base + (s + 1) * stp;
                      SCAN_LD8(nw, p, 0); SCAN_LD8(nd, p, 64); SCAN_LD8(nb, p, 128); SCAN_LD8(nn, p, 192); SCAN_LD8(nr, p, 256); nv2 = *(const LAS f32x2*)(p + 320 + vrow); }
                    f32x2 t8[8];
                    SA_SUM(pk, t8, v2, d8);
                    UPD(S2, t8, pk, b8, w8);
                    f32x2 yk, yk1; DOT8(yk, yk1, S2, r8);
                    f32x2 npk, npk1; YSUM(yk, npk, npk1, S2, nn);
                    *(LAS f32x2*)(yaddr + s * ystp) = yk;
                    pk = npk;
                }
#undef PKM_LO
#undef PKM_HI
#undef PKF_LO
#undef PKF_HI
#undef PKN_LO
#undef PKN_HI
#undef DPPA
#undef SA_SUM
#undef UPD
#undef DOT8
#undef YSUM
#undef SCAN_LD8
                __syncthreads();
            }
        }
        __syncthreads();
#undef SCAN_M0
    }
}

__device__ __forceinline__ void outprep_phase(const Frame F, KArgs* a, int jr) {
    const int lane_ = lane_opaque(), tid_ = F.wave * 64 + lane_; (void)tid_; (void)lane_;
    const bf16_t* YS = (const bf16_t*)(a->ws + WS_YS); const float* BON = (const float*)(a->ws + WS_BON);
    const bf16_t* VV = (const bf16_t*)(a->ws + WS_VV); const bf16_t* GG = (const bf16_t*)(a->ws + WS_GG);
    bf16_t* PREP = (bf16_t*)(a->ws + WS_PREP);
    const float* lw = a->in[28] + (size_t)jr * D; const float* lb = a->in[29] + (size_t)jr * D;
    for (int m = F.bid * NWAVES + F.wave; m < M; m += F.G * NWAVES) {
#pragma unroll
        for (int q = 0; q < 4; ++q) { const int e0 = 512 * q + 8 * lane_; const size_t ro = (size_t)m * D + e0;
            float y0[8], y1[8], o[8];
            unpack8(*(const u32x4*)(YS + ro), y0); unpack8(*(const u32x4*)(YS + (size_t)M * D + ro), y1);
            float sm = 0.f;
#pragma unroll
            for (int i = 0; i < 8; ++i) { o[i] = y0[i] + y1[i]; sm += o[i]; }
            const float mean = sum8(sm) * (1.0f / 64.0f);
            float sq = 0.f;
#pragma unroll
            for (int i = 0; i < 8; ++i) { o[i] -= mean; sq += o[i] * o[i]; }
            const float rs = rsqrtf(sum8(sq) * (1.0f / 64.0f) + 64e-5f);
            float v[8], g[8];
            unpack8(*(const u32x4*)(VV + ro), v); unpack8(*(const u32x4*)(GG + ro), g);
            const int hd = e0 >> 6;
            const float bs = BON[(size_t)m * 32 + hd] + BON[(size_t)M * 32 + (size_t)m * 32 + hd];
            float out[8];
#pragma unroll
            for (int i = 0; i < 8; ++i) out[i] = (o[i] * rs * lw[e0 + i] + lb[e0 + i] + bs * v[i]) * g[i];
            *(u32x4*)(PREP + ro) = pack8(out); }
    }
}

__device__ __forceinline__ float attn_score_bound(KArgs* a, int ja) {
    const int ln = lane_opaque(); float mq = fmaxf(fabsf(a->in[12][ja * 128 + ln]), fabsf(a->in[12][ja * 128 + 64 + ln])), mk = fmaxf(fabsf(a->in[13][ja * 128 + ln]), fabsf(a->in[13][ja * 128 + 64 + ln]));
#pragma unroll
    for (int o = 1; o < 64; o <<= 1) { mq = fmaxf(mq, __shfl_xor(mq, o)); mk = fmaxf(mk, __shfl_xor(mk, o)); }
    return __builtin_bit_cast(float, __builtin_amdgcn_readfirstlane(__builtin_bit_cast(int, 128.0f * 1.02f * mq * mk)));
}
__device__ __forceinline__ void attention_phase(const Frame F, KArgs* a, int ja) {
    const attn::bf16* Q = (const attn::bf16*)(a->ws + WS_Q); const attn::bf16* K = (const attn::bf16*)(a->ws + WS_K); const attn::bf16* V = (const attn::bf16*)(a->ws + WS_V);
    attn::bf16* O = (attn::bf16*)(a->ws + WS_O);
    const float mfix = attn_score_bound(a, ja);
    const bool fixm = mfix * attn::SCALE <= 30.0f;
    for (int u = F.bid; u < 1024 + 64; u += F.G) {
        size_t qoff, koff; int seq;
        if (u < 1024) { const int c = u & 255, i = u >> 8, grp = (c & 7) >> 1, member = (c & 1) * 32 + (c >> 3), bk = i * 4 + grp, b = bk >> 2, kvh = bk & 3, hq = kvh * 4 + (member >> 4), qb = member & 15;
            qoff = (size_t)(b * TB + CTXL + qb * 256) * 2048 + hq * 128; koff = (size_t)b * TB * 512 + kvh * 128; seq = TB; }
        else { const int cu = u - 1024, b = cu >> 4, hq = cu & 15, kvh = hq >> 2;
            qoff = (size_t)(b * TB) * 2048 + hq * 128; koff = (size_t)b * TB * 512 + kvh * 128; seq = CTXL; }
        if (fixm) attn::attn_dense_body<attn::bf16, true>(Q + qoff, K + koff, V + koff, O + qoff, seq, (char*)F.ldsg, F.wave, mfix);
        else attn::attn_dense_body<attn::bf16, false>(Q + qoff, K + koff, V + koff, O + qoff, seq, (char*)F.ldsg, F.wave);
        __syncthreads();
    }
}

#ifndef EN_P0
#define EN_P0 1
#endif
#ifndef EN_THIN
#define EN_THIN 1
#endif
#ifndef EN_QKN
#define EN_QKN 1
#endif
#ifndef EN_ATT
#define EN_ATT 1
#endif
#ifndef EN_MIX
#define EN_MIX 1
#endif
#ifndef EN_SCAN
#define EN_SCAN 1
#endif
#ifndef EN_OPREP
#define EN_OPREP 1
#endif
#ifndef EN_FFN
#define EN_FFN 1
#endif
#ifndef EN_GQKV
#define EN_GQKV 1
#endif
#ifndef EN_GWO
#define EN_GWO 1
#endif
#ifndef EN_RW1
#define EN_RW1 1
#endif
#ifndef EN_RW2
#define EN_RW2 1
#endif
__device__ __forceinline__ KArgs* opaque_k(KArgs* p) { asm volatile("" : "+s"(p)); return p; }
#ifndef DBG_STOP
#define DBG_STOP -1
#endif
__device__ __forceinline__ Frame fresh(const Frame& F) { Frame R = F; asm volatile("" : "+s"(R.bid), "+s"(R.G), "+s"(R.wave)); return R; }
#ifndef GEMM_ALIGN
#define GEMM_ALIGN true
#define GEMM_SP2 true
#endif
#ifndef RW2_ALIGN
#define RW2_ALIGN true
#define RW2_SP2 true
#endif
#ifndef RW1_ALIGN
#define RW1_ALIGN true
#define RW1_SP2 true
#endif
#ifndef REP_THIN
#define REP_THIN 1
#endif
#ifndef REP_OG
#define REP_OG 1
#endif
#ifndef REP_EW
#define REP_EW 1
#endif
#ifndef REP_FFN1
#define REP_FFN1 1
#endif
#ifndef REP_FFN2
#define REP_FFN2 1
#endif
#ifndef REP_P0
#define REP_P0 1
#endif
#ifndef REP_SCAN
#define REP_SCAN 1
#endif
#ifndef REP_ATT
#define REP_ATT 1
#endif
#ifndef REP_RW1
#define REP_RW1 1
#endif
constexpr int NPHASE = 50;
constexpr int STOP_PHASE = (DBG_STOP >= 0) ? DBG_STOP : NPHASE - 1;
__global__ void __launch_bounds__(NTHR, 2) fwd_kernel(Args args) {
    extern __shared__ __attribute__((aligned(16))) unsigned char lds[];
    Frame F;
    F.lds = (LAS unsigned char*)lds; F.ldsg = lds;
    F.wave = __builtin_amdgcn_readfirstlane((int)threadIdx.x >> 6);
    F.G = gridDim.x; F.bid = blockIdx.x;
    for (int u = threadIdx.x; u < (LDS_BYTES - LDSCTL_OFF) / 4; u += NTHR) ((LAS unsigned*)(F.lds + LDSCTL_OFF))[u] = 0u;
    __syncthreads();
    KArgs* const kap = (KArgs*)__builtin_amdgcn_kernarg_segment_ptr();
    XcdBarrier bar = xcd_barrier_post((unsigned*)(kap->ws + WS_CTL) + CW_BAR + kap->li * XCD_BAR_WORDS, (volatile LAS unsigned*)(F.lds + MISC_OFF) + 8);
#define KA (opaque_k(kap))
#define ws (KA->ws)
#define IN(k) ((k) <= STOP_PHASE)
#define SEAM(k) do { if (IN(k) && IN((k) + 1)) { XcdBarrier bb_ = bar; asm volatile("" : "+s"(bb_.x), "+s"(bb_.bar)); xcd_barrier(bb_, fresh(F).wave == 0 && lane_opaque() == 0); } } while (0)
#define Yb ((bf16_t*)(ws + WS_Y))
#define ACTb ((bf16_t*)(ws + WS_ACT))
#define OUTb ((bf16_t*)(ws + WS_OUT))
#define BAR_NOW() do { XcdBarrier bb_ = bar; asm volatile("" : "+s"(bb_.x), "+s"(bb_.bar)); xcd_barrier(bb_, fresh(F).wave == 0 && lane_opaque() == 0); } while (0)
#define FFN_HALF(pk, lh, FINAL, tl, ts, tw, tnl, tns) do { \
    for (int rep_ = 0; rep_ < REP_FFN1; ++rep_) { if (rep_) __syncthreads(); \
    if (EN_FFN && IN(pk)) { const Frame Ff_ = fresh(F); const bf16_t* w1_ = (const bf16_t*)(ws + WS_WB) + (size_t)(lh) * (E_F1 + E_F2); \
        pg8::Gemm g_{Yb, w1_, D}; EpiSwiGLU E_{ACTb}; \
        if (FINAL) { LatentOrder S_; S_.init_lat(2 * FF, Ff_.G, Ff_.bid); pg8::gemm_phase<EpiSwiGLU, LatentOrder, pg8::Gemm, GEMM_ALIGN, GEMM_SP2>(Ff_.lds, g_, S_, E_, Ff_.wave); } \
        else { Ffn1Order S_{Ff_.G, Ff_.bid, (unsigned*)(ws + WS_CTL) + CW_FC + (lh) * 64}; pg8::gemm_phase<EpiSwiGLU, Ffn1Order, pg8::Gemm, true, GEMM_SP2>(Ff_.lds, g_, S_, E_, Ff_.wave); \
            if (rep_ == REP_FFN1 - 1 && Ff_.G == 256 && Ff_.bid >= 176 && Ff_.bid < 176 + NCTXWG) {     \
                const Frame Fc_ = fresh(F); XcdBarrier bg_ = bar; asm volatile("" : "+s"(bg_.bar)); \
                asm volatile("s_waitcnt vmcnt(0)" ::: "memory"); __syncthreads(); \
                if (Fc_.wave == 0 && lane_opaque() == 0) { unsigned* pc_ = (unsigned*)(ws + WS_CTL) + CW_FC + (lh) * 64; XB_SPIN(xb_ld(pc_) < 176u, bg_.bar); __builtin_amdgcn_fence(__ATOMIC_ACQUIRE, "agent"); asm volatile("s_waitcnt vmcnt(0)" ::: "memory"); } \
                __syncthreads(); \
                const bf16_t* w2c_ = (const bf16_t*)(ws + WS_WB) + (size_t)(lh) * (E_F1 + E_F2) + E_F1; \
                GemmCtxSplit gc_{ACTb, w2c_, FF}; CtxOrder2 Sc_{Fc_.bid - 176}; EpiCtxPart Ec_{(float*)(ws + WS_PART)}; \
                pg8::gemm_phase<EpiCtxPart, CtxOrder2, GemmCtxSplit, GEMM_ALIGN, GEMM_SP2>(Fc_.lds, gc_, Sc_, Ec_, Fc_.wave); } } } } \
    SEAM(pk); \
    for (int rep_ = 0; rep_ < REP_FFN2; ++rep_) { if (rep_) __syncthreads(); \
    if (EN_FFN && IN((pk) + 1)) { const Frame Ff_ = fresh(F); const bf16_t* w2_ = (const bf16_t*)(ws + WS_WB) + (size_t)(lh) * (E_F1 + E_F2) + E_F1; \
        pg8::Gemm g_{ACTb, w2_, FF}; LatentOrder S_; S_.init_lat(D, Ff_.G, Ff_.bid); EpiPlain E_{OUTb, D}; \
        pg8::gemm_phase<EpiPlain, LatentOrder, pg8::Gemm, GEMM_ALIGN, GEMM_SP2>(Ff_.lds, g_, S_, E_, Ff_.wave); } } \
    SEAM((pk) + 1); \
    if (IN((pk) + 2)) { const Frame Ff_ = fresh(F); \
        if (FINAL) thin_phase<2, 1, 0>(Ff_, KA, tl, ts, tw, tnl, tns); \
        else { for (int rt_ = 1; rt_ < REP_THIN; ++rt_) thin_phase<1, 1, 0>(Ff_, KA, tl, ts, 0.f, tnl, tns); thin_phase<1, 1, 0>(Ff_, KA, tl, ts, tw, tnl, tns); thin_phase<1, 2>(fresh(F), KA, tl, ts, tw, tnl, tns); } \
        } \
    SEAM((pk) + 2); } while (0)

    for (int rep_ = 0; rep_ < REP_P0; ++rep_) { if (rep_) __syncthreads(); if (EN_P0 && IN(0)) p0a_phase(fresh(F), KA); }
    SEAM(0);
    if (EN_THIN && IN(1)) thin_phase<0, 0>(fresh(F), KA, 0, 0, 0.f, 0, 0);
    SEAM(1);
    for (int lp = 0; lp < 2; ++lp) {
        const int pb = 2 + 24 * lp, la = 2 * lp, lr = 2 * lp + 1;
        FFN_HALF(pb + 0, la * 2 + 0, 0, la, 0, 0.5f, la, 1);
        for (int rep_ = 0; rep_ < REP_OG; ++rep_) { if (rep_) __syncthreads();
        if (EN_GQKV && IN(pb + 3)) { const Frame Ff = fresh(F); const bf16_t* wq = (const bf16_t*)(ws + WS_WA) + (size_t)lp * (E_QKV + E_SQ);
            pg8::Gemm g{Yb, wq, D}; pg8::StaticOrder S; S.init(M, 3072, Ff.G, Ff.bid); EpiQKVN E{ws, KA->in[12] + lp * 128, KA->in[13] + lp * 128, (LAS float*)(Ff.lds + 132096), attn_score_bound(KA, lp) * attn::SCALE <= 30.0f ? attn::SCALE * 1.4426950408889634f : 1.0f};
            pg8::gemm_phase<EpiQKVN, pg8::StaticOrder, pg8::Gemm, true, GEMM_SP2>(Ff.lds, g, S, E, Ff.wave); } }
        SEAM(pb + 3);
        for (int rep_ = 0; rep_ < REP_ATT; ++rep_) { if (rep_) __syncthreads(); if (EN_ATT && IN(pb + 5)) attention_phase(fresh(F), KA, lp); }
        SEAM(pb + 5);
        for (int rep_ = 0; rep_ < REP_OG; ++rep_) { if (rep_) __syncthreads();
        if (EN_GWO && IN(pb + 6)) { const Frame Ff = fresh(F); const bf16_t* wo = (const bf16_t*)(ws + WS_WA) + (size_t)lp * (E_QKV + E_SQ) + E_QKV;
            pg8::Gemm g{(const bf16_t*)(ws + WS_O), wo, D}; LatentOrder S; S.init_lat(D, Ff.G, Ff.bid); EpiPlain E{OUTb, D};
            pg8::gemm_phase<EpiPlain, LatentOrder, pg8::Gemm, GEMM_ALIGN, GEMM_SP2>(Ff.lds, g, S, E, Ff.wave); } }
        SEAM(pb + 6);
        if (EN_THIN && IN(pb + 7)) { const Frame Ff = fresh(F);
            if (Ff.bid < 32) { const bf16_t* wo = (const bf16_t*)(ws + WS_WA) + (size_t)lp * (E_QKV + E_SQ) + E_QKV;
                pg8::Gemm g{(const bf16_t*)(ws + WS_O), wo, D}; CtxOrder8 S{Ff.bid}; EpiPlain E{OUTb, D};
                pg8::gemm_phase<EpiPlain, CtxOrder8, pg8::Gemm, GEMM_ALIGN, GEMM_SP2>(Ff.lds, g, S, E, Ff.wave);
                { XcdBarrier bg = bar; asm volatile("" : "+s"(bg.bar)); ctx_mixer_thin(fresh(F), KA, bg.bar, 8 + lp, la, 1, 1.0f, la, 2); } }
            else thin_phase<1, 1, 32, 0>(Ff, KA, la, 1, 1.0f, la, 2); }
        SEAM(pb + 7);
        FFN_HALF(pb + 8, la * 2 + 1, 0, la, 2, 0.5f, lr, 0);
        FFN_HALF(pb + 11, lr * 2 + 0, 0, lr, 0, 0.5f, lr, 1);
        for (int rep_ = 0; rep_ < REP_EW; ++rep_) { if (EN_MIX && IN(pb + 14)) mixes_phase(fresh(F), KA, lp); }
        SEAM(pb + 14);
#ifdef DBG_DOUBLE_BAR
        SEAM(pb + 14);
#endif
#define rw1 ((const bf16_t*)(ws + WS_WR) + (size_t)lp * (E_RW1 + E_RW2 + E_SQ))
        for (int rep_ = 0; rep_ < REP_OG; ++rep_) { if (rep_) __syncthreads();
        if (EN_RW1 && IN(pb + 15)) { const Frame Ff = fresh(F); GemmRw1 g{(const bf16_t*)(ws + WS_MIX6), rw1, D}; pg8::StaticOrder S; S.init(M, 6912, Ff.G, Ff.bid);
            EpiRw1 E{ws, KA->in[25] + (size_t)lp * D};
            pg8::gemm_phase<EpiRw1, pg8::StaticOrder, GemmRw1, RW1_ALIGN, RW1_SP2>(Ff.lds, g, S, E, Ff.wave); } }
        SEAM(pb + 15);
        for (int rep_ = 0; rep_ < REP_OG; ++rep_) { if (rep_) __syncthreads();
        if (EN_RW2 && IN(pb + 16)) {
            { const Frame Ff = fresh(F); int k2_ = 256; asm volatile("" : "+s"(k2_));
              GemmRw2 g{ws, rw1 + E_RW1, 256, k2_}; pg8::StaticOrder S; S.init(M, 2048, Ff.G, Ff.bid);
              EpiRw2 E{ws, KA->in[19] + (size_t)lp * 2 * D, KA->in[22] + (size_t)lp * 2 * D, WS_AA};
              pg8::gemm_phase<EpiRw2, pg8::StaticOrder, GemmRw2, RW2_ALIGN, RW2_SP2>(Ff.lds, g, S, E, Ff.wave); }
            __syncthreads();
            { const Frame Ff = fresh(F); int k3_ = 128; asm volatile("" : "+s"(k3_));
              GemmRw2 g{ws, rw1 + E_RW1, 256, k3_}; Rw2WAOrder S; S.init(M, 8192, Ff.G, Ff.G - 1 - Ff.bid);
              EpiRw2 E{ws, KA->in[19] + (size_t)lp * 2 * D, KA->in[22] + (size_t)lp * 2 * D, WS_AA};
              pg8::gemm_phase<EpiRw2, Rw2WAOrder, GemmRw2, RW2_ALIGN, RW2_SP2>(Ff.lds, g, S, E, Ff.wave); } } }
        #ifdef DBG_RW2_TWICE
        __syncthreads();
        if (EN_RW2 && IN(pb + 16)) { const Frame Ff = fresh(F); int k2_ = 256; asm volatile("" : "+s"(k2_));     GemmRw2 g{ws, rw1 + E_RW1, k2_}; pg8::StaticOrder S; S.init(M, 10240, Ff.G, Ff.bid);
            EpiRw2 E{ws,
                     KA->in[19] + (size_t)lp * 2 * D, KA->in[22] + (size_t)lp * 2 * D, WS_END};
            pg8::gemm_phase<EpiRw2, pg8::StaticOrder, GemmRw2, RW2_ALIGN, RW2_SP2>(Ff.lds, g, S, E, Ff.wave); }
#endif
        SEAM(pb + 16);
        for (int rep_ = 0; rep_ < REP_SCAN; ++rep_) { if (rep_) __syncthreads(); if (EN_SCAN && IN(pb + 17)) { XcdBarrier bg = bar; asm volatile("" : "+s"(bg.bar)); scan_phase(fresh(F), KA, lp, lp == 0 && rep_ == 0, bg.bar); } }
        SEAM(pb + 17);
        for (int rep_ = 0; rep_ < REP_OG; ++rep_) { if (rep_) __syncthreads();
        if (EN_GWO && IN(pb + 19)) { const Frame Ff = fresh(F); pg8::Gemm g{(const bf16_t*)(ws + WS_PREP), rw1 + E_RW1 + E_RW2, D}; LatentOrder S; S.init_lat(D, Ff.G, Ff.bid); EpiPlain E{OUTb, D};
            pg8::gemm_phase<EpiPlain, LatentOrder, pg8::Gemm, GEMM_ALIGN, GEMM_SP2>(Ff.lds, g, S, E, Ff.wave); } }
        SEAM(pb + 19);
        if (EN_THIN && IN(pb + 20)) { const Frame Ff = fresh(F);
            if (lp == 1) thin_phase<1, 1, 0>(Ff, KA, lr, 1, 1.0f, lr, 2);
            else if (Ff.bid < 32) { pg8::Gemm g{(const bf16_t*)(ws + WS_PREP), rw1 + E_RW1 + E_RW2, D}; CtxOrder8 S{Ff.bid}; EpiPlain E{OUTb, D};
                pg8::gemm_phase<EpiPlain, CtxOrder8, pg8::Gemm, GEMM_ALIGN, GEMM_SP2>(Ff.lds, g, S, E, Ff.wave);
                { XcdBarrier bg = bar; asm volatile("" : "+s"(bg.bar)); ctx_mixer_thin(fresh(F), KA, bg.bar, 10 + lp, lr, 1, 1.0f, lr, 2); } }
            else thin_phase<1, 1, 32, 0>(Ff, KA, lr, 1, 1.0f, lr, 2); }
        SEAM(pb + 20);
        if (lp == 1) FFN_HALF(pb + 21, lr * 2 + 1, 1, lr, 2, 0.5f, 0, 0); else FFN_HALF(pb + 21, lr * 2 + 1, 0, lr, 2, 0.5f, lr + 1, 0);
    }
    if (DBG_STOP >= 0) { xcd_barrier(bar, fresh(F).wave == 0 && lane_opaque() == 0); copyout_phase(fresh(F), KA); }
#undef IN
#undef SEAM
#undef FFN_HALF
#undef BAR_NOW
#undef rw1
#undef ws
#undef KA
#undef Yb
#undef ACTb
#undef OUTb
}

extern "C" void kernel_launch(void* const* d_in, const int* in_sizes, int n_in, void* d_out, int out_size, void* d_ws, size_t ws_size, hipStream_t stream) {
    static int grid = 0;
    if (grid == 0) {
        if (n_in != 30 || in_sizes[0] != NB * SEQ * D || out_size != NB * SEQ * D || ws_size < WS_END) {
            fprintf(stderr, "kernel_launch: shape mismatch: n_in %d in0 %d out %d ws %zu (need >= %zu)\n", n_in, n_in > 0 ? in_sizes[0] : -1, out_size, ws_size, (size_t)WS_END); grid = -1; return; }
        int dev = 0, cus = 0, per_cu = 0;
        if (hipGetDevice(&dev) != hipSuccess || hipDeviceGetAttribute(&cus, hipDeviceAttributeMultiprocessorCount, dev) != hipSuccess) { fprintf(stderr, "kernel_launch: device query failed\n"); grid = -1; return; }
        if (hipFuncSetAttribute((const void*)fwd_kernel, hipFuncAttributeMaxDynamicSharedMemorySize, LDS_BYTES) != hipSuccess) { fprintf(stderr, "kernel_launch: hipFuncSetAttribute failed\n"); grid = -1; return; }
        if (hipOccupancyMaxActiveBlocksPerMultiprocessor(&per_cu, (const void*)fwd_kernel, NTHR, LDS_BYTES) != hipSuccess || per_cu < 1) { fprintf(stderr, "kernel_launch: occupancy query says %d blocks per CU\n", per_cu); }
        (void)hipGetLastError();
        grid = cus;
        if (grid > 256) grid = 256;
    }
    if (grid < 0) return;
    if (hipMemsetAsync((char*)d_ws + WS_CTL, 0, CTL_ZERO_BYTES, stream) != hipSuccess) { fprintf(stderr, "kernel_launch: memset failed\n"); return; }
    Args a{};
    for (int i = 0; i < 30; ++i) a.in[i] = (const float*)d_in[i];
    a.out = (float*)d_out; a.ws = (unsigned char*)d_ws;
    a.ph_lo = 0; a.ph_hi = NPHASE; a.li = 0; a.dbg = 0;
    hipLaunchKernelGGL(fwd_kernel, dim3(grid), dim3(NTHR), LDS_BYTES, stream, a);
    const hipError_t le = hipPeekAtLastError();
    if (le != hipSuccess) fprintf(stderr, "kernel_launch: launch failed: %s\n", hipGetErrorName(le));
}
```
